# Optimizing an MI355X kernel written in HIP

```python
import math
import jax
import jax.numpy as jnp
from jax import lax
import numpy as np

D_MODEL = 1024
BATCH = 8
SEQ = 4096
DEPTH = 1

HEAD_DIM = 64
DIL_GROUPS = ((128, 1), (512, 4), (2048, 16))
N_DIL_GROUPS = 3
DIL_HEADS = 4
MOBA_HEADS = 8
MOBA_BLOCK = 256
MOBA_TOPK = 3
MOBA_Q_CHUNK = 16
N_SELF_HEADS = N_DIL_GROUPS * DIL_HEADS + MOBA_HEADS
REL_BUCKETS = 32
REL_MAX_DIST = 2048
N_MEM = 256
CROSS_HEADS = 4
CROSS_HEAD_DIM = 128
PEER_HEADS = 8
PEER_N_KEYS = 128
PEER_N_EXPERTS = PEER_N_KEYS * PEER_N_KEYS
PEER_KEY_DIM = 256
PEER_TOPK = 16
PEER_TOKEN_CHUNK = 128
RMS_EPS = 1e-6
NEG_INF = -1e30
DIL_WIDTH = N_DIL_GROUPS * 3 * DIL_HEADS * HEAD_DIM
MOBA_WIDTH = 3 * MOBA_HEADS * HEAD_DIM
GATE_WIDTH = 2 * D_MODEL
IN_COLS = DIL_WIDTH + MOBA_WIDTH + GATE_WIDTH

kernel_name = 'hybrid_dilated_moba_peer_layer'


def rmsnorm(x, g):
    xf = x.astype(jnp.float32)
    y = xf * lax.rsqrt(jnp.mean(xf * xf, axis=-1, keepdims=True) + RMS_EPS)
    return (y * g.astype(jnp.float32)).astype(x.dtype)


def t5_bucket(n):
    max_exact = REL_BUCKETS // 2
    nf = jnp.maximum(n, 1).astype(jnp.float32)
    large = max_exact + (jnp.log(nf / max_exact) / math.log(REL_MAX_DIST / max_exact)
                         * (REL_BUCKETS - max_exact)).astype(jnp.int32)
    large = jnp.minimum(large, REL_BUCKETS - 1)
    return jnp.where(n < max_exact, n, large)


def dilated_group(q, k, v, window, dilation, bias_tab):
    B, S, H, hd = q.shape
    d = dilation
    blk = window // d
    L = S // d
    nb = -(-L // blk)
    Lp = nb * blk

    def to_sub(t):
        return t.reshape(B, L, d, H, hd).transpose(0, 2, 3, 1, 4)

    qs = jnp.pad(to_sub(q), ((0, 0), (0, 0), (0, 0), (0, Lp - L), (0, 0))).reshape(B, d, H, nb, blk, hd)

    def windows(t):
        tp = jnp.pad(to_sub(t), ((0, 0), (0, 0), (0, 0), (blk, Lp - L), (0, 0))).reshape(B, d, H, nb + 1, blk, hd)
        return jnp.concatenate([tp[:, :, :, :-1], tp[:, :, :, 1:]], axis=-2)

    kw = windows(k)
    vw = windows(v)
    logits = jnp.einsum('bdhnqc,bdhnkc->bdhnqk', qs, kw).astype(jnp.float32) * (hd ** -0.5)
    rel = (blk + jnp.arange(blk))[:, None] - jnp.arange(2 * blk)[None, :]
    in_window = (rel >= 0) & (rel <= blk)
    key_sub = (jnp.arange(nb)[:, None] - 1) * blk + jnp.arange(2 * blk)[None, :]
    mask = in_window[None] & (key_sub >= 0)[:, None, :]
    bias = bias_tab[t5_bucket(jnp.clip(rel, 0) * d)].transpose(2, 0, 1).astype(jnp.float32)
    logits = jnp.where(mask, logits + bias[:, None], NEG_INF)
    lse = jax.nn.logsumexp(logits, axis=-1)
    p = jnp.exp(logits - lse[..., None])
    out = jnp.einsum('bdhnqk,bdhnkc->bdhnqc', p, vw.astype(jnp.float32))
    out = out.reshape(B, d, H, Lp, hd)[:, :, :, :L].transpose(0, 3, 1, 2, 4).reshape(B, S, H, hd)
    lse = lse.reshape(B, d, H, Lp)[:, :, :, :L].transpose(0, 3, 1, 2).reshape(B, S, H)
    return out, lse


def moba(q, k, v, bias_tab):
    B, S, H, hd = q.shape
    blk = MOBA_BLOCK
    nblk = -(-S // blk)
    Sp = nblk * blk
    scale = hd ** -0.5

    def prep(t):
        return jnp.pad(t, ((0, 0), (0, Sp - S), (0, 0), (0, 0))).transpose(0, 2, 1, 3)

    qt, kt, vt = prep(q), prep(k), prep(v)
    qb = qt.reshape(B, H, nblk, blk, hd)
    kb = kt.reshape(B, H, nblk, blk, hd)
    vb = vt.reshape(B, H, nblk, blk, hd)
    table_t = bias_tab.T.astype(jnp.float32)

    rel = jnp.arange(blk)[:, None] - jnp.arange(blk)[None, :]
    own_bias = bias_tab[t5_bucket(jnp.clip(rel, 0))].transpose(2, 0, 1).astype(jnp.float32)
    lo = jnp.einsum('bhnqc,bhnkc->bhnqk', qb, kb).astype(jnp.float32) * scale
    lo = jnp.where(rel >= 0, lo + own_bias[:, None], NEG_INF)
    m_own = jnp.max(lo, axis=-1)
    p_own = jnp.exp(lo - m_own[..., None])
    s_own = jnp.sum(p_own, axis=-1).reshape(B, H, Sp)
    acc_own = jnp.einsum('bhnqk,bhnkc->bhnqc', p_own, vb.astype(jnp.float32)).reshape(B, H, Sp, hd)
    m_own = m_own.reshape(B, H, Sp)

    kmean = jnp.mean(kb.astype(jnp.float32), axis=-2)
    gs = jnp.einsum('bhsc,bhnc->bhsn', qt.astype(jnp.float32), kmean)
    q_blk = jnp.arange(Sp) // blk
    gs = jnp.where(jnp.arange(nblk)[None, :] < q_blk[:, None], gs, NEG_INF)
    topk = min(MOBA_TOPK, nblk)
    _, sel = lax.top_k(gs, topk)
    sel_ok = jnp.arange(topk)[None, :] < q_blk[:, None]

    qc_n = MOBA_Q_CHUNK
    nc = Sp // qc_n
    xs = (qt.reshape(B, H, nc, qc_n, hd).transpose(2, 0, 1, 3, 4),
          sel.reshape(B, H, nc, qc_n, topk).transpose(2, 0, 1, 3, 4),
          sel_ok.reshape(nc, qc_n, topk),
          jnp.arange(Sp).reshape(nc, qc_n))
    b_i = jnp.arange(B)[:, None, None, None]
    h_i = jnp.arange(H)[None, :, None, None]

    def past_blocks(args):
        qc, ic, okc, pos = args
        kg = kb[b_i, h_i, ic]
        vg = vb[b_i, h_i, ic]
        lg = jnp.einsum('bhqc,bhqnjc->bhqnj', qc, kg).astype(jnp.float32) * scale
        dist = pos[None, None, :, None, None] - (ic[..., None] * blk + jnp.arange(blk))
        lg = jnp.where(okc[None, None, :, :, None], lg + table_t[h_i[..., None], t5_bucket(dist)], NEG_INF)
        lg = lg.reshape(B, H, qc_n, topk * blk)
        m = jnp.max(lg, axis=-1)
        p = jnp.exp(lg - m[..., None])
        s = jnp.sum(p, axis=-1)
        acc = jnp.einsum('bhqk,bhqkc->bhqc', p, vg.reshape(B, H, qc_n, topk * blk, hd).astype(jnp.float32))
        return acc, s, m

    acc_p, s_p, m_p = lax.map(past_blocks, xs)
    acc_p = acc_p.transpose(1, 2, 0, 3, 4).reshape(B, H, Sp, hd)
    s_p = s_p.transpose(1, 2, 0, 3).reshape(B, H, Sp)
    m_p = m_p.transpose(1, 2, 0, 3).reshape(B, H, Sp)

    m = jnp.maximum(m_own, m_p)
    a_o = jnp.exp(m_own - m)
    a_p = jnp.exp(m_p - m)
    out = (acc_own * a_o[..., None] + acc_p * a_p[..., None]) / (s_own * a_o + s_p * a_p)[..., None]
    return out[:, :, :S].transpose(0, 2, 1, 3).reshape(B, S, H * hd)


def cross_attention(h, m, w_q, w_kv, w_o):
    B, S, _ = h.shape
    M = m.shape[1]
    q = (h @ w_q).reshape(B, S, CROSS_HEADS, CROSS_HEAD_DIM)
    kv = (m @ w_kv).reshape(B, M, 2, CROSS_HEADS, CROSS_HEAD_DIM)
    lg = jnp.einsum('bshc,bmhc->bhsm', q, kv[:, :, 0]).astype(jnp.float32) * (CROSS_HEAD_DIM ** -0.5)
    p = jax.nn.softmax(lg, axis=-1)
    o = jnp.einsum('bhsm,bmhc->bshc', p, kv[:, :, 1].astype(jnp.float32)).reshape(B, S, CROSS_HEADS * CROSS_HEAD_DIM)
    return o.astype(h.dtype) @ w_o


def peer(h, w_q, sub_keys, u, v):
    B, S, D = h.shape
    T = B * S
    hf = h.reshape(T, D)
    q = (hf @ w_q).reshape(T, PEER_HEADS, 2, PEER_KEY_DIM // 2)
    sc = jnp.einsum('thpc,pkc->thpk', q, sub_keys).astype(jnp.float32)
    v1, i1 = lax.top_k(sc, PEER_TOPK)
    cand = (v1[:, :, 0, :, None] + v1[:, :, 1, None, :]).reshape(T, PEER_HEADS, PEER_TOPK * PEER_TOPK)
    cidx = (i1[:, :, 0, :, None] * PEER_N_KEYS + i1[:, :, 1, None, :]).reshape(T, PEER_HEADS, PEER_TOPK * PEER_TOPK)
    top, pos = lax.top_k(cand, PEER_TOPK)
    experts = jnp.take_along_axis(cidx, pos, axis=-1).reshape(T, PEER_HEADS * PEER_TOPK)
    gates = jax.nn.softmax(top, axis=-1).reshape(T, PEER_HEADS * PEER_TOPK)
    C = PEER_TOKEN_CHUNK
    nc = T // C

    def token_block(args):
        xc, ec, gc = args
        a = jax.nn.gelu(jnp.einsum('cd,ced->ce', xc, u[ec]).astype(jnp.float32), approximate=False)
        return jnp.einsum('ce,ced->cd', gc * a, v[ec].astype(jnp.float32))

    y = lax.map(token_block, (hf.reshape(nc, C, D), experts.reshape(nc, C, -1), gates.reshape(nc, C, -1)))
    return y.reshape(B, S, D).astype(h.dtype)


def setup_inputs(seed: int = 0) -> dict:
    key = jax.random.key(seed)
    ks = jax.random.split(key, 20)
    f32 = jnp.float32
    D = D_MODEL

    def nrm(k, shape, scale):
        return jax.random.normal(k, shape, f32) * scale

    def gain(k, shape):
        return 1.0 + 0.05 * jax.random.normal(k, shape, f32)

    wa = DIL_HEADS * HEAD_DIM
    wb = MOBA_HEADS * HEAD_DIM
    wc = CROSS_HEADS * CROSS_HEAD_DIM
    return {
        'x': nrm(ks[0], (BATCH, SEQ, D), 1.0),
        'mem': nrm(ks[1], (BATCH, N_MEM, D), 1.0),
        'rel_bias': nrm(ks[2], (REL_BUCKETS, N_SELF_HEADS), 0.5),
        'g_mix': gain(ks[3], (DEPTH, D)),
        'w_in': nrm(ks[4], (DEPTH, D, IN_COLS), D ** -0.5),
        'b_gate': nrm(ks[5], (DEPTH, GATE_WIDTH), 0.02),
        'w_branch_a': nrm(ks[6], (DEPTH, wa, D), wa ** -0.5),
        'w_branch_b': nrm(ks[7], (DEPTH, wb, D), wb ** -0.5),
        'w_out': nrm(ks[8], (DEPTH, D, D), D ** -0.5),
        'g_cross': gain(ks[9], (DEPTH, D)),
        'g_mem': gain(ks[10], (DEPTH, D)),
        'w_q_cross': nrm(ks[11], (DEPTH, D, wc), D ** -0.5),
        'w_kv_cross': nrm(ks[12], (DEPTH, D, 2 * wc), D ** -0.5),
        'w_o_cross': nrm(ks[13], (DEPTH, wc, D), wc ** -0.5),
        'g_ffn': gain(ks[14], (DEPTH, D)),
        'w_q_peer': nrm(ks[15], (DEPTH, D, PEER_HEADS * PEER_KEY_DIM), D ** -0.5),
        'peer_sub_keys': nrm(ks[16], (DEPTH, 2, PEER_N_KEYS, PEER_KEY_DIM // 2), (PEER_KEY_DIM // 2) ** -0.5),
        'peer_u': nrm(ks[17], (DEPTH, PEER_N_EXPERTS, D), D ** -0.5),
        'peer_v': nrm(ks[18], (DEPTH, PEER_N_EXPERTS, D), 0.5),
        'g_final': gain(ks[19], (D,)),
    }


def reference(x, mem, rel_bias, g_mix, w_in, b_gate, w_branch_a, w_branch_b, w_out,
              g_cross, g_mem, w_q_cross, w_kv_cross, w_o_cross,
              g_ffn, w_q_peer, peer_sub_keys, peer_u, peer_v, g_final):
    B, S, D = x.shape
    for l in range(DEPTH):
        h = rmsnorm(x, g_mix[l])
        proj = h @ w_in[l]
        p_dil = proj[..., :DIL_WIDTH].reshape(B, S, N_DIL_GROUPS, 3, DIL_HEADS, HEAD_DIM)
        p_moba = proj[..., DIL_WIDTH:DIL_WIDTH + MOBA_WIDTH].reshape(B, S, 3, MOBA_HEADS, HEAD_DIM)
        p_gate = proj[..., DIL_WIDTH + MOBA_WIDTH:] + b_gate[l]
        outs = []
        lses = []
        for gi, (win, dil) in enumerate(DIL_GROUPS):
            o, s = dilated_group(p_dil[:, :, gi, 0], p_dil[:, :, gi, 1], p_dil[:, :, gi, 2], win, dil,
                                 rel_bias[:, gi * DIL_HEADS:(gi + 1) * DIL_HEADS])
            outs.append(o)
            lses.append(s)
        wgt = jax.nn.softmax(jnp.stack(lses, axis=0), axis=0)
        o_dil = jnp.sum(wgt[..., None] * jnp.stack(outs, axis=0), axis=0).reshape(B, S, DIL_HEADS * HEAD_DIM).astype(x.dtype)
        o_moba = moba(p_moba[:, :, 0], p_moba[:, :, 1], p_moba[:, :, 2],
                      rel_bias[:, N_DIL_GROUPS * DIL_HEADS:]).astype(x.dtype)
        gates = jax.nn.sigmoid(p_gate.astype(jnp.float32)).astype(x.dtype).reshape(B, S, 2, D)
        merged = gates[:, :, 0] * (o_dil @ w_branch_a[l]) + gates[:, :, 1] * (o_moba @ w_branch_b[l])
        x = x + merged @ w_out[l]
        x = x + cross_attention(rmsnorm(x, g_cross[l]), rmsnorm(mem, g_mem[l]),
                                w_q_cross[l], w_kv_cross[l], w_o_cross[l])
        x = x + peer(rmsnorm(x, g_ffn[l]), w_q_peer[l], peer_sub_keys[l], peer_u[l], peer_v[l])
    return rmsnorm(x, g_final)
```

```cpp
#include <hip/hip_runtime.h>
#include <cstdio>
#include <cstdint>
#include <cmath>
namespace pg8 {
#define PG8_LAS __attribute__((address_space(3)))
typedef unsigned short bf16_t;
typedef short bf16x8 __attribute__((ext_vector_type(8)));
typedef float f32x4 __attribute__((ext_vector_type(4)));
typedef unsigned u32x4 __attribute__((ext_vector_type(4)));
constexpr int BM = 256, BK = 64, HALF = 128, HTB = HALF * BK * 2  , STAGE_BYTES = 8 * HTB, NXCD = 8, WGM = 8;

__host__ __device__ __forceinline__ int lds_byte(int r, int c) { const int st = (r >> 4) * 2 + (c >> 5), rr = r & 15, cc = c & 31, ob = rr * 64 + cc * 2; return st * 1024 + (ob ^ (((ob >> 9) & 1) << 5)); }
__host__ __device__ __forceinline__ void stage_rc(int b, int& R, int& C) { const int st = b / 1024, sb = b % 1024, swz = sb ^ (((sb >> 9) & 1) << 5); R = (st >> 1) * 16 + swz / 64; C = (st & 1) * 32 + (swz % 64) / 2; }
__host__ __device__ __forceinline__ int perm32(int rho) { const int n = rho >> 4, i = rho & 15; return 8 * (i >> 2) + 4 * n + (i & 3); }

struct Unit { int pm, pn; };
struct Gemm { const bf16_t* A; const bf16_t* Bt; int M, N, K; };

struct StaticOrder {
    int nM, nN, nwg, G, c;
    __host__ __device__ void init(int M, int N, int G_, int c_) { nM = M / BM; nN = N / BM; nwg = nM * nN; G = G_; c = c_; }
    __host__ __device__ bool next(int i, Unit& u) const {
        const long L = (long)i * G + c; if (L >= nwg) return false;
        int wgid = (int)L; { const int q = nwg / NXCD, r = nwg % NXCD, xcd = wgid % NXCD, off = wgid / NXCD; wgid = (xcd < r ? xcd * (q + 1) : r * (q + 1) + (xcd - r) * q) + off; }
        const int nig = WGM * nN, gid = wgid / nig, fm = gid * WGM, gsz = (nM - fm) < WGM ? (nM - fm) : WGM;
        u.pm = fm + ((wgid % nig) % gsz); u.pn = (wgid % nig) / gsz; return true;
    }
    __device__ __forceinline__ void a_ready(const Unit&) const {}
    __device__ __forceinline__ void done(const Unit&) const {}
};

__device__ __forceinline__ unsigned cvt_pk_bf16(float lo, float hi) { unsigned r; asm volatile("v_cvt_pk_bf16_f32 %0, %1, %2" : "=v"(r) : "v"(lo), "v"(hi)); return r; }
typedef float f32x2 __attribute__((ext_vector_type(2)));
__device__ __forceinline__ float bf_lo(unsigned w) { return __uint_as_float(w << 16); }
__device__ __forceinline__ float bf_hi(unsigned w) { return __uint_as_float(w & 0xffff0000u); }
__device__ __forceinline__ float sigmoidf_(float x) { return 1.0f / (1.0f + __expf(-x)); }
struct EpiStore {
    static constexpr bool PERM = true, AFTER_DRAIN = false;
    bf16_t* O; int ldc;
    __device__ __forceinline__ void operator()(const f32x4 (&acc)[2][2][4][2], const Unit& u, int wr, int wc, int fr, int fq) const {
        const int row0 = u.pm * BM + wr * 64 + fr, col0 = u.pn * BM + wc * 32 + 8 * fq;
#pragma unroll
        for (int ai = 0; ai < 2; ++ai)
#pragma unroll
            for (int m = 0; m < 4; ++m) { bf16_t* rowp = O + (size_t)(row0 + ai * HALF + m * 16) * ldc + col0;
#pragma unroll
                for (int bj = 0; bj < 2; ++bj) { const f32x4 v0 = acc[ai][bj][m][0], v1 = acc[ai][bj][m][1];
                    u32x4 w; w.x = cvt_pk_bf16(v0[0], v0[1]); w.y = cvt_pk_bf16(v0[2], v0[3]); w.z = cvt_pk_bf16(v1[0], v1[1]); w.w = cvt_pk_bf16(v1[2], v1[3]);
                    *(u32x4*)(rowp + bj * HALF) = w; } }
    }
};
struct EpiIn {
    static constexpr bool PERM = true, AFTER_DRAIN = false;
    bf16_t* P; bf16_t* G; const float* bgate;
    __device__ __forceinline__ void operator()(const f32x4 (&acc)[2][2][4][2], const Unit& u, int wr, int wc, int fr, int fq) const {
        const int row0 = u.pm * BM + wr * 64 + fr;
        if (u.pn < 15) {
            const int col0 = u.pn * BM + wc * 32 + 8 * fq;
#pragma unroll
            for (int ai = 0; ai < 2; ++ai)
#pragma unroll
                for (int m = 0; m < 4; ++m) { bf16_t* rowp = P + (size_t)(row0 + ai * HALF + m * 16) * 3840 + col0;
#pragma unroll
                    for (int bj = 0; bj < 2; ++bj) { const f32x4 v0 = acc[ai][bj][m][0], v1 = acc[ai][bj][m][1];
                        u32x4 w; w.x = cvt_pk_bf16(v0[0], v0[1]); w.y = cvt_pk_bf16(v0[2], v0[3]); w.z = cvt_pk_bf16(v1[0], v1[1]); w.w = cvt_pk_bf16(v1[2], v1[3]);
                        *(u32x4*)(rowp + bj * HALF) = w; } }
        } else {
            const int col0 = (u.pn - 15) * BM + wc * 32 + 8 * fq;
            f32x4 bv[2][2];
#pragma unroll
            for (int bj = 0; bj < 2; ++bj)
#pragma unroll
                for (int n = 0; n < 2; ++n) bv[bj][n] = *(const f32x4*)(bgate + col0 + bj * HALF + 4 * n);
#pragma unroll
            for (int ai = 0; ai < 2; ++ai)
#pragma unroll
                for (int m = 0; m < 4; ++m) { bf16_t* rowp = G + (size_t)(row0 + ai * HALF + m * 16) * 2048 + col0;
#pragma unroll
                    for (int bj = 0; bj < 2; ++bj) { const f32x4 v0 = acc[ai][bj][m][0] + bv[bj][0], v1 = acc[ai][bj][m][1] + bv[bj][1];
                        u32x4 w; w.x = cvt_pk_bf16(sigmoidf_(v0[0]), sigmoidf_(v0[1])); w.y = cvt_pk_bf16(sigmoidf_(v0[2]), sigmoidf_(v0[3]));
                        w.z = cvt_pk_bf16(sigmoidf_(v1[0]), sigmoidf_(v1[1])); w.w = cvt_pk_bf16(sigmoidf_(v1[2]), sigmoidf_(v1[3]));
                        *(u32x4*)(rowp + bj * HALF) = w; } }
        }
    }
};
template <bool ADD> struct EpiGate {
    static constexpr bool PERM = true, AFTER_DRAIN = false;
    bf16_t* O; const bf16_t* G; int gcol;
    __device__ __forceinline__ void operator()(const f32x4 (&acc)[2][2][4][2], const Unit& u, int wr, int wc, int fr, int fq) const {
        const int row0 = u.pm * BM + wr * 64 + fr, col0 = u.pn * BM + wc * 32 + 8 * fq;
#pragma unroll
        for (int ai = 0; ai < 2; ++ai)
#pragma unroll
            for (int m = 0; m < 4; ++m) { const size_t row = (size_t)(row0 + ai * HALF + m * 16); bf16_t* rowp = O + row * 1024 + col0; const bf16_t* gp = G + row * 2048 + gcol + col0;
#pragma unroll
                for (int bj = 0; bj < 2; ++bj) { const f32x4 v0 = acc[ai][bj][m][0], v1 = acc[ai][bj][m][1];
                    const u32x4 g = *(const u32x4*)(gp + bj * HALF);
                    float r0 = bf_lo(g.x) * v0[0], r1 = bf_hi(g.x) * v0[1], r2 = bf_lo(g.y) * v0[2], r3 = bf_hi(g.y) * v0[3];
                    float r4 = bf_lo(g.z) * v1[0], r5 = bf_hi(g.z) * v1[1], r6 = bf_lo(g.w) * v1[2], r7 = bf_hi(g.w) * v1[3];
                    if (ADD) { const u32x4 p = *(const u32x4*)(rowp + bj * HALF);
                        r0 += bf_lo(p.x); r1 += bf_hi(p.x); r2 += bf_lo(p.y); r3 += bf_hi(p.y); r4 += bf_lo(p.z); r5 += bf_hi(p.z); r6 += bf_lo(p.w); r7 += bf_hi(p.w); }
                    u32x4 w; w.x = cvt_pk_bf16(r0, r1); w.y = cvt_pk_bf16(r2, r3); w.z = cvt_pk_bf16(r4, r5); w.w = cvt_pk_bf16(r6, r7);
                    *(u32x4*)(rowp + bj * HALF) = w; } }
    }
};
struct EpiRes {
    static constexpr bool PERM = false, AFTER_DRAIN = false;
    const float* base; float* out; int ldc; float sc;
    __device__ __forceinline__ void operator()(const f32x4 (&acc)[2][2][4][2], const Unit& u, int wr, int wc, int fr, int fq) const {
        const int col0 = u.pn * BM + wc * 32 + 4 * fq;
#pragma unroll
        for (int ai = 0; ai < 2; ++ai)
#pragma unroll
            for (int m = 0; m < 4; ++m) { const size_t off = (size_t)(u.pm * BM + ai * HALF + wr * 64 + m * 16 + fr) * ldc + col0;
#pragma unroll
                for (int bj = 0; bj < 2; ++bj)
#pragma unroll
                    for (int n = 0; n < 2; ++n) { const f32x4 bs = *(const f32x4*)(base + off + bj * HALF + n * 16); *(f32x4*)(out + off + bj * HALF + n * 16) = (sc != 0.f) ? bs + acc[ai][bj][m][n] * sc : bs; } }
    }
};
template <class Epi, class Sched, bool ALIGN_EPI = false, bool SP2 = false>
__device__ __forceinline__ void gemm_phase(PG8_LAS unsigned char* lds, const Gemm g, const Sched& S, const Epi& E) {
    const int tid = threadIdx.x, wid = __builtin_amdgcn_readfirstlane(tid >> 6), lane = tid & 63, wr = wid >> 2, wc = wid & 3, fr = lane & 15, fq = lane >> 4;
    const int K = g.K, nt = K / BK;
    unsigned voffA[2], voffB[2];
#pragma unroll
    for (int i = 0; i < 2; ++i) { int R, C; stage_rc(tid * 16 + i * 8192, R, C); const int Rb = Epi::PERM ? ((R & ~31) + perm32(R & 31)) : R;
        voffA[i] = (unsigned)(R * K + C) * 2u; voffB[i] = (unsigned)(Rb * K + C) * 2u; }
    const size_t kstep = (size_t)(BK * 2);
    const size_t hstep = (size_t)HALF * K * 2;
    const size_t tstep = 2 * hstep;
    const unsigned ldsw = (unsigned)wid * 1024u;
    const int aoff = lds_byte(wr * 64 + fr, fq * 8), boff = lds_byte(wc * 32 + fr, fq * 8);
#define PG8_SA(b, h) (((b) * 2 + (h)) * HTB)
#define PG8_SB(b, h) ((4 + (b) * 2 + (h)) * HTB)
#define PG8_STAGE(bufoff, gbase, voff) do { _Pragma("unroll") for (int _i = 0; _i < 2; ++_i) \
        __builtin_amdgcn_global_load_lds((const unsigned*)((const char*)(gbase) + (voff)[_i]), (PG8_LAS unsigned*)(lds + (bufoff) + ldsw + _i * 8192), 16, 0, 0); } while (0)
#define PG8_LDA(dst, b, h) do { _Pragma("unroll") for (int m = 0; m < 4; ++m) _Pragma("unroll") for (int k = 0; k < 2; ++k) dst[m][k] = *(const PG8_LAS bf16x8*)(lds + PG8_SA(b, h) + aoff + m * 2048 + k * 1024); } while (0)
#define PG8_LDB(dst, b, h) do { _Pragma("unroll") for (int n = 0; n < 2; ++n) _Pragma("unroll") for (int k = 0; k < 2; ++k) dst[n][k] = *(const PG8_LAS bf16x8*)(lds + PG8_SB(b, h) + boff + n * 2048 + k * 1024); } while (0)
#define PG8_MMA(ai, bj, At, Bt) do { __builtin_amdgcn_s_setprio(1); _Pragma("unroll") for (int m = 0; m < 4; ++m) _Pragma("unroll") for (int n = 0; n < 2; ++n) _Pragma("unroll") for (int k = 0; k < 2; ++k) \
        acc[ai][bj][m][n] = __builtin_amdgcn_mfma_f32_16x16x32_bf16(Bt[n][k], At[m][k], acc[ai][bj][m][n], 0, 0, 0); __builtin_amdgcn_s_setprio(0); } while (0)
#define PG8_WAIT_V(n) asm volatile("s_waitcnt vmcnt(" #n ")" ::: "memory")
#define PG8_WAIT_L(n) asm volatile("s_waitcnt lgkmcnt(" #n ")" ::: "memory")
#define PG8_BAR __builtin_amdgcn_s_barrier()
#define PG8_SCHED __builtin_amdgcn_sched_barrier(0)
    Unit cur, nxt; int ui = 0;
    if (!S.next(0, cur)) return;
    f32x4 acc[2][2][4][2];
#pragma unroll
    for (int a = 0; a < 2; ++a)
#pragma unroll
        for (int b = 0; b < 2; ++b)
#pragma unroll
            for (int m = 0; m < 4; ++m)
#pragma unroll
                for (int n = 0; n < 2; ++n) acc[a][b][m][n] = (f32x4){0.f, 0.f, 0.f, 0.f};
    bf16x8 At[4][2], B0[2][2], B1[2][2];
    const char* cA = (const char*)g.A + (size_t)cur.pm * tstep; const char* cB = (const char*)g.Bt + (size_t)cur.pn * tstep;
    S.a_ready(cur);
    if constexpr (SP2) {
        PG8_STAGE(PG8_SB(0, 0), cB, voffB); PG8_STAGE(PG8_SB(0, 1), cB + hstep, voffB); PG8_STAGE(PG8_SA(0, 0), cA, voffA); PG8_STAGE(PG8_SA(0, 1), cA + hstep, voffA);
        if (wr == 1) PG8_BAR;
        PG8_WAIT_V(2); PG8_BAR;
        PG8_STAGE(PG8_SB(1, 0), cB + kstep, voffB); PG8_STAGE(PG8_SA(1, 0), cA + kstep, voffA); PG8_STAGE(PG8_SB(1, 1), cB + hstep + kstep, voffB);
        PG8_WAIT_V(6); PG8_BAR;
    } else {
        PG8_STAGE(PG8_SB(0, 0), cB, voffB); PG8_STAGE(PG8_SA(0, 0), cA, voffA); PG8_STAGE(PG8_SB(0, 1), cB + hstep, voffB); PG8_STAGE(PG8_SA(0, 1), cA + hstep, voffA);
        if (wr == 1) PG8_BAR;
        PG8_WAIT_V(4); PG8_BAR;
        PG8_STAGE(PG8_SB(1, 0), cB + kstep, voffB); PG8_STAGE(PG8_SA(1, 0), cA + kstep, voffA); PG8_STAGE(PG8_SB(1, 1), cB + hstep + kstep, voffB);
        PG8_WAIT_V(6); PG8_BAR;
    }
    for (;;) {
        const bool has_next = S.next(ui + 1, nxt);
        const char* nA = has_next ? (const char*)g.A + (size_t)nxt.pm * tstep : cA; const char* nB = has_next ? (const char*)g.Bt + (size_t)nxt.pn * tstep : cB;
        for (int t = 0; t < nt; t += 2) {
            const bool last = (t == nt - 2);
            const char* a1 = cA + (size_t)(t + 1) * kstep;
            const char* a2 = last ? nA : cA + (size_t)(t + 2) * kstep; const char* b2 = last ? nB : cB + (size_t)(t + 2) * kstep;
            const char* a3 = a2 + kstep; const char* b3 = b2 + kstep;
            if (last && has_next) S.a_ready(nxt);
            if constexpr (SP2) {
            PG8_LDB(B0, 0, 0); PG8_LDB(B1, 0, 1); PG8_SCHED; PG8_LDA(At, 0, 0); PG8_STAGE(PG8_SA(1, 1), a1 + hstep, voffA);
            PG8_WAIT_V(8); PG8_WAIT_L(0); PG8_BAR; PG8_MMA(0, 0, At, B0); PG8_MMA(0, 1, At, B1); PG8_BAR; PG8_SCHED;
            PG8_LDA(At, 0, 1); PG8_STAGE(PG8_SB(0, 0), b2, voffB); PG8_STAGE(PG8_SB(0, 1), b2 + hstep, voffB); PG8_STAGE(PG8_SA(0, 0), a2, voffA);
            PG8_WAIT_V(8); PG8_WAIT_L(0); PG8_BAR; PG8_MMA(1, 0, At, B0); PG8_MMA(1, 1, At, B1); PG8_BAR; PG8_SCHED;
            PG8_LDB(B0, 1, 0); PG8_LDB(B1, 1, 1); PG8_SCHED; PG8_LDA(At, 1, 0); PG8_STAGE(PG8_SA(0, 1), a2 + hstep, voffA);
            PG8_WAIT_V(8); PG8_WAIT_L(0); PG8_BAR; PG8_MMA(0, 0, At, B0); PG8_MMA(0, 1, At, B1); PG8_BAR; PG8_SCHED;
            PG8_LDA(At, 1, 1); PG8_STAGE(PG8_SB(1, 0), b3, voffB); PG8_STAGE(PG8_SB(1, 1), b3 + hstep, voffB); PG8_STAGE(PG8_SA(1, 0), a3, voffA);
            PG8_WAIT_V(8); PG8_WAIT_L(0); PG8_BAR; PG8_MMA(1, 0, At, B0); PG8_MMA(1, 1, At, B1); PG8_BAR; PG8_SCHED;
            } else {
            PG8_LDB(B0, 0, 0); PG8_SCHED; PG8_LDA(At, 0, 0); PG8_STAGE(PG8_SA(1, 1), a1 + hstep, voffA);
            PG8_WAIT_L(8); PG8_BAR; PG8_WAIT_L(0); PG8_MMA(0, 0, At, B0); PG8_BAR; PG8_SCHED;
            PG8_LDB(B1, 0, 1); PG8_STAGE(PG8_SB(0, 0), b2, voffB);
            PG8_BAR; PG8_WAIT_L(0); PG8_MMA(0, 1, At, B1); PG8_BAR;
            PG8_LDA(At, 0, 1); PG8_STAGE(PG8_SA(0, 0), a2, voffA);
            PG8_BAR; PG8_WAIT_L(0); PG8_MMA(1, 0, At, B0); PG8_BAR; PG8_SCHED;
            PG8_STAGE(PG8_SB(0, 1), b2 + hstep, voffB);
            PG8_WAIT_V(6); PG8_BAR; PG8_MMA(1, 1, At, B1); PG8_BAR;
            PG8_LDB(B0, 1, 0); PG8_SCHED; PG8_LDA(At, 1, 0); PG8_STAGE(PG8_SA(0, 1), a2 + hstep, voffA);
            PG8_WAIT_L(8); PG8_BAR; PG8_WAIT_L(0); PG8_MMA(0, 0, At, B0); PG8_BAR; PG8_SCHED;
            PG8_LDB(B1, 1, 1); PG8_STAGE(PG8_SB(1, 0), b3, voffB);
            PG8_BAR; PG8_WAIT_L(0); PG8_MMA(0, 1, At, B1); PG8_BAR;
            PG8_LDA(At, 1, 1); PG8_STAGE(PG8_SA(1, 0), a3, voffA);
            PG8_BAR; PG8_WAIT_L(0); PG8_MMA(1, 0, At, B0); PG8_BAR; PG8_SCHED;
            PG8_STAGE(PG8_SB(1, 1), b3 + hstep, voffB);
            PG8_WAIT_V(6); PG8_BAR; PG8_MMA(1, 1, At, B1); PG8_BAR;
            }
        }
        if constexpr (ALIGN_EPI) { if (wr == 0) PG8_BAR; }
        if constexpr (!Epi::AFTER_DRAIN) { E(acc, cur, wr, wc, fr, fq); S.done(cur); }
        if (!has_next) break;
#pragma unroll
        for (int a = 0; a < 2; ++a)
#pragma unroll
            for (int b = 0; b < 2; ++b)
#pragma unroll
                for (int m = 0; m < 4; ++m)
#pragma unroll
                    for (int n = 0; n < 2; ++n) acc[a][b][m][n] = (f32x4){0.f, 0.f, 0.f, 0.f};
        cur = nxt; cA = nA; cB = nB; ++ui;
        if constexpr (ALIGN_EPI) { if (wr == 1) PG8_BAR; }
    }
    PG8_WAIT_V(0);
    if constexpr (!ALIGN_EPI) { if (wr == 0) PG8_BAR; }
    PG8_BAR;
    if constexpr (Epi::AFTER_DRAIN) { E.fused(acc, cur, wr, wc, fr, fq, lds, wid, lane); S.done(cur); }
#undef PG8_SA
#undef PG8_SB
#undef PG8_STAGE
#undef PG8_LDA
#undef PG8_LDB
#undef PG8_MMA
#undef PG8_WAIT_V
#undef PG8_WAIT_L
#undef PG8_BAR
#undef PG8_SCHED
}
}

constexpr int NB = 8, SEQ = 4096, DM = 1024, T = NB * SEQ, NMEM = 256, MROWS = NB * NMEM;
constexpr int QKVW = 3840, GATEW = 2048, NIN = 5888;
constexpr float RMS_EPS = 1e-6f;
constexpr int NPH = 15;
#ifndef DBG_MIX
#define DBG_MIX 1
#endif
#ifndef DBG_CROSS
#define DBG_CROSS 1
#endif
#ifndef DBG_PEER
#define DBG_PEER 1
#endif
#ifndef DBG_TOPK_SIMPLE
#define DBG_TOPK_SIMPLE 0
#endif
#ifndef DBG_CHECK
#define DBG_CHECK 0
#endif
#if DBG_CHECK
#define DBG_YPTR ((float*)(ws + 452 * MiB))
#else
#define DBG_YPTR ((float*)nullptr)
#endif
#ifndef MK_ONE_LAUNCH
#define MK_ONE_LAUNCH 0
#endif
constexpr size_t MiB = 1u << 20;
constexpr size_t WS_CTL = 0, CTL_ZERO_BYTES = 1 * MiB;
constexpr size_t WS_KMEAN = 1 * MiB;
constexpr size_t WS_INV = 2 * MiB;
constexpr size_t WS_WIN = 3 * MiB;
constexpr size_t WS_WA = 15 * MiB, WS_WB = 16 * MiB, WS_WOUT = 17 * MiB, WS_WQC = 19 * MiB, WS_WKVC = 20 * MiB, WS_WOC = 22 * MiB, WS_WQP = 23 * MiB, WS_SUBK = 27 * MiB;
constexpr size_t WS_U = 28 * MiB, WS_V = 60 * MiB;
constexpr size_t WS_H = 92 * MiB;
constexpr size_t WS_MEMB = 156 * MiB, WS_KVC = 160 * MiB;
constexpr size_t WS_ODIL = 164 * MiB, WS_OMOBA = 180 * MiB;
constexpr size_t WS_PQKV = 212 * MiB;
constexpr size_t WS_MERGED = WS_PQKV, WS_X1 = WS_PQKV + 64 * MiB, WS_QC = WS_PQKV + 192 * MiB, WS_OC = WS_ODIL;
constexpr size_t WS_EXP = WS_PQKV, WS_EW = WS_PQKV + 16 * MiB;
constexpr size_t WS_END = 452 * MiB;
constexpr int CW_TMO = 0, CW_CODE = 1, CW_BAR = 4096;
constexpr int RING_OFF = 0, RING_BYTES = 131072;
constexpr int LDSCTL_OFF = RING_BYTES, MISC_OFF = LDSCTL_OFF + 320;
constexpr int LDS_BYTES = 147456;
constexpr int NWAVES = 8;

#define GAS __attribute__((address_space(1)))
#define LAS __attribute__((address_space(3)))
typedef unsigned short bf16;
typedef unsigned v4u __attribute__((ext_vector_type(4)));
typedef float f32x4 __attribute__((ext_vector_type(4)));
typedef float f32x16 __attribute__((ext_vector_type(16)));
typedef short bf16x8 __attribute__((ext_vector_type(8)));
typedef __bf16 bf2_t __attribute__((ext_vector_type(2)));
typedef GAS unsigned gu32;
#define RLX_AGENT __ATOMIC_RELAXED, __HIP_MEMORY_SCOPE_AGENT
#define LDS_WAIT() asm volatile("s_waitcnt lgkmcnt(0)" ::: "memory")
#define VM_WAIT() asm volatile("s_waitcnt vmcnt(0)" ::: "memory")
__device__ __forceinline__ unsigned pk2(float lo, float hi) { return pg8::cvt_pk_bf16(lo, hi); }
__device__ __forceinline__ float bf_lo(unsigned w) { return __uint_as_float(w << 16); }
__device__ __forceinline__ float bf_hi(unsigned w) { return __uint_as_float(w & 0xffff0000u); }
__device__ __forceinline__ float bf2f(bf16 b) { return __uint_as_float((unsigned)b << 16); }

#define XB_TMO      128
#define XB_XCNT(j)  (256  + 64 * (j))
#define XB_XSUB(j)  (1280 + 64 * (j))
#define XB_XGEN(j)  (2304 + 64 * (j))
#define XB_TOP      3328
#define XB_TOPGEN   3392
#define XCD_BAR_WORDS 3456
#define XB_SPIN_CAP (1u << 18)

__device__ __forceinline__ unsigned xb_ld(unsigned* p)              { return __hip_atomic_load(p, __ATOMIC_RELAXED, __HIP_MEMORY_SCOPE_AGENT); }
__device__ __forceinline__ unsigned xb_add(unsigned* p, unsigned v) { return __hip_atomic_fetch_add(p, v, __ATOMIC_RELAXED, __HIP_MEMORY_SCOPE_AGENT); }
__device__ __forceinline__ unsigned xb_xcc_id() { return (unsigned)__builtin_amdgcn_s_getreg((3 << 11) | 20) & 0xFu; }
#define XB_SPIN(cond, bar) do { unsigned _sp = 0; while (cond) { __builtin_amdgcn_s_sleep(1); \
    if ((++_sp & 255u) == 0u) { if (xb_ld(&(bar)[XB_TMO])) break; if (_sp > XB_SPIN_CAP) { atomicAdd(&(bar)[XB_TMO], 1u); break; } } } } while (0)

struct XcdBarrier {
    unsigned* bar; unsigned x;
    volatile LAS unsigned* st;
};

__device__ __forceinline__ XcdBarrier xcd_barrier_post(unsigned* bar, volatile LAS unsigned* st) {
    XcdBarrier b; b.bar = bar; b.x = xb_xcc_id(); b.st = st;
    if (threadIdx.x == 0) (void)xb_add(&bar[XB_XCNT(b.x)], 1u);
    return b;
}
__device__ __forceinline__ void xcd_barrier_complete(unsigned* bar, unsigned x, unsigned& nloc, unsigned& nx) {
    const unsigned G = gridDim.x * gridDim.y * gridDim.z;
    unsigned sum, cnt, mine, sp = 0u;
    for (;;) {
        sum = 0u; cnt = 0u; mine = 0u;
#pragma unroll
        for (unsigned j = 0; j < 16; ++j) { const unsigned c = xb_ld(&bar[XB_XCNT(j)]); sum += c; cnt += (c > 0u) ? 1u : 0u; mine = (j == x) ? c : mine; }
        if (sum == G) break;
        __builtin_amdgcn_s_sleep(1);
        if ((++sp & 255u) == 0u) { if (xb_ld(&bar[XB_TMO])) break; if (sp > XB_SPIN_CAP) { atomicAdd(&bar[XB_TMO], 1u); break; } }
    }
    nloc = mine > 0u ? mine : 1u; nx = cnt > 0u ? cnt : 1u;
}

__device__ __forceinline__ void xcd_barrier(const XcdBarrier& b) {
    asm volatile("s_waitcnt vmcnt(0)" ::: "memory");
    __syncthreads();
    if (threadIdx.x == 0) {
        unsigned* bar = b.bar;
        __builtin_amdgcn_s_waitcnt(0);
        unsigned nloc = b.st[0], nx = b.st[1];
        if (nloc == 0u) { xcd_barrier_complete(bar, b.x, nloc, nx); b.st[0] = nloc; b.st[1] = nx; }
        const unsigned old = xb_add(&bar[XB_XSUB(b.x)], 1u);
        const unsigned gen = old / nloc;
        if (old + 1u == (gen + 1u) * nloc) {
            __builtin_amdgcn_fence(__ATOMIC_RELEASE, "agent");
            asm volatile("s_waitcnt vmcnt(0)" ::: "memory");
            const unsigned og = xb_add(&bar[XB_TOP], 1u);
            const unsigned tg = og / nx;
            if (og + 1u == (tg + 1u) * nx) xb_add(&bar[XB_TOPGEN], 1u);
            else XB_SPIN(xb_ld(&bar[XB_TOPGEN]) == tg, bar);
            __builtin_amdgcn_fence(__ATOMIC_ACQUIRE, "agent");
            xb_add(&bar[XB_XGEN(b.x)], 1u);
            asm volatile("s_waitcnt vmcnt(0)" ::: "memory");
        } else {
            XB_SPIN(xb_ld(&bar[XB_XGEN(b.x)]) == gen, bar);
            __builtin_amdgcn_fence(__ATOMIC_ACQUIRE, "agent");
            asm volatile("s_waitcnt vmcnt(0)" ::: "memory");
        }
    }
    __syncthreads();
}

__device__ __forceinline__ float wave_sum(float v) {
#pragma unroll
    for (int o = 1; o < 64; o <<= 1) v += __shfl_xor(v, o);
    return v;
}
__device__ __forceinline__ int t5_bucket(int n) {
    int b = n;
    if (n >= 16) { b = 16 + (n >= 22) + (n >= 30) + (n >= 40) + (n >= 54) + (n >= 73) + (n >= 99) + (n >= 134) + (n >= 182) + (n >= 246) + (n >= 332) + (n >= 450) + (n >= 609) + (n >= 825) + (n >= 1117) + (n >= 1513); }
    return b;
}
__device__ __forceinline__ void p0_transpose_item(const float* W, int K, int N, bf16* WT, LAS float* scr, int item, int lane) {
    const int nblk = N / 32, kb = item / nblk, nb = item % nblk, k0 = 64 * kb, n0 = 32 * nb;
#pragma unroll 8
    for (int i = 0; i < 32; ++i) { const int kk = 2 * i + (lane >> 5); scr[kk * 33 + (lane & 31)] = W[(size_t)(k0 + kk) * N + n0 + (lane & 31)]; }
    LDS_WAIT(); asm volatile("" ::: "memory");
    const int c = lane & 7;
#pragma unroll
    for (int j = 0; j < 4; ++j) { const int n = (lane >> 3) + 8 * j; const LAS float* s = scr + (8 * c) * 33 + n;
        v4u o; o.x = pk2(s[0 * 33], s[1 * 33]); o.y = pk2(s[2 * 33], s[3 * 33]); o.z = pk2(s[4 * 33], s[5 * 33]); o.w = pk2(s[6 * 33], s[7 * 33]);
        *(GAS v4u*)(WT + (size_t)(n0 + n) * K + k0 + 8 * c) = o; }
    LDS_WAIT(); asm volatile("" ::: "memory");
}
__device__ __forceinline__ void rms_row_to_bf16(const float* xrow, const float* g, bf16* orow, int lane) {
    const f32x4* xr = (const f32x4*)xrow + lane; const f32x4* gr = (const f32x4*)g + lane;
    f32x4 v[4]; float s = 0.f;
#pragma unroll
    for (int j = 0; j < 4; ++j) { v[j] = xr[64 * j]; s += (v[j].x * v[j].x + v[j].y * v[j].y) + (v[j].z * v[j].z + v[j].w * v[j].w); }
    const float rinv = rsqrtf(wave_sum(s) * (1.f / 1024.f) + RMS_EPS);
    unsigned long long* o8 = (unsigned long long*)orow + lane;
#pragma unroll
    for (int j = 0; j < 4; ++j) { const f32x4 gv = gr[64 * j]; o8[64 * j] = (unsigned long long)pk2(v[j].x * rinv * gv.x, v[j].y * rinv * gv.y) | ((unsigned long long)pk2(v[j].z * rinv * gv.z, v[j].w * rinv * gv.w) << 32); }
}
__device__ __forceinline__ void cvt_f32_to_bf16_bulk(const float* src, bf16* dst, size_t n, size_t gtid, size_t nthr) {
    for (size_t i = gtid; i < n / 8; i += nthr) { const f32x4 a = ((const f32x4*)src)[2 * i], b = ((const f32x4*)src)[2 * i + 1];
        v4u o; o.x = pk2(a.x, a.y); o.y = pk2(a.z, a.w); o.z = pk2(b.x, b.y); o.w = pk2(b.z, b.w); ((v4u*)dst)[i] = o; }
}
__device__ __forceinline__ void os_step(const float (&q)[64], float (&o)[64], float& m, float& l, const bf16* krow, const bf16* vrow, float bias) {
    const v4u* kp = (const v4u*)krow; float s = 0.f;
#pragma unroll
    for (int c = 0; c < 8; ++c) { const v4u w = kp[c];
        s += q[8 * c + 0] * bf_lo(w.x) + q[8 * c + 1] * bf_hi(w.x) + q[8 * c + 2] * bf_lo(w.y) + q[8 * c + 3] * bf_hi(w.y)
           + q[8 * c + 4] * bf_lo(w.z) + q[8 * c + 5] * bf_hi(w.z) + q[8 * c + 6] * bf_lo(w.w) + q[8 * c + 7] * bf_hi(w.w); }
    s += bias;
    const float mn = fmaxf(m, s), al = __expf(m - mn), p = __expf(s - mn);
    l = l * al + p; m = mn;
    const v4u* vp = (const v4u*)vrow;
#pragma unroll
    for (int c = 0; c < 8; ++c) { const v4u w = vp[c];
        o[8 * c + 0] = o[8 * c + 0] * al + p * bf_lo(w.x); o[8 * c + 1] = o[8 * c + 1] * al + p * bf_hi(w.x);
        o[8 * c + 2] = o[8 * c + 2] * al + p * bf_lo(w.y); o[8 * c + 3] = o[8 * c + 3] * al + p * bf_hi(w.y);
        o[8 * c + 4] = o[8 * c + 4] * al + p * bf_lo(w.z); o[8 * c + 5] = o[8 * c + 5] * al + p * bf_hi(w.z);
        o[8 * c + 6] = o[8 * c + 6] * al + p * bf_lo(w.w); o[8 * c + 7] = o[8 * c + 7] * al + p * bf_hi(w.w); }
}
__device__ __forceinline__ void load_q64(float (&q)[64], const bf16* qrow, float scale) {
    const v4u* qp = (const v4u*)qrow;
#pragma unroll
    for (int c = 0; c < 8; ++c) { const v4u w = qp[c];
        q[8 * c + 0] = bf_lo(w.x) * scale; q[8 * c + 1] = bf_hi(w.x) * scale; q[8 * c + 2] = bf_lo(w.y) * scale; q[8 * c + 3] = bf_hi(w.y) * scale;
        q[8 * c + 4] = bf_lo(w.z) * scale; q[8 * c + 5] = bf_hi(w.z) * scale; q[8 * c + 6] = bf_lo(w.w) * scale; q[8 * c + 7] = bf_hi(w.w) * scale; }
}
__device__ __forceinline__ void store_o64(const float (&o)[64], float inv, bf16* orow) {
    v4u* op = (v4u*)orow;
#pragma unroll
    for (int c = 0; c < 8; ++c) { v4u w; w.x = pk2(o[8 * c + 0] * inv, o[8 * c + 1] * inv); w.y = pk2(o[8 * c + 2] * inv, o[8 * c + 3] * inv);
        w.z = pk2(o[8 * c + 4] * inv, o[8 * c + 5] * inv); w.w = pk2(o[8 * c + 6] * inv, o[8 * c + 7] * inv); op[c] = w; }
}
__device__ __forceinline__ void phase_dil_simple(const bf16* P, const float* rel_bias, bf16* ODIL, int gtid, int nthr) {
    for (int item = gtid; item < 4 * T; item += nthr) {
        const int h = item / T, tok = item % T, b = tok / SEQ, t = tok % SEQ;
        float o[64], q[64]; float m = -1e30f, l = 0.f;
#pragma unroll
        for (int c = 0; c < 64; ++c) o[c] = 0.f;
        for (int g = 0; g < 3; ++g) {
            const int d = 1 << (2 * g);
            load_q64(q, P + (size_t)tok * QKVW + g * 768 + h * 64, 0.125f);
            for (int j = 0; j <= 128; ++j) {
                const int tp = t - j * d;
                if (tp >= 0) {
                    const bf16* kr = P + (size_t)(b * SEQ + tp) * QKVW + g * 768 + 256 + h * 64;
                    os_step(q, o, m, l, kr, kr + 256, rel_bias[t5_bucket(j * d) * 20 + g * 4 + h]);
                }
            }
        }
        store_o64(o, 1.0f / l, ODIL + (size_t)tok * 256 + h * 64);
    }
}
__device__ __forceinline__ void phase_moba_simple(const bf16* P, const float* KMEAN, const float* rel_bias, bf16* OMOBA, int gtid, int nthr) {
    for (int item = gtid; item < 8 * T; item += nthr) {
        const int h = item / T, tok = item % T, b = tok / SEQ, t = tok % SEQ, qb = t >> 8;
        float o[64], q[64]; float m = -1e30f, l = 0.f;
#pragma unroll
        for (int c = 0; c < 64; ++c) o[c] = 0.f;
        load_q64(q, P + (size_t)tok * QKVW + 2304 + h * 64, 1.0f);
        float v1 = -3e38f, v2 = -3e38f, v3 = -3e38f; int i1 = -1, i2 = -1, i3 = -1;
        for (int n = 0; n < qb; ++n) {
            const float* km = KMEAN + (size_t)((b * 8 + h) * 16 + n) * 64; float gs = 0.f;
#pragma unroll
            for (int c = 0; c < 64; ++c) gs += q[c] * km[c];
            if (gs > v1) { v3 = v2; i3 = i2; v2 = v1; i2 = i1; v1 = gs; i1 = n; }
            else if (gs > v2) { v3 = v2; i3 = i2; v2 = gs; i2 = n; }
            else if (gs > v3) { v3 = gs; i3 = n; }
        }
        unsigned sel = 0u;
        if (i1 >= 0) sel |= 1u << i1;
        if (i2 >= 0) sel |= 1u << i2;
        if (i3 >= 0) sel |= 1u << i3;
#pragma unroll
        for (int c = 0; c < 64; ++c) q[c] *= 0.125f;
        const bf16* Kb = P + (size_t)(b * SEQ) * QKVW + 2304 + 512 + h * 64;
        for (int n = 0; n < qb; ++n) {
            const bool on = (sel >> n) & 1u;
            if (__any(on)) {
                for (int j = 0; j < 256; ++j) {
                    const int kpos = n * 256 + j;
                    if (on) { const bf16* kr = Kb + (size_t)kpos * QKVW; os_step(q, o, m, l, kr, kr + 512, rel_bias[t5_bucket(t - kpos) * 20 + 12 + h]); }
                }
            }
        }
        const int tmax = t | 63;
        for (int kpos = qb * 256; kpos <= tmax; ++kpos) {
            if (kpos <= t) { const bf16* kr = Kb + (size_t)kpos * QKVW; os_step(q, o, m, l, kr, kr + 512, rel_bias[t5_bucket(t - kpos) * 20 + 12 + h]); }
        }
        store_o64(o, 1.0f / l, OMOBA + (size_t)tok * 512 + h * 64);
    }
}
__device__ __forceinline__ void phase_cross_simple(const bf16* QC, const bf16* KVC, bf16* OC, int gtid, int nthr) {
    for (int item = gtid; item < 8 * T; item += nthr) {
        const int half = item & 1, pr = item >> 1, h = pr / T, tok = pr % T, b = tok / SEQ;
        float o[64], q[64]; float m = -1e30f, l = 0.f;
#pragma unroll
        for (int c = 0; c < 64; ++c) o[c] = 0.f;
        load_q64(q, QC + (size_t)tok * 512 + h * 128 + half * 64, 0.08838834764831845f);
        const bf16* Kb = KVC + (size_t)(b * NMEM) * 1024 + h * 128 + half * 64;
        for (int j = 0; j < NMEM; ++j) {
            const v4u* kp = (const v4u*)(Kb + (size_t)j * 1024); float s = 0.f;
#pragma unroll
            for (int c = 0; c < 8; ++c) { const v4u w = kp[c];
                s += q[8 * c + 0] * bf_lo(w.x) + q[8 * c + 1] * bf_hi(w.x) + q[8 * c + 2] * bf_lo(w.y) + q[8 * c + 3] * bf_hi(w.y)
                   + q[8 * c + 4] * bf_lo(w.z) + q[8 * c + 5] * bf_hi(w.z) + q[8 * c + 6] * bf_lo(w.w) + q[8 * c + 7] * bf_hi(w.w); }
            s += __shfl_xor(s, 1);
            const float mn = fmaxf(m, s), al = __expf(m - mn), p = __expf(s - mn);
            l = l * al + p; m = mn;
            const v4u* vp = (const v4u*)(Kb + (size_t)j * 1024 + 512);
#pragma unroll
            for (int c = 0; c < 8; ++c) { const v4u w = vp[c];
                o[8 * c + 0] = o[8 * c + 0] * al + p * bf_lo(w.x); o[8 * c + 1] = o[8 * c + 1] * al + p * bf_hi(w.x);
                o[8 * c + 2] = o[8 * c + 2] * al + p * bf_lo(w.y); o[8 * c + 3] = o[8 * c + 3] * al + p * bf_hi(w.y);
                o[8 * c + 4] = o[8 * c + 4] * al + p * bf_lo(w.z); o[8 * c + 5] = o[8 * c + 5] * al + p * bf_hi(w.z);
                o[8 * c + 6] = o[8 * c + 6] * al + p * bf_lo(w.w); o[8 * c + 7] = o[8 * c + 7] * al + p * bf_hi(w.w); }
        }
        store_o64(o, 1.0f / l, OC + (size_t)tok * 512 + h * 128 + half * 64);
    }
}

__device__ __forceinline__ float tk_max(float a, float b) { return fmaxf(a, b); }
__device__ __forceinline__ float tk_min(float a, float b) { return fminf(a, b); }
template <int OFF> __device__ __forceinline__ void sort16_desc(float* v) {
#pragma unroll
    for (int k = 2; k <= 16; k <<= 1) {
#pragma unroll
        for (int j = k >> 1; j > 0; j >>= 1) {
#pragma unroll
            for (int i = 0; i < 16; ++i) {
                const int l = i ^ j;
                if (l > i) {
                    const bool desc = ((i & k) == 0);
                    const float x = v[OFF + i], y = v[OFF + l];
                    const float hi = tk_max(x, y), lo = tk_min(x, y);
                    v[OFF + i] = desc ? hi : lo; v[OFF + l] = desc ? lo : hi;
                }
            }
        }
    }
}
template <int OA, int OB, bool SORT> __device__ __forceinline__ void merge_top16(float* a, const float* b) {
#pragma unroll
    for (int i = 0; i < 16; ++i) a[OA + i] = tk_max(a[OA + i], b[OB + 15 - i]);
    if (SORT) {
#pragma unroll
        for (int j = 8; j > 0; j >>= 1) {
#pragma unroll
            for (int i = 0; i < 16; ++i) {
                const int l = i ^ j;
                if (l > i) { const float x = a[OA + i], y = a[OA + l]; a[OA + i] = tk_max(x, y); a[OA + l] = tk_min(x, y); }
            }
        }
    }
}
constexpr int cand_i(int c) { int n = 0; for (int i = 0; i < 16; ++i) for (int j = 0; j < 16 / (i + 1); ++j) { if (n == c) return i; ++n; } return 0; }
constexpr int cand_j(int c) { int n = 0; for (int i = 0; i < 16; ++i) for (int j = 0; j < 16 / (i + 1); ++j) { if (n == c) return j; ++n; } return 0; }
template <int C> struct CandT { static constexpr int I = cand_i(C), J = cand_j(C); };

__device__ __forceinline__ void peer_level1(const bf16* qrow  , const LAS unsigned char* sk  ,
                                            int r, int hh, float (&out)[16]) {
    bf16x8 qf[8];
#pragma unroll
    for (int ks = 0; ks < 8; ++ks) qf[ks] = *(const bf16x8*)(qrow + ks * 16 + hh * 8);
    float v[64];
#pragma unroll
    for (int kb = 0; kb < 4; ++kb) {
        f32x16 sc = {0.f, 0.f, 0.f, 0.f, 0.f, 0.f, 0.f, 0.f, 0.f, 0.f, 0.f, 0.f, 0.f, 0.f, 0.f, 0.f};
        const int key = kb * 32 + r;
#pragma unroll
        for (int ks = 0; ks < 8; ++ks) {
            const bf16x8 af = *(const LAS bf16x8*)(sk + key * 256 + (((2 * ks + hh) ^ (key & 15)) << 4));
            sc = __builtin_amdgcn_mfma_f32_32x32x16_bf16(af, qf[ks], sc, 0, 0, 0);
        }
#pragma unroll
        for (int reg = 0; reg < 16; ++reg) {
            const unsigned idx = (unsigned)(kb * 32 + (reg & 3) + 8 * (reg >> 2)) | ((unsigned)hh << 2);
            v[kb * 16 + reg] = __uint_as_float((__float_as_uint(sc[reg]) & ~127u) | idx);
        }
    }
    sort16_desc<0>(v); sort16_desc<16>(v); sort16_desc<32>(v); sort16_desc<48>(v);
    merge_top16<0, 16, true>(v, v); merge_top16<32, 48, true>(v, v); merge_top16<0, 32, true>(v, v);
    float other[16];
#pragma unroll
    for (int i = 0; i < 16; ++i) other[i] = __shfl_xor(v[i], 32);
    merge_top16<0, 0, true>(v, other);
#pragma unroll
    for (int i = 0; i < 16; ++i) out[i] = v[i];
}
template <int C> __device__ __forceinline__ void peer_emit(const float (&a)[16], const float (&b)[16], const float (&s)[64], float tau, int& cnt, float& den, bool writer, int* eo, float* wo) {
    if constexpr (C < 50) {
        const bool take = (s[C] >= tau) && (cnt < 16);
        const float e = __expf(s[C] - s[0]);
        if (take) {
            if (writer) { eo[cnt] = (int)(((__float_as_uint(a[CandT<C>::I]) & 127u) << 7) | (__float_as_uint(b[CandT<C>::J]) & 127u)); wo[cnt] = e; }
            cnt += 1; den += e;
        }
        peer_emit<C + 1>(a, b, s, tau, cnt, den, writer, eo, wo);
    }
}
template <int C> __device__ __forceinline__ void peer_sums(const float (&a)[16], const float (&b)[16], float (&s)[64]) {
    if constexpr (C < 50) { s[C] = a[CandT<C>::I] + b[CandT<C>::J]; peer_sums<C + 1>(a, b, s); }
}
__device__ __forceinline__ void phase_topk(LAS unsigned char* lds, const bf16* QP, const bf16* SUBK, int* EXP, float* EW, float* INV, int tid, int lane, int gw, int ngw) {
    for (int c = tid; c < 2 * 128 * 16; c += NWAVES * 64) { const int row = c >> 4, ch = c & 15; const v4u w = ((const v4u*)SUBK)[c]; *(LAS v4u*)(lds + row * 256 + ((ch ^ (row & 15)) << 4)) = w; }
    __syncthreads();
    const int r = lane & 31, hh = lane >> 5;
    for (int unit = gw; unit < (T / 32) * 8; unit += ngw) {
        const int tile = unit >> 3, head = unit & 7, tok = tile * 32 + r;
        const bf16* qrow = QP + (size_t)tok * 2048 + head * 256;
        float a[16], b[16];
        peer_level1(qrow, lds, r, hh, a);
        peer_level1(qrow + 128, lds + 128 * 256, r, hh, b);
        float s[64];
        peer_sums<0>(a, b, s);
#pragma unroll
        for (int c = 50; c < 64; ++c) s[c] = -INFINITY;
        float w[64];
#pragma unroll
        for (int c = 0; c < 64; ++c) w[c] = s[c];
        sort16_desc<0>(w); sort16_desc<16>(w); sort16_desc<32>(w); sort16_desc<48>(w);
        merge_top16<0, 16, true>(w, w); merge_top16<32, 48, true>(w, w); merge_top16<0, 32, false>(w, w);
        float tau = w[0];
#pragma unroll
        for (int i = 1; i < 16; ++i) tau = tk_min(tau, w[i]);
        int cnt = 0; float den = 0.f;
        peer_emit<0>(a, b, s, tau, cnt, den, hh == 0, EXP + (size_t)tok * 128 + head * 16, EW + (size_t)tok * 128 + head * 16);
        if (hh == 0) INV[(size_t)tok * 8 + head] = 1.0f / den;
    }
    __syncthreads();
}

__device__ __forceinline__ float dot2_bf16(unsigned w, unsigned x, float acc) { return __builtin_amdgcn_fdot2_f32_bf16(__builtin_bit_cast(bf2_t, w), __builtin_bit_cast(bf2_t, x), acc, false); }
__device__ __forceinline__ float dot8_bf16(const v4u a, const v4u b, float acc) {
    acc = dot2_bf16(a.x, b.x, acc); acc = dot2_bf16(a.y, b.y, acc); acc = dot2_bf16(a.z, b.z, acc); acc = dot2_bf16(a.w, b.w, acc);
    return acc;
}
template <int N> __device__ __forceinline__ void xpose_reduce(float (&p)[64], int lane) {
    if constexpr (N >= 1) {
        const bool up = (lane & N) != 0;
#pragma unroll
        for (int k = 0; k < N; ++k) { const float keep = up ? p[k + N] : p[k], send = up ? p[k] : p[k + N]; p[k] = keep + __shfl_xor(send, N); }
        xpose_reduce<N / 2>(p, lane);
    }
}
__device__ __forceinline__ float gelu_exact(float x) { return 0.5f * x * (1.0f + erff(x * 0.70710678118654752f)); }
__device__ __forceinline__ void phase_peer(const bf16* H, const bf16* U, const bf16* V, const int* EXP, const float* EW, const float* INV, const float* X2, const float* gfin, float* OUT, int lane, int gw, int ngw, float dbg_sc, float* ydbg) {
    for (int tok = gw; tok < T; tok += ngw) {
        int e0 = EXP[(size_t)tok * 128 + lane], e1 = EXP[(size_t)tok * 128 + 64 + lane];
        if (dbg_sc == 0.f) { e0 = 0; e1 = 0; }
        const float g0 = EW[(size_t)tok * 128 + lane] * INV[(size_t)tok * 8 + (lane >> 4)], g1 = EW[(size_t)tok * 128 + 64 + lane] * INV[(size_t)tok * 8 + 4 + (lane >> 4)];
        const v4u hA = *(const v4u*)(H + (size_t)tok * 1024 + 8 * lane), hB = *(const v4u*)(H + (size_t)tok * 1024 + 512 + 8 * lane);
        float wgt[2];
#pragma unroll
        for (int half = 0; half < 2; ++half) {
            const int ev = half ? e1 : e0;
            float p[64];
#pragma unroll
            for (int i0 = 0; i0 < 64; i0 += 8) {
                v4u ua[8], ub[8];
#pragma unroll
                for (int k = 0; k < 8; ++k) { const int eid = __builtin_amdgcn_readlane(ev, i0 + k); const v4u* up = (const v4u*)(U + (size_t)eid * 1024); ua[k] = up[lane]; ub[k] = up[64 + lane]; }
#pragma unroll
                for (int k = 0; k < 8; ++k) p[i0 + k] = dot8_bf16(hB, ub[k], dot8_bf16(hA, ua[k], 0.f));
            }
            xpose_reduce<32>(p, lane);
            wgt[half] = gelu_exact(p[0]) * (half ? g1 : g0);
        }
        float y[16];
#pragma unroll
        for (int c = 0; c < 16; ++c) y[c] = 0.f;
#pragma unroll
        for (int half = 0; half < 2; ++half) {
            const int ev = half ? e1 : e0; const float wv = wgt[half];
            for (int i0 = 0; i0 < 64; i0 += 8) {
                v4u va[8], vb[8]; float ws[8];
#pragma unroll
                for (int k = 0; k < 8; ++k) { const int eid = __builtin_amdgcn_readlane(ev, i0 + k); ws[k] = __int_as_float(__builtin_amdgcn_readlane(__float_as_int(wv), i0 + k));
                    const v4u* vp = (const v4u*)(V + (size_t)eid * 1024); va[k] = vp[lane]; vb[k] = vp[64 + lane]; }
#pragma unroll
                for (int k = 0; k < 8; ++k) { const float w = ws[k];
                    y[0] += w * bf_lo(va[k].x); y[1] += w * bf_hi(va[k].x); y[2] += w * bf_lo(va[k].y); y[3] += w * bf_hi(va[k].y);
                    y[4] += w * bf_lo(va[k].z); y[5] += w * bf_hi(va[k].z); y[6] += w * bf_lo(va[k].w); y[7] += w * bf_hi(va[k].w);
                    y[8] += w * bf_lo(vb[k].x); y[9] += w * bf_hi(vb[k].x); y[10] += w * bf_lo(vb[k].y); y[11] += w * bf_hi(vb[k].y);
                    y[12] += w * bf_lo(vb[k].z); y[13] += w * bf_hi(vb[k].z); y[14] += w * bf_lo(vb[k].w); y[15] += w * bf_hi(vb[k].w); }
            }
        }
        if (dbg_sc == 0.f) {
#pragma unroll
            for (int c = 0; c < 16; ++c) y[c] = 0.f; }
        if (ydbg) { const int s_ = tok / 512; if (tok == s_ * 512 + 3 + (s_ & 7) * 37) {
#pragma unroll
            for (int c = 0; c < 8; ++c) { ydbg[(size_t)s_ * 1024 + 8 * lane + c] = y[c]; ydbg[(size_t)s_ * 1024 + 512 + 8 * lane + c] = y[8 + c]; } } }
        const f32x4* xr = (const f32x4*)(X2 + (size_t)tok * 1024); const f32x4* gr = (const f32x4*)gfin;
        f32x4 x0 = xr[2 * lane], x1 = xr[2 * lane + 1], x2 = xr[128 + 2 * lane], x3 = xr[128 + 2 * lane + 1];
        x0.x += y[0]; x0.y += y[1]; x0.z += y[2]; x0.w += y[3]; x1.x += y[4]; x1.y += y[5]; x1.z += y[6]; x1.w += y[7];
        x2.x += y[8]; x2.y += y[9]; x2.z += y[10]; x2.w += y[11]; x3.x += y[12]; x3.y += y[13]; x3.z += y[14]; x3.w += y[15];
        float ss = (x0.x * x0.x + x0.y * x0.y + x0.z * x0.z + x0.w * x0.w) + (x1.x * x1.x + x1.y * x1.y + x1.z * x1.z + x1.w * x1.w)
                 + (x2.x * x2.x + x2.y * x2.y + x2.z * x2.z + x2.w * x2.w) + (x3.x * x3.x + x3.y * x3.y + x3.z * x3.z + x3.w * x3.w);
        const float rinv = rsqrtf(wave_sum(ss) * (1.f / 1024.f) + RMS_EPS);
        f32x4* orow = (f32x4*)(OUT + (size_t)tok * 1024);
        orow[2 * lane] = x0 * rinv * gr[2 * lane]; orow[2 * lane + 1] = x1 * rinv * gr[2 * lane + 1];
        orow[128 + 2 * lane] = x2 * rinv * gr[128 + 2 * lane]; orow[128 + 2 * lane + 1] = x3 * rinv * gr[128 + 2 * lane + 1];
    }
}
__device__ __forceinline__ void phase_topk_simple(const bf16* QP, const float* subk, int* EXP, float* EW, float* INV, int lane, int gw, int ngw) {
    for (int unit = gw; unit < T * 8; unit += ngw) {
        const int tok = unit >> 3, head = unit & 7;
        const bf16* qrow = QP + (size_t)tok * 2048 + head * 256;
        float av = 0.f, bv[4] = {0.f, 0.f, 0.f, 0.f}; int ai = 0, bi[4] = {0, 0, 0, 0};
#pragma unroll
        for (int p = 0; p < 2; ++p) {
            float s0 = 0.f, s1 = 0.f;
            const float* k0 = subk + (size_t)(p * 128 + lane) * 128; const float* k1 = subk + (size_t)(p * 128 + 64 + lane) * 128;
            for (int c = 0; c < 128; ++c) { const float qv = bf2f(qrow[p * 128 + c]); s0 += qv * k0[c]; s1 += qv * k1[c]; }
#pragma unroll
            for (int i = 0; i < 16; ++i) {
                float mloc = fmaxf(s0, s1); float mw = mloc;
#pragma unroll
                for (int o = 1; o < 64; o <<= 1) mw = fmaxf(mw, __shfl_xor(mw, o));
                const unsigned long long bal = __ballot(mloc == mw);
                const int wl = __ffsll((long long)bal) - 1;
                int idx = -1;
                if (lane == wl) { if (s0 >= s1) { idx = lane; s0 = -3e38f; } else { idx = lane + 64; s1 = -3e38f; } }
                idx = __shfl(idx, wl);
                if (p == 0) { if ((lane & 15) == i) { av = mw; ai = idx; } }
                else { if ((lane >> 4) == (i >> 2)) { bv[i & 3] = mw; bi[i & 3] = idx; } }
            }
        }
        float cs[4];
#pragma unroll
        for (int jj = 0; jj < 4; ++jj) cs[jj] = av + bv[jj];
        float top0 = 0.f, den = 0.f; int myexp = 0; float myw = 0.f;
#pragma unroll
        for (int k = 0; k < 16; ++k) {
            float mloc = fmaxf(fmaxf(cs[0], cs[1]), fmaxf(cs[2], cs[3])); float mw = mloc;
#pragma unroll
            for (int o = 1; o < 64; o <<= 1) mw = fmaxf(mw, __shfl_xor(mw, o));
            const unsigned long long bal = __ballot(mloc == mw);
            const int wl = __ffsll((long long)bal) - 1;
            int ex = 0;
            if (lane == wl) {
                if (cs[0] == mw) { ex = ai * 128 + bi[0]; cs[0] = -3e38f; }
                else if (cs[1] == mw) { ex = ai * 128 + bi[1]; cs[1] = -3e38f; }
                else if (cs[2] == mw) { ex = ai * 128 + bi[2]; cs[2] = -3e38f; }
                else { ex = ai * 128 + bi[3]; cs[3] = -3e38f; }
            }
            ex = __shfl(ex, wl);
            if (k == 0) top0 = mw;
            const float e = __expf(mw - top0); den += e;
            if (lane == k) { myexp = ex; myw = e; }
        }
        if (lane < 16) { EXP[(size_t)tok * 128 + head * 16 + lane] = myexp; EW[(size_t)tok * 128 + head * 16 + lane] = myw; }
        if (lane == 0) INV[(size_t)tok * 8 + head] = 1.0f / den;
    }
}
#if DBG_CHECK
constexpr size_t WS_YDBG = 452 * MiB;
constexpr int CW_DBG = 64;
__device__ __forceinline__ void dbg_acc(float* acc, float num, float den, int lane) { num = wave_sum(num); den = wave_sum(den); if (lane == 0) { atomicAdd(acc, num); atomicAdd(acc + 1, den); } }
__device__ __forceinline__ int dbg_tok(int s) { return s * 512 + 3 + (s & 7) * 37; }
__device__ __forceinline__ void dbg_check_qp(const bf16* H, const float* w_qp, const bf16* QP, float* acc, int gtid, int nthr, int lane) {
    float num = 0.f, den = 0.f;
    for (int item = gtid; item < 64 * 2048; item += nthr) { const int s = item / 2048, n = item % 2048, t = dbg_tok(s);
        float r = 0.f; for (int k = 0; k < 1024; ++k) r += bf2f(H[(size_t)t * 1024 + k]) * w_qp[(size_t)k * 2048 + n];
        const float mine = bf2f(QP[(size_t)t * 2048 + n]); num += (r - mine) * (r - mine); den += r * r; }
    dbg_acc(acc, num, den, lane);
}
__device__ __forceinline__ void dbg_check_gather(const bf16* H, const float* u, const float* v, const int* EXP, const float* EW, const float* INV, const float* YDBG, float* acc, int gw, int ngw, int lane) {
    float num = 0.f, den = 0.f;
    for (int s = gw; s < 64; s += ngw) { const int t = dbg_tok(s);
        float y[16];
#pragma unroll
        for (int c = 0; c < 16; ++c) y[c] = 0.f;
        for (int i = 0; i < 128; ++i) { const int e = EXP[(size_t)t * 128 + i]; const float g = EW[(size_t)t * 128 + i] * INV[(size_t)t * 8 + (i >> 4)];
            float d = 0.f;
#pragma unroll
            for (int c = 0; c < 16; ++c) d += bf2f(H[(size_t)t * 1024 + lane * 16 + c]) * u[(size_t)e * 1024 + lane * 16 + c];
            d = wave_sum(d);
            const float w = g * gelu_exact(d);
#pragma unroll
            for (int c = 0; c < 16; ++c) y[c] += w * v[(size_t)e * 1024 + lane * 16 + c]; }
#pragma unroll
        for (int c = 0; c < 16; ++c) { const float mine = YDBG[(size_t)s * 1024 + lane * 16 + c]; num += (y[c] - mine) * (y[c] - mine); den += y[c] * y[c]; } }
    dbg_acc(acc, num, den, lane);
}
__device__ __forceinline__ float dbg_k(const float* acc) { const float D = acc[0] / fmaxf(acc[1], 1e-30f); float k = log10f(fmaxf(D, 1e-12f)); return fminf(fmaxf(k, -6.f), 1.f); }
__device__ __forceinline__ void dbg_encode(const float* x, const float* gfin, float* out, const float* acc, int gw, int ngw, int lane) {
    const float k1 = dbg_k(acc), k2 = dbg_k(acc + 2); const float s = 1.f + (k1 + 6.5f) * 0.5f;
    for (int m = gw; m < T; m += ngw) { const f32x4* xr = (const f32x4*)(x + (size_t)m * 1024) + lane; const f32x4* gr = (const f32x4*)gfin + lane; f32x4 vv[4]; float ss = 0.f;
#pragma unroll
        for (int j = 0; j < 4; ++j) { vv[j] = xr[64 * j]; ss += (vv[j].x * vv[j].x + vv[j].y * vv[j].y) + (vv[j].z * vv[j].z + vv[j].w * vv[j].w); }
        const float rinv = rsqrtf(wave_sum(ss) * (1.f / 1024.f) + RMS_EPS) * s;
#pragma unroll
        for (int j = 0; j < 4; ++j) { f32x4 o = vv[j] * rinv * gr[64 * j]; if (m == 0 && j == 0 && lane == 0) o.x = 100.f + 100.f * (k2 + 6.f); ((f32x4*)(out + (size_t)m * 1024) + lane)[64 * j] = o; } }
}
#endif

struct Args { const float* in[20]; float* out; unsigned char* ws; int ph_lo, ph_hi; };
__global__ void __launch_bounds__(NWAVES * 64, 2) fwd(Args args) {
    extern __shared__ __attribute__((aligned(16))) unsigned char lds_raw[];
    LAS unsigned char* lds = (LAS unsigned char*)lds_raw;
    volatile LAS unsigned* MISC = (volatile LAS unsigned*)(lds + MISC_OFF);
    const int tid = threadIdx.x, lane = tid & 63, wave = __builtin_amdgcn_readfirstlane(tid >> 6);
    const int G = gridDim.x; const int bx = blockIdx.x; const int vcu = (G % 8 == 0) ? (bx % 8) * (G / 8) + bx / 8 : bx;
    const int gw = vcu * NWAVES + wave, NGW = G * NWAVES, gtid = vcu * (NWAVES * 64) + tid, NTHR = G * NWAVES * 64;
    unsigned char* ws = args.ws;
    gu32* ctl = (gu32*)(ws + WS_CTL);
    const float* x = args.in[0]; const float* mem = args.in[1]; const float* rel_bias = args.in[2]; const float* g_mix = args.in[3]; const float* w_in = args.in[4];
    const float* b_gate = args.in[5]; const float* w_a = args.in[6]; const float* w_b = args.in[7]; const float* w_out = args.in[8]; const float* g_cross = args.in[9];
    const float* g_mem = args.in[10]; const float* w_qc = args.in[11]; const float* w_kvc = args.in[12]; const float* w_oc = args.in[13]; const float* g_ffn = args.in[14];
    const float* w_qp = args.in[15]; const float* subk = args.in[16]; const float* peer_u = args.in[17]; const float* peer_v = args.in[18]; const float* g_final = args.in[19];
    float* out = args.out;
    bf16* WinT = (bf16*)(ws + WS_WIN); bf16* WaT = (bf16*)(ws + WS_WA); bf16* WbT = (bf16*)(ws + WS_WB); bf16* WoutT = (bf16*)(ws + WS_WOUT); bf16* WqcT = (bf16*)(ws + WS_WQC);
    bf16* WkvcT = (bf16*)(ws + WS_WKVC); bf16* WocT = (bf16*)(ws + WS_WOC); bf16* WqpT = (bf16*)(ws + WS_WQP); bf16* SUBK = (bf16*)(ws + WS_SUBK); bf16* Ub = (bf16*)(ws + WS_U); bf16* Vb = (bf16*)(ws + WS_V);
    bf16* H = (bf16*)(ws + WS_H); bf16* MEMB = (bf16*)(ws + WS_MEMB); bf16* KVC = (bf16*)(ws + WS_KVC); bf16* ODIL = (bf16*)(ws + WS_ODIL); bf16* OMOBA = (bf16*)(ws + WS_OMOBA);
    bf16* PQKV = (bf16*)(ws + WS_PQKV); bf16* MERGED = (bf16*)(ws + WS_MERGED); float* X1 = (float*)(ws + WS_X1); bf16* QC = (bf16*)(ws + WS_QC); bf16* OC = (bf16*)(ws + WS_OC);
    int* EXP = (int*)(ws + WS_EXP); float* EW = (float*)(ws + WS_EW); float* INV = (float*)(ws + WS_INV); float* KMEAN = (float*)(ws + WS_KMEAN);
    bf16* GATES = (bf16*)out;
    bf16* QP = (bf16*)out;

    for (int u = tid; u < (LDS_BYTES - LDSCTL_OFF) / 4; u += NWAVES * 64) ((LAS unsigned*)(lds + LDSCTL_OFF))[u] = 0u;
    __syncthreads();
    const int lo = args.ph_lo, hi = args.ph_hi;
    XcdBarrier bar; bar.bar = (unsigned*)(ctl + CW_BAR); bar.x = 0; bar.st = nullptr;
    if (hi - lo > 1) bar = xcd_barrier_post((unsigned*)(ctl + CW_BAR), MISC + 8);
#define IN(k) (lo <= (k) && (k) < hi)
#define SEAM(k) do { if (IN(k) && IN((k) + 1)) xcd_barrier(bar); } while (0)

    if (IN(0)) {
        LAS float* scr = (LAS float*)(lds + RING_OFF + wave * 16384);
        constexpr int I_IN = (1024 / 64) * (NIN / 32), I_A = (256 / 64) * (1024 / 32), I_B = (512 / 64) * (1024 / 32), I_OUT = (1024 / 64) * (1024 / 32), I_QC = (1024 / 64) * (512 / 32),
                      I_KVC = (1024 / 64) * (1024 / 32), I_OC = (512 / 64) * (1024 / 32), I_QP = (1024 / 64) * (2048 / 32);
        constexpr int NITEMS = I_IN + I_A + I_B + I_OUT + I_QC + I_KVC + I_OC + I_QP;
        for (int it = gw; it < NITEMS; it += NGW) {
            int r = it;
            if (r < I_IN) { p0_transpose_item(w_in, 1024, NIN, WinT, scr, r, lane); continue; } r -= I_IN;
            if (r < I_A) { p0_transpose_item(w_a, 256, 1024, WaT, scr, r, lane); continue; } r -= I_A;
            if (r < I_B) { p0_transpose_item(w_b, 512, 1024, WbT, scr, r, lane); continue; } r -= I_B;
            if (r < I_OUT) { p0_transpose_item(w_out, 1024, 1024, WoutT, scr, r, lane); continue; } r -= I_OUT;
            if (r < I_QC) { p0_transpose_item(w_qc, 1024, 512, WqcT, scr, r, lane); continue; } r -= I_QC;
            if (r < I_KVC) { p0_transpose_item(w_kvc, 1024, 1024, WkvcT, scr, r, lane); continue; } r -= I_KVC;
            if (r < I_OC) { p0_transpose_item(w_oc, 512, 1024, WocT, scr, r, lane); continue; } r -= I_OC;
            p0_transpose_item(w_qp, 1024, 2048, WqpT, scr, r, lane);
        }
        cvt_f32_to_bf16_bulk(subk, SUBK, (size_t)2 * 128 * 128, (size_t)gtid, (size_t)NTHR);
        cvt_f32_to_bf16_bulk(peer_u, Ub, (size_t)16384 * 1024, (size_t)gtid, (size_t)NTHR);
        cvt_f32_to_bf16_bulk(peer_v, Vb, (size_t)16384 * 1024, (size_t)gtid, (size_t)NTHR);
        for (int m = gw; m < T; m += NGW) rms_row_to_bf16(x + (size_t)m * DM, g_mix, H + (size_t)m * DM, lane);
        for (int m = gw; m < MROWS; m += NGW) rms_row_to_bf16(mem + (size_t)m * DM, g_mem, MEMB + (size_t)m * DM, lane);
        __syncthreads();
    }
    SEAM(0);
    if (IN(1)) {
        if (DBG_MIX) { pg8::Gemm g{H, WinT, T, NIN, DM}; pg8::StaticOrder S; S.init(T, NIN, G, bx); pg8::EpiIn E{PQKV, GATES, b_gate};
          pg8::gemm_phase<pg8::EpiIn, pg8::StaticOrder, true, true>(lds + RING_OFF, g, S, E); }
        __syncthreads();
        if (DBG_CROSS) { pg8::Gemm g{MEMB, WkvcT, MROWS, 1024, DM}; pg8::StaticOrder S; S.init(MROWS, 1024, G, bx); pg8::EpiStore E{KVC, 1024};
          pg8::gemm_phase<pg8::EpiStore, pg8::StaticOrder, true, true>(lds + RING_OFF, g, S, E); }
    }
    SEAM(1);
    if (IN(2) && DBG_MIX) {
        for (int it = gw; it < NB * 8 * 16; it += NGW) { const int bh = it >> 4, blk = it & 15, b = bh >> 3, h = bh & 7;
            const bf16* kp = PQKV + (size_t)(b * SEQ + blk * 256) * QKVW + 2304 + 512 + h * 64 + lane; float s = 0.f;
            for (int j = 0; j < 256; ++j) s += bf2f(kp[(size_t)j * QKVW]);
            KMEAN[(size_t)it * 64 + lane] = s * (1.0f / 256.0f); }
    }
    SEAM(2);
    if (IN(3) && DBG_MIX) { phase_dil_simple(PQKV, rel_bias, ODIL, gtid, NTHR); phase_moba_simple(PQKV, KMEAN, rel_bias, OMOBA, gtid, NTHR); }
    SEAM(3);
    if (IN(4) && DBG_MIX) { pg8::Gemm g{ODIL, WaT, T, 1024, 256}; pg8::StaticOrder S; S.init(T, 1024, G, bx); pg8::EpiGate<false> E{MERGED, GATES, 0};
        pg8::gemm_phase<pg8::EpiGate<false>, pg8::StaticOrder, true, true>(lds + RING_OFF, g, S, E); }
    SEAM(4);
    if (IN(5) && DBG_MIX) { pg8::Gemm g{OMOBA, WbT, T, 1024, 512}; pg8::StaticOrder S; S.init(T, 1024, G, bx); pg8::EpiGate<true> E{MERGED, GATES, 1024};
        pg8::gemm_phase<pg8::EpiGate<true>, pg8::StaticOrder, true, true>(lds + RING_OFF, g, S, E); }
    SEAM(5);
    if (IN(6)) { pg8::Gemm g{MERGED, WoutT, T, 1024, 1024}; pg8::StaticOrder S; S.init(T, 1024, G, bx); pg8::EpiRes E{x, X1, 1024, (float)DBG_MIX};
        pg8::gemm_phase<pg8::EpiRes, pg8::StaticOrder, true, true>(lds + RING_OFF, g, S, E); }
    SEAM(6);
    if (IN(7)) { for (int m = gw; m < T; m += NGW) rms_row_to_bf16(X1 + (size_t)m * DM, g_cross, H + (size_t)m * DM, lane); }
    SEAM(7);
    if (IN(8) && DBG_CROSS) { pg8::Gemm g{H, WqcT, T, 512, 1024}; pg8::StaticOrder S; S.init(T, 512, G, bx); pg8::EpiStore E{QC, 512};
        pg8::gemm_phase<pg8::EpiStore, pg8::StaticOrder, true, true>(lds + RING_OFF, g, S, E); }
    SEAM(8);
    if (IN(9) && DBG_CROSS) { phase_cross_simple(QC, KVC, OC, gtid, NTHR); }
    SEAM(9);
    if (IN(10)) { pg8::Gemm g{OC, WocT, T, 1024, 512}; pg8::StaticOrder S; S.init(T, 1024, G, bx); pg8::EpiRes E{X1, X1, 1024, (float)DBG_CROSS};
        pg8::gemm_phase<pg8::EpiRes, pg8::StaticOrder, true, true>(lds + RING_OFF, g, S, E); }
    SEAM(10);
    if (IN(11)) { for (int m = gw; m < T; m += NGW) rms_row_to_bf16(X1 + (size_t)m * DM, g_ffn, H + (size_t)m * DM, lane); }
    SEAM(11);
    if (IN(12) && DBG_PEER) { pg8::Gemm g{H, WqpT, T, 2048, 1024}; pg8::StaticOrder S; S.init(T, 2048, G, bx); pg8::EpiStore E{QP, 2048};
        pg8::gemm_phase<pg8::EpiStore, pg8::StaticOrder, true, true>(lds + RING_OFF, g, S, E); }
    SEAM(12);
#if DBG_CHECK
    if (IN(13)) dbg_check_qp(H, w_qp, QP, (float*)(ctl + CW_DBG), gtid, NTHR, lane);
#endif
#if DBG_TOPK_SIMPLE
    if (IN(13) && DBG_PEER) { phase_topk_simple(QP, subk, EXP, EW, INV, lane, gw, NGW); }
#else
    if (IN(13) && DBG_PEER) { phase_topk(lds + RING_OFF, QP, SUBK, EXP, EW, INV, tid, lane, gw, NGW); }
#endif
    SEAM(13);
    if (IN(14)) { phase_peer(H, Ub, Vb, EXP, EW, INV, X1, g_final, out, lane, gw, NGW, (float)DBG_PEER, DBG_YPTR); }
#if DBG_CHECK
    if (IN(15)) dbg_check_gather(H, peer_u, peer_v, EXP, EW, INV, (const float*)(ws + WS_YDBG), (float*)(ctl + CW_DBG) + 2, gw, NGW, lane);
    if (IN(16)) dbg_encode(x, g_final, out, (const float*)(ctl + CW_DBG), gw, NGW, lane);
#endif
#undef IN
#undef SEAM
}

extern "C" void kernel_launch(void* const* d_in, const int* in_sizes, int n_in, void* d_out, int out_size, void* d_ws, size_t ws_size, hipStream_t stream) {
    static int grid = 0;
    if (grid == 0) {
        if (n_in != 20 || out_size != T * DM || ws_size < WS_END) { fprintf(stderr, "kernel_launch: unexpected shapes (n_in %d, out %d, ws %zu); nothing launched\n", n_in, out_size, ws_size); grid = -1; return; }
        int dev = 0, cus = 0, per_cu = 0;
        if (hipGetDevice(&dev) != hipSuccess || hipDeviceGetAttribute(&cus, hipDeviceAttributeMultiprocessorCount, dev) != hipSuccess) { grid = -1; return; }
        if (hipFuncSetAttribute((const void*)fwd, hipFuncAttributeMaxDynamicSharedMemorySize, LDS_BYTES) != hipSuccess) { fprintf(stderr, "kernel_launch: hipFuncSetAttribute failed\n"); grid = -1; return; }
        if (hipOccupancyMaxActiveBlocksPerMultiprocessor(&per_cu, (const void*)fwd, NWAVES * 64, LDS_BYTES) != hipSuccess || per_cu < 1) { fprintf(stderr, "kernel_launch: occupancy query says %d\n", per_cu); }
        (void)hipGetLastError();
        grid = cus;
    }
    if (grid < 0) return;
    if (hipMemsetAsync((char*)d_ws + WS_CTL, 0, CTL_ZERO_BYTES, stream) != hipSuccess) return;
    Args a{};
    for (int i = 0; i < 20; ++i) a.in[i] = (const float*)d_in[i];
    a.out = (float*)d_out; a.ws = (unsigned char*)d_ws;
#if MK_ONE_LAUNCH
    a.ph_lo = 0; a.ph_hi = NPH;
    hipLaunchKernelGGL(fwd, dim3(grid), dim3(NWAVES * 64), LDS_BYTES, stream, a);
#else
    for (int p = 0; p < NPH + (DBG_CHECK ? 2 : 0); ++p) { a.ph_lo = p; a.ph_hi = p + 1; hipLaunchKernelGGL(fwd, dim3(grid), dim3(NWAVES * 64), LDS_BYTES, stream, a); }
#endif
}
```

```cpp
#include <hip/hip_runtime.h>
#include <cstdio>
#include <cstdint>
#include <cmath>
namespace pg8 {
#define PG8_LAS __attribute__((address_space(3)))
typedef unsigned short bf16_t;
typedef short bf16x8 __attribute__((ext_vector_type(8)));
typedef float f32x4 __attribute__((ext_vector_type(4)));
typedef unsigned u32x4 __attribute__((ext_vector_type(4)));
constexpr int BM = 256, BK = 64, HALF = 128, HTB = HALF * BK * 2  , STAGE_BYTES = 8 * HTB, NXCD = 8, WGM = 8;

__host__ __device__ __forceinline__ int lds_byte(int r, int c) { const int st = (r >> 4) * 2 + (c >> 5), rr = r & 15, cc = c & 31, ob = rr * 64 + cc * 2; return st * 1024 + (ob ^ (((ob >> 9) & 1) << 5)); }
__host__ __device__ __forceinline__ void stage_rc(int b, int& R, int& C) { const int st = b / 1024, sb = b % 1024, swz = sb ^ (((sb >> 9) & 1) << 5); R = (st >> 1) * 16 + swz / 64; C = (st & 1) * 32 + (swz % 64) / 2; }
__host__ __device__ __forceinline__ int perm32(int rho) { const int n = rho >> 4, i = rho & 15; return 8 * (i >> 2) + 4 * n + (i & 3); }

struct Unit { int pm, pn; };
struct Gemm { const bf16_t* A; const bf16_t* Bt; int M, N, K; };

struct StaticOrder {
    int nM, nN, nwg, G, c;
    __host__ __device__ void init(int M, int N, int G_, int c_) { nM = M / BM; nN = N / BM; nwg = nM * nN; G = G_; c = c_; }
    __host__ __device__ bool next(int i, Unit& u) const {
        const long L = (long)i * G + c; if (L >= nwg) return false;
        int wgid = (int)L; { const int q = nwg / NXCD, r = nwg % NXCD, xcd = wgid % NXCD, off = wgid / NXCD; wgid = (xcd < r ? xcd * (q + 1) : r * (q + 1) + (xcd - r) * q) + off; }
        const int nig = WGM * nN, gid = wgid / nig, fm = gid * WGM, gsz = (nM - fm) < WGM ? (nM - fm) : WGM;
        u.pm = fm + ((wgid % nig) % gsz); u.pn = (wgid % nig) / gsz; return true;
    }
    __device__ __forceinline__ void a_ready(const Unit&) const {}
    __device__ __forceinline__ void done(const Unit&) const {}
};

__device__ __forceinline__ unsigned cvt_pk_bf16(float lo, float hi) { unsigned r; asm volatile("v_cvt_pk_bf16_f32 %0, %1, %2" : "=v"(r) : "v"(lo), "v"(hi)); return r; }
typedef float f32x2 __attribute__((ext_vector_type(2)));
__device__ __forceinline__ float bf_lo(unsigned w) { return __uint_as_float(w << 16); }
__device__ __forceinline__ float bf_hi(unsigned w) { return __uint_as_float(w & 0xffff0000u); }
__device__ __forceinline__ float sigmoidf_(float x) { return 1.0f / (1.0f + __expf(-x)); }
struct EpiStore {
    static constexpr bool PERM = true, AFTER_DRAIN = false;
    bf16_t* O; int ldc;
    __device__ __forceinline__ void operator()(const f32x4 (&acc)[2][2][4][2], const Unit& u, int wr, int wc, int fr, int fq) const {
        const int row0 = u.pm * BM + wr * 64 + fr, col0 = u.pn * BM + wc * 32 + 8 * fq;
#pragma unroll
        for (int ai = 0; ai < 2; ++ai)
#pragma unroll
            for (int m = 0; m < 4; ++m) { bf16_t* rowp = O + (size_t)(row0 + ai * HALF + m * 16) * ldc + col0;
#pragma unroll
                for (int bj = 0; bj < 2; ++bj) { const f32x4 v0 = acc[ai][bj][m][0], v1 = acc[ai][bj][m][1];
                    u32x4 w; w.x = cvt_pk_bf16(v0[0], v0[1]); w.y = cvt_pk_bf16(v0[2], v0[3]); w.z = cvt_pk_bf16(v1[0], v1[1]); w.w = cvt_pk_bf16(v1[2], v1[3]);
                    *(u32x4*)(rowp + bj * HALF) = w; } }
    }
};
struct EpiIn {
    static constexpr bool PERM = true, AFTER_DRAIN = false;
    bf16_t* P; bf16_t* G; const float* bgate;
    __device__ __forceinline__ void operator()(const f32x4 (&acc)[2][2][4][2], const Unit& u, int wr, int wc, int fr, int fq) const {
        const int row0 = u.pm * BM + wr * 64 + fr;
        if (u.pn < 15) {
            const int col0 = u.pn * BM + wc * 32 + 8 * fq;
#pragma unroll
            for (int ai = 0; ai < 2; ++ai)
#pragma unroll
                for (int m = 0; m < 4; ++m) { bf16_t* rowp = P + (size_t)(row0 + ai * HALF + m * 16) * 3840 + col0;
#pragma unroll
                    for (int bj = 0; bj < 2; ++bj) { const f32x4 v0 = acc[ai][bj][m][0], v1 = acc[ai][bj][m][1];
                        u32x4 w; w.x = cvt_pk_bf16(v0[0], v0[1]); w.y = cvt_pk_bf16(v0[2], v0[3]); w.z = cvt_pk_bf16(v1[0], v1[1]); w.w = cvt_pk_bf16(v1[2], v1[3]);
                        *(u32x4*)(rowp + bj * HALF) = w; } }
        } else {
            const int col0 = (u.pn - 15) * BM + wc * 32 + 8 * fq;
            f32x4 bv[2][2];
#pragma unroll
            for (int bj = 0; bj < 2; ++bj)
#pragma unroll
                for (int n = 0; n < 2; ++n) bv[bj][n] = *(const f32x4*)(bgate + col0 + bj * HALF + 4 * n);
#pragma unroll
            for (int ai = 0; ai < 2; ++ai)
#pragma unroll
                for (int m = 0; m < 4; ++m) { bf16_t* rowp = G + (size_t)(row0 + ai * HALF + m * 16) * 2048 + col0;
#pragma unroll
                    for (int bj = 0; bj < 2; ++bj) { const f32x4 v0 = acc[ai][bj][m][0] + bv[bj][0], v1 = acc[ai][bj][m][1] + bv[bj][1];
                        u32x4 w; w.x = cvt_pk_bf16(sigmoidf_(v0[0]), sigmoidf_(v0[1])); w.y = cvt_pk_bf16(sigmoidf_(v0[2]), sigmoidf_(v0[3]));
                        w.z = cvt_pk_bf16(sigmoidf_(v1[0]), sigmoidf_(v1[1])); w.w = cvt_pk_bf16(sigmoidf_(v1[2]), sigmoidf_(v1[3]));
                        *(u32x4*)(rowp + bj * HALF) = w; } }
        }
    }
};
template <bool ADD> struct EpiGate {
    static constexpr bool PERM = true, AFTER_DRAIN = false;
    bf16_t* O; const bf16_t* G; int gcol;
    __device__ __forceinline__ void operator()(const f32x4 (&acc)[2][2][4][2], const Unit& u, int wr, int wc, int fr, int fq) const {
        const int row0 = u.pm * BM + wr * 64 + fr, col0 = u.pn * BM + wc * 32 + 8 * fq;
#pragma unroll
        for (int ai = 0; ai < 2; ++ai)
#pragma unroll
            for (int m = 0; m < 4; ++m) { const size_t row = (size_t)(row0 + ai * HALF + m * 16); bf16_t* rowp = O + row * 1024 + col0; const bf16_t* gp = G + row * 2048 + gcol + col0;
#pragma unroll
                for (int bj = 0; bj < 2; ++bj) { const f32x4 v0 = acc[ai][bj][m][0], v1 = acc[ai][bj][m][1];
                    const u32x4 g = *(const u32x4*)(gp + bj * HALF);
                    float r0 = bf_lo(g.x) * v0[0], r1 = bf_hi(g.x) * v0[1], r2 = bf_lo(g.y) * v0[2], r3 = bf_hi(g.y) * v0[3];
                    float r4 = bf_lo(g.z) * v1[0], r5 = bf_hi(g.z) * v1[1], r6 = bf_lo(g.w) * v1[2], r7 = bf_hi(g.w) * v1[3];
                    if (ADD) { const u32x4 p = *(const u32x4*)(rowp + bj * HALF);
                        r0 += bf_lo(p.x); r1 += bf_hi(p.x); r2 += bf_lo(p.y); r3 += bf_hi(p.y); r4 += bf_lo(p.z); r5 += bf_hi(p.z); r6 += bf_lo(p.w); r7 += bf_hi(p.w); }
                    u32x4 w; w.x = cvt_pk_bf16(r0, r1); w.y = cvt_pk_bf16(r2, r3); w.z = cvt_pk_bf16(r4, r5); w.w = cvt_pk_bf16(r6, r7);
                    *(u32x4*)(rowp + bj * HALF) = w; } }
    }
};
struct EpiRes {
    static constexpr bool PERM = false, AFTER_DRAIN = false;
    const float* base; float* out; int ldc; float sc;
    __device__ __forceinline__ void operator()(const f32x4 (&acc)[2][2][4][2], const Unit& u, int wr, int wc, int fr, int fq) const {
        const int col0 = u.pn * BM + wc * 32 + 4 * fq;
#pragma unroll
        for (int ai = 0; ai < 2; ++ai)
#pragma unroll
            for (int m = 0; m < 4; ++m) { const size_t off = (size_t)(u.pm * BM + ai * HALF + wr * 64 + m * 16 + fr) * ldc + col0;
#pragma unroll
                for (int bj = 0; bj < 2; ++bj)
#pragma unroll
                    for (int n = 0; n < 2; ++n) { const f32x4 bs = *(const f32x4*)(base + off + bj * HALF + n * 16); *(f32x4*)(out + off + bj * HALF + n * 16) = (sc != 0.f) ? bs + acc[ai][bj][m][n] * sc : bs; } }
    }
};
template <class Epi, class Sched, bool ALIGN_EPI = false, bool SP2 = false>
__device__ __forceinline__ void gemm_phase(PG8_LAS unsigned char* lds, const Gemm g, const Sched& S, const Epi& E) {
    const int tid = threadIdx.x, wid = __builtin_amdgcn_readfirstlane(tid >> 6), lane = tid & 63, wr = wid >> 2, wc = wid & 3, fr = lane & 15, fq = lane >> 4;
    const int K = g.K, nt = K / BK;
    unsigned voffA[2], voffB[2];
#pragma unroll
    for (int i = 0; i < 2; ++i) { int R, C; stage_rc(tid * 16 + i * 8192, R, C); const int Rb = Epi::PERM ? ((R & ~31) + perm32(R & 31)) : R;
        voffA[i] = (unsigned)(R * K + C) * 2u; voffB[i] = (unsigned)(Rb * K + C) * 2u; }
    const size_t kstep = (size_t)(BK * 2);
    const size_t hstep = (size_t)HALF * K * 2;
    const size_t tstep = 2 * hstep;
    const unsigned ldsw = (unsigned)wid * 1024u;
    const int aoff = lds_byte(wr * 64 + fr, fq * 8), boff = lds_byte(wc * 32 + fr, fq * 8);
#define PG8_SA(b, h) (((b) * 2 + (h)) * HTB)
#define PG8_SB(b, h) ((4 + (b) * 2 + (h)) * HTB)
#define PG8_STAGE(bufoff, gbase, voff) do { _Pragma("unroll") for (int _i = 0; _i < 2; ++_i) \
        __builtin_amdgcn_global_load_lds((const unsigned*)((const char*)(gbase) + (voff)[_i]), (PG8_LAS unsigned*)(lds + (bufoff) + ldsw + _i * 8192), 16, 0, 0); } while (0)
#define PG8_LDA(dst, b, h) do { _Pragma("unroll") for (int m = 0; m < 4; ++m) _Pragma("unroll") for (int k = 0; k < 2; ++k) dst[m][k] = *(const PG8_LAS bf16x8*)(lds + PG8_SA(b, h) + aoff + m * 2048 + k * 1024); } while (0)
#define PG8_LDB(dst, b, h) do { _Pragma("unroll") for (int n = 0; n < 2; ++n) _Pragma("unroll") for (int k = 0; k < 2; ++k) dst[n][k] = *(const PG8_LAS bf16x8*)(lds + PG8_SB(b, h) + boff + n * 2048 + k * 1024); } while (0)
#define PG8_MMA(ai, bj, At, Bt) do { __builtin_amdgcn_s_setprio(1); _Pragma("unroll") for (int m = 0; m < 4; ++m) _Pragma("unroll") for (int n = 0; n < 2; ++n) _Pragma("unroll") for (int k = 0; k < 2; ++k) \
        acc[ai][bj][m][n] = __builtin_amdgcn_mfma_f32_16x16x32_bf16(Bt[n][k], At[m][k], acc[ai][bj][m][n], 0, 0, 0); __builtin_amdgcn_s_setprio(0); } while (0)
#define PG8_WAIT_V(n) asm volatile("s_waitcnt vmcnt(" #n ")" ::: "memory")
#define PG8_WAIT_L(n) asm volatile("s_waitcnt lgkmcnt(" #n ")" ::: "memory")
#define PG8_BAR __builtin_amdgcn_s_barrier()
#define PG8_SCHED __builtin_amdgcn_sched_barrier(0)
    Unit cur, nxt; int ui = 0;
    if (!S.next(0, cur)) return;
    f32x4 acc[2][2][4][2];
#pragma unroll
    for (int a = 0; a < 2; ++a)
#pragma unroll
        for (int b = 0; b < 2; ++b)
#pragma unroll
            for (int m = 0; m < 4; ++m)
#pragma unroll
                for (int n = 0; n < 2; ++n) acc[a][b][m][n] = (f32x4){0.f, 0.f, 0.f, 0.f};
    bf16x8 At[4][2], B0[2][2], B1[2][2];
    const char* cA = (const char*)g.A + (size_t)cur.pm * tstep; const char* cB = (const char*)g.Bt + (size_t)cur.pn * tstep;
    S.a_ready(cur);
    if constexpr (SP2) {
        PG8_STAGE(PG8_SB(0, 0), cB, voffB); PG8_STAGE(PG8_SB(0, 1), cB + hstep, voffB); PG8_STAGE(PG8_SA(0, 0), cA, voffA); PG8_STAGE(PG8_SA(0, 1), cA + hstep, voffA);
        if (wr == 1) PG8_BAR;
        PG8_WAIT_V(2); PG8_BAR;
        PG8_STAGE(PG8_SB(1, 0), cB + kstep, voffB); PG8_STAGE(PG8_SA(1, 0), cA + kstep, voffA); PG8_STAGE(PG8_SB(1, 1), cB + hstep + kstep, voffB);
        PG8_WAIT_V(6); PG8_BAR;
    } else {
        PG8_STAGE(PG8_SB(0, 0), cB, voffB); PG8_STAGE(PG8_SA(0, 0), cA, voffA); PG8_STAGE(PG8_SB(0, 1), cB + hstep, voffB); PG8_STAGE(PG8_SA(0, 1), cA + hstep, voffA);
        if (wr == 1) PG8_BAR;
        PG8_WAIT_V(4); PG8_BAR;
        PG8_STAGE(PG8_SB(1, 0), cB + kstep, voffB); PG8_STAGE(PG8_SA(1, 0), cA + kstep, voffA); PG8_STAGE(PG8_SB(1, 1), cB + hstep + kstep, voffB);
        PG8_WAIT_V(6); PG8_BAR;
    }
    for (;;) {
        const bool has_next = S.next(ui + 1, nxt);
        const char* nA = has_next ? (const char*)g.A + (size_t)nxt.pm * tstep : cA; const char* nB = has_next ? (const char*)g.Bt + (size_t)nxt.pn * tstep : cB;
        for (int t = 0; t < nt; t += 2) {
            const bool last = (t == nt - 2);
            const char* a1 = cA + (size_t)(t + 1) * kstep;
            const char* a2 = last ? nA : cA + (size_t)(t + 2) * kstep; const char* b2 = last ? nB : cB + (size_t)(t + 2) * kstep;
            const char* a3 = a2 + kstep; const char* b3 = b2 + kstep;
            if (last && has_next) S.a_ready(nxt);
            if constexpr (SP2) {
            PG8_LDB(B0, 0, 0); PG8_LDB(B1, 0, 1); PG8_SCHED; PG8_LDA(At, 0, 0); PG8_STAGE(PG8_SA(1, 1), a1 + hstep, voffA);
            PG8_WAIT_V(8); PG8_WAIT_L(0); PG8_BAR; PG8_MMA(0, 0, At, B0); PG8_MMA(0, 1, At, B1); PG8_BAR; PG8_SCHED;
            PG8_LDA(At, 0, 1); PG8_STAGE(PG8_SB(0, 0), b2, voffB); PG8_STAGE(PG8_SB(0, 1), b2 + hstep, voffB); PG8_STAGE(PG8_SA(0, 0), a2, voffA);
            PG8_WAIT_V(8); PG8_WAIT_L(0); PG8_BAR; PG8_MMA(1, 0, At, B0); PG8_MMA(1, 1, At, B1); PG8_BAR; PG8_SCHED;
            PG8_LDB(B0, 1, 0); PG8_LDB(B1, 1, 1); PG8_SCHED; PG8_LDA(At, 1, 0); PG8_STAGE(PG8_SA(0, 1), a2 + hstep, voffA);
            PG8_WAIT_V(8); PG8_WAIT_L(0); PG8_BAR; PG8_MMA(0, 0, At, B0); PG8_MMA(0, 1, At, B1); PG8_BAR; PG8_SCHED;
            PG8_LDA(At, 1, 1); PG8_STAGE(PG8_SB(1, 0), b3, voffB); PG8_STAGE(PG8_SB(1, 1), b3 + hstep, voffB); PG8_STAGE(PG8_SA(1, 0), a3, voffA);
            PG8_WAIT_V(8); PG8_WAIT_L(0); PG8_BAR; PG8_MMA(1, 0, At, B0); PG8_MMA(1, 1, At, B1); PG8_BAR; PG8_SCHED;
            } else {
            PG8_LDB(B0, 0, 0); PG8_SCHED; PG8_LDA(At, 0, 0); PG8_STAGE(PG8_SA(1, 1), a1 + hstep, voffA);
            PG8_WAIT_L(8); PG8_BAR; PG8_WAIT_L(0); PG8_MMA(0, 0, At, B0); PG8_BAR; PG8_SCHED;
            PG8_LDB(B1, 0, 1); PG8_STAGE(PG8_SB(0, 0), b2, voffB);
            PG8_BAR; PG8_WAIT_L(0); PG8_MMA(0, 1, At, B1); PG8_BAR;
            PG8_LDA(At, 0, 1); PG8_STAGE(PG8_SA(0, 0), a2, voffA);
            PG8_BAR; PG8_WAIT_L(0); PG8_MMA(1, 0, At, B0); PG8_BAR; PG8_SCHED;
            PG8_STAGE(PG8_SB(0, 1), b2 + hstep, voffB);
            PG8_WAIT_V(6); PG8_BAR; PG8_MMA(1, 1, At, B1); PG8_BAR;
            PG8_LDB(B0, 1, 0); PG8_SCHED; PG8_LDA(At, 1, 0); PG8_STAGE(PG8_SA(0, 1), a2 + hstep, voffA);
            PG8_WAIT_L(8); PG8_BAR; PG8_WAIT_L(0); PG8_MMA(0, 0, At, B0); PG8_BAR; PG8_SCHED;
            PG8_LDB(B1, 1, 1); PG8_STAGE(PG8_SB(1, 0), b3, voffB);
            PG8_BAR; PG8_WAIT_L(0); PG8_MMA(0, 1, At, B1); PG8_BAR;
            PG8_LDA(At, 1, 1); PG8_STAGE(PG8_SA(1, 0), a3, voffA);
            PG8_BAR; PG8_WAIT_L(0); PG8_MMA(1, 0, At, B0); PG8_BAR; PG8_SCHED;
            PG8_STAGE(PG8_SB(1, 1), b3 + hstep, voffB);
            PG8_WAIT_V(6); PG8_BAR; PG8_MMA(1, 1, At, B1); PG8_BAR;
            }
        }
        if constexpr (ALIGN_EPI) { if (wr == 0) PG8_BAR; }
        if constexpr (!Epi::AFTER_DRAIN) { E(acc, cur, wr, wc, fr, fq); S.done(cur); }
        if (!has_next) break;
#pragma unroll
        for (int a = 0; a < 2; ++a)
#pragma unroll
            for (int b = 0; b < 2; ++b)
#pragma unroll
                for (int m = 0; m < 4; ++m)
#pragma unroll
                    for (int n = 0; n < 2; ++n) acc[a][b][m][n] = (f32x4){0.f, 0.f, 0.f, 0.f};
        cur = nxt; cA = nA; cB = nB; ++ui;
        if constexpr (ALIGN_EPI) { if (wr == 1) PG8_BAR; }
    }
    PG8_WAIT_V(0);
    if constexpr (!ALIGN_EPI) { if (wr == 0) PG8_BAR; }
    PG8_BAR;
    if constexpr (Epi::AFTER_DRAIN) { E.fused(acc, cur, wr, wc, fr, fq, lds, wid, lane); S.done(cur); }
#undef PG8_SA
#undef PG8_SB
#undef PG8_STAGE
#undef PG8_LDA
#undef PG8_LDB
#undef PG8_MMA
#undef PG8_WAIT_V
#undef PG8_WAIT_L
#undef PG8_BAR
#undef PG8_SCHED
}
}

constexpr int NB = 8, SEQ = 4096, DM = 1024, T = NB * SEQ, NMEM = 256, MROWS = NB * NMEM;
constexpr int QKVW = 3840, GATEW = 2048, NIN = 5888;
constexpr float RMS_EPS = 1e-6f;
constexpr int NPH = 15;
#ifndef DBG_MIX
#define DBG_MIX 1
#endif
#ifndef DBG_CROSS
#define DBG_CROSS 1
#endif
#ifndef DBG_PEER
#define DBG_PEER 1
#endif
#ifndef DBG_TOPK_SIMPLE
#define DBG_TOPK_SIMPLE 0
#endif
#ifndef DBG_CHECK
#define DBG_CHECK 0
#endif
#if DBG_CHECK
#define DBG_YPTR ((float*)(ws + 452 * MiB))
#else
#define DBG_YPTR ((float*)nullptr)
#endif
#ifndef MK_ONE_LAUNCH
#define MK_ONE_LAUNCH 1
#endif
constexpr size_t MiB = 1u << 20;
constexpr size_t WS_CTL = 0, CTL_ZERO_BYTES = 1 * MiB;
constexpr size_t WS_KMEAN = 1 * MiB;
constexpr size_t WS_INV = 2 * MiB;
constexpr size_t WS_WIN = 3 * MiB;
constexpr size_t WS_WA = 15 * MiB, WS_WB = 16 * MiB, WS_WOUT = 17 * MiB, WS_WQC = 19 * MiB, WS_WKVC = 20 * MiB, WS_WOC = 22 * MiB, WS_WQP = 23 * MiB, WS_SUBK = 27 * MiB;
constexpr size_t WS_U = 28 * MiB, WS_V = 60 * MiB;
constexpr size_t WS_H = 92 * MiB;
constexpr size_t WS_MEMB = 156 * MiB, WS_KVC = 160 * MiB;
constexpr size_t WS_ODIL = 164 * MiB, WS_OMOBA = 180 * MiB;
constexpr size_t WS_PQKV = 212 * MiB;
constexpr size_t WS_MERGED = WS_PQKV, WS_X1 = WS_PQKV + 64 * MiB, WS_QC = WS_PQKV + 192 * MiB, WS_OC = WS_ODIL;
constexpr size_t WS_EXP = WS_PQKV, WS_EW = WS_PQKV + 16 * MiB;
constexpr size_t WS_END = 452 * MiB;
constexpr int CW_TMO = 0, CW_CODE = 1, CW_BAR = 4096;
constexpr int RING_OFF = 0, RING_BYTES = 131072;
constexpr int LDSCTL_OFF = RING_BYTES, MISC_OFF = LDSCTL_OFF + 320;
constexpr int LDS_BYTES = 147456;
constexpr int NWAVES = 8;

#define GAS __attribute__((address_space(1)))
#define LAS __attribute__((address_space(3)))
typedef unsigned short bf16;
typedef unsigned v4u __attribute__((ext_vector_type(4)));
typedef float f32x4 __attribute__((ext_vector_type(4)));
typedef float f32x16 __attribute__((ext_vector_type(16)));
typedef short bf16x8 __attribute__((ext_vector_type(8)));
typedef __bf16 bf2_t __attribute__((ext_vector_type(2)));
typedef GAS unsigned gu32;
#define RLX_AGENT __ATOMIC_RELAXED, __HIP_MEMORY_SCOPE_AGENT
#define LDS_WAIT() asm volatile("s_waitcnt lgkmcnt(0)" ::: "memory")
#define VM_WAIT() asm volatile("s_waitcnt vmcnt(0)" ::: "memory")
__device__ __forceinline__ unsigned pk2(float lo, float hi) { return pg8::cvt_pk_bf16(lo, hi); }
__device__ __forceinline__ float bf_lo(unsigned w) { return __uint_as_float(w << 16); }
__device__ __forceinline__ float bf_hi(unsigned w) { return __uint_as_float(w & 0xffff0000u); }
__device__ __forceinline__ float bf2f(bf16 b) { return __uint_as_float((unsigned)b << 16); }

#define XB_TMO      128
#define XB_XCNT(j)  (256  + 64 * (j))
#define XB_XSUB(j)  (1280 + 64 * (j))
#define XB_XGEN(j)  (2304 + 64 * (j))
#define XB_TOP      3328
#define XB_TOPGEN   3392
#define XCD_BAR_WORDS 3456
#define XB_SPIN_CAP (1u << 18)

__device__ __forceinline__ unsigned xb_ld(unsigned* p)              { return __hip_atomic_load(p, __ATOMIC_RELAXED, __HIP_MEMORY_SCOPE_AGENT); }
__device__ __forceinline__ unsigned xb_add(unsigned* p, unsigned v) { return __hip_atomic_fetch_add(p, v, __ATOMIC_RELAXED, __HIP_MEMORY_SCOPE_AGENT); }
__device__ __forceinline__ unsigned xb_xcc_id() { return (unsigned)__builtin_amdgcn_s_getreg((3 << 11) | 20) & 0xFu; }
#define XB_SPIN(cond, bar) do { unsigned _sp = 0; while (cond) { __builtin_amdgcn_s_sleep(1); \
    if ((++_sp & 255u) == 0u) { if (xb_ld(&(bar)[XB_TMO])) break; if (_sp > XB_SPIN_CAP) { atomicAdd(&(bar)[XB_TMO], 1u); break; } } } } while (0)

struct XcdBarrier {
    unsigned* bar; unsigned x;
    volatile LAS unsigned* st;
};

__device__ __forceinline__ XcdBarrier xcd_barrier_post(unsigned* bar, volatile LAS unsigned* st) {
    XcdBarrier b; b.bar = bar; b.x = xb_xcc_id(); b.st = st;
    if (threadIdx.x == 0) (void)xb_add(&bar[XB_XCNT(b.x)], 1u);
    return b;
}
__device__ __forceinline__ void xcd_barrier_complete(unsigned* bar, unsigned x, unsigned& nloc, unsigned& nx) {
    const unsigned G = gridDim.x * gridDim.y * gridDim.z;
    unsigned sum, cnt, mine, sp = 0u;
    for (;;) {
        sum = 0u; cnt = 0u; mine = 0u;
#pragma unroll
        for (unsigned j = 0; j < 16; ++j) { const unsigned c = xb_ld(&bar[XB_XCNT(j)]); sum += c; cnt += (c > 0u) ? 1u : 0u; mine = (j == x) ? c : mine; }
        if (sum == G) break;
        __builtin_amdgcn_s_sleep(1);
        if ((++sp & 255u) == 0u) { if (xb_ld(&bar[XB_TMO])) break; if (sp > XB_SPIN_CAP) { atomicAdd(&bar[XB_TMO], 1u); break; } }
    }
    nloc = mine > 0u ? mine : 1u; nx = cnt > 0u ? cnt : 1u;
}

__device__ __forceinline__ void xcd_barrier(const XcdBarrier& b) {
    asm volatile("s_waitcnt vmcnt(0)" ::: "memory");
    __syncthreads();
    if (threadIdx.x == 0) {
        unsigned* bar = b.bar;
        __builtin_amdgcn_s_waitcnt(0);
        unsigned nloc = b.st[0], nx = b.st[1];
        if (nloc == 0u) { xcd_barrier_complete(bar, b.x, nloc, nx); b.st[0] = nloc; b.st[1] = nx; }
        const unsigned old = xb_add(&bar[XB_XSUB(b.x)], 1u);
        const unsigned gen = old / nloc;
        if (old + 1u == (gen + 1u) * nloc) {
            __builtin_amdgcn_fence(__ATOMIC_RELEASE, "agent");
            asm volatile("s_waitcnt vmcnt(0)" ::: "memory");
            const unsigned og = xb_add(&bar[XB_TOP], 1u);
            const unsigned tg = og / nx;
            if (og + 1u == (tg + 1u) * nx) xb_add(&bar[XB_TOPGEN], 1u);
            else XB_SPIN(xb_ld(&bar[XB_TOPGEN]) == tg, bar);
            __builtin_amdgcn_fence(__ATOMIC_ACQUIRE, "agent");
            xb_add(&bar[XB_XGEN(b.x)], 1u);
            asm volatile("s_waitcnt vmcnt(0)" ::: "memory");
        } else {
            XB_SPIN(xb_ld(&bar[XB_XGEN(b.x)]) == gen, bar);
            __builtin_amdgcn_fence(__ATOMIC_ACQUIRE, "agent");
            asm volatile("s_waitcnt vmcnt(0)" ::: "memory");
        }
    }
    __syncthreads();
}

__device__ __forceinline__ float wave_sum(float v) {
#pragma unroll
    for (int o = 1; o < 64; o <<= 1) v += __shfl_xor(v, o);
    return v;
}
__device__ __forceinline__ int t5_bucket(int n) {
    int b = n;
    if (n >= 16) { b = 16 + (n >= 22) + (n >= 30) + (n >= 40) + (n >= 54) + (n >= 73) + (n >= 99) + (n >= 134) + (n >= 182) + (n >= 246) + (n >= 332) + (n >= 450) + (n >= 609) + (n >= 825) + (n >= 1117) + (n >= 1513); }
    return b;
}
__device__ __forceinline__ void p0_transpose_item(const float* W, int K, int N, bf16* WT, LAS float* scr, int item, int lane) {
    const int nblk = N / 32, kb = item / nblk, nb = item % nblk, k0 = 64 * kb, n0 = 32 * nb;
#pragma unroll 8
    for (int i = 0; i < 32; ++i) { const int kk = 2 * i + (lane >> 5); scr[kk * 33 + (lane & 31)] = W[(size_t)(k0 + kk) * N + n0 + (lane & 31)]; }
    LDS_WAIT(); asm volatile("" ::: "memory");
    const int c = lane & 7;
#pragma unroll
    for (int j = 0; j < 4; ++j) { const int n = (lane >> 3) + 8 * j; const LAS float* s = scr + (8 * c) * 33 + n;
        v4u o; o.x = pk2(s[0 * 33], s[1 * 33]); o.y = pk2(s[2 * 33], s[3 * 33]); o.z = pk2(s[4 * 33], s[5 * 33]); o.w = pk2(s[6 * 33], s[7 * 33]);
        *(GAS v4u*)(WT + (size_t)(n0 + n) * K + k0 + 8 * c) = o; }
    LDS_WAIT(); asm volatile("" ::: "memory");
}
__device__ __forceinline__ void rms_row_to_bf16(const float* xrow, const float* g, bf16* orow, int lane) {
    const f32x4* xr = (const f32x4*)xrow + lane; const f32x4* gr = (const f32x4*)g + lane;
    f32x4 v[4]; float s = 0.f;
#pragma unroll
    for (int j = 0; j < 4; ++j) { v[j] = xr[64 * j]; s += (v[j].x * v[j].x + v[j].y * v[j].y) + (v[j].z * v[j].z + v[j].w * v[j].w); }
    const float rinv = rsqrtf(wave_sum(s) * (1.f / 1024.f) + RMS_EPS);
    unsigned long long* o8 = (unsigned long long*)orow + lane;
#pragma unroll
    for (int j = 0; j < 4; ++j) { const f32x4 gv = gr[64 * j]; o8[64 * j] = (unsigned long long)pk2(v[j].x * rinv * gv.x, v[j].y * rinv * gv.y) | ((unsigned long long)pk2(v[j].z * rinv * gv.z, v[j].w * rinv * gv.w) << 32); }
}
__device__ __forceinline__ void cvt_f32_to_bf16_bulk(const float* src, bf16* dst, size_t n, size_t gtid, size_t nthr) {
    for (size_t i = gtid; i < n / 8; i += nthr) { const f32x4 a = ((const f32x4*)src)[2 * i], b = ((const f32x4*)src)[2 * i + 1];
        v4u o; o.x = pk2(a.x, a.y); o.y = pk2(a.z, a.w); o.z = pk2(b.x, b.y); o.w = pk2(b.z, b.w); ((v4u*)dst)[i] = o; }
}
__device__ __forceinline__ void os_step(const float (&q)[64], float (&o)[64], float& m, float& l, const bf16* krow, const bf16* vrow, float bias) {
    const v4u* kp = (const v4u*)krow; float s = 0.f;
#pragma unroll
    for (int c = 0; c < 8; ++c) { const v4u w = kp[c];
        s += q[8 * c + 0] * bf_lo(w.x) + q[8 * c + 1] * bf_hi(w.x) + q[8 * c + 2] * bf_lo(w.y) + q[8 * c + 3] * bf_hi(w.y)
           + q[8 * c + 4] * bf_lo(w.z) + q[8 * c + 5] * bf_hi(w.z) + q[8 * c + 6] * bf_lo(w.w) + q[8 * c + 7] * bf_hi(w.w); }
    s += bias;
    const float mn = fmaxf(m, s), al = __expf(m - mn), p = __expf(s - mn);
    l = l * al + p; m = mn;
    const v4u* vp = (const v4u*)vrow;
#pragma unroll
    for (int c = 0; c < 8; ++c) { const v4u w = vp[c];
        o[8 * c + 0] = o[8 * c + 0] * al + p * bf_lo(w.x); o[8 * c + 1] = o[8 * c + 1] * al + p * bf_hi(w.x);
        o[8 * c + 2] = o[8 * c + 2] * al + p * bf_lo(w.y); o[8 * c + 3] = o[8 * c + 3] * al + p * bf_hi(w.y);
        o[8 * c + 4] = o[8 * c + 4] * al + p * bf_lo(w.z); o[8 * c + 5] = o[8 * c + 5] * al + p * bf_hi(w.z);
        o[8 * c + 6] = o[8 * c + 6] * al + p * bf_lo(w.w); o[8 * c + 7] = o[8 * c + 7] * al + p * bf_hi(w.w); }
}
__device__ __forceinline__ void load_q64(float (&q)[64], const bf16* qrow, float scale) {
    const v4u* qp = (const v4u*)qrow;
#pragma unroll
    for (int c = 0; c < 8; ++c) { const v4u w = qp[c];
        q[8 * c + 0] = bf_lo(w.x) * scale; q[8 * c + 1] = bf_hi(w.x) * scale; q[8 * c + 2] = bf_lo(w.y) * scale; q[8 * c + 3] = bf_hi(w.y) * scale;
        q[8 * c + 4] = bf_lo(w.z) * scale; q[8 * c + 5] = bf_hi(w.z) * scale; q[8 * c + 6] = bf_lo(w.w) * scale; q[8 * c + 7] = bf_hi(w.w) * scale; }
}
__device__ __forceinline__ void store_o64(const float (&o)[64], float inv, bf16* orow) {
    v4u* op = (v4u*)orow;
#pragma unroll
    for (int c = 0; c < 8; ++c) { v4u w; w.x = pk2(o[8 * c + 0] * inv, o[8 * c + 1] * inv); w.y = pk2(o[8 * c + 2] * inv, o[8 * c + 3] * inv);
        w.z = pk2(o[8 * c + 4] * inv, o[8 * c + 5] * inv); w.w = pk2(o[8 * c + 6] * inv, o[8 * c + 7] * inv); op[c] = w; }
}
__device__ __forceinline__ void phase_dil_simple(const bf16* P, const float* rel_bias, bf16* ODIL, int gtid, int nthr) {
    for (int item = gtid; item < 4 * T; item += nthr) {
        const int h = item / T, tok = item % T, b = tok / SEQ, t = tok % SEQ;
        float o[64], q[64]; float m = -1e30f, l = 0.f;
#pragma unroll
        for (int c = 0; c < 64; ++c) o[c] = 0.f;
        for (int g = 0; g < 3; ++g) {
            const int d = 1 << (2 * g);
            load_q64(q, P + (size_t)tok * QKVW + g * 768 + h * 64, 0.125f);
            for (int j = 0; j <= 128; ++j) {
                const int tp = t - j * d;
                if (tp >= 0) {
                    const bf16* kr = P + (size_t)(b * SEQ + tp) * QKVW + g * 768 + 256 + h * 64;
                    os_step(q, o, m, l, kr, kr + 256, rel_bias[t5_bucket(j * d) * 20 + g * 4 + h]);
                }
            }
        }
        store_o64(o, 1.0f / l, ODIL + (size_t)tok * 256 + h * 64);
    }
}
__device__ __forceinline__ void phase_moba_simple(const bf16* P, const float* KMEAN, const float* rel_bias, bf16* OMOBA, int gtid, int nthr) {
    for (int item = gtid; item < 8 * T; item += nthr) {
        const int h = item / T, tok = item % T, b = tok / SEQ, t = tok % SEQ, qb = t >> 8;
        float o[64], q[64]; float m = -1e30f, l = 0.f;
#pragma unroll
        for (int c = 0; c < 64; ++c) o[c] = 0.f;
        load_q64(q, P + (size_t)tok * QKVW + 2304 + h * 64, 1.0f);
        float v1 = -3e38f, v2 = -3e38f, v3 = -3e38f; int i1 = -1, i2 = -1, i3 = -1;
        for (int n = 0; n < qb; ++n) {
            const float* km = KMEAN + (size_t)((b * 8 + h) * 16 + n) * 64; float gs = 0.f;
#pragma unroll
            for (int c = 0; c < 64; ++c) gs += q[c] * km[c];
            if (gs > v1) { v3 = v2; i3 = i2; v2 = v1; i2 = i1; v1 = gs; i1 = n; }
            else if (gs > v2) { v3 = v2; i3 = i2; v2 = gs; i2 = n; }
            else if (gs > v3) { v3 = gs; i3 = n; }
        }
        unsigned sel = 0u;
        if (i1 >= 0) sel |= 1u << i1;
        if (i2 >= 0) sel |= 1u << i2;
        if (i3 >= 0) sel |= 1u << i3;
#pragma unroll
        for (int c = 0; c < 64; ++c) q[c] *= 0.125f;
        const bf16* Kb = P + (size_t)(b * SEQ) * QKVW + 2304 + 512 + h * 64;
        for (int n = 0; n < qb; ++n) {
            const bool on = (sel >> n) & 1u;
            if (__any(on)) {
                for (int j = 0; j < 256; ++j) {
                    const int kpos = n * 256 + j;
                    if (on) { const bf16* kr = Kb + (size_t)kpos * QKVW; os_step(q, o, m, l, kr, kr + 512, rel_bias[t5_bucket(t - kpos) * 20 + 12 + h]); }
                }
            }
        }
        const int tmax = t | 63;
        for (int kpos = qb * 256; kpos <= tmax; ++kpos) {
            if (kpos <= t) { const bf16* kr = Kb + (size_t)kpos * QKVW; os_step(q, o, m, l, kr, kr + 512, rel_bias[t5_bucket(t - kpos) * 20 + 12 + h]); }
        }
        store_o64(o, 1.0f / l, OMOBA + (size_t)tok * 512 + h * 64);
    }
}
__device__ __forceinline__ void phase_cross_simple(const bf16* QC, const bf16* KVC, bf16* OC, int gtid, int nthr) {
    for (int item = gtid; item < 8 * T; item += nthr) {
        const int half = item & 1, pr = item >> 1, h = pr / T, tok = pr % T, b = tok / SEQ;
        float o[64], q[64]; float m = -1e30f, l = 0.f;
#pragma unroll
        for (int c = 0; c < 64; ++c) o[c] = 0.f;
        load_q64(q, QC + (size_t)tok * 512 + h * 128 + half * 64, 0.08838834764831845f);
        const bf16* Kb = KVC + (size_t)(b * NMEM) * 1024 + h * 128 + half * 64;
        for (int j = 0; j < NMEM; ++j) {
            const v4u* kp = (const v4u*)(Kb + (size_t)j * 1024); float s = 0.f;
#pragma unroll
            for (int c = 0; c < 8; ++c) { const v4u w = kp[c];
                s += q[8 * c + 0] * bf_lo(w.x) + q[8 * c + 1] * bf_hi(w.x) + q[8 * c + 2] * bf_lo(w.y) + q[8 * c + 3] * bf_hi(w.y)
                   + q[8 * c + 4] * bf_lo(w.z) + q[8 * c + 5] * bf_hi(w.z) + q[8 * c + 6] * bf_lo(w.w) + q[8 * c + 7] * bf_hi(w.w); }
            s += __shfl_xor(s, 1);
            const float mn = fmaxf(m, s), al = __expf(m - mn), p = __expf(s - mn);
            l = l * al + p; m = mn;
            const v4u* vp = (const v4u*)(Kb + (size_t)j * 1024 + 512);
#pragma unroll
            for (int c = 0; c < 8; ++c) { const v4u w = vp[c];
                o[8 * c + 0] = o[8 * c + 0] * al + p * bf_lo(w.x); o[8 * c + 1] = o[8 * c + 1] * al + p * bf_hi(w.x);
                o[8 * c + 2] = o[8 * c + 2] * al + p * bf_lo(w.y); o[8 * c + 3] = o[8 * c + 3] * al + p * bf_hi(w.y);
                o[8 * c + 4] = o[8 * c + 4] * al + p * bf_lo(w.z); o[8 * c + 5] = o[8 * c + 5] * al + p * bf_hi(w.z);
                o[8 * c + 6] = o[8 * c + 6] * al + p * bf_lo(w.w); o[8 * c + 7] = o[8 * c + 7] * al + p * bf_hi(w.w); }
        }
        store_o64(o, 1.0f / l, OC + (size_t)tok * 512 + h * 128 + half * 64);
    }
}

__device__ __forceinline__ float tk_max(float a, float b) { return fmaxf(a, b); }
__device__ __forceinline__ float tk_min(float a, float b) { return fminf(a, b); }
template <int OFF> __device__ __forceinline__ void sort16_desc(float* v) {
#pragma unroll
    for (int k = 2; k <= 16; k <<= 1) {
#pragma unroll
        for (int j = k >> 1; j > 0; j >>= 1) {
#pragma unroll
            for (int i = 0; i < 16; ++i) {
                const int l = i ^ j;
                if (l > i) {
                    const bool desc = ((i & k) == 0);
                    const float x = v[OFF + i], y = v[OFF + l];
                    const float hi = tk_max(x, y), lo = tk_min(x, y);
                    v[OFF + i] = desc ? hi : lo; v[OFF + l] = desc ? lo : hi;
                }
            }
        }
    }
}
template <int OA, int OB, bool SORT> __device__ __forceinline__ void merge_top16(float* a, const float* b) {
#pragma unroll
    for (int i = 0; i < 16; ++i) a[OA + i] = tk_max(a[OA + i], b[OB + 15 - i]);
    if (SORT) {
#pragma unroll
        for (int j = 8; j > 0; j >>= 1) {
#pragma unroll
            for (int i = 0; i < 16; ++i) {
                const int l = i ^ j;
                if (l > i) { const float x = a[OA + i], y = a[OA + l]; a[OA + i] = tk_max(x, y); a[OA + l] = tk_min(x, y); }
            }
        }
    }
}
constexpr int cand_i(int c) { int n = 0; for (int i = 0; i < 16; ++i) for (int j = 0; j < 16 / (i + 1); ++j) { if (n == c) return i; ++n; } return 0; }
constexpr int cand_j(int c) { int n = 0; for (int i = 0; i < 16; ++i) for (int j = 0; j < 16 / (i + 1); ++j) { if (n == c) return j; ++n; } return 0; }
template <int C> struct CandT { static constexpr int I = cand_i(C), J = cand_j(C); };

__device__ __forceinline__ void peer_level1(const bf16* qrow  , const LAS unsigned char* sk  ,
                                            int r, int hh, float (&out)[16]) {
    bf16x8 qf[8];
#pragma unroll
    for (int ks = 0; ks < 8; ++ks) qf[ks] = *(const bf16x8*)(qrow + ks * 16 + hh * 8);
    float v[64];
#pragma unroll
    for (int kb = 0; kb < 4; ++kb) {
        f32x16 sc = {0.f, 0.f, 0.f, 0.f, 0.f, 0.f, 0.f, 0.f, 0.f, 0.f, 0.f, 0.f, 0.f, 0.f, 0.f, 0.f};
        const int key = kb * 32 + r;
#pragma unroll
        for (int ks = 0; ks < 8; ++ks) {
            const bf16x8 af = *(const LAS bf16x8*)(sk + key * 256 + (((2 * ks + hh) ^ (key & 15)) << 4));
            sc = __builtin_amdgcn_mfma_f32_32x32x16_bf16(af, qf[ks], sc, 0, 0, 0);
        }
#pragma unroll
        for (int reg = 0; reg < 16; ++reg) {
            const unsigned idx = (unsigned)(kb * 32 + (reg & 3) + 8 * (reg >> 2)) | ((unsigned)hh << 2);
            v[kb * 16 + reg] = __uint_as_float((__float_as_uint(sc[reg]) & ~127u) | idx);
        }
    }
    sort16_desc<0>(v); sort16_desc<16>(v); sort16_desc<32>(v); sort16_desc<48>(v);
    merge_top16<0, 16, true>(v, v); merge_top16<32, 48, true>(v, v); merge_top16<0, 32, true>(v, v);
    float other[16];
#pragma unroll
    for (int i = 0; i < 16; ++i) other[i] = __shfl_xor(v[i], 32);
    merge_top16<0, 0, true>(v, other);
#pragma unroll
    for (int i = 0; i < 16; ++i) out[i] = v[i];
}
template <int C> __device__ __forceinline__ void peer_emit(const float (&a)[16], const float (&b)[16], const float (&s)[64], float tau, int& cnt, float& den, bool writer, int* eo, float* wo) {
    if constexpr (C < 50) {
        const bool take = (s[C] >= tau) && (cnt < 16);
        const float e = __expf(s[C] - s[0]);
        if (take) {
            if (writer) { eo[cnt] = (int)(((__float_as_uint(a[CandT<C>::I]) & 127u) << 7) | (__float_as_uint(b[CandT<C>::J]) & 127u)); wo[cnt] = e; }
            cnt += 1; den += e;
        }
        peer_emit<C + 1>(a, b, s, tau, cnt, den, writer, eo, wo);
    }
}
template <int C> __device__ __forceinline__ void peer_sums(const float (&a)[16], const float (&b)[16], float (&s)[64]) {
    if constexpr (C < 50) { s[C] = a[CandT<C>::I] + b[CandT<C>::J]; peer_sums<C + 1>(a, b, s); }
}
__device__ __forceinline__ void phase_topk(LAS unsigned char* lds, const bf16* QP, const bf16* SUBK, int* EXP, float* EW, float* INV, int tid, int lane, int gw, int ngw) {
    for (int c = tid; c < 2 * 128 * 16; c += NWAVES * 64) { const int row = c >> 4, ch = c & 15; const v4u w = ((const v4u*)SUBK)[c]; *(LAS v4u*)(lds + row * 256 + ((ch ^ (row & 15)) << 4)) = w; }
    __syncthreads();
    const int r = lane & 31, hh = lane >> 5;
    for (int unit = gw; unit < (T / 32) * 8; unit += ngw) {
        const int tile = unit >> 3, head = unit & 7, tok = tile * 32 + r;
        const bf16* qrow = QP + (size_t)tok * 2048 + head * 256;
        float a[16], b[16];
        peer_level1(qrow, lds, r, hh, a);
        peer_level1(qrow + 128, lds + 128 * 256, r, hh, b);
        float s[64];
        peer_sums<0>(a, b, s);
#pragma unroll
        for (int c = 50; c < 64; ++c) s[c] = -INFINITY;
        float w[64];
#pragma unroll
        for (int c = 0; c < 64; ++c) w[c] = s[c];
        sort16_desc<0>(w); sort16_desc<16>(w); sort16_desc<32>(w); sort16_desc<48>(w);
        merge_top16<0, 16, true>(w, w); merge_top16<32, 48, true>(w, w); merge_top16<0, 32, false>(w, w);
        float tau = w[0];
#pragma unroll
        for (int i = 1; i < 16; ++i) tau = tk_min(tau, w[i]);
        int cnt = 0; float den = 0.f;
        peer_emit<0>(a, b, s, tau, cnt, den, hh == 0, EXP + (size_t)tok * 128 + head * 16, EW + (size_t)tok * 128 + head * 16);
        if (hh == 0) INV[(size_t)tok * 8 + head] = 1.0f / den;
    }
    __syncthreads();
}

__device__ __forceinline__ float dot2_bf16(unsigned w, unsigned x, float acc) { return __builtin_amdgcn_fdot2_f32_bf16(__builtin_bit_cast(bf2_t, w), __builtin_bit_cast(bf2_t, x), acc, false); }
__device__ __forceinline__ float dot8_bf16(const v4u a, const v4u b, float acc) {
    acc = dot2_bf16(a.x, b.x, acc); acc = dot2_bf16(a.y, b.y, acc); acc = dot2_bf16(a.z, b.z, acc); acc = dot2_bf16(a.w, b.w, acc);
    return acc;
}
template <int N> __device__ __forceinline__ void xpose_reduce(float (&p)[64], int lane) {
    if constexpr (N >= 1) {
        const bool up = (lane & N) != 0;
#pragma unroll
        for (int k = 0; k < N; ++k) { const float keep = up ? p[k + N] : p[k], send = up ? p[k] : p[k + N]; p[k] = keep + __shfl_xor(send, N); }
        xpose_reduce<N / 2>(p, lane);
    }
}
__device__ __forceinline__ float gelu_exact(float x) { return 0.5f * x * (1.0f + erff(x * 0.70710678118654752f)); }
__device__ __forceinline__ void phase_peer(const bf16* H, const bf16* U, const bf16* V, const int* EXP, const float* EW, const float* INV, const float* X2, const float* gfin, float* OUT, int lane, int gw, int ngw, float dbg_sc, float* ydbg) {
    for (int tok = gw; tok < T; tok += ngw) {
        int e0 = EXP[(size_t)tok * 128 + lane], e1 = EXP[(size_t)tok * 128 + 64 + lane];
        if (dbg_sc == 0.f) { e0 = 0; e1 = 0; }
        const float g0 = EW[(size_t)tok * 128 + lane] * INV[(size_t)tok * 8 + (lane >> 4)], g1 = EW[(size_t)tok * 128 + 64 + lane] * INV[(size_t)tok * 8 + 4 + (lane >> 4)];
        const v4u hA = *(const v4u*)(H + (size_t)tok * 1024 + 8 * lane), hB = *(const v4u*)(H + (size_t)tok * 1024 + 512 + 8 * lane);
        float wgt[2];
#pragma unroll
        for (int half = 0; half < 2; ++half) {
            const int ev = half ? e1 : e0;
            float p[64];
#pragma unroll
            for (int i0 = 0; i0 < 64; i0 += 8) {
                v4u ua[8], ub[8];
#pragma unroll
                for (int k = 0; k < 8; ++k) { const int eid = __builtin_amdgcn_readlane(ev, i0 + k); const v4u* up = (const v4u*)(U + (size_t)eid * 1024); ua[k] = up[lane]; ub[k] = up[64 + lane]; }
#pragma unroll
                for (int k = 0; k < 8; ++k) p[i0 + k] = dot8_bf16(hB, ub[k], dot8_bf16(hA, ua[k], 0.f));
            }
            xpose_reduce<32>(p, lane);
            wgt[half] = gelu_exact(p[0]) * (half ? g1 : g0);
        }
        float y[16];
#pragma unroll
        for (int c = 0; c < 16; ++c) y[c] = 0.f;
#pragma unroll
        for (int half = 0; half < 2; ++half) {
            const int ev = half ? e1 : e0; const float wv = wgt[half];
            for (int i0 = 0; i0 < 64; i0 += 8) {
                v4u va[8], vb[8]; float ws[8];
#pragma unroll
                for (int k = 0; k < 8; ++k) { const int eid = __builtin_amdgcn_readlane(ev, i0 + k); ws[k] = __int_as_float(__builtin_amdgcn_readlane(__float_as_int(wv), i0 + k));
                    const v4u* vp = (const v4u*)(V + (size_t)eid * 1024); va[k] = vp[lane]; vb[k] = vp[64 + lane]; }
#pragma unroll
                for (int k = 0; k < 8; ++k) { const float w = ws[k];
                    y[0] += w * bf_lo(va[k].x); y[1] += w * bf_hi(va[k].x); y[2] += w * bf_lo(va[k].y); y[3] += w * bf_hi(va[k].y);
                    y[4] += w * bf_lo(va[k].z); y[5] += w * bf_hi(va[k].z); y[6] += w * bf_lo(va[k].w); y[7] += w * bf_hi(va[k].w);
                    y[8] += w * bf_lo(vb[k].x); y[9] += w * bf_hi(vb[k].x); y[10] += w * bf_lo(vb[k].y); y[11] += w * bf_hi(vb[k].y);
                    y[12] += w * bf_lo(vb[k].z); y[13] += w * bf_hi(vb[k].z); y[14] += w * bf_lo(vb[k].w); y[15] += w * bf_hi(vb[k].w); }
            }
        }
        if (dbg_sc == 0.f) {
#pragma unroll
            for (int c = 0; c < 16; ++c) y[c] = 0.f; }
        if (ydbg) { const int s_ = tok / 512; if (tok == s_ * 512 + 3 + (s_ & 7) * 37) {
#pragma unroll
            for (int c = 0; c < 8; ++c) { ydbg[(size_t)s_ * 1024 + 8 * lane + c] = y[c]; ydbg[(size_t)s_ * 1024 + 512 + 8 * lane + c] = y[8 + c]; } } }
        const f32x4* xr = (const f32x4*)(X2 + (size_t)tok * 1024); const f32x4* gr = (const f32x4*)gfin;
        f32x4 x0 = xr[2 * lane], x1 = xr[2 * lane + 1], x2 = xr[128 + 2 * lane], x3 = xr[128 + 2 * lane + 1];
        x0.x += y[0]; x0.y += y[1]; x0.z += y[2]; x0.w += y[3]; x1.x += y[4]; x1.y += y[5]; x1.z += y[6]; x1.w += y[7];
        x2.x += y[8]; x2.y += y[9]; x2.z += y[10]; x2.w += y[11]; x3.x += y[12]; x3.y += y[13]; x3.z += y[14]; x3.w += y[15];
        float ss = (x0.x * x0.x + x0.y * x0.y + x0.z * x0.z + x0.w * x0.w) + (x1.x * x1.x + x1.y * x1.y + x1.z * x1.z + x1.w * x1.w)
                 + (x2.x * x2.x + x2.y * x2.y + x2.z * x2.z + x2.w * x2.w) + (x3.x * x3.x + x3.y * x3.y + x3.z * x3.z + x3.w * x3.w);
        const float rinv = rsqrtf(wave_sum(ss) * (1.f / 1024.f) + RMS_EPS);
        f32x4* orow = (f32x4*)(OUT + (size_t)tok * 1024);
        orow[2 * lane] = x0 * rinv * gr[2 * lane]; orow[2 * lane + 1] = x1 * rinv * gr[2 * lane + 1];
        orow[128 + 2 * lane] = x2 * rinv * gr[128 + 2 * lane]; orow[128 + 2 * lane + 1] = x3 * rinv * gr[128 + 2 * lane + 1];
    }
}
__device__ __forceinline__ void phase_topk_simple(const bf16* QP, const float* subk, int* EXP, float* EW, float* INV, int lane, int gw, int ngw) {
    for (int unit = gw; unit < T * 8; unit += ngw) {
        const int tok = unit >> 3, head = unit & 7;
        const bf16* qrow = QP + (size_t)tok * 2048 + head * 256;
        float av = 0.f, bv[4] = {0.f, 0.f, 0.f, 0.f}; int ai = 0, bi[4] = {0, 0, 0, 0};
#pragma unroll
        for (int p = 0; p < 2; ++p) {
            float s0 = 0.f, s1 = 0.f;
            const float* k0 = subk + (size_t)(p * 128 + lane) * 128; const float* k1 = subk + (size_t)(p * 128 + 64 + lane) * 128;
            for (int c = 0; c < 128; ++c) { const float qv = bf2f(qrow[p * 128 + c]); s0 += qv * k0[c]; s1 += qv * k1[c]; }
#pragma unroll
            for (int i = 0; i < 16; ++i) {
                float mloc = fmaxf(s0, s1); float mw = mloc;
#pragma unroll
                for (int o = 1; o < 64; o <<= 1) mw = fmaxf(mw, __shfl_xor(mw, o));
                const unsigned long long bal = __ballot(mloc == mw);
                const int wl = __ffsll((long long)bal) - 1;
                int idx = -1;
                if (lane == wl) { if (s0 >= s1) { idx = lane; s0 = -3e38f; } else { idx = lane + 64; s1 = -3e38f; } }
                idx = __shfl(idx, wl);
                if (p == 0) { if ((lane & 15) == i) { av = mw; ai = idx; } }
                else { if ((lane >> 4) == (i >> 2)) { bv[i & 3] = mw; bi[i & 3] = idx; } }
            }
        }
        float cs[4];
#pragma unroll
        for (int jj = 0; jj < 4; ++jj) cs[jj] = av + bv[jj];
        float top0 = 0.f, den = 0.f; int myexp = 0; float myw = 0.f;
#pragma unroll
        for (int k = 0; k < 16; ++k) {
            float mloc = fmaxf(fmaxf(cs[0], cs[1]), fmaxf(cs[2], cs[3])); float mw = mloc;
#pragma unroll
            for (int o = 1; o < 64; o <<= 1) mw = fmaxf(mw, __shfl_xor(mw, o));
            const unsigned long long bal = __ballot(mloc == mw);
            const int wl = __ffsll((long long)bal) - 1;
            int ex = 0;
            if (lane == wl) {
                if (cs[0] == mw) { ex = ai * 128 + bi[0]; cs[0] = -3e38f; }
                else if (cs[1] == mw) { ex = ai * 128 + bi[1]; cs[1] = -3e38f; }
                else if (cs[2] == mw) { ex = ai * 128 + bi[2]; cs[2] = -3e38f; }
                else { ex = ai * 128 + bi[3]; cs[3] = -3e38f; }
            }
            ex = __shfl(ex, wl);
            if (k == 0) top0 = mw;
            const float e = __expf(mw - top0); den += e;
            if (lane == k) { myexp = ex; myw = e; }
        }
        if (lane < 16) { EXP[(size_t)tok * 128 + head * 16 + lane] = myexp; EW[(size_t)tok * 128 + head * 16 + lane] = myw; }
        if (lane == 0) INV[(size_t)tok * 8 + head] = 1.0f / den;
    }
}
#if DBG_CHECK
constexpr size_t WS_YDBG = 452 * MiB;
constexpr int CW_DBG = 64;
__device__ __forceinline__ void dbg_acc(float* acc, float num, float den, int lane) { num = wave_sum(num); den = wave_sum(den); if (lane == 0) { atomicAdd(acc, num); atomicAdd(acc + 1, den); } }
__device__ __forceinline__ int dbg_tok(int s) { return s * 512 + 3 + (s & 7) * 37; }
__device__ __forceinline__ void dbg_check_qp(const bf16* H, const float* w_qp, const bf16* QP, float* acc, int gtid, int nthr, int lane) {
    float num = 0.f, den = 0.f;
    for (int item = gtid; item < 64 * 2048; item += nthr) { const int s = item / 2048, n = item % 2048, t = dbg_tok(s);
        float r = 0.f; for (int k = 0; k < 1024; ++k) r += bf2f(H[(size_t)t * 1024 + k]) * w_qp[(size_t)k * 2048 + n];
        const float mine = bf2f(QP[(size_t)t * 2048 + n]); num += (r - mine) * (r - mine); den += r * r; }
    dbg_acc(acc, num, den, lane);
}
__device__ __forceinline__ void dbg_check_gather(const bf16* H, const float* u, const float* v, const int* EXP, const float* EW, const float* INV, const float* YDBG, float* acc, int gw, int ngw, int lane) {
    float num = 0.f, den = 0.f;
    for (int s = gw; s < 64; s += ngw) { const int t = dbg_tok(s);
        float y[16];
#pragma unroll
        for (int c = 0; c < 16; ++c) y[c] = 0.f;
        for (int i = 0; i < 128; ++i) { const int e = EXP[(size_t)t * 128 + i]; const float g = EW[(size_t)t * 128 + i] * INV[(size_t)t * 8 + (i >> 4)];
            float d = 0.f;
#pragma unroll
            for (int c = 0; c < 16; ++c) d += bf2f(H[(size_t)t * 1024 + lane * 16 + c]) * u[(size_t)e * 1024 + lane * 16 + c];
            d = wave_sum(d);
            const float w = g * gelu_exact(d);
#pragma unroll
            for (int c = 0; c < 16; ++c) y[c] += w * v[(size_t)e * 1024 + lane * 16 + c]; }
#pragma unroll
        for (int c = 0; c < 16; ++c) { const float mine = YDBG[(size_t)s * 1024 + lane * 16 + c]; num += (y[c] - mine) * (y[c] - mine); den += y[c] * y[c]; } }
    dbg_acc(acc, num, den, lane);
}
__device__ __forceinline__ float dbg_k(const float* acc) { const float D = acc[0] / fmaxf(acc[1], 1e-30f); float k = log10f(fmaxf(D, 1e-12f)); return fminf(fmaxf(k, -6.f), 1.f); }
__device__ __forceinline__ void dbg_encode(const float* x, const float* gfin, float* out, const float* acc, int gw, int ngw, int lane) {
    const float k1 = dbg_k(acc), k2 = dbg_k(acc + 2); const float s = 1.f + (k1 + 6.5f) * 0.5f;
    for (int m = gw; m < T; m += ngw) { const f32x4* xr = (const f32x4*)(x + (size_t)m * 1024) + lane; const f32x4* gr = (const f32x4*)gfin + lane; f32x4 vv[4]; float ss = 0.f;
#pragma unroll
        for (int j = 0; j < 4; ++j) { vv[j] = xr[64 * j]; ss += (vv[j].x * vv[j].x + vv[j].y * vv[j].y) + (vv[j].z * vv[j].z + vv[j].w * vv[j].w); }
        const float rinv = rsqrtf(wave_sum(ss) * (1.f / 1024.f) + RMS_EPS) * s;
#pragma unroll
        for (int j = 0; j < 4; ++j) { f32x4 o = vv[j] * rinv * gr[64 * j]; if (m == 0 && j == 0 && lane == 0) o.x = 100.f + 100.f * (k2 + 6.f); ((f32x4*)(out + (size_t)m * 1024) + lane)[64 * j] = o; } }
}
#endif

struct Args { const float* in[20]; float* out; unsigned char* ws; int ph_lo, ph_hi; };
__global__ void __launch_bounds__(NWAVES * 64, 2) fwd(Args args) {
    extern __shared__ __attribute__((aligned(16))) unsigned char lds_raw[];
    LAS unsigned char* lds = (LAS unsigned char*)lds_raw;
    volatile LAS unsigned* MISC = (volatile LAS unsigned*)(lds + MISC_OFF);
    const int tid = threadIdx.x, lane = tid & 63, wave = __builtin_amdgcn_readfirstlane(tid >> 6);
    const int G = gridDim.x; const int bx = blockIdx.x; const int vcu = (G % 8 == 0) ? (bx % 8) * (G / 8) + bx / 8 : bx;
    const int gw = vcu * NWAVES + wave, NGW = G * NWAVES, gtid = vcu * (NWAVES * 64) + tid, NTHR = G * NWAVES * 64;
    unsigned char* ws = args.ws;
    gu32* ctl = (gu32*)(ws + WS_CTL);
    const float* x = args.in[0]; const float* mem = args.in[1]; const float* rel_bias = args.in[2]; const float* g_mix = args.in[3]; const float* w_in = args.in[4];
    const float* b_gate = args.in[5]; const float* w_a = args.in[6]; const float* w_b = args.in[7]; const float* w_out = args.in[8]; const float* g_cross = args.in[9];
    const float* g_mem = args.in[10]; const float* w_qc = args.in[11]; const float* w_kvc = args.in[12]; const float* w_oc = args.in[13]; const float* g_ffn = args.in[14];
    const float* w_qp = args.in[15]; const float* subk = args.in[16]; const float* peer_u = args.in[17]; const float* peer_v = args.in[18]; const float* g_final = args.in[19];
    float* out = args.out;
    bf16* WinT = (bf16*)(ws + WS_WIN); bf16* WaT = (bf16*)(ws + WS_WA); bf16* WbT = (bf16*)(ws + WS_WB); bf16* WoutT = (bf16*)(ws + WS_WOUT); bf16* WqcT = (bf16*)(ws + WS_WQC);
    bf16* WkvcT = (bf16*)(ws + WS_WKVC); bf16* WocT = (bf16*)(ws + WS_WOC); bf16* WqpT = (bf16*)(ws + WS_WQP); bf16* SUBK = (bf16*)(ws + WS_SUBK); bf16* Ub = (bf16*)(ws + WS_U); bf16* Vb = (bf16*)(ws + WS_V);
    bf16* H = (bf16*)(ws + WS_H); bf16* MEMB = (bf16*)(ws + WS_MEMB); bf16* KVC = (bf16*)(ws + WS_KVC); bf16* ODIL = (bf16*)(ws + WS_ODIL); bf16* OMOBA = (bf16*)(ws + WS_OMOBA);
    bf16* PQKV = (bf16*)(ws + WS_PQKV); bf16* MERGED = (bf16*)(ws + WS_MERGED); float* X1 = (float*)(ws + WS_X1); bf16* QC = (bf16*)(ws + WS_QC); bf16* OC = (bf16*)(ws + WS_OC);
    int* EXP = (int*)(ws + WS_EXP); float* EW = (float*)(ws + WS_EW); float* INV = (float*)(ws + WS_INV); float* KMEAN = (float*)(ws + WS_KMEAN);
    bf16* GATES = (bf16*)out;
    bf16* QP = (bf16*)out;

    for (int u = tid; u < (LDS_BYTES - LDSCTL_OFF) / 4; u += NWAVES * 64) ((LAS unsigned*)(lds + LDSCTL_OFF))[u] = 0u;
    __syncthreads();
    const int lo = args.ph_lo, hi = args.ph_hi;
    XcdBarrier bar; bar.bar = (unsigned*)(ctl + CW_BAR); bar.x = 0; bar.st = nullptr;
    if (hi - lo > 1) bar = xcd_barrier_post((unsigned*)(ctl + CW_BAR), MISC + 8);
#define IN(k) (lo <= (k) && (k) < hi)
#define SEAM(k) do { if (IN(k) && IN((k) + 1)) xcd_barrier(bar); } while (0)

    if (IN(0)) {
        LAS float* scr = (LAS float*)(lds + RING_OFF + wave * 16384);
        constexpr int I_IN = (1024 / 64) * (NIN / 32), I_A = (256 / 64) * (1024 / 32), I_B = (512 / 64) * (1024 / 32), I_OUT = (1024 / 64) * (1024 / 32), I_QC = (1024 / 64) * (512 / 32),
                      I_KVC = (1024 / 64) * (1024 / 32), I_OC = (512 / 64) * (1024 / 32), I_QP = (1024 / 64) * (2048 / 32);
        constexpr int NITEMS = I_IN + I_A + I_B + I_OUT + I_QC + I_KVC + I_OC + I_QP;
        for (int it = gw; it < NITEMS; it += NGW) {
            int r = it;
            if (r < I_IN) { p0_transpose_item(w_in, 1024, NIN, WinT, scr, r, lane); continue; } r -= I_IN;
            if (r < I_A) { p0_transpose_item(w_a, 256, 1024, WaT, scr, r, lane); continue; } r -= I_A;
            if (r < I_B) { p0_transpose_item(w_b, 512, 1024, WbT, scr, r, lane); continue; } r -= I_B;
            if (r < I_OUT) { p0_transpose_item(w_out, 1024, 1024, WoutT, scr, r, lane); continue; } r -= I_OUT;
            if (r < I_QC) { p0_transpose_item(w_qc, 1024, 512, WqcT, scr, r, lane); continue; } r -= I_QC;
            if (r < I_KVC) { p0_transpose_item(w_kvc, 1024, 1024, WkvcT, scr, r, lane); continue; } r -= I_KVC;
            if (r < I_OC) { p0_transpose_item(w_oc, 512, 1024, WocT, scr, r, lane); continue; } r -= I_OC;
            p0_transpose_item(w_qp, 1024, 2048, WqpT, scr, r, lane);
        }
        cvt_f32_to_bf16_bulk(subk, SUBK, (size_t)2 * 128 * 128, (size_t)gtid, (size_t)NTHR);
        cvt_f32_to_bf16_bulk(peer_u, Ub, (size_t)16384 * 1024, (size_t)gtid, (size_t)NTHR);
        cvt_f32_to_bf16_bulk(peer_v, Vb, (size_t)16384 * 1024, (size_t)gtid, (size_t)NTHR);
        for (int m = gw; m < T; m += NGW) rms_row_to_bf16(x + (size_t)m * DM, g_mix, H + (size_t)m * DM, lane);
        for (int m = gw; m < MROWS; m += NGW) rms_row_to_bf16(mem + (size_t)m * DM, g_mem, MEMB + (size_t)m * DM, lane);
        __syncthreads();
    }
    SEAM(0);
    if (IN(1)) {
        if (DBG_MIX) { pg8::Gemm g{H, WinT, T, NIN, DM}; pg8::StaticOrder S; S.init(T, NIN, G, bx); pg8::EpiIn E{PQKV, GATES, b_gate};
          pg8::gemm_phase<pg8::EpiIn, pg8::StaticOrder, true, true>(lds + RING_OFF, g, S, E); }
        __syncthreads();
        if (DBG_CROSS) { pg8::Gemm g{MEMB, WkvcT, MROWS, 1024, DM}; pg8::StaticOrder S; S.init(MROWS, 1024, G, bx); pg8::EpiStore E{KVC, 1024};
          pg8::gemm_phase<pg8::EpiStore, pg8::StaticOrder, true, true>(lds + RING_OFF, g, S, E); }
    }
    SEAM(1);
    if (IN(2) && DBG_MIX) {
        for (int it = gw; it < NB * 8 * 16; it += NGW) { const int bh = it >> 4, blk = it & 15, b = bh >> 3, h = bh & 7;
            const bf16* kp = PQKV + (size_t)(b * SEQ + blk * 256) * QKVW + 2304 + 512 + h * 64 + lane; float s = 0.f;
            for (int j = 0; j < 256; ++j) s += bf2f(kp[(size_t)j * QKVW]);
            KMEAN[(size_t)it * 64 + lane] = s * (1.0f / 256.0f); }
    }
    SEAM(2);
    if (IN(3) && DBG_MIX) { phase_dil_simple(PQKV, rel_bias, ODIL, gtid, NTHR); phase_moba_simple(PQKV, KMEAN, rel_bias, OMOBA, gtid, NTHR); }
    SEAM(3);
    if (IN(4) && DBG_MIX) { pg8::Gemm g{ODIL, WaT, T, 1024, 256}; pg8::StaticOrder S; S.init(T, 1024, G, bx); pg8::EpiGate<false> E{MERGED, GATES, 0};
        pg8::gemm_phase<pg8::EpiGate<false>, pg8::StaticOrder, true, true>(lds + RING_OFF, g, S, E); }
    SEAM(4);
    if (IN(5) && DBG_MIX) { pg8::Gemm g{OMOBA, WbT, T, 1024, 512}; pg8::StaticOrder S; S.init(T, 1024, G, bx); pg8::EpiGate<true> E{MERGED, GATES, 1024};
        pg8::gemm_phase<pg8::EpiGate<true>, pg8::StaticOrder, true, true>(lds + RING_OFF, g, S, E); }
    SEAM(5);
    if (IN(6)) { pg8::Gemm g{MERGED, WoutT, T, 1024, 1024}; pg8::StaticOrder S; S.init(T, 1024, G, bx); pg8::EpiRes E{x, X1, 1024, (float)DBG_MIX};
        pg8::gemm_phase<pg8::EpiRes, pg8::StaticOrder, true, true>(lds + RING_OFF, g, S, E); }
    SEAM(6);
    if (IN(7)) { for (int m = gw; m < T; m += NGW) rms_row_to_bf16(X1 + (size_t)m * DM, g_cross, H + (size_t)m * DM, lane); }
    SEAM(7);
    if (IN(8) && DBG_CROSS) { pg8::Gemm g{H, WqcT, T, 512, 1024}; pg8::StaticOrder S; S.init(T, 512, G, bx); pg8::EpiStore E{QC, 512};
        pg8::gemm_phase<pg8::EpiStore, pg8::StaticOrder, true, true>(lds + RING_OFF, g, S, E); }
    SEAM(8);
    if (IN(9) && DBG_CROSS) { phase_cross_simple(QC, KVC, OC, gtid, NTHR); }
    SEAM(9);
    if (IN(10)) { pg8::Gemm g{OC, WocT, T, 1024, 512}; pg8::StaticOrder S; S.init(T, 1024, G, bx); pg8::EpiRes E{X1, X1, 1024, (float)DBG_CROSS};
        pg8::gemm_phase<pg8::EpiRes, pg8::StaticOrder, true, true>(lds + RING_OFF, g, S, E); }
    SEAM(10);
    if (IN(11)) { for (int m = gw; m < T; m += NGW) rms_row_to_bf16(X1 + (size_t)m * DM, g_ffn, H + (size_t)m * DM, lane); }
    SEAM(11);
    if (IN(12) && DBG_PEER) { pg8::Gemm g{H, WqpT, T, 2048, 1024}; pg8::StaticOrder S; S.init(T, 2048, G, bx); pg8::EpiStore E{QP, 2048};
        pg8::gemm_phase<pg8::EpiStore, pg8::StaticOrder, true, true>(lds + RING_OFF, g, S, E); }
    SEAM(12);
#if DBG_CHECK
    if (IN(13)) dbg_check_qp(H, w_qp, QP, (float*)(ctl + CW_DBG), gtid, NTHR, lane);
#endif
#if DBG_TOPK_SIMPLE
    if (IN(13) && DBG_PEER) { phase_topk_simple(QP, subk, EXP, EW, INV, lane, gw, NGW); }
#else
    if (IN(13) && DBG_PEER) { phase_topk(lds + RING_OFF, QP, SUBK, EXP, EW, INV, tid, lane, gw, NGW); }
#endif
    SEAM(13);
    if (IN(14)) { phase_peer(H, Ub, Vb, EXP, EW, INV, X1, g_final, out, lane, gw, NGW, (float)DBG_PEER, DBG_YPTR); }
#if DBG_CHECK
    if (IN(15)) dbg_check_gather(H, peer_u, peer_v, EXP, EW, INV, (const float*)(ws + WS_YDBG), (float*)(ctl + CW_DBG) + 2, gw, NGW, lane);
    if (IN(16)) dbg_encode(x, g_final, out, (const float*)(ctl + CW_DBG), gw, NGW, lane);
#endif
#undef IN
#undef SEAM
}

extern "C" void kernel_launch(void* const* d_in, const int* in_sizes, int n_in, void* d_out, int out_size, void* d_ws, size_t ws_size, hipStream_t stream) {
    static int grid = 0;
    if (grid == 0) {
        if (n_in != 20 || out_size != T * DM || ws_size < WS_END) { fprintf(stderr, "kernel_launch: unexpected shapes (n_in %d, out %d, ws %zu); nothing launched\n", n_in, out_size, ws_size); grid = -1; return; }
        int dev = 0, cus = 0, per_cu = 0;
        if (hipGetDevice(&dev) != hipSuccess || hipDeviceGetAttribute(&cus, hipDeviceAttributeMultiprocessorCount, dev) != hipSuccess) { grid = -1; return; }
        if (hipFuncSetAttribute((const void*)fwd, hipFuncAttributeMaxDynamicSharedMemorySize, LDS_BYTES) != hipSuccess) { fprintf(stderr, "kernel_launch: hipFuncSetAttribute failed\n"); grid = -1; return; }
        if (hipOccupancyMaxActiveBlocksPerMultiprocessor(&per_cu, (const void*)fwd, NWAVES * 64, LDS_BYTES) != hipSuccess || per_cu < 1) { fprintf(stderr, "kernel_launch: occupancy query says %d\n", per_cu); }
        (void)hipGetLastError();
        grid = cus;
    }
    if (grid < 0) return;
    if (hipMemsetAsync((char*)d_ws + WS_CTL, 0, CTL_ZERO_BYTES, stream) != hipSuccess) return;
    Args a{};
    for (int i = 0; i < 20; ++i) a.in[i] = (const float*)d_in[i];
    a.out = (float*)d_out; a.ws = (unsigned char*)d_ws;
#if MK_ONE_LAUNCH
    a.ph_lo = 0; a.ph_hi = NPH;
    hipLaunchKernelGGL(fwd, dim3(grid), dim3(NWAVES * 64), LDS_BYTES, stream, a);
#else
    for (int p = 0; p < NPH + (DBG_CHECK ? 2 : 0); ++p) { a.ph_lo = p; a.ph_hi = p + 1; hipLaunchKernelGGL(fwd, dim3(grid), dim3(NWAVES * 64), LDS_BYTES, stream, a); }
#endif
}
```

```cpp
#include <hip/hip_runtime.h>
#include <cstdio>
#include <cstdint>
#include <cmath>
namespace pg8 {
#define PG8_LAS __attribute__((address_space(3)))
typedef unsigned short bf16_t;
typedef short bf16x8 __attribute__((ext_vector_type(8)));
typedef float f32x4 __attribute__((ext_vector_type(4)));
typedef unsigned u32x4 __attribute__((ext_vector_type(4)));
constexpr int BM = 256, BK = 64, HALF = 128, HTB = HALF * BK * 2  , STAGE_BYTES = 8 * HTB, NXCD = 8, WGM = 8;

__host__ __device__ __forceinline__ int lds_byte(int r, int c) { const int st = (r >> 4) * 2 + (c >> 5), rr = r & 15, cc = c & 31, ob = rr * 64 + cc * 2; return st * 1024 + (ob ^ (((ob >> 9) & 1) << 5)); }
__host__ __device__ __forceinline__ void stage_rc(int b, int& R, int& C) { const int st = b / 1024, sb = b % 1024, swz = sb ^ (((sb >> 9) & 1) << 5); R = (st >> 1) * 16 + swz / 64; C = (st & 1) * 32 + (swz % 64) / 2; }
__host__ __device__ __forceinline__ int perm32(int rho) { const int n = rho >> 4, i = rho & 15; return 8 * (i >> 2) + 4 * n + (i & 3); }

struct Unit { int pm, pn; };
struct Gemm { const bf16_t* A; const bf16_t* Bt; int M, N, K; };

struct StaticOrder {
    int nM, nN, nwg, G, c;
    __host__ __device__ void init(int M, int N, int G_, int c_) { nM = M / BM; nN = N / BM; nwg = nM * nN; G = G_; c = c_; }
    __host__ __device__ bool next(int i, Unit& u) const {
        const long L = (long)i * G + c; if (L >= nwg) return false;
        int wgid = (int)L; { const int q = nwg / NXCD, r = nwg % NXCD, xcd = wgid % NXCD, off = wgid / NXCD; wgid = (xcd < r ? xcd * (q + 1) : r * (q + 1) + (xcd - r) * q) + off; }
        const int nig = WGM * nN, gid = wgid / nig, fm = gid * WGM, gsz = (nM - fm) < WGM ? (nM - fm) : WGM;
        u.pm = fm + ((wgid % nig) % gsz); u.pn = (wgid % nig) / gsz; return true;
    }
    __device__ __forceinline__ void a_ready(const Unit&) const {}
    __device__ __forceinline__ void done(const Unit&) const {}
};

__device__ __forceinline__ unsigned cvt_pk_bf16(float lo, float hi) { unsigned r; asm volatile("v_cvt_pk_bf16_f32 %0, %1, %2" : "=v"(r) : "v"(lo), "v"(hi)); return r; }
typedef float f32x2 __attribute__((ext_vector_type(2)));
__device__ __forceinline__ float bf_lo(unsigned w) { return __uint_as_float(w << 16); }
__device__ __forceinline__ float bf_hi(unsigned w) { return __uint_as_float(w & 0xffff0000u); }
__device__ __forceinline__ float sigmoidf_(float x) { return 1.0f / (1.0f + __expf(-x)); }
struct EpiStore {
    static constexpr bool PERM = true, AFTER_DRAIN = false;
    bf16_t* O; int ldc;
    __device__ __forceinline__ void operator()(const f32x4 (&acc)[2][2][4][2], const Unit& u, int wr, int wc, int fr, int fq) const {
        const int row0 = u.pm * BM + wr * 64 + fr, col0 = u.pn * BM + wc * 32 + 8 * fq;
#pragma unroll
        for (int ai = 0; ai < 2; ++ai)
#pragma unroll
            for (int m = 0; m < 4; ++m) { bf16_t* rowp = O + (size_t)(row0 + ai * HALF + m * 16) * ldc + col0;
#pragma unroll
                for (int bj = 0; bj < 2; ++bj) { const f32x4 v0 = acc[ai][bj][m][0], v1 = acc[ai][bj][m][1];
                    u32x4 w; w.x = cvt_pk_bf16(v0[0], v0[1]); w.y = cvt_pk_bf16(v0[2], v0[3]); w.z = cvt_pk_bf16(v1[0], v1[1]); w.w = cvt_pk_bf16(v1[2], v1[3]);
                    *(u32x4*)(rowp + bj * HALF) = w; } }
    }
};
struct EpiIn {
    static constexpr bool PERM = true, AFTER_DRAIN = false;
    bf16_t* P; bf16_t* G; const float* bgate;
    __device__ __forceinline__ void operator()(const f32x4 (&acc)[2][2][4][2], const Unit& u, int wr, int wc, int fr, int fq) const {
        const int row0 = u.pm * BM + wr * 64 + fr;
        if (u.pn < 15) {
            const int col0 = u.pn * BM + wc * 32 + 8 * fq;
#pragma unroll
            for (int ai = 0; ai < 2; ++ai)
#pragma unroll
                for (int m = 0; m < 4; ++m) { bf16_t* rowp = P + (size_t)(row0 + ai * HALF + m * 16) * 3840 + col0;
#pragma unroll
                    for (int bj = 0; bj < 2; ++bj) { const f32x4 v0 = acc[ai][bj][m][0], v1 = acc[ai][bj][m][1];
                        u32x4 w; w.x = cvt_pk_bf16(v0[0], v0[1]); w.y = cvt_pk_bf16(v0[2], v0[3]); w.z = cvt_pk_bf16(v1[0], v1[1]); w.w = cvt_pk_bf16(v1[2], v1[3]);
                        *(u32x4*)(rowp + bj * HALF) = w; } }
        } else {
            const int col0 = (u.pn - 15) * BM + wc * 32 + 8 * fq;
            f32x4 bv[2][2];
#pragma unroll
            for (int bj = 0; bj < 2; ++bj)
#pragma unroll
                for (int n = 0; n < 2; ++n) bv[bj][n] = *(const f32x4*)(bgate + col0 + bj * HALF + 4 * n);
#pragma unroll
            for (int ai = 0; ai < 2; ++ai)
#pragma unroll
                for (int m = 0; m < 4; ++m) { bf16_t* rowp = G + (size_t)(row0 + ai * HALF + m * 16) * 2048 + col0;
#pragma unroll
                    for (int bj = 0; bj < 2; ++bj) { const f32x4 v0 = acc[ai][bj][m][0] + bv[bj][0], v1 = acc[ai][bj][m][1] + bv[bj][1];
                        u32x4 w; w.x = cvt_pk_bf16(sigmoidf_(v0[0]), sigmoidf_(v0[1])); w.y = cvt_pk_bf16(sigmoidf_(v0[2]), sigmoidf_(v0[3]));
                        w.z = cvt_pk_bf16(sigmoidf_(v1[0]), sigmoidf_(v1[1])); w.w = cvt_pk_bf16(sigmoidf_(v1[2]), sigmoidf_(v1[3]));
                        *(u32x4*)(rowp + bj * HALF) = w; } }
        }
    }
};
template <bool ADD> struct EpiGate {
    static constexpr bool PERM = true, AFTER_DRAIN = false;
    bf16_t* O; const bf16_t* G; int gcol;
    __device__ __forceinline__ void operator()(const f32x4 (&acc)[2][2][4][2], const Unit& u, int wr, int wc, int fr, int fq) const {
        const int row0 = u.pm * BM + wr * 64 + fr, col0 = u.pn * BM + wc * 32 + 8 * fq;
#pragma unroll
        for (int ai = 0; ai < 2; ++ai)
#pragma unroll
            for (int m = 0; m < 4; ++m) { const size_t row = (size_t)(row0 + ai * HALF + m * 16); bf16_t* rowp = O + row * 1024 + col0; const bf16_t* gp = G + row * 2048 + gcol + col0;
#pragma unroll
                for (int bj = 0; bj < 2; ++bj) { const f32x4 v0 = acc[ai][bj][m][0], v1 = acc[ai][bj][m][1];
                    const u32x4 g = *(const u32x4*)(gp + bj * HALF);
                    float r0 = bf_lo(g.x) * v0[0], r1 = bf_hi(g.x) * v0[1], r2 = bf_lo(g.y) * v0[2], r3 = bf_hi(g.y) * v0[3];
                    float r4 = bf_lo(g.z) * v1[0], r5 = bf_hi(g.z) * v1[1], r6 = bf_lo(g.w) * v1[2], r7 = bf_hi(g.w) * v1[3];
                    if (ADD) { const u32x4 p = *(const u32x4*)(rowp + bj * HALF);
                        r0 += bf_lo(p.x); r1 += bf_hi(p.x); r2 += bf_lo(p.y); r3 += bf_hi(p.y); r4 += bf_lo(p.z); r5 += bf_hi(p.z); r6 += bf_lo(p.w); r7 += bf_hi(p.w); }
                    u32x4 w; w.x = cvt_pk_bf16(r0, r1); w.y = cvt_pk_bf16(r2, r3); w.z = cvt_pk_bf16(r4, r5); w.w = cvt_pk_bf16(r6, r7);
                    *(u32x4*)(rowp + bj * HALF) = w; } }
    }
};
struct EpiRes {
    static constexpr bool PERM = false, AFTER_DRAIN = false;
    const float* base; float* out; int ldc; float sc;
    __device__ __forceinline__ void operator()(const f32x4 (&acc)[2][2][4][2], const Unit& u, int wr, int wc, int fr, int fq) const {
        const int col0 = u.pn * BM + wc * 32 + 4 * fq;
#pragma unroll
        for (int ai = 0; ai < 2; ++ai)
#pragma unroll
            for (int m = 0; m < 4; ++m) { const size_t off = (size_t)(u.pm * BM + ai * HALF + wr * 64 + m * 16 + fr) * ldc + col0;
#pragma unroll
                for (int bj = 0; bj < 2; ++bj)
#pragma unroll
                    for (int n = 0; n < 2; ++n) { const f32x4 bs = *(const f32x4*)(base + off + bj * HALF + n * 16); *(f32x4*)(out + off + bj * HALF + n * 16) = (sc != 0.f) ? bs + acc[ai][bj][m][n] * sc : bs; } }
    }
};
template <class Epi, class Sched, bool ALIGN_EPI = false, bool SP2 = false>
__device__ __forceinline__ void gemm_phase(PG8_LAS unsigned char* lds, const Gemm g, const Sched& S, const Epi& E) {
    const int tid = threadIdx.x, wid = __builtin_amdgcn_readfirstlane(tid >> 6), lane = tid & 63, wr = wid >> 2, wc = wid & 3, fr = lane & 15, fq = lane >> 4;
    const int K = g.K, nt = K / BK;
    unsigned voffA[2], voffB[2];
#pragma unroll
    for (int i = 0; i < 2; ++i) { int R, C; stage_rc(tid * 16 + i * 8192, R, C); const int Rb = Epi::PERM ? ((R & ~31) + perm32(R & 31)) : R;
        voffA[i] = (unsigned)(R * K + C) * 2u; voffB[i] = (unsigned)(Rb * K + C) * 2u; }
    const size_t kstep = (size_t)(BK * 2);
    const size_t hstep = (size_t)HALF * K * 2;
    const size_t tstep = 2 * hstep;
    const unsigned ldsw = (unsigned)wid * 1024u;
    const int aoff = lds_byte(wr * 64 + fr, fq * 8), boff = lds_byte(wc * 32 + fr, fq * 8);
#define PG8_SA(b, h) (((b) * 2 + (h)) * HTB)
#define PG8_SB(b, h) ((4 + (b) * 2 + (h)) * HTB)
#define PG8_STAGE(bufoff, gbase, voff) do { _Pragma("unroll") for (int _i = 0; _i < 2; ++_i) \
        __builtin_amdgcn_global_load_lds((const unsigned*)((const char*)(gbase) + (voff)[_i]), (PG8_LAS unsigned*)(lds + (bufoff) + ldsw + _i * 8192), 16, 0, 0); } while (0)
#define PG8_LDA(dst, b, h) do { _Pragma("unroll") for (int m = 0; m < 4; ++m) _Pragma("unroll") for (int k = 0; k < 2; ++k) dst[m][k] = *(const PG8_LAS bf16x8*)(lds + PG8_SA(b, h) + aoff + m * 2048 + k * 1024); } while (0)
#define PG8_LDB(dst, b, h) do { _Pragma("unroll") for (int n = 0; n < 2; ++n) _Pragma("unroll") for (int k = 0; k < 2; ++k) dst[n][k] = *(const PG8_LAS bf16x8*)(lds + PG8_SB(b, h) + boff + n * 2048 + k * 1024); } while (0)
#define PG8_MMA(ai, bj, At, Bt) do { __builtin_amdgcn_s_setprio(1); _Pragma("unroll") for (int m = 0; m < 4; ++m) _Pragma("unroll") for (int n = 0; n < 2; ++n) _Pragma("unroll") for (int k = 0; k < 2; ++k) \
        acc[ai][bj][m][n] = __builtin_amdgcn_mfma_f32_16x16x32_bf16(Bt[n][k], At[m][k], acc[ai][bj][m][n], 0, 0, 0); __builtin_amdgcn_s_setprio(0); } while (0)
#define PG8_WAIT_V(n) asm volatile("s_waitcnt vmcnt(" #n ")" ::: "memory")
#define PG8_WAIT_L(n) asm volatile("s_waitcnt lgkmcnt(" #n ")" ::: "memory")
#define PG8_BAR __builtin_amdgcn_s_barrier()
#define PG8_SCHED __builtin_amdgcn_sched_barrier(0)
    Unit cur, nxt; int ui = 0;
    if (!S.next(0, cur)) return;
    f32x4 acc[2][2][4][2];
#pragma unroll
    for (int a = 0; a < 2; ++a)
#pragma unroll
        for (int b = 0; b < 2; ++b)
#pragma unroll
            for (int m = 0; m < 4; ++m)
#pragma unroll
                for (int n = 0; n < 2; ++n) acc[a][b][m][n] = (f32x4){0.f, 0.f, 0.f, 0.f};
    bf16x8 At[4][2], B0[2][2], B1[2][2];
    const char* cA = (const char*)g.A + (size_t)cur.pm * tstep; const char* cB = (const char*)g.Bt + (size_t)cur.pn * tstep;
    S.a_ready(cur);
    if constexpr (SP2) {
        PG8_STAGE(PG8_SB(0, 0), cB, voffB); PG8_STAGE(PG8_SB(0, 1), cB + hstep, voffB); PG8_STAGE(PG8_SA(0, 0), cA, voffA); PG8_STAGE(PG8_SA(0, 1), cA + hstep, voffA);
        if (wr == 1) PG8_BAR;
        PG8_WAIT_V(2); PG8_BAR;
        PG8_STAGE(PG8_SB(1, 0), cB + kstep, voffB); PG8_STAGE(PG8_SA(1, 0), cA + kstep, voffA); PG8_STAGE(PG8_SB(1, 1), cB + hstep + kstep, voffB);
        PG8_WAIT_V(6); PG8_BAR;
    } else {
        PG8_STAGE(PG8_SB(0, 0), cB, voffB); PG8_STAGE(PG8_SA(0, 0), cA, voffA); PG8_STAGE(PG8_SB(0, 1), cB + hstep, voffB); PG8_STAGE(PG8_SA(0, 1), cA + hstep, voffA);
        if (wr == 1) PG8_BAR;
        PG8_WAIT_V(4); PG8_BAR;
        PG8_STAGE(PG8_SB(1, 0), cB + kstep, voffB); PG8_STAGE(PG8_SA(1, 0), cA + kstep, voffA); PG8_STAGE(PG8_SB(1, 1), cB + hstep + kstep, voffB);
        PG8_WAIT_V(6); PG8_BAR;
    }
    for (;;) {
        const bool has_next = S.next(ui + 1, nxt);
        const char* nA = has_next ? (const char*)g.A + (size_t)nxt.pm * tstep : cA; const char* nB = has_next ? (const char*)g.Bt + (size_t)nxt.pn * tstep : cB;
        for (int t = 0; t < nt; t += 2) {
            const bool last = (t == nt - 2);
            const char* a1 = cA + (size_t)(t + 1) * kstep;
            const char* a2 = last ? nA : cA + (size_t)(t + 2) * kstep; const char* b2 = last ? nB : cB + (size_t)(t + 2) * kstep;
            const char* a3 = a2 + kstep; const char* b3 = b2 + kstep;
            if (last && has_next) S.a_ready(nxt);
            if constexpr (SP2) {
            PG8_LDB(B0, 0, 0); PG8_LDB(B1, 0, 1); PG8_SCHED; PG8_LDA(At, 0, 0); PG8_STAGE(PG8_SA(1, 1), a1 + hstep, voffA);
            PG8_WAIT_V(8); PG8_WAIT_L(0); PG8_BAR; PG8_MMA(0, 0, At, B0); PG8_MMA(0, 1, At, B1); PG8_BAR; PG8_SCHED;
            PG8_LDA(At, 0, 1); PG8_STAGE(PG8_SB(0, 0), b2, voffB); PG8_STAGE(PG8_SB(0, 1), b2 + hstep, voffB); PG8_STAGE(PG8_SA(0, 0), a2, voffA);
            PG8_WAIT_V(8); PG8_WAIT_L(0); PG8_BAR; PG8_MMA(1, 0, At, B0); PG8_MMA(1, 1, At, B1); PG8_BAR; PG8_SCHED;
            PG8_LDB(B0, 1, 0); PG8_LDB(B1, 1, 1); PG8_SCHED; PG8_LDA(At, 1, 0); PG8_STAGE(PG8_SA(0, 1), a2 + hstep, voffA);
            PG8_WAIT_V(8); PG8_WAIT_L(0); PG8_BAR; PG8_MMA(0, 0, At, B0); PG8_MMA(0, 1, At, B1); PG8_BAR; PG8_SCHED;
            PG8_LDA(At, 1, 1); PG8_STAGE(PG8_SB(1, 0), b3, voffB); PG8_STAGE(PG8_SB(1, 1), b3 + hstep, voffB); PG8_STAGE(PG8_SA(1, 0), a3, voffA);
            PG8_WAIT_V(8); PG8_WAIT_L(0); PG8_BAR; PG8_MMA(1, 0, At, B0); PG8_MMA(1, 1, At, B1); PG8_BAR; PG8_SCHED;
            } else {
            PG8_LDB(B0, 0, 0); PG8_SCHED; PG8_LDA(At, 0, 0); PG8_STAGE(PG8_SA(1, 1), a1 + hstep, voffA);
            PG8_WAIT_L(8); PG8_BAR; PG8_WAIT_L(0); PG8_MMA(0, 0, At, B0); PG8_BAR; PG8_SCHED;
            PG8_LDB(B1, 0, 1); PG8_STAGE(PG8_SB(0, 0), b2, voffB);
            PG8_BAR; PG8_WAIT_L(0); PG8_MMA(0, 1, At, B1); PG8_BAR;
            PG8_LDA(At, 0, 1); PG8_STAGE(PG8_SA(0, 0), a2, voffA);
            PG8_BAR; PG8_WAIT_L(0); PG8_MMA(1, 0, At, B0); PG8_BAR; PG8_SCHED;
            PG8_STAGE(PG8_SB(0, 1), b2 + hstep, voffB);
            PG8_WAIT_V(6); PG8_BAR; PG8_MMA(1, 1, At, B1); PG8_BAR;
            PG8_LDB(B0, 1, 0); PG8_SCHED; PG8_LDA(At, 1, 0); PG8_STAGE(PG8_SA(0, 1), a2 + hstep, voffA);
            PG8_WAIT_L(8); PG8_BAR; PG8_WAIT_L(0); PG8_MMA(0, 0, At, B0); PG8_BAR; PG8_SCHED;
            PG8_LDB(B1, 1, 1); PG8_STAGE(PG8_SB(1, 0), b3, voffB);
            PG8_BAR; PG8_WAIT_L(0); PG8_MMA(0, 1, At, B1); PG8_BAR;
            PG8_LDA(At, 1, 1); PG8_STAGE(PG8_SA(1, 0), a3, voffA);
            PG8_BAR; PG8_WAIT_L(0); PG8_MMA(1, 0, At, B0); PG8_BAR; PG8_SCHED;
            PG8_STAGE(PG8_SB(1, 1), b3 + hstep, voffB);
            PG8_WAIT_V(6); PG8_BAR; PG8_MMA(1, 1, At, B1); PG8_BAR;
            }
        }
        if constexpr (ALIGN_EPI) { if (wr == 0) PG8_BAR; }
        if constexpr (!Epi::AFTER_DRAIN) { E(acc, cur, wr, wc, fr, fq); S.done(cur); }
        if (!has_next) break;
#pragma unroll
        for (int a = 0; a < 2; ++a)
#pragma unroll
            for (int b = 0; b < 2; ++b)
#pragma unroll
                for (int m = 0; m < 4; ++m)
#pragma unroll
                    for (int n = 0; n < 2; ++n) acc[a][b][m][n] = (f32x4){0.f, 0.f, 0.f, 0.f};
        cur = nxt; cA = nA; cB = nB; ++ui;
        if constexpr (ALIGN_EPI) { if (wr == 1) PG8_BAR; }
    }
    PG8_WAIT_V(0);
    if constexpr (!ALIGN_EPI) { if (wr == 0) PG8_BAR; }
    PG8_BAR;
    if constexpr (Epi::AFTER_DRAIN) { E.fused(acc, cur, wr, wc, fr, fq, lds, wid, lane); S.done(cur); }
#undef PG8_SA
#undef PG8_SB
#undef PG8_STAGE
#undef PG8_LDA
#undef PG8_LDB
#undef PG8_MMA
#undef PG8_WAIT_V
#undef PG8_WAIT_L
#undef PG8_BAR
#undef PG8_SCHED
}
}

constexpr int NB = 8, SEQ = 4096, DM = 1024, T = NB * SEQ, NMEM = 256, MROWS = NB * NMEM;
constexpr int QKVW = 3840, GATEW = 2048, NIN = 5888;
constexpr float RMS_EPS = 1e-6f;
constexpr int NPH = 15;
#ifndef DBG_MIX
#define DBG_MIX 1
#endif
#ifndef DBG_CROSS
#define DBG_CROSS 1
#endif
#ifndef DBG_PEER
#define DBG_PEER 1
#endif
#ifndef DBG_TOPK_SIMPLE
#define DBG_TOPK_SIMPLE 0
#endif
#ifndef DBG_CHECK
#define DBG_CHECK 0
#endif
#ifndef DBG_ATTN_CHECK
#define DBG_ATTN_CHECK 0
#endif
#ifndef DBG_CROSS_CHECK
#define DBG_CROSS_CHECK 0
#endif
#ifndef DBG_NOBIAS
#define DBG_NOBIAS 0
#endif
#ifndef DBG_DIL_CHECK
#define DBG_DIL_CHECK 0
#endif
#ifndef ATTN_MFMA
#define ATTN_MFMA 1
#endif
#if DBG_CHECK
#define DBG_YPTR ((float*)(ws + 510 * MiB))
#else
#define DBG_YPTR ((float*)nullptr)
#endif
#ifndef MK_ONE_LAUNCH
#define MK_ONE_LAUNCH 1
#endif
constexpr size_t MiB = 1u << 20;
constexpr size_t WS_CTL = 0, CTL_ZERO_BYTES = 1 * MiB;
constexpr size_t WS_KMEAN = 1 * MiB;
constexpr size_t WS_INV = 2 * MiB;
constexpr size_t WS_WIN = 3 * MiB;
constexpr size_t WS_WA = 15 * MiB, WS_WB = 16 * MiB, WS_WOUT = 17 * MiB, WS_WQC = 19 * MiB, WS_WKVC = 20 * MiB, WS_WOC = 22 * MiB, WS_WQP = 23 * MiB, WS_SUBK = 27 * MiB;
constexpr size_t WS_U = 28 * MiB, WS_V = 60 * MiB;
constexpr size_t WS_H = 92 * MiB;
constexpr size_t WS_MEMB = 156 * MiB, WS_KVC = 160 * MiB;
constexpr size_t WS_ODIL = 164 * MiB, WS_OMOBA = 180 * MiB;
constexpr size_t WS_PQKV = 212 * MiB;
constexpr size_t WS_MERGED = WS_PQKV, WS_X1 = WS_PQKV + 64 * MiB, WS_QC = WS_PQKV + 192 * MiB, WS_OC = WS_ODIL;
constexpr size_t WS_EXP = WS_PQKV, WS_EW = WS_PQKV + 16 * MiB;
constexpr size_t WS_ODG = 452 * MiB, WS_LSE = 500 * MiB;
constexpr size_t WS_END = 502 * MiB;
constexpr int CW_TMO = 0, CW_CODE = 1, CW_BAR = 4096;
constexpr int RING_OFF = 0, RING_BYTES = 131072;
constexpr int LDSCTL_OFF = RING_BYTES, MISC_OFF = LDSCTL_OFF + 320;
constexpr int LDS_BYTES = 147456;
constexpr int NWAVES = 8;

#define GAS __attribute__((address_space(1)))
#define LAS __attribute__((address_space(3)))
typedef unsigned short bf16;
typedef unsigned v4u __attribute__((ext_vector_type(4)));
typedef float f32x4 __attribute__((ext_vector_type(4)));
typedef float f32x16 __attribute__((ext_vector_type(16)));
typedef short bf16x8 __attribute__((ext_vector_type(8)));
typedef __bf16 bf2_t __attribute__((ext_vector_type(2)));
typedef GAS unsigned gu32;
#define RLX_AGENT __ATOMIC_RELAXED, __HIP_MEMORY_SCOPE_AGENT
#define LDS_WAIT() asm volatile("s_waitcnt lgkmcnt(0)" ::: "memory")
#define VM_WAIT() asm volatile("s_waitcnt vmcnt(0)" ::: "memory")
__device__ __forceinline__ unsigned pk2(float lo, float hi) { return pg8::cvt_pk_bf16(lo, hi); }
__device__ __forceinline__ float bf_lo(unsigned w) { return __uint_as_float(w << 16); }
__device__ __forceinline__ float bf_hi(unsigned w) { return __uint_as_float(w & 0xffff0000u); }
__device__ __forceinline__ float bf2f(bf16 b) { return __uint_as_float((unsigned)b << 16); }

#define XB_TMO      128
#define XB_XCNT(j)  (256  + 64 * (j))
#define XB_XSUB(j)  (1280 + 64 * (j))
#define XB_XGEN(j)  (2304 + 64 * (j))
#define XB_TOP      3328
#define XB_TOPGEN   3392
#define XCD_BAR_WORDS 3456
#define XB_SPIN_CAP (1u << 18)

__device__ __forceinline__ unsigned xb_ld(unsigned* p)              { return __hip_atomic_load(p, __ATOMIC_RELAXED, __HIP_MEMORY_SCOPE_AGENT); }
__device__ __forceinline__ unsigned xb_add(unsigned* p, unsigned v) { return __hip_atomic_fetch_add(p, v, __ATOMIC_RELAXED, __HIP_MEMORY_SCOPE_AGENT); }
__device__ __forceinline__ unsigned xb_xcc_id() { return (unsigned)__builtin_amdgcn_s_getreg((3 << 11) | 20) & 0xFu; }
#define XB_SPIN(cond, bar) do { unsigned _sp = 0; while (cond) { __builtin_amdgcn_s_sleep(1); \
    if ((++_sp & 255u) == 0u) { if (xb_ld(&(bar)[XB_TMO])) break; if (_sp > XB_SPIN_CAP) { atomicAdd(&(bar)[XB_TMO], 1u); break; } } } } while (0)

struct XcdBarrier {
    unsigned* bar; unsigned x;
    volatile LAS unsigned* st;
};

__device__ __forceinline__ XcdBarrier xcd_barrier_post(unsigned* bar, volatile LAS unsigned* st) {
    XcdBarrier b; b.bar = bar; b.x = xb_xcc_id(); b.st = st;
    if (threadIdx.x == 0) (void)xb_add(&bar[XB_XCNT(b.x)], 1u);
    return b;
}
__device__ __forceinline__ void xcd_barrier_complete(unsigned* bar, unsigned x, unsigned& nloc, unsigned& nx) {
    const unsigned G = gridDim.x * gridDim.y * gridDim.z;
    unsigned sum, cnt, mine, sp = 0u;
    for (;;) {
        sum = 0u; cnt = 0u; mine = 0u;
#pragma unroll
        for (unsigned j = 0; j < 16; ++j) { const unsigned c = xb_ld(&bar[XB_XCNT(j)]); sum += c; cnt += (c > 0u) ? 1u : 0u; mine = (j == x) ? c : mine; }
        if (sum == G) break;
        __builtin_amdgcn_s_sleep(1);
        if ((++sp & 255u) == 0u) { if (xb_ld(&bar[XB_TMO])) break; if (sp > XB_SPIN_CAP) { atomicAdd(&bar[XB_TMO], 1u); break; } }
    }
    nloc = mine > 0u ? mine : 1u; nx = cnt > 0u ? cnt : 1u;
}

__device__ __forceinline__ void xcd_barrier(const XcdBarrier& b) {
    asm volatile("s_waitcnt vmcnt(0)" ::: "memory");
    __syncthreads();
    if (threadIdx.x == 0) {
        unsigned* bar = b.bar;
        __builtin_amdgcn_s_waitcnt(0);
        unsigned nloc = b.st[0], nx = b.st[1];
        if (nloc == 0u) { xcd_barrier_complete(bar, b.x, nloc, nx); b.st[0] = nloc; b.st[1] = nx; }
        const unsigned old = xb_add(&bar[XB_XSUB(b.x)], 1u);
        const unsigned gen = old / nloc;
        if (old + 1u == (gen + 1u) * nloc) {
            __builtin_amdgcn_fence(__ATOMIC_RELEASE, "agent");
            asm volatile("s_waitcnt vmcnt(0)" ::: "memory");
            const unsigned og = xb_add(&bar[XB_TOP], 1u);
            const unsigned tg = og / nx;
            if (og + 1u == (tg + 1u) * nx) xb_add(&bar[XB_TOPGEN], 1u);
            else XB_SPIN(xb_ld(&bar[XB_TOPGEN]) == tg, bar);
            __builtin_amdgcn_fence(__ATOMIC_ACQUIRE, "agent");
            xb_add(&bar[XB_XGEN(b.x)], 1u);
            asm volatile("s_waitcnt vmcnt(0)" ::: "memory");
        } else {
            XB_SPIN(xb_ld(&bar[XB_XGEN(b.x)]) == gen, bar);
            __builtin_amdgcn_fence(__ATOMIC_ACQUIRE, "agent");
            asm volatile("s_waitcnt vmcnt(0)" ::: "memory");
        }
    }
    __syncthreads();
}

__device__ __forceinline__ float wave_sum(float v) {
#pragma unroll
    for (int o = 1; o < 64; o <<= 1) v += __shfl_xor(v, o);
    return v;
}
__device__ __forceinline__ int t5_bucket(int n) {
    int b = n;
    if (n >= 16) { b = 16 + (n >= 22) + (n >= 30) + (n >= 40) + (n >= 54) + (n >= 73) + (n >= 99) + (n >= 134) + (n >= 182) + (n >= 246) + (n >= 332) + (n >= 450) + (n >= 609) + (n >= 825) + (n >= 1117) + (n >= 1513); }
    return b;
}
__device__ __forceinline__ void p0_transpose_item(const float* W, int K, int N, bf16* WT, LAS float* scr, int item, int lane) {
    const int nblk = N / 32, kb = item / nblk, nb = item % nblk, k0 = 64 * kb, n0 = 32 * nb;
#pragma unroll 8
    for (int i = 0; i < 32; ++i) { const int kk = 2 * i + (lane >> 5); scr[kk * 33 + (lane & 31)] = W[(size_t)(k0 + kk) * N + n0 + (lane & 31)]; }
    LDS_WAIT(); asm volatile("" ::: "memory");
    const int c = lane & 7;
#pragma unroll
    for (int j = 0; j < 4; ++j) { const int n = (lane >> 3) + 8 * j; const LAS float* s = scr + (8 * c) * 33 + n;
        v4u o; o.x = pk2(s[0 * 33], s[1 * 33]); o.y = pk2(s[2 * 33], s[3 * 33]); o.z = pk2(s[4 * 33], s[5 * 33]); o.w = pk2(s[6 * 33], s[7 * 33]);
        *(GAS v4u*)(WT + (size_t)(n0 + n) * K + k0 + 8 * c) = o; }
    LDS_WAIT(); asm volatile("" ::: "memory");
}
__device__ __forceinline__ void rms_row_to_bf16(const float* xrow, const float* g, bf16* orow, int lane) {
    const f32x4* xr = (const f32x4*)xrow + lane; const f32x4* gr = (const f32x4*)g + lane;
    f32x4 v[4]; float s = 0.f;
#pragma unroll
    for (int j = 0; j < 4; ++j) { v[j] = xr[64 * j]; s += (v[j].x * v[j].x + v[j].y * v[j].y) + (v[j].z * v[j].z + v[j].w * v[j].w); }
    const float rinv = rsqrtf(wave_sum(s) * (1.f / 1024.f) + RMS_EPS);
    unsigned long long* o8 = (unsigned long long*)orow + lane;
#pragma unroll
    for (int j = 0; j < 4; ++j) { const f32x4 gv = gr[64 * j]; o8[64 * j] = (unsigned long long)pk2(v[j].x * rinv * gv.x, v[j].y * rinv * gv.y) | ((unsigned long long)pk2(v[j].z * rinv * gv.z, v[j].w * rinv * gv.w) << 32); }
}
__device__ __forceinline__ void cvt_f32_to_bf16_bulk(const float* src, bf16* dst, size_t n, size_t gtid, size_t nthr) {
    for (size_t i = gtid; i < n / 8; i += nthr) { const f32x4 a = ((const f32x4*)src)[2 * i], b = ((const f32x4*)src)[2 * i + 1];
        v4u o; o.x = pk2(a.x, a.y); o.y = pk2(a.z, a.w); o.z = pk2(b.x, b.y); o.w = pk2(b.z, b.w); ((v4u*)dst)[i] = o; }
}
__device__ __forceinline__ void os_step(const float (&q)[64], float (&o)[64], float& m, float& l, const bf16* krow, const bf16* vrow, float bias) {
    const v4u* kp = (const v4u*)krow; float s = 0.f;
#pragma unroll
    for (int c = 0; c < 8; ++c) { const v4u w = kp[c];
        s += q[8 * c + 0] * bf_lo(w.x) + q[8 * c + 1] * bf_hi(w.x) + q[8 * c + 2] * bf_lo(w.y) + q[8 * c + 3] * bf_hi(w.y)
           + q[8 * c + 4] * bf_lo(w.z) + q[8 * c + 5] * bf_hi(w.z) + q[8 * c + 6] * bf_lo(w.w) + q[8 * c + 7] * bf_hi(w.w); }
    s += bias;
    const float mn = fmaxf(m, s), al = __expf(m - mn), p = __expf(s - mn);
    l = l * al + p; m = mn;
    const v4u* vp = (const v4u*)vrow;
#pragma unroll
    for (int c = 0; c < 8; ++c) { const v4u w = vp[c];
        o[8 * c + 0] = o[8 * c + 0] * al + p * bf_lo(w.x); o[8 * c + 1] = o[8 * c + 1] * al + p * bf_hi(w.x);
        o[8 * c + 2] = o[8 * c + 2] * al + p * bf_lo(w.y); o[8 * c + 3] = o[8 * c + 3] * al + p * bf_hi(w.y);
        o[8 * c + 4] = o[8 * c + 4] * al + p * bf_lo(w.z); o[8 * c + 5] = o[8 * c + 5] * al + p * bf_hi(w.z);
        o[8 * c + 6] = o[8 * c + 6] * al + p * bf_lo(w.w); o[8 * c + 7] = o[8 * c + 7] * al + p * bf_hi(w.w); }
}
__device__ __forceinline__ void load_q64(float (&q)[64], const bf16* qrow, float scale) {
    const v4u* qp = (const v4u*)qrow;
#pragma unroll
    for (int c = 0; c < 8; ++c) { const v4u w = qp[c];
        q[8 * c + 0] = bf_lo(w.x) * scale; q[8 * c + 1] = bf_hi(w.x) * scale; q[8 * c + 2] = bf_lo(w.y) * scale; q[8 * c + 3] = bf_hi(w.y) * scale;
        q[8 * c + 4] = bf_lo(w.z) * scale; q[8 * c + 5] = bf_hi(w.z) * scale; q[8 * c + 6] = bf_lo(w.w) * scale; q[8 * c + 7] = bf_hi(w.w) * scale; }
}
__device__ __forceinline__ void store_o64(const float (&o)[64], float inv, bf16* orow) {
    v4u* op = (v4u*)orow;
#pragma unroll
    for (int c = 0; c < 8; ++c) { v4u w; w.x = pk2(o[8 * c + 0] * inv, o[8 * c + 1] * inv); w.y = pk2(o[8 * c + 2] * inv, o[8 * c + 3] * inv);
        w.z = pk2(o[8 * c + 4] * inv, o[8 * c + 5] * inv); w.w = pk2(o[8 * c + 6] * inv, o[8 * c + 7] * inv); op[c] = w; }
}
__device__ __forceinline__ void cmp_o64(const float (&o)[64], float inv, const bf16* ref, float& num, float& den) {
#pragma unroll
    for (int c = 0; c < 64; ++c) { const float a = o[c] * inv, b = bf2f(ref[c]); num += (a - b) * (a - b); den += a * a; }
}
__device__ __forceinline__ void dbg_acc2(float* acc, float num, float den) { num = wave_sum(num); den = wave_sum(den); if ((threadIdx.x & 63) == 0 && acc) { atomicAdd(acc, num); atomicAdd(acc + 1, den); } }
template <bool SAMP> __device__ __forceinline__ void phase_dil_simple(const bf16* P, const float* rel_bias, bf16* ODIL, int gtid, int nthr, float* acc = nullptr) {
    float cnum = 0.f, cden = 0.f;
    constexpr int NTOK = SAMP ? T / 16 : T;
    for (int item = gtid; item < 4 * NTOK; item += nthr) {
        const int h = item / NTOK, ti = item % NTOK, tok = SAMP ? ti * 16 + 5 : ti, b = tok / SEQ, t = tok % SEQ;
        float o[64], q[64]; float m = -1e30f, l = 0.f;
#pragma unroll
        for (int c = 0; c < 64; ++c) o[c] = 0.f;
        for (int g = 0; g < 3; ++g) {
            const int d = 1 << (2 * g);
            load_q64(q, P + (size_t)tok * QKVW + g * 768 + h * 64, 0.125f);
            for (int j = 0; j <= 128; ++j) {
                const int tp = t - j * d;
                if (tp >= 0) {
                    const bf16* kr = P + (size_t)(b * SEQ + tp) * QKVW + g * 768 + 256 + h * 64;
                    os_step(q, o, m, l, kr, kr + 256, DBG_NOBIAS ? 0.f : rel_bias[t5_bucket(j * d) * 20 + g * 4 + h]);
                }
            }
        }
        if (SAMP) cmp_o64(o, 1.0f / l, ODIL + (size_t)tok * 256 + h * 64, cnum, cden); else store_o64(o, 1.0f / l, ODIL + (size_t)ti * 256 + h * 64);
    }
    if (SAMP) dbg_acc2(acc, cnum, cden);
}
template <bool SAMP> __device__ __forceinline__ void phase_moba_simple(const bf16* P, const float* KMEAN, const float* rel_bias, bf16* OMOBA, int gtid, int nthr, float* acc = nullptr) {
    float cnum = 0.f, cden = 0.f, cnum2 = 0.f, cden2 = 0.f;
    constexpr int NTOK = SAMP ? T / 16 : T;
    for (int item = gtid; item < 8 * NTOK; item += nthr) {
        const int h = item / NTOK, ti = item % NTOK, tok = SAMP ? ti * 16 + 5 : ti, b = tok / SEQ, t = tok % SEQ, qb = t >> 8;
        float o[64], q[64]; float m = -1e30f, l = 0.f;
#pragma unroll
        for (int c = 0; c < 64; ++c) o[c] = 0.f;
        load_q64(q, P + (size_t)tok * QKVW + 2304 + h * 64, 1.0f);
        float v1 = -3e38f, v2 = -3e38f, v3 = -3e38f; int i1 = -1, i2 = -1, i3 = -1;
        for (int n = 0; n < qb; ++n) {
            const float* km = KMEAN + (size_t)((b * 8 + h) * 16 + n) * 64; float gs = 0.f;
#pragma unroll
            for (int c = 0; c < 64; ++c) gs += q[c] * km[c];
            if (gs > v1) { v3 = v2; i3 = i2; v2 = v1; i2 = i1; v1 = gs; i1 = n; }
            else if (gs > v2) { v3 = v2; i3 = i2; v2 = gs; i2 = n; }
            else if (gs > v3) { v3 = gs; i3 = n; }
        }
        unsigned sel = 0u;
        if (i1 >= 0) sel |= 1u << i1;
        if (i2 >= 0) sel |= 1u << i2;
        if (i3 >= 0) sel |= 1u << i3;
#pragma unroll
        for (int c = 0; c < 64; ++c) q[c] *= 0.125f;
        const bf16* Kb = P + (size_t)(b * SEQ) * QKVW + 2304 + 512 + h * 64;
        for (int n = 0; n < 16; ++n) {
            const bool on = ((sel >> n) & 1u) && (n < qb);
            if (__any(on)) {
                for (int j = 0; j < 256; ++j) {
                    const int kpos = n * 256 + j;
                    if (on) { const bf16* kr = Kb + (size_t)kpos * QKVW; os_step(q, o, m, l, kr, kr + 512, DBG_NOBIAS ? 0.f : rel_bias[t5_bucket(t - kpos) * 20 + 12 + h]); }
                }
            }
        }
        for (int j = 0; j < 256; ++j) { const int kpos = qb * 256 + j;
            if (kpos <= t) { const bf16* kr = Kb + (size_t)kpos * QKVW; os_step(q, o, m, l, kr, kr + 512, DBG_NOBIAS ? 0.f : rel_bias[t5_bucket(t - kpos) * 20 + 12 + h]); }
        }
        if (SAMP) { if (qb == 0) cmp_o64(o, 1.0f / l, OMOBA + (size_t)tok * 512 + h * 64, cnum, cden); else cmp_o64(o, 1.0f / l, OMOBA + (size_t)tok * 512 + h * 64, cnum2, cden2); } else store_o64(o, 1.0f / l, OMOBA + (size_t)ti * 512 + h * 64);
    }
    if (SAMP) { dbg_acc2(acc, cnum, cden); dbg_acc2(acc + 2, cnum2, cden2); }
}
template <bool SAMP> __device__ __forceinline__ void phase_cross_simple(const bf16* QC, const bf16* KVC, bf16* OC, int gtid, int nthr, float* acc = nullptr) {
    float cnum = 0.f, cden = 0.f;
    constexpr int NTOK = SAMP ? T / 16 : T;
    for (int item = gtid; item < 8 * NTOK; item += nthr) {
        const int half = item & 1, pr = item >> 1, h = pr / NTOK, ti = pr % NTOK, tok = SAMP ? ti * 16 + 5 : ti, b = tok / SEQ;
        float o[64], q[64]; float m = -1e30f, l = 0.f;
#pragma unroll
        for (int c = 0; c < 64; ++c) o[c] = 0.f;
        load_q64(q, QC + (size_t)tok * 512 + h * 128 + half * 64, 0.08838834764831845f);
        const bf16* Kb = KVC + (size_t)(b * NMEM) * 1024 + h * 128 + half * 64;
        for (int j = 0; j < NMEM; ++j) {
            const v4u* kp = (const v4u*)(Kb + (size_t)j * 1024); float s = 0.f;
#pragma unroll
            for (int c = 0; c < 8; ++c) { const v4u w = kp[c];
                s += q[8 * c + 0] * bf_lo(w.x) + q[8 * c + 1] * bf_hi(w.x) + q[8 * c + 2] * bf_lo(w.y) + q[8 * c + 3] * bf_hi(w.y)
                   + q[8 * c + 4] * bf_lo(w.z) + q[8 * c + 5] * bf_hi(w.z) + q[8 * c + 6] * bf_lo(w.w) + q[8 * c + 7] * bf_hi(w.w); }
            s += __shfl_xor(s, 1);
            const float mn = fmaxf(m, s), al = __expf(m - mn), p = __expf(s - mn);
            l = l * al + p; m = mn;
            const v4u* vp = (const v4u*)(Kb + (size_t)j * 1024 + 512);
#pragma unroll
            for (int c = 0; c < 8; ++c) { const v4u w = vp[c];
                o[8 * c + 0] = o[8 * c + 0] * al + p * bf_lo(w.x); o[8 * c + 1] = o[8 * c + 1] * al + p * bf_hi(w.x);
                o[8 * c + 2] = o[8 * c + 2] * al + p * bf_lo(w.y); o[8 * c + 3] = o[8 * c + 3] * al + p * bf_hi(w.y);
                o[8 * c + 4] = o[8 * c + 4] * al + p * bf_lo(w.z); o[8 * c + 5] = o[8 * c + 5] * al + p * bf_hi(w.z);
                o[8 * c + 6] = o[8 * c + 6] * al + p * bf_lo(w.w); o[8 * c + 7] = o[8 * c + 7] * al + p * bf_hi(w.w); }
        }
        if (SAMP) cmp_o64(o, 1.0f / l, OC + (size_t)tok * 512 + h * 128 + half * 64, cnum, cden); else store_o64(o, 1.0f / l, OC + (size_t)ti * 512 + h * 128 + half * 64);
    }
    if (SAMP) dbg_acc2(acc, cnum, cden);
}

__device__ __forceinline__ float tk_max(float a, float b) { return fmaxf(a, b); }
__device__ __forceinline__ float tk_min(float a, float b) { return fminf(a, b); }
template <int OFF> __device__ __forceinline__ void sort16_desc(float* v) {
#pragma unroll
    for (int k = 2; k <= 16; k <<= 1) {
#pragma unroll
        for (int j = k >> 1; j > 0; j >>= 1) {
#pragma unroll
            for (int i = 0; i < 16; ++i) {
                const int l = i ^ j;
                if (l > i) {
                    const bool desc = ((i & k) == 0);
                    const float x = v[OFF + i], y = v[OFF + l];
                    const float hi = tk_max(x, y), lo = tk_min(x, y);
                    v[OFF + i] = desc ? hi : lo; v[OFF + l] = desc ? lo : hi;
                }
            }
        }
    }
}
template <int OA, int OB, bool SORT> __device__ __forceinline__ void merge_top16(float* a, const float* b) {
#pragma unroll
    for (int i = 0; i < 16; ++i) a[OA + i] = tk_max(a[OA + i], b[OB + 15 - i]);
    if (SORT) {
#pragma unroll
        for (int j = 8; j > 0; j >>= 1) {
#pragma unroll
            for (int i = 0; i < 16; ++i) {
                const int l = i ^ j;
                if (l > i) { const float x = a[OA + i], y = a[OA + l]; a[OA + i] = tk_max(x, y); a[OA + l] = tk_min(x, y); }
            }
        }
    }
}
constexpr int cand_i(int c) { int n = 0; for (int i = 0; i < 16; ++i) for (int j = 0; j < 16 / (i + 1); ++j) { if (n == c) return i; ++n; } return 0; }
constexpr int cand_j(int c) { int n = 0; for (int i = 0; i < 16; ++i) for (int j = 0; j < 16 / (i + 1); ++j) { if (n == c) return j; ++n; } return 0; }
template <int C> struct CandT { static constexpr int I = cand_i(C), J = cand_j(C); };

__device__ __forceinline__ void peer_level1(const bf16* qrow  , const LAS unsigned char* sk  ,
                                            int r, int hh, float (&out)[16]) {
    bf16x8 qf[8];
#pragma unroll
    for (int ks = 0; ks < 8; ++ks) qf[ks] = *(const bf16x8*)(qrow + ks * 16 + hh * 8);
    float v[64];
#pragma unroll
    for (int kb = 0; kb < 4; ++kb) {
        f32x16 sc = {0.f, 0.f, 0.f, 0.f, 0.f, 0.f, 0.f, 0.f, 0.f, 0.f, 0.f, 0.f, 0.f, 0.f, 0.f, 0.f};
        const int key = kb * 32 + r;
#pragma unroll
        for (int ks = 0; ks < 8; ++ks) {
            const bf16x8 af = *(const LAS bf16x8*)(sk + key * 256 + (((2 * ks + hh) ^ (key & 15)) << 4));
            sc = __builtin_amdgcn_mfma_f32_32x32x16_bf16(af, qf[ks], sc, 0, 0, 0);
        }
#pragma unroll
        for (int reg = 0; reg < 16; ++reg) {
            const unsigned idx = (unsigned)(kb * 32 + (reg & 3) + 8 * (reg >> 2)) | ((unsigned)hh << 2);
            v[kb * 16 + reg] = __uint_as_float((__float_as_uint(sc[reg]) & ~127u) | idx);
        }
    }
    sort16_desc<0>(v); sort16_desc<16>(v); sort16_desc<32>(v); sort16_desc<48>(v);
    merge_top16<0, 16, true>(v, v); merge_top16<32, 48, true>(v, v); merge_top16<0, 32, true>(v, v);
    float other[16];
#pragma unroll
    for (int i = 0; i < 16; ++i) other[i] = __shfl_xor(v[i], 32);
    merge_top16<0, 0, true>(v, other);
#pragma unroll
    for (int i = 0; i < 16; ++i) out[i] = v[i];
}
template <int C> __device__ __forceinline__ void peer_emit(const float (&a)[16], const float (&b)[16], const float (&s)[64], float tau, int& cnt, float& den, bool writer, int* eo, float* wo) {
    if constexpr (C < 50) {
        const bool take = (s[C] >= tau) && (cnt < 16);
        const float e = __expf(s[C] - s[0]);
        if (take) {
            if (writer) { eo[cnt] = (int)(((__float_as_uint(a[CandT<C>::I]) & 127u) << 7) | (__float_as_uint(b[CandT<C>::J]) & 127u)); wo[cnt] = e; }
            cnt += 1; den += e;
        }
        peer_emit<C + 1>(a, b, s, tau, cnt, den, writer, eo, wo);
    }
}
template <int C> __device__ __forceinline__ void peer_sums(const float (&a)[16], const float (&b)[16], float (&s)[64]) {
    if constexpr (C < 50) { s[C] = a[CandT<C>::I] + b[CandT<C>::J]; peer_sums<C + 1>(a, b, s); }
}
__device__ __forceinline__ void phase_topk(LAS unsigned char* lds, const bf16* QP, const bf16* SUBK, int* EXP, float* EW, float* INV, int tid, int lane, int gw, int ngw) {
    for (int c = tid; c < 2 * 128 * 16; c += NWAVES * 64) { const int row = c >> 4, ch = c & 15; const v4u w = ((const v4u*)SUBK)[c]; *(LAS v4u*)(lds + row * 256 + ((ch ^ (row & 15)) << 4)) = w; }
    __syncthreads();
    const int r = lane & 31, hh = lane >> 5;
    for (int unit = gw; unit < (T / 32) * 8; unit += ngw) {
        const int tile = unit >> 3, head = unit & 7, tok = tile * 32 + r;
        const bf16* qrow = QP + (size_t)tok * 2048 + head * 256;
        float a[16], b[16];
        peer_level1(qrow, lds, r, hh, a);
        peer_level1(qrow + 128, lds + 128 * 256, r, hh, b);
        float s[64];
        peer_sums<0>(a, b, s);
#pragma unroll
        for (int c = 50; c < 64; ++c) s[c] = -INFINITY;
        float w[64];
#pragma unroll
        for (int c = 0; c < 64; ++c) w[c] = s[c];
        sort16_desc<0>(w); sort16_desc<16>(w); sort16_desc<32>(w); sort16_desc<48>(w);
        merge_top16<0, 16, true>(w, w); merge_top16<32, 48, true>(w, w); merge_top16<0, 32, false>(w, w);
        float tau = w[0];
#pragma unroll
        for (int i = 1; i < 16; ++i) tau = tk_min(tau, w[i]);
        int cnt = 0; float den = 0.f;
        peer_emit<0>(a, b, s, tau, cnt, den, hh == 0, EXP + (size_t)tok * 128 + head * 16, EW + (size_t)tok * 128 + head * 16);
        if (hh == 0) INV[(size_t)tok * 8 + head] = 1.0f / den;
    }
    __syncthreads();
}

__device__ __forceinline__ float dot2_bf16(unsigned w, unsigned x, float acc) { return __builtin_amdgcn_fdot2_f32_bf16(__builtin_bit_cast(bf2_t, w), __builtin_bit_cast(bf2_t, x), acc, false); }
__device__ __forceinline__ float dot8_bf16(const v4u a, const v4u b, float acc) {
    acc = dot2_bf16(a.x, b.x, acc); acc = dot2_bf16(a.y, b.y, acc); acc = dot2_bf16(a.z, b.z, acc); acc = dot2_bf16(a.w, b.w, acc);
    return acc;
}
template <int N> __device__ __forceinline__ void xpose_reduce(float (&p)[64], int lane) {
    if constexpr (N >= 1) {
        const bool up = (lane & N) != 0;
#pragma unroll
        for (int k = 0; k < N; ++k) { const float keep = up ? p[k + N] : p[k], send = up ? p[k] : p[k + N]; p[k] = keep + __shfl_xor(send, N); }
        xpose_reduce<N / 2>(p, lane);
    }
}
__device__ __forceinline__ float gelu_exact(float x) { return 0.5f * x * (1.0f + erff(x * 0.70710678118654752f)); }
__device__ __forceinline__ void phase_peer(const bf16* H, const bf16* U, const bf16* V, const int* EXP, const float* EW, const float* INV, const float* X2, const float* gfin, float* OUT, int lane, int gw, int ngw, float dbg_sc, float* ydbg) {
    for (int tok = gw; tok < T; tok += ngw) {
        int e0 = EXP[(size_t)tok * 128 + lane], e1 = EXP[(size_t)tok * 128 + 64 + lane];
        if (dbg_sc == 0.f) { e0 = 0; e1 = 0; }
        const float g0 = EW[(size_t)tok * 128 + lane] * INV[(size_t)tok * 8 + (lane >> 4)], g1 = EW[(size_t)tok * 128 + 64 + lane] * INV[(size_t)tok * 8 + 4 + (lane >> 4)];
        const v4u hA = *(const v4u*)(H + (size_t)tok * 1024 + 8 * lane), hB = *(const v4u*)(H + (size_t)tok * 1024 + 512 + 8 * lane);
        float wgt[2];
#pragma unroll
        for (int half = 0; half < 2; ++half) {
            const int ev = half ? e1 : e0;
            float p[64];
#pragma unroll
            for (int i0 = 0; i0 < 64; i0 += 8) {
                v4u ua[8], ub[8];
#pragma unroll
                for (int k = 0; k < 8; ++k) { const int eid = __builtin_amdgcn_readlane(ev, i0 + k); const v4u* up = (const v4u*)(U + (size_t)eid * 1024); ua[k] = up[lane]; ub[k] = up[64 + lane]; }
#pragma unroll
                for (int k = 0; k < 8; ++k) p[i0 + k] = dot8_bf16(hB, ub[k], dot8_bf16(hA, ua[k], 0.f));
            }
            xpose_reduce<32>(p, lane);
            wgt[half] = gelu_exact(p[0]) * (half ? g1 : g0);
        }
        float y[16];
#pragma unroll
        for (int c = 0; c < 16; ++c) y[c] = 0.f;
#pragma unroll
        for (int half = 0; half < 2; ++half) {
            const int ev = half ? e1 : e0; const float wv = wgt[half];
            for (int i0 = 0; i0 < 64; i0 += 8) {
                v4u va[8], vb[8]; float ws[8];
#pragma unroll
                for (int k = 0; k < 8; ++k) { const int eid = __builtin_amdgcn_readlane(ev, i0 + k); ws[k] = __int_as_float(__builtin_amdgcn_readlane(__float_as_int(wv), i0 + k));
                    const v4u* vp = (const v4u*)(V + (size_t)eid * 1024); va[k] = vp[lane]; vb[k] = vp[64 + lane]; }
#pragma unroll
                for (int k = 0; k < 8; ++k) { const float w = ws[k];
                    y[0] += w * bf_lo(va[k].x); y[1] += w * bf_hi(va[k].x); y[2] += w * bf_lo(va[k].y); y[3] += w * bf_hi(va[k].y);
                    y[4] += w * bf_lo(va[k].z); y[5] += w * bf_hi(va[k].z); y[6] += w * bf_lo(va[k].w); y[7] += w * bf_hi(va[k].w);
                    y[8] += w * bf_lo(vb[k].x); y[9] += w * bf_hi(vb[k].x); y[10] += w * bf_lo(vb[k].y); y[11] += w * bf_hi(vb[k].y);
                    y[12] += w * bf_lo(vb[k].z); y[13] += w * bf_hi(vb[k].z); y[14] += w * bf_lo(vb[k].w); y[15] += w * bf_hi(vb[k].w); }
            }
        }
        if (dbg_sc == 0.f) {
#pragma unroll
            for (int c = 0; c < 16; ++c) y[c] = 0.f; }
        if (ydbg) { const int s_ = tok / 512; if (tok == s_ * 512 + 3 + (s_ & 7) * 37) {
#pragma unroll
            for (int c = 0; c < 8; ++c) { ydbg[(size_t)s_ * 1024 + 8 * lane + c] = y[c]; ydbg[(size_t)s_ * 1024 + 512 + 8 * lane + c] = y[8 + c]; } } }
        const f32x4* xr = (const f32x4*)(X2 + (size_t)tok * 1024); const f32x4* gr = (const f32x4*)gfin;
        f32x4 x0 = xr[2 * lane], x1 = xr[2 * lane + 1], x2 = xr[128 + 2 * lane], x3 = xr[128 + 2 * lane + 1];
        x0.x += y[0]; x0.y += y[1]; x0.z += y[2]; x0.w += y[3]; x1.x += y[4]; x1.y += y[5]; x1.z += y[6]; x1.w += y[7];
        x2.x += y[8]; x2.y += y[9]; x2.z += y[10]; x2.w += y[11]; x3.x += y[12]; x3.y += y[13]; x3.z += y[14]; x3.w += y[15];
        float ss = (x0.x * x0.x + x0.y * x0.y + x0.z * x0.z + x0.w * x0.w) + (x1.x * x1.x + x1.y * x1.y + x1.z * x1.z + x1.w * x1.w)
                 + (x2.x * x2.x + x2.y * x2.y + x2.z * x2.z + x2.w * x2.w) + (x3.x * x3.x + x3.y * x3.y + x3.z * x3.z + x3.w * x3.w);
        const float rinv = rsqrtf(wave_sum(ss) * (1.f / 1024.f) + RMS_EPS);
        f32x4* orow = (f32x4*)(OUT + (size_t)tok * 1024);
        orow[2 * lane] = x0 * rinv * gr[2 * lane]; orow[2 * lane + 1] = x1 * rinv * gr[2 * lane + 1];
        orow[128 + 2 * lane] = x2 * rinv * gr[128 + 2 * lane]; orow[128 + 2 * lane + 1] = x3 * rinv * gr[128 + 2 * lane + 1];
    }
}
constexpr float L2E = 1.4426950408889634f;
typedef short v4i16_t __attribute__((ext_vector_type(4)));
template <int D> struct ACfg { static constexpr int KS = D / 16, NBLK = D / 32, PITCH = D * 2 + 16, TILEB = 64 * PITCH, PIECES = D / 64, CPR = D / 8; };
__device__ __forceinline__ bf16x8 pack8(float a0, float a1, float a2, float a3, float a4, float a5, float a6, float a7) {
    v4u u; u.x = pk2(a0, a1); u.y = pk2(a2, a3); u.z = pk2(a4, a5); u.w = pk2(a6, a7); return __builtin_bit_cast(bf16x8, u);
}
template <int D> __device__ __forceinline__ void attn_stage_load(v4u (&kr)[D / 64], v4u (&vr)[D / 64], const bf16* Kg, const bf16* Vg, size_t rowstride, int tid) {
#pragma unroll
    for (int p = 0; p < D / 64; ++p) { const int idx = tid + 512 * p, row = idx / ACfg<D>::CPR, ch = idx % ACfg<D>::CPR;
        kr[p] = *(const v4u*)(Kg + (size_t)row * rowstride + ch * 8); vr[p] = *(const v4u*)(Vg + (size_t)row * rowstride + ch * 8); }
}
template <int D> __device__ __forceinline__ void attn_stage_store(const v4u (&kr)[D / 64], const v4u (&vr)[D / 64], LAS unsigned char* Kl, LAS unsigned char* Vl, int tid) {
#pragma unroll
    for (int p = 0; p < D / 64; ++p) { const int idx = tid + 512 * p, row = idx / ACfg<D>::CPR, ch = idx % ACfg<D>::CPR;
        *(LAS v4u*)(Kl + row * ACfg<D>::PITCH + ch * 16) = kr[p]; *(LAS v4u*)(Vl + row * ACfg<D>::PITCH + ch * 16) = vr[p]; }
}
template <int D> __device__ __forceinline__ void attn_load_q(bf16x8 (&qf)[D / 16], const bf16* qrow, int hh, float scale) {
#pragma unroll
    for (int ks = 0; ks < D / 16; ++ks) { const v4u w = *(const v4u*)(qrow + ks * 16 + hh * 8);
        qf[ks] = pack8(bf_lo(w.x) * scale, bf_hi(w.x) * scale, bf_lo(w.y) * scale, bf_hi(w.y) * scale, bf_lo(w.z) * scale, bf_hi(w.z) * scale, bf_lo(w.w) * scale, bf_hi(w.w) * scale); }
}
template <int D, bool BIAS> __device__ __forceinline__ void attn_tile(const LAS unsigned char* Kl, const LAS unsigned char* Vl, const bf16x8 (&qf)[D / 16], f32x16 (&o)[D / 32], float& m, float& l,
                                                                      const LAS float* tb, bool active, int lane) {
    constexpr int PITCH = ACfg<D>::PITCH;
    const int r = lane & 31, hh = lane >> 5;
    f32x16 s0 = {0.f, 0.f, 0.f, 0.f, 0.f, 0.f, 0.f, 0.f, 0.f, 0.f, 0.f, 0.f, 0.f, 0.f, 0.f, 0.f}, s1 = s0;
#pragma unroll
    for (int ks = 0; ks < D / 16; ++ks) {
        const bf16x8 k0 = *(const LAS bf16x8*)(Kl + r * PITCH + (2 * ks + hh) * 16);
        const bf16x8 k1 = *(const LAS bf16x8*)(Kl + (32 + r) * PITCH + (2 * ks + hh) * 16);
        s0 = __builtin_amdgcn_mfma_f32_32x32x16_bf16(k0, qf[ks], s0, 0, 0, 0);
        s1 = __builtin_amdgcn_mfma_f32_32x32x16_bf16(k1, qf[ks], s1, 0, 0, 0);
    }
    if (BIAS) {
#pragma unroll
        for (int reg = 0; reg < 16; ++reg) { s0[reg] += tb[(reg & 3) + 8 * (reg >> 2)]; s1[reg] += tb[32 + (reg & 3) + 8 * (reg >> 2)]; }
    }
    float mx = fmaxf(s0[0], s1[0]);
#pragma unroll
    for (int reg = 1; reg < 16; ++reg) mx = fmaxf(mx, fmaxf(s0[reg], s1[reg]));
    mx = fmaxf(mx, __shfl_xor(mx, 32));
    const float mn = active ? fmaxf(m, mx) : m;
    const float alpha = __builtin_amdgcn_exp2f(m - mn);
    const float meff = active ? mn : __builtin_inff();
    float ls = 0.f;
#pragma unroll
    for (int reg = 0; reg < 16; ++reg) { s0[reg] = __builtin_amdgcn_exp2f(s0[reg] - meff); s1[reg] = __builtin_amdgcn_exp2f(s1[reg] - meff); ls += s0[reg] + s1[reg]; }
    l = l * alpha + ls; m = mn;
#pragma unroll
    for (int blk = 0; blk < D / 32; ++blk)
#pragma unroll
        for (int reg = 0; reg < 16; ++reg) o[blk][reg] *= alpha;
    bf16x8 pf[4];
    pf[0] = pack8(s0[0], s0[1], s0[2], s0[3], s0[4], s0[5], s0[6], s0[7]); pf[1] = pack8(s0[8], s0[9], s0[10], s0[11], s0[12], s0[13], s0[14], s0[15]);
    pf[2] = pack8(s1[0], s1[1], s1[2], s1[3], s1[4], s1[5], s1[6], s1[7]); pf[3] = pack8(s1[8], s1[9], s1[10], s1[11], s1[12], s1[13], s1[14], s1[15]);
    const int i16 = lane & 15;
    const LAS unsigned char* vb = Vl + (4 * hh + (i16 >> 2)) * PITCH + (16 * ((lane >> 4) & 1) + 4 * (i16 & 3)) * 2;
#pragma unroll
    for (int blk = 0; blk < D / 32; ++blk) {
#pragma unroll
        for (int ks = 0; ks < 4; ++ks) {
            const v4i16_t lo = __builtin_amdgcn_ds_read_tr16_b64_v4i16((LAS v4i16_t*)(vb + (16 * ks) * PITCH + blk * 64));
            const v4i16_t hi = __builtin_amdgcn_ds_read_tr16_b64_v4i16((LAS v4i16_t*)(vb + (16 * ks + 8) * PITCH + blk * 64));
            const bf16x8 va = {lo[0], lo[1], lo[2], lo[3], hi[0], hi[1], hi[2], hi[3]};
            o[blk] = __builtin_amdgcn_mfma_f32_32x32x16_bf16(va, pf[ks], o[blk], 0, 0, 0);
        }
    }
}
template <int D> __device__ __forceinline__ void attn_store_o(const f32x16 (&o)[D / 32], float inv, bf16* orow, int hh) {
#pragma unroll
    for (int blk = 0; blk < D / 32; ++blk)
#pragma unroll
        for (int g4 = 0; g4 < 4; ++g4) { unsigned long long w = (unsigned long long)pk2(o[blk][4 * g4] * inv, o[blk][4 * g4 + 1] * inv) | ((unsigned long long)pk2(o[blk][4 * g4 + 2] * inv, o[blk][4 * g4 + 3] * inv) << 32);
            *(unsigned long long*)(orow + 32 * blk + 8 * g4 + 4 * hh) = w; }
}
constexpr int ATT_TB_BYTES = 18432;

__device__ __forceinline__ void moba_unit(LAS unsigned char* lds, const bf16* P, const float* KMEAN, const float* rel_bias, bf16* OMOBA, int b, int h, int qb, int tid, int lane, int wave) {
    constexpr int PITCH = ACfg<64>::PITCH, TILEB = ACfg<64>::TILEB;
    const int r = lane & 31, hh = lane >> 5;
    LAS float* TB = (LAS float*)lds;
    LAS unsigned char* Kb = lds + ATT_TB_BYTES; LAS unsigned char* Vb = Kb + 2 * TILEB;
    for (int x = tid; x < 4352; x += NWAVES * 64) { const int dist = 4095 - x; float tv = -__builtin_inff(); if (dist >= 0) tv = DBG_NOBIAS ? 0.f : rel_bias[t5_bucket(dist) * 20 + 12 + h] * L2E; TB[x] = tv; }
    const int qpos = qb * 256 + wave * 32 + r; const size_t tokq = (size_t)b * SEQ + qpos;
    const bf16* qrow = P + tokq * QKVW + 2304 + h * 64;
    unsigned sel = 0u;
    {
        float q[64]; load_q64(q, qrow, 1.0f);
        float v1 = -3e38f, v2 = -3e38f, v3 = -3e38f; int i1 = -1, i2 = -1, i3 = -1;
        for (int n = 0; n < qb; ++n) {
            const float* km = KMEAN + (size_t)((b * 8 + h) * 16 + n) * 64; float gs = 0.f;
#pragma unroll
            for (int c = 0; c < 64; ++c) gs += q[c] * km[c];
            if (gs > v1) { v3 = v2; i3 = i2; v2 = v1; i2 = i1; v1 = gs; i1 = n; }
            else if (gs > v2) { v3 = v2; i3 = i2; v2 = gs; i2 = n; }
            else if (gs > v3) { v3 = gs; i3 = n; }
        }
        if (i1 >= 0) sel |= 1u << i1;
        if (i2 >= 0) sel |= 1u << i2;
        if (i3 >= 0) sel |= 1u << i3;
    }
    bf16x8 qf[4]; attn_load_q<64>(qf, qrow, hh, 0.125f * L2E);
    f32x16 o[2];
#pragma unroll
    for (int reg = 0; reg < 16; ++reg) { o[0][reg] = 0.f; o[1][reg] = 0.f; }
    float m = -1e30f, l = 0.f;
    const bf16* Kg0 = P + (size_t)b * SEQ * QKVW + 2304 + 512 + h * 64;
    const int nt = 4 + 4 * qb;
    v4u kr[1], vr[1];
#define MOBA_K0(i) ((i) < 4 ? qb * 256 + 64 * (i) : 64 * ((i) - 4))
    { const int k0 = MOBA_K0(0); attn_stage_load<64>(kr, vr, Kg0 + (size_t)k0 * QKVW, Kg0 + (size_t)k0 * QKVW + 512, QKVW, tid); attn_stage_store<64>(kr, vr, Kb, Vb, tid); }
    __syncthreads();
    for (int i = 0; i < nt; ++i) {
        const int k0 = MOBA_K0(i);
        if (i + 1 < nt) { const int k1 = MOBA_K0(i + 1); attn_stage_load<64>(kr, vr, Kg0 + (size_t)k1 * QKVW, Kg0 + (size_t)k1 * QKVW + 512, QKVW, tid); }
        bool on; bool go;
        if (i < 4) { on = true; go = (i <= (wave >> 1)); }
        else { on = (sel >> ((i - 4) >> 2)) & 1u; go = __any(on) != 0; }
        if (go) attn_tile<64, true>(Kb + (i & 1) * TILEB, Vb + (i & 1) * TILEB, qf, o, m, l, TB + (k0 - qpos + 4095 + 4 * hh), on, lane);
        if (i + 1 < nt) attn_stage_store<64>(kr, vr, Kb + ((i + 1) & 1) * TILEB, Vb + ((i + 1) & 1) * TILEB, tid);
        __syncthreads();
    }
#undef MOBA_K0
    const float lt = l + __shfl_xor(l, 32);
    attn_store_o<64>(o, 1.0f / lt, OMOBA + tokq * 512 + h * 64, hh);
}
__device__ __forceinline__ void dil_unit(LAS unsigned char* lds, const bf16* P, const float* rel_bias, bf16* ODG, float* LSE, int b, int g, int h, int res, int blk, int tid, int lane, int wave) {
    constexpr int TILEB = ACfg<64>::TILEB;
    const int r = lane & 31, hh = lane >> 5, d = 1 << (2 * g), l0 = blk * 256;
    LAS float* TB = (LAS float*)lds;
    LAS unsigned char* Kb = lds + ATT_TB_BYTES; LAS unsigned char* Vb = Kb + 2 * TILEB;
    for (int x = tid; x < 512; x += NWAVES * 64) { const int j = 256 - x; float tv = -__builtin_inff(); if (j >= 0 && j <= 128) tv = DBG_NOBIAS ? 0.f : rel_bias[t5_bucket(j * d) * 20 + g * 4 + h] * L2E; TB[x] = tv; }
    const int q0w = l0 + wave * 32, lq = q0w + r; const size_t tokq = (size_t)b * SEQ + (size_t)lq * d + res;
    bf16x8 qf[4]; attn_load_q<64>(qf, P + tokq * QKVW + g * 768 + h * 64, hh, 0.125f * L2E);
    f32x16 o[2];
#pragma unroll
    for (int reg = 0; reg < 16; ++reg) { o[0][reg] = 0.f; o[1][reg] = 0.f; }
    float m = -1e30f, l = 0.f;
    const bf16* Kg0 = P + ((size_t)b * SEQ + res) * QKVW + g * 768 + 256 + h * 64;
    const size_t rs = (size_t)QKVW * d;
    const int kt0 = (l0 == 0) ? 0 : -2, nt = 4 - kt0;
    v4u kr[1], vr[1];
    { const int k0 = l0 + 64 * kt0; attn_stage_load<64>(kr, vr, Kg0 + (size_t)k0 * rs, Kg0 + (size_t)k0 * rs + 256, rs, tid); attn_stage_store<64>(kr, vr, Kb, Vb, tid); }
    __syncthreads();
    for (int i = 0; i < nt; ++i) {
        const int k0 = l0 + 64 * (kt0 + i);
        if (i + 1 < nt) { const int k1 = k0 + 64; attn_stage_load<64>(kr, vr, Kg0 + (size_t)k1 * rs, Kg0 + (size_t)k1 * rs + 256, rs, tid); }
        const bool go = (k0 + 63 >= q0w - 128) && (k0 <= q0w + 31);
        if (go) attn_tile<64, true>(Kb + (i & 1) * TILEB, Vb + (i & 1) * TILEB, qf, o, m, l, TB + (k0 - lq + 256 + 4 * hh), true, lane);
        if (i + 1 < nt) attn_stage_store<64>(kr, vr, Kb + ((i + 1) & 1) * TILEB, Vb + ((i + 1) & 1) * TILEB, tid);
        __syncthreads();
    }
    const float lt = l + __shfl_xor(l, 32);
    attn_store_o<64>(o, 1.0f / lt, ODG + ((size_t)g * T + tokq) * 256 + h * 64, hh);
    if (hh == 0) LSE[((size_t)g * T + tokq) * 4 + h] = (m + __builtin_amdgcn_logf(lt)) * 0.6931471805599453f;
}
__device__ __forceinline__ void cross_unit(LAS unsigned char* lds, const bf16* QC, const bf16* KVC, bf16* OC, int b, int h, int qblk, int tid, int lane, int wave) {
    constexpr int TILEB = ACfg<128>::TILEB;
    const int r = lane & 31, hh = lane >> 5;
    LAS unsigned char* Kb = lds + ATT_TB_BYTES; LAS unsigned char* Vb = Kb + 2 * TILEB;
    const size_t tokq = (size_t)b * SEQ + qblk * 256 + wave * 32 + r;
    bf16x8 qf[8]; attn_load_q<128>(qf, QC + tokq * 512 + h * 128, hh, 0.08838834764831845f * L2E);
    f32x16 o[4];
#pragma unroll
    for (int reg = 0; reg < 16; ++reg) { o[0][reg] = 0.f; o[1][reg] = 0.f; o[2][reg] = 0.f; o[3][reg] = 0.f; }
    float m = -1e30f, l = 0.f;
    const bf16* Kg0 = KVC + (size_t)b * NMEM * 1024 + h * 128;
    v4u kr[2], vr[2];
    attn_stage_load<128>(kr, vr, Kg0, Kg0 + 512, 1024, tid); attn_stage_store<128>(kr, vr, Kb, Vb, tid);
    __syncthreads();
    for (int i = 0; i < 4; ++i) {
        if (i + 1 < 4) attn_stage_load<128>(kr, vr, Kg0 + (size_t)(64 * (i + 1)) * 1024, Kg0 + (size_t)(64 * (i + 1)) * 1024 + 512, 1024, tid);
        attn_tile<128, false>(Kb + (i & 1) * TILEB, Vb + (i & 1) * TILEB, qf, o, m, l, (const LAS float*)lds, true, lane);
        if (i + 1 < 4) attn_stage_store<128>(kr, vr, Kb + ((i + 1) & 1) * TILEB, Vb + ((i + 1) & 1) * TILEB, tid);
        __syncthreads();
    }
    const float lt = l + __shfl_xor(l, 32);
    attn_store_o<128>(o, 1.0f / lt, OC + tokq * 512 + h * 128, hh);
}
__device__ __forceinline__ void dil_combine(const bf16* ODG, const float* LSE, bf16* ODIL, int gtid, int nthr) {
    for (int it = gtid; it < T * 32; it += nthr) { const int tok = it >> 5, c = it & 31, h = c >> 3;
        const float a0 = LSE[((size_t)0 * T + tok) * 4 + h], a1 = LSE[((size_t)1 * T + tok) * 4 + h], a2 = LSE[((size_t)2 * T + tok) * 4 + h];
        const float mx = fmaxf(a0, fmaxf(a1, a2)); float w0 = __expf(a0 - mx), w1 = __expf(a1 - mx), w2 = __expf(a2 - mx); const float inv = 1.0f / (w0 + w1 + w2); w0 *= inv; w1 *= inv; w2 *= inv;
        const v4u x0 = *(const v4u*)(ODG + ((size_t)0 * T + tok) * 256 + c * 8), x1 = *(const v4u*)(ODG + ((size_t)1 * T + tok) * 256 + c * 8), x2 = *(const v4u*)(ODG + ((size_t)2 * T + tok) * 256 + c * 8);
        v4u o; o.x = pk2(w0 * bf_lo(x0.x) + w1 * bf_lo(x1.x) + w2 * bf_lo(x2.x), w0 * bf_hi(x0.x) + w1 * bf_hi(x1.x) + w2 * bf_hi(x2.x));
        o.y = pk2(w0 * bf_lo(x0.y) + w1 * bf_lo(x1.y) + w2 * bf_lo(x2.y), w0 * bf_hi(x0.y) + w1 * bf_hi(x1.y) + w2 * bf_hi(x2.y));
        o.z = pk2(w0 * bf_lo(x0.z) + w1 * bf_lo(x1.z) + w2 * bf_lo(x2.z), w0 * bf_hi(x0.z) + w1 * bf_hi(x1.z) + w2 * bf_hi(x2.z));
        o.w = pk2(w0 * bf_lo(x0.w) + w1 * bf_lo(x1.w) + w2 * bf_lo(x2.w), w0 * bf_hi(x0.w) + w1 * bf_hi(x1.w) + w2 * bf_hi(x2.w));
        *(v4u*)(ODIL + (size_t)tok * 256 + c * 8) = o; }
}
__device__ __forceinline__ void phase_topk_simple(const bf16* QP, const float* subk, int* EXP, float* EW, float* INV, int lane, int gw, int ngw) {
    for (int unit = gw; unit < T * 8; unit += ngw) {
        const int tok = unit >> 3, head = unit & 7;
        const bf16* qrow = QP + (size_t)tok * 2048 + head * 256;
        float av = 0.f, bv[4] = {0.f, 0.f, 0.f, 0.f}; int ai = 0, bi[4] = {0, 0, 0, 0};
#pragma unroll
        for (int p = 0; p < 2; ++p) {
            float s0 = 0.f, s1 = 0.f;
            const float* k0 = subk + (size_t)(p * 128 + lane) * 128; const float* k1 = subk + (size_t)(p * 128 + 64 + lane) * 128;
            for (int c = 0; c < 128; ++c) { const float qv = bf2f(qrow[p * 128 + c]); s0 += qv * k0[c]; s1 += qv * k1[c]; }
#pragma unroll
            for (int i = 0; i < 16; ++i) {
                float mloc = fmaxf(s0, s1); float mw = mloc;
#pragma unroll
                for (int o = 1; o < 64; o <<= 1) mw = fmaxf(mw, __shfl_xor(mw, o));
                const unsigned long long bal = __ballot(mloc == mw);
                const int wl = __ffsll((long long)bal) - 1;
                int idx = -1;
                if (lane == wl) { if (s0 >= s1) { idx = lane; s0 = -3e38f; } else { idx = lane + 64; s1 = -3e38f; } }
                idx = __shfl(idx, wl);
                if (p == 0) { if ((lane & 15) == i) { av = mw; ai = idx; } }
                else { if ((lane >> 4) == (i >> 2)) { bv[i & 3] = mw; bi[i & 3] = idx; } }
            }
        }
        float cs[4];
#pragma unroll
        for (int jj = 0; jj < 4; ++jj) cs[jj] = av + bv[jj];
        float top0 = 0.f, den = 0.f; int myexp = 0; float myw = 0.f;
#pragma unroll
        for (int k = 0; k < 16; ++k) {
            float mloc = fmaxf(fmaxf(cs[0], cs[1]), fmaxf(cs[2], cs[3])); float mw = mloc;
#pragma unroll
            for (int o = 1; o < 64; o <<= 1) mw = fmaxf(mw, __shfl_xor(mw, o));
            const unsigned long long bal = __ballot(mloc == mw);
            const int wl = __ffsll((long long)bal) - 1;
            int ex = 0;
            if (lane == wl) {
                if (cs[0] == mw) { ex = ai * 128 + bi[0]; cs[0] = -3e38f; }
                else if (cs[1] == mw) { ex = ai * 128 + bi[1]; cs[1] = -3e38f; }
                else if (cs[2] == mw) { ex = ai * 128 + bi[2]; cs[2] = -3e38f; }
                else { ex = ai * 128 + bi[3]; cs[3] = -3e38f; }
            }
            ex = __shfl(ex, wl);
            if (k == 0) top0 = mw;
            const float e = __expf(mw - top0); den += e;
            if (lane == k) { myexp = ex; myw = e; }
        }
        if (lane < 16) { EXP[(size_t)tok * 128 + head * 16 + lane] = myexp; EW[(size_t)tok * 128 + head * 16 + lane] = myw; }
        if (lane == 0) INV[(size_t)tok * 8 + head] = 1.0f / den;
    }
}
#if DBG_CHECK || DBG_ATTN_CHECK
constexpr size_t WS_YDBG = 510 * MiB;
constexpr int CW_DBG = 64;
__device__ __forceinline__ void dbg_acc(float* acc, float num, float den, int lane) { num = wave_sum(num); den = wave_sum(den); if (lane == 0) { atomicAdd(acc, num); atomicAdd(acc + 1, den); } }
__device__ __forceinline__ int dbg_tok(int s) { return s * 512 + 3 + (s & 7) * 37; }
__device__ __forceinline__ void dbg_check_qp(const bf16* H, const float* w_qp, const bf16* QP, float* acc, int gtid, int nthr, int lane) {
    float num = 0.f, den = 0.f;
    for (int item = gtid; item < 64 * 2048; item += nthr) { const int s = item / 2048, n = item % 2048, t = dbg_tok(s);
        float r = 0.f; for (int k = 0; k < 1024; ++k) r += bf2f(H[(size_t)t * 1024 + k]) * w_qp[(size_t)k * 2048 + n];
        const float mine = bf2f(QP[(size_t)t * 2048 + n]); num += (r - mine) * (r - mine); den += r * r; }
    dbg_acc(acc, num, den, lane);
}
__device__ __forceinline__ void dbg_check_gather(const bf16* H, const float* u, const float* v, const int* EXP, const float* EW, const float* INV, const float* YDBG, float* acc, int gw, int ngw, int lane) {
    float num = 0.f, den = 0.f;
    for (int s = gw; s < 64; s += ngw) { const int t = dbg_tok(s);
        float y[16];
#pragma unroll
        for (int c = 0; c < 16; ++c) y[c] = 0.f;
        for (int i = 0; i < 128; ++i) { const int e = EXP[(size_t)t * 128 + i]; const float g = EW[(size_t)t * 128 + i] * INV[(size_t)t * 8 + (i >> 4)];
            float d = 0.f;
#pragma unroll
            for (int c = 0; c < 16; ++c) d += bf2f(H[(size_t)t * 1024 + lane * 16 + c]) * u[(size_t)e * 1024 + lane * 16 + c];
            d = wave_sum(d);
            const float w = g * gelu_exact(d);
#pragma unroll
            for (int c = 0; c < 16; ++c) y[c] += w * v[(size_t)e * 1024 + lane * 16 + c]; }
#pragma unroll
        for (int c = 0; c < 16; ++c) { const float mine = YDBG[(size_t)s * 1024 + lane * 16 + c]; num += (y[c] - mine) * (y[c] - mine); den += y[c] * y[c]; } }
    dbg_acc(acc, num, den, lane);
}
__device__ __forceinline__ float dbg_k(const float* acc) { const float D = acc[0] / fmaxf(acc[1], 1e-30f); float k = log10f(fmaxf(D, 1e-12f)); return fminf(fmaxf(k, -6.f), 1.f); }
__device__ __forceinline__ void dbg_encode(const float* x, const float* gfin, float* out, const float* acc, int gw, int ngw, int lane) {
    const float k1 = dbg_k(acc), k2 = dbg_k(acc + 2); const float s = 1.f + (k1 + 6.5f) * 0.5f;
    for (int m = gw; m < T; m += ngw) { const f32x4* xr = (const f32x4*)(x + (size_t)m * 1024) + lane; const f32x4* gr = (const f32x4*)gfin + lane; f32x4 vv[4]; float ss = 0.f;
#pragma unroll
        for (int j = 0; j < 4; ++j) { vv[j] = xr[64 * j]; ss += (vv[j].x * vv[j].x + vv[j].y * vv[j].y) + (vv[j].z * vv[j].z + vv[j].w * vv[j].w); }
        const float rinv = rsqrtf(wave_sum(ss) * (1.f / 1024.f) + RMS_EPS) * s;
#pragma unroll
        for (int j = 0; j < 4; ++j) { f32x4 o = vv[j] * rinv * gr[64 * j]; if (m == 0 && j == 0 && lane == 0) o.x = 100.f + 100.f * (k2 + 6.f); ((f32x4*)(out + (size_t)m * 1024) + lane)[64 * j] = o; } }
}
#endif

struct Args { const float* in[20]; float* out; unsigned char* ws; int ph_lo, ph_hi; };
__global__ void __launch_bounds__(NWAVES * 64, 2) fwd(Args args) {
    extern __shared__ __attribute__((aligned(16))) unsigned char lds_raw[];
    LAS unsigned char* lds = (LAS unsigned char*)lds_raw;
    volatile LAS unsigned* MISC = (volatile LAS unsigned*)(lds + MISC_OFF);
    const int tid = threadIdx.x, lane = tid & 63, wave = __builtin_amdgcn_readfirstlane(tid >> 6);
    const int G = gridDim.x; const int bx = blockIdx.x; const int vcu = (G % 8 == 0) ? (bx % 8) * (G / 8) + bx / 8 : bx;
    const int gw = vcu * NWAVES + wave, NGW = G * NWAVES, gtid = vcu * (NWAVES * 64) + tid, NTHR = G * NWAVES * 64;
    unsigned char* ws = args.ws;
    gu32* ctl = (gu32*)(ws + WS_CTL);
    const float* x = args.in[0]; const float* mem = args.in[1]; const float* rel_bias = args.in[2]; const float* g_mix = args.in[3]; const float* w_in = args.in[4];
    const float* b_gate = args.in[5]; const float* w_a = args.in[6]; const float* w_b = args.in[7]; const float* w_out = args.in[8]; const float* g_cross = args.in[9];
    const float* g_mem = args.in[10]; const float* w_qc = args.in[11]; const float* w_kvc = args.in[12]; const float* w_oc = args.in[13]; const float* g_ffn = args.in[14];
    const float* w_qp = args.in[15]; const float* subk = args.in[16]; const float* peer_u = args.in[17]; const float* peer_v = args.in[18]; const float* g_final = args.in[19];
    float* out = args.out;
    bf16* WinT = (bf16*)(ws + WS_WIN); bf16* WaT = (bf16*)(ws + WS_WA); bf16* WbT = (bf16*)(ws + WS_WB); bf16* WoutT = (bf16*)(ws + WS_WOUT); bf16* WqcT = (bf16*)(ws + WS_WQC);
    bf16* WkvcT = (bf16*)(ws + WS_WKVC); bf16* WocT = (bf16*)(ws + WS_WOC); bf16* WqpT = (bf16*)(ws + WS_WQP); bf16* SUBK = (bf16*)(ws + WS_SUBK); bf16* Ub = (bf16*)(ws + WS_U); bf16* Vb = (bf16*)(ws + WS_V);
    bf16* H = (bf16*)(ws + WS_H); bf16* MEMB = (bf16*)(ws + WS_MEMB); bf16* KVC = (bf16*)(ws + WS_KVC); bf16* ODIL = (bf16*)(ws + WS_ODIL); bf16* OMOBA = (bf16*)(ws + WS_OMOBA);
    bf16* PQKV = (bf16*)(ws + WS_PQKV); bf16* MERGED = (bf16*)(ws + WS_MERGED); float* X1 = (float*)(ws + WS_X1); bf16* QC = (bf16*)(ws + WS_QC); bf16* OC = (bf16*)(ws + WS_OC);
    bf16* ODG = (bf16*)(ws + WS_ODG); float* LSE = (float*)(ws + WS_LSE);
    int* EXP = (int*)(ws + WS_EXP); float* EW = (float*)(ws + WS_EW); float* INV = (float*)(ws + WS_INV); float* KMEAN = (float*)(ws + WS_KMEAN);
    bf16* GATES = (bf16*)out;
    bf16* QP = (bf16*)out;

    for (int u = tid; u < (LDS_BYTES - LDSCTL_OFF) / 4; u += NWAVES * 64) ((LAS unsigned*)(lds + LDSCTL_OFF))[u] = 0u;
    __syncthreads();
    const int lo = args.ph_lo, hi = args.ph_hi;
    XcdBarrier bar; bar.bar = (unsigned*)(ctl + CW_BAR); bar.x = 0; bar.st = nullptr;
    if (hi - lo > 1) bar = xcd_barrier_post((unsigned*)(ctl + CW_BAR), MISC + 8);
#define IN(k) (lo <= (k) && (k) < hi)
#define SEAM(k) do { if (IN(k) && IN((k) + 1)) xcd_barrier(bar); } while (0)

    if (IN(0)) {
        LAS float* scr = (LAS float*)(lds + RING_OFF + wave * 16384);
        constexpr int I_IN = (1024 / 64) * (NIN / 32), I_A = (256 / 64) * (1024 / 32), I_B = (512 / 64) * (1024 / 32), I_OUT = (1024 / 64) * (1024 / 32), I_QC = (1024 / 64) * (512 / 32),
                      I_KVC = (1024 / 64) * (1024 / 32), I_OC = (512 / 64) * (1024 / 32), I_QP = (1024 / 64) * (2048 / 32);
        constexpr int NITEMS = I_IN + I_A + I_B + I_OUT + I_QC + I_KVC + I_OC + I_QP;
        for (int it = gw; it < NITEMS; it += NGW) {
            int r = it;
            if (r < I_IN) { p0_transpose_item(w_in, 1024, NIN, WinT, scr, r, lane); continue; } r -= I_IN;
            if (r < I_A) { p0_transpose_item(w_a, 256, 1024, WaT, scr, r, lane); continue; } r -= I_A;
            if (r < I_B) { p0_transpose_item(w_b, 512, 1024, WbT, scr, r, lane); continue; } r -= I_B;
            if (r < I_OUT) { p0_transpose_item(w_out, 1024, 1024, WoutT, scr, r, lane); continue; } r -= I_OUT;
            if (r < I_QC) { p0_transpose_item(w_qc, 1024, 512, WqcT, scr, r, lane); continue; } r -= I_QC;
            if (r < I_KVC) { p0_transpose_item(w_kvc, 1024, 1024, WkvcT, scr, r, lane); continue; } r -= I_KVC;
            if (r < I_OC) { p0_transpose_item(w_oc, 512, 1024, WocT, scr, r, lane); continue; } r -= I_OC;
            p0_transpose_item(w_qp, 1024, 2048, WqpT, scr, r, lane);
        }
        cvt_f32_to_bf16_bulk(subk, SUBK, (size_t)2 * 128 * 128, (size_t)gtid, (size_t)NTHR);
        cvt_f32_to_bf16_bulk(peer_u, Ub, (size_t)16384 * 1024, (size_t)gtid, (size_t)NTHR);
        cvt_f32_to_bf16_bulk(peer_v, Vb, (size_t)16384 * 1024, (size_t)gtid, (size_t)NTHR);
        for (int m = gw; m < T; m += NGW) rms_row_to_bf16(x + (size_t)m * DM, g_mix, H + (size_t)m * DM, lane);
        for (int m = gw; m < MROWS; m += NGW) rms_row_to_bf16(mem + (size_t)m * DM, g_mem, MEMB + (size_t)m * DM, lane);
        __syncthreads();
    }
    SEAM(0);
    if (IN(1)) {
        if (DBG_MIX) { pg8::Gemm g{H, WinT, T, NIN, DM}; pg8::StaticOrder S; S.init(T, NIN, G, bx); pg8::EpiIn E{PQKV, GATES, b_gate};
          pg8::gemm_phase<pg8::EpiIn, pg8::StaticOrder, true, true>(lds + RING_OFF, g, S, E); }
        __syncthreads();
        if (DBG_CROSS) { pg8::Gemm g{MEMB, WkvcT, MROWS, 1024, DM}; pg8::StaticOrder S; S.init(MROWS, 1024, G, bx); pg8::EpiStore E{KVC, 1024};
          pg8::gemm_phase<pg8::EpiStore, pg8::StaticOrder, true, true>(lds + RING_OFF, g, S, E); }
    }
    SEAM(1);
    if (IN(2) && DBG_MIX) {
#if ATTN_MFMA
        for (int u = bx; u < NB * 3 * 4 * 16; u += G) { const int u16 = u & 15, bgh = u >> 4, h = bgh & 3, g = (bgh >> 2) % 3, b = (bgh >> 2) / 3;
            dil_unit(lds + RING_OFF, PQKV, rel_bias, ODG, LSE, b, g, h, u16 & ((1 << (2 * g)) - 1), u16 >> (2 * g), tid, lane, wave); }
#endif
        for (int it = gw; it < NB * 8 * 16; it += NGW) { const int bh = it >> 4, blk = it & 15, b = bh >> 3, h = bh & 7;
            const bf16* kp = PQKV + (size_t)(b * SEQ + blk * 256) * QKVW + 2304 + 512 + h * 64 + lane; float s = 0.f;
            for (int j = 0; j < 256; ++j) s += bf2f(kp[(size_t)j * QKVW]);
            KMEAN[(size_t)it * 64 + lane] = s * (1.0f / 256.0f); }
    }
    SEAM(2);
    if (IN(3) && DBG_MIX) {
#if ATTN_MFMA
        for (int pu = bx; pu < NB * 8 * 8; pu += G) { const int bh = pu >> 3, p = pu & 7, b = bh >> 3, h = bh & 7;
            moba_unit(lds + RING_OFF, PQKV, KMEAN, rel_bias, OMOBA, b, h, p, tid, lane, wave);
            moba_unit(lds + RING_OFF, PQKV, KMEAN, rel_bias, OMOBA, b, h, 15 - p, tid, lane, wave); }
        dil_combine(ODG, LSE, ODIL, gtid, NTHR);
#else
        phase_dil_simple<false>(PQKV, rel_bias, ODIL, gtid, NTHR); phase_moba_simple<false>(PQKV, KMEAN, rel_bias, OMOBA, gtid, NTHR);
#endif
    }
    SEAM(3);
#if DBG_ATTN_CHECK
    if (IN(4)) { if (DBG_DIL_CHECK) phase_dil_simple<true>(PQKV, rel_bias, ODIL, gtid, NTHR, (float*)(ctl + CW_DBG)); else phase_moba_simple<true>(PQKV, KMEAN, rel_bias, OMOBA, gtid, NTHR, (float*)(ctl + CW_DBG)); }
#endif
    if (IN(4) && DBG_MIX) { pg8::Gemm g{ODIL, WaT, T, 1024, 256}; pg8::StaticOrder S; S.init(T, 1024, G, bx); pg8::EpiGate<false> E{MERGED, GATES, 0};
        pg8::gemm_phase<pg8::EpiGate<false>, pg8::StaticOrder, true, true>(lds + RING_OFF, g, S, E); }
    SEAM(4);
    if (IN(5) && DBG_MIX) { pg8::Gemm g{OMOBA, WbT, T, 1024, 512}; pg8::StaticOrder S; S.init(T, 1024, G, bx); pg8::EpiGate<true> E{MERGED, GATES, 1024};
        pg8::gemm_phase<pg8::EpiGate<true>, pg8::StaticOrder, true, true>(lds + RING_OFF, g, S, E); }
    SEAM(5);
    if (IN(6)) { pg8::Gemm g{MERGED, WoutT, T, 1024, 1024}; pg8::StaticOrder S; S.init(T, 1024, G, bx); pg8::EpiRes E{x, X1, 1024, (float)DBG_MIX};
        pg8::gemm_phase<pg8::EpiRes, pg8::StaticOrder, true, true>(lds + RING_OFF, g, S, E); }
    SEAM(6);
    if (IN(7)) { for (int m = gw; m < T; m += NGW) rms_row_to_bf16(X1 + (size_t)m * DM, g_cross, H + (size_t)m * DM, lane); }
    SEAM(7);
    if (IN(8) && DBG_CROSS) { pg8::Gemm g{H, WqcT, T, 512, 1024}; pg8::StaticOrder S; S.init(T, 512, G, bx); pg8::EpiStore E{QC, 512};
        pg8::gemm_phase<pg8::EpiStore, pg8::StaticOrder, true, true>(lds + RING_OFF, g, S, E); }
    SEAM(8);
    if (IN(9) && DBG_CROSS) {
#if ATTN_MFMA
        for (int u = bx; u < NB * 4 * 16; u += G) cross_unit(lds + RING_OFF, QC, KVC, OC, u >> 6, (u >> 4) & 3, u & 15, tid, lane, wave);
#else
        phase_cross_simple<false>(QC, KVC, OC, gtid, NTHR);
#endif
    }
    SEAM(9);
#if DBG_ATTN_CHECK
    if (IN(10) && DBG_CROSS_CHECK) phase_cross_simple<true>(QC, KVC, OC, gtid, NTHR, (float*)(ctl + CW_DBG) + 2);
#endif
    if (IN(10)) { pg8::Gemm g{OC, WocT, T, 1024, 512}; pg8::StaticOrder S; S.init(T, 1024, G, bx); pg8::EpiRes E{X1, X1, 1024, (float)DBG_CROSS};
        pg8::gemm_phase<pg8::EpiRes, pg8::StaticOrder, true, true>(lds + RING_OFF, g, S, E); }
    SEAM(10);
    if (IN(11)) { for (int m = gw; m < T; m += NGW) rms_row_to_bf16(X1 + (size_t)m * DM, g_ffn, H + (size_t)m * DM, lane); }
    SEAM(11);
    if (IN(12) && DBG_PEER) { pg8::Gemm g{H, WqpT, T, 2048, 1024}; pg8::StaticOrder S; S.init(T, 2048, G, bx); pg8::EpiStore E{QP, 2048};
        pg8::gemm_phase<pg8::EpiStore, pg8::StaticOrder, true, true>(lds + RING_OFF, g, S, E); }
    SEAM(12);
#if DBG_CHECK
    if (IN(13)) dbg_check_qp(H, w_qp, QP, (float*)(ctl + CW_DBG), gtid, NTHR, lane);
#endif
#if DBG_TOPK_SIMPLE
    if (IN(13) && DBG_PEER) { phase_topk_simple(QP, subk, EXP, EW, INV, lane, gw, NGW); }
#else
    if (IN(13) && DBG_PEER) { phase_topk(lds + RING_OFF, QP, SUBK, EXP, EW, INV, tid, lane, gw, NGW); }
#endif
    SEAM(13);
    if (IN(14)) { phase_peer(H, Ub, Vb, EXP, EW, INV, X1, g_final, out, lane, gw, NGW, (float)DBG_PEER, DBG_YPTR); }
#if DBG_CHECK || DBG_ATTN_CHECK
#if DBG_CHECK
    if (IN(15)) dbg_check_gather(H, peer_u, peer_v, EXP, EW, INV, (const float*)(ws + WS_YDBG), (float*)(ctl + CW_DBG) + 2, gw, NGW, lane);
#endif
    if (IN(16)) dbg_encode(x, g_final, out, (const float*)(ctl + CW_DBG), gw, NGW, lane);
#endif
#undef IN
#undef SEAM
}

extern "C" void kernel_launch(void* const* d_in, const int* in_sizes, int n_in, void* d_out, int out_size, void* d_ws, size_t ws_size, hipStream_t stream) {
    static int grid = 0;
    if (grid == 0) {
        if (n_in != 20 || out_size != T * DM || ws_size < WS_END) { fprintf(stderr, "kernel_launch: unexpected shapes (n_in %d, out %d, ws %zu); nothing launched\n", n_in, out_size, ws_size); grid = -1; return; }
        int dev = 0, cus = 0, per_cu = 0;
        if (hipGetDevice(&dev) != hipSuccess || hipDeviceGetAttribute(&cus, hipDeviceAttributeMultiprocessorCount, dev) != hipSuccess) { grid = -1; return; }
        if (hipFuncSetAttribute((const void*)fwd, hipFuncAttributeMaxDynamicSharedMemorySize, LDS_BYTES) != hipSuccess) { fprintf(stderr, "kernel_launch: hipFuncSetAttribute failed\n"); grid = -1; return; }
        if (hipOccupancyMaxActiveBlocksPerMultiprocessor(&per_cu, (const void*)fwd, NWAVES * 64, LDS_BYTES) != hipSuccess || per_cu < 1) { fprintf(stderr, "kernel_launch: occupancy query says %d\n", per_cu); }
        (void)hipGetLastError();
        grid = cus;
    }
    if (grid < 0) return;
    if (hipMemsetAsync((char*)d_ws + WS_CTL, 0, CTL_ZERO_BYTES, stream) != hipSuccess) return;
    Args a{};
    for (int i = 0; i < 20; ++i) a.in[i] = (const float*)d_in[i];
    a.out = (float*)d_out; a.ws = (unsigned char*)d_ws;
#if MK_ONE_LAUNCH
    a.ph_lo = 0; a.ph_hi = NPH;
    hipLaunchKernelGGL(fwd, dim3(grid), dim3(NWAVES * 64), LDS_BYTES, stream, a);
#else
    for (int p = 0; p < NPH + ((DBG_CHECK || DBG_ATTN_CHECK) ? 2 : 0); ++p) { a.ph_lo = p; a.ph_hi = p + 1; hipLaunchKernelGGL(fwd, dim3(grid), dim3(NWAVES * 64), LDS_BYTES, stream, a); }
#endif
}
```

```cpp
#include <hip/hip_runtime.h>
#include <cstdio>
#include <cstdint>
#include <cmath>
namespace pg8 {
#define PG8_LAS __attribute__((address_space(3)))
typedef unsigned short bf16_t;
typedef short bf16x8 __attribute__((ext_vector_type(8)));
typedef float f32x4 __attribute__((ext_vector_type(4)));
typedef unsigned u32x4 __attribute__((ext_vector_type(4)));
typedef int v4i32 __attribute__((ext_vector_type(4)));
typedef int v8i32 __attribute__((ext_vector_type(8)));
constexpr int BM = 256, BK = 64, HALF = 128, HTB = HALF * BK * 2  , STAGE_BYTES = 8 * HTB, NXCD = 8, WGM = 8;

__host__ __device__ __forceinline__ int lds_byte(int r, int c) { const int st = (r >> 4) * 2 + (c >> 5), rr = r & 15, cc = c & 31, ob = rr * 64 + cc * 2; return st * 1024 + (ob ^ (((ob >> 9) & 1) << 5)); }
__host__ __device__ __forceinline__ void stage_rc(int b, int& R, int& C) { const int st = b / 1024, sb = b % 1024, swz = sb ^ (((sb >> 9) & 1) << 5); R = (st >> 1) * 16 + swz / 64; C = (st & 1) * 32 + (swz % 64) / 2; }
__host__ __device__ __forceinline__ int perm32(int rho) { const int n = rho >> 4, i = rho & 15; return 8 * (i >> 2) + 4 * n + (i & 3); }

struct Unit { int pm, pn; };
struct Gemm { const bf16_t* A; const bf16_t* Bt; int M, N, K; };

struct StaticOrder {
    int nM, nN, nwg, G, c;
    __host__ __device__ void init(int M, int N, int G_, int c_) { nM = M / BM; nN = N / BM; nwg = nM * nN; G = G_; c = c_; }
    __host__ __device__ bool next(int i, Unit& u) const {
        const long L = (long)i * G + c; if (L >= nwg) return false;
        int wgid = (int)L; { const int q = nwg / NXCD, r = nwg % NXCD, xcd = wgid % NXCD, off = wgid / NXCD; wgid = (xcd < r ? xcd * (q + 1) : r * (q + 1) + (xcd - r) * q) + off; }
        const int nig = WGM * nN, gid = wgid / nig, fm = gid * WGM, gsz = (nM - fm) < WGM ? (nM - fm) : WGM;
        u.pm = fm + ((wgid % nig) % gsz); u.pn = (wgid % nig) / gsz; return true;
    }
    __device__ __forceinline__ void a_ready(const Unit&) const {}
    __device__ __forceinline__ void done(const Unit&) const {}
};

__device__ __forceinline__ unsigned cvt_pk_bf16(float lo, float hi) { unsigned r; asm volatile("v_cvt_pk_bf16_f32 %0, %1, %2" : "=v"(r) : "v"(lo), "v"(hi)); return r; }
typedef float f32x2 __attribute__((ext_vector_type(2)));
__device__ __forceinline__ float bf_lo(unsigned w) { return __uint_as_float(w << 16); }
__device__ __forceinline__ float bf_hi(unsigned w) { return __uint_as_float(w & 0xffff0000u); }
__device__ __forceinline__ float sigmoidf_(float x) { return 1.0f / (1.0f + __expf(-x)); }
struct EpiStore {
    static constexpr bool PERM = true, AFTER_DRAIN = false;
    bf16_t* O; int ldc;
    __device__ __forceinline__ void operator()(const f32x4 (&acc)[2][2][4][2], const Unit& u, int wr, int wc, int fr, int fq) const {
        const int row0 = u.pm * BM + wr * 64 + fr, col0 = u.pn * BM + wc * 32 + 8 * fq;
#pragma unroll
        for (int ai = 0; ai < 2; ++ai)
#pragma unroll
            for (int m = 0; m < 4; ++m) { bf16_t* rowp = O + (size_t)(row0 + ai * HALF + m * 16) * ldc + col0;
#pragma unroll
                for (int bj = 0; bj < 2; ++bj) { const f32x4 v0 = acc[ai][bj][m][0], v1 = acc[ai][bj][m][1];
                    u32x4 w; w.x = cvt_pk_bf16(v0[0], v0[1]); w.y = cvt_pk_bf16(v0[2], v0[3]); w.z = cvt_pk_bf16(v1[0], v1[1]); w.w = cvt_pk_bf16(v1[2], v1[3]);
                    *(u32x4*)(rowp + bj * HALF) = w; } }
    }
};
struct EpiIn {
    static constexpr bool PERM = true, AFTER_DRAIN = false;
    bf16_t* P; bf16_t* G; const float* bgate; float wsc;
    __device__ __forceinline__ void operator()(const f32x4 (&acc)[2][2][4][2], const Unit& u, int wr, int wc, int fr, int fq) const {
        const int row0 = u.pm * BM + wr * 64 + fr;
        if (u.pn < 15) {
            const int col0 = u.pn * BM + wc * 32 + 8 * fq;
#pragma unroll
            for (int ai = 0; ai < 2; ++ai)
#pragma unroll
                for (int m = 0; m < 4; ++m) { bf16_t* rowp = P + (size_t)(row0 + ai * HALF + m * 16) * 3840 + col0;
#pragma unroll
                    for (int bj = 0; bj < 2; ++bj) { const f32x4 v0 = acc[ai][bj][m][0] * wsc, v1 = acc[ai][bj][m][1] * wsc;
                        u32x4 w; w.x = cvt_pk_bf16(v0[0], v0[1]); w.y = cvt_pk_bf16(v0[2], v0[3]); w.z = cvt_pk_bf16(v1[0], v1[1]); w.w = cvt_pk_bf16(v1[2], v1[3]);
                        *(u32x4*)(rowp + bj * HALF) = w; } }
        } else {
            const int col0 = (u.pn - 15) * BM + wc * 32 + 8 * fq;
            f32x4 bv[2][2];
#pragma unroll
            for (int bj = 0; bj < 2; ++bj)
#pragma unroll
                for (int n = 0; n < 2; ++n) bv[bj][n] = *(const f32x4*)(bgate + col0 + bj * HALF + 4 * n);
#pragma unroll
            for (int ai = 0; ai < 2; ++ai)
#pragma unroll
                for (int m = 0; m < 4; ++m) { unsigned char* rowp = (unsigned char*)G + (size_t)(row0 + ai * HALF + m * 16) * 2048 + col0;
#pragma unroll
                    for (int bj = 0; bj < 2; ++bj) { const f32x4 v0 = acc[ai][bj][m][0] * wsc + bv[bj][0], v1 = acc[ai][bj][m][1] * wsc + bv[bj][1];
                        int w0 = 0, w1 = 0;
                        w0 = __builtin_amdgcn_cvt_pk_fp8_f32(sigmoidf_(v0[0]), sigmoidf_(v0[1]), w0, false); w0 = __builtin_amdgcn_cvt_pk_fp8_f32(sigmoidf_(v0[2]), sigmoidf_(v0[3]), w0, true);
                        w1 = __builtin_amdgcn_cvt_pk_fp8_f32(sigmoidf_(v1[0]), sigmoidf_(v1[1]), w1, false); w1 = __builtin_amdgcn_cvt_pk_fp8_f32(sigmoidf_(v1[2]), sigmoidf_(v1[3]), w1, true);
                        *(unsigned long long*)(rowp + bj * HALF) = (unsigned long long)(unsigned)w0 | ((unsigned long long)(unsigned)w1 << 32); } }
        }
    }
};
template <bool ADD, bool F8OUT> struct EpiGate {
    static constexpr bool PERM = true, AFTER_DRAIN = false;
    bf16_t* O; const bf16_t* G; int gcol; unsigned char* O8; float o8scale;
    __device__ __forceinline__ void operator()(const f32x4 (&acc)[2][2][4][2], const Unit& u, int wr, int wc, int fr, int fq) const {
        const int row0 = u.pm * BM + wr * 64 + fr, col0 = u.pn * BM + wc * 32 + 8 * fq;
#pragma unroll
        for (int ai = 0; ai < 2; ++ai)
#pragma unroll
            for (int m = 0; m < 4; ++m) { const size_t row = (size_t)(row0 + ai * HALF + m * 16); bf16_t* rowp = O + row * 1024 + col0;
#pragma unroll
                for (int bj = 0; bj < 2; ++bj) { const f32x4 v0 = acc[ai][bj][m][0], v1 = acc[ai][bj][m][1];
                    const unsigned long long g8 = *(const unsigned long long*)((const unsigned char*)G + row * 2048 + gcol + col0 + bj * HALF); const int gl = (int)(unsigned)g8, gh = (int)(unsigned)(g8 >> 32);
                    typedef float f32x2g __attribute__((ext_vector_type(2)));
                    const f32x2g ga = __builtin_amdgcn_cvt_pk_f32_fp8(gl, false), gb = __builtin_amdgcn_cvt_pk_f32_fp8(gl, true), gc = __builtin_amdgcn_cvt_pk_f32_fp8(gh, false), gd = __builtin_amdgcn_cvt_pk_f32_fp8(gh, true);
                    float r0 = ga.x * v0[0], r1 = ga.y * v0[1], r2 = gb.x * v0[2], r3 = gb.y * v0[3];
                    float r4 = gc.x * v1[0], r5 = gc.y * v1[1], r6 = gd.x * v1[2], r7 = gd.y * v1[3];
                    if (ADD) {
                        const unsigned long long p8 = *(const unsigned long long*)(O8 + row * 1024 + col0 + bj * HALF); const int pl = (int)(unsigned)p8, phh = (int)(unsigned)(p8 >> 32); const float is = 1.0f / o8scale;
                        const f32x2g pa = __builtin_amdgcn_cvt_pk_f32_fp8(pl, false), pb = __builtin_amdgcn_cvt_pk_f32_fp8(pl, true), pc = __builtin_amdgcn_cvt_pk_f32_fp8(phh, false), pd = __builtin_amdgcn_cvt_pk_f32_fp8(phh, true);
                        r0 += pa.x * is; r1 += pa.y * is; r2 += pb.x * is; r3 += pb.y * is; r4 += pc.x * is; r5 += pc.y * is; r6 += pd.x * is; r7 += pd.y * is; }
                    if (F8OUT) { int w0 = 0, w1 = 0;
                        w0 = __builtin_amdgcn_cvt_pk_fp8_f32(r0 * o8scale, r1 * o8scale, w0, false); w0 = __builtin_amdgcn_cvt_pk_fp8_f32(r2 * o8scale, r3 * o8scale, w0, true);
                        w1 = __builtin_amdgcn_cvt_pk_fp8_f32(r4 * o8scale, r5 * o8scale, w1, false); w1 = __builtin_amdgcn_cvt_pk_fp8_f32(r6 * o8scale, r7 * o8scale, w1, true);
                        *(unsigned long long*)(O8 + row * 1024 + col0 + bj * HALF) = (unsigned long long)(unsigned)w0 | ((unsigned long long)(unsigned)w1 << 32);
                    } else { u32x4 w; w.x = cvt_pk_bf16(r0, r1); w.y = cvt_pk_bf16(r2, r3); w.z = cvt_pk_bf16(r4, r5); w.w = cvt_pk_bf16(r6, r7);
                        *(u32x4*)(rowp + bj * HALF) = w; } } }
    }
};
struct EpiRes {
    static constexpr bool PERM = false, AFTER_DRAIN = false;
    const float* base; float* out; int ldc; float sc; bf16_t* xb; float* rowss; unsigned char* xb8; const bf16_t* base16;
    __device__ __forceinline__ void operator()(const f32x4 (&acc)[2][2][4][2], const Unit& u, int wr, int wc, int fr, int fq) const {
        const int col0 = u.pn * BM + wc * 32 + 4 * fq;
#pragma unroll
        for (int ai = 0; ai < 2; ++ai)
#pragma unroll
            for (int m = 0; m < 4; ++m) { const int row = u.pm * BM + ai * HALF + wr * 64 + m * 16 + fr; const size_t off = (size_t)row * ldc + col0; float ss = 0.f;
#pragma unroll
                for (int bj = 0; bj < 2; ++bj)
#pragma unroll
                    for (int n = 0; n < 2; ++n) { f32x4 bs;
                        if (base16) { const unsigned long long w = *(const unsigned long long*)(base16 + off + bj * HALF + n * 16); const unsigned lo = (unsigned)w, hi = (unsigned)(w >> 32); bs = (f32x4){bf_lo(lo), bf_hi(lo), bf_lo(hi), bf_hi(hi)}; }
                        else bs = *(const f32x4*)(base + off + bj * HALF + n * 16);
                        const f32x4 o = (sc != 0.f) ? bs + acc[ai][bj][m][n] * sc : bs;
                        if (out) *(f32x4*)(out + off + bj * HALF + n * 16) = o;
                        if (xb) { unsigned long long w = (unsigned long long)cvt_pk_bf16(o[0], o[1]) | ((unsigned long long)cvt_pk_bf16(o[2], o[3]) << 32); *(unsigned long long*)(xb + off + bj * HALF + n * 16) = w; }
                        if (xb8) { int w8 = 0; w8 = __builtin_amdgcn_cvt_pk_fp8_f32(o[0], o[1], w8, false); w8 = __builtin_amdgcn_cvt_pk_fp8_f32(o[2], o[3], w8, true); *(unsigned*)(xb8 + off + bj * HALF + n * 16) = (unsigned)w8; }
                        if (rowss) ss += (o[0] * o[0] + o[1] * o[1]) + (o[2] * o[2] + o[3] * o[3]); }
                if (rowss) { ss += __shfl_xor(ss, 16); ss += __shfl_xor(ss, 32); if (fq == 0) atomicAdd(rowss + row, ss); } }
    }
};
struct EpiStoreRs {
    static constexpr bool PERM = true, AFTER_DRAIN = false;
    bf16_t* O; int ldc; const float* rowss; float sc;
    __device__ __forceinline__ void operator()(const f32x4 (&acc)[2][2][4][2], const Unit& u, int wr, int wc, int fr, int fq) const {
        const int row0 = u.pm * BM + wr * 64 + fr, col0 = u.pn * BM + wc * 32 + 8 * fq;
#pragma unroll
        for (int ai = 0; ai < 2; ++ai)
#pragma unroll
            for (int m = 0; m < 4; ++m) { const int row = row0 + ai * HALF + m * 16; bf16_t* rowp = O + (size_t)row * ldc + col0; const float ri = rsqrtf(rowss[row] * (1.0f / 1024.0f) + 1e-6f) * sc;
#pragma unroll
                for (int bj = 0; bj < 2; ++bj) { const f32x4 v0 = acc[ai][bj][m][0] * ri, v1 = acc[ai][bj][m][1] * ri;
                    u32x4 w; w.x = cvt_pk_bf16(v0[0], v0[1]); w.y = cvt_pk_bf16(v0[2], v0[3]); w.z = cvt_pk_bf16(v1[0], v1[1]); w.w = cvt_pk_bf16(v1[2], v1[3]);
                    *(u32x4*)(rowp + bj * HALF) = w; } }
    }
};
template <class Epi, class Sched, bool ALIGN_EPI = false, bool SP2 = false, bool F8 = false>
__device__ __forceinline__ void gemm_phase(PG8_LAS unsigned char* lds, const Gemm g, const Sched& S, const Epi& E) {
    const int tid = threadIdx.x, wid = __builtin_amdgcn_readfirstlane(tid >> 6), lane = tid & 63, wr = wid >> 2, wc = wid & 3, fr = lane & 15, fq = lane >> 4;
    const int K = g.K, nt = K / BK;
    unsigned voffA[2], voffB[2];
#pragma unroll
    for (int i = 0; i < 2; ++i) { int R, C; stage_rc(tid * 16 + i * 8192, R, C); const int Rb = Epi::PERM ? ((R & ~31) + perm32(R & 31)) : R;
        voffA[i] = (unsigned)(R * K + C) * 2u; voffB[i] = (unsigned)(Rb * K + C) * 2u; }
    const size_t kstep = (size_t)(BK * 2);
    const size_t hstep = (size_t)HALF * K * 2;
    const size_t tstep = 2 * hstep;
    const unsigned ldsw = (unsigned)wid * 1024u;
    const int aoff = lds_byte(wr * 64 + fr, fq * 8), boff = lds_byte(wc * 32 + fr, fq * 8);
#define PG8_SA(b, h) (((b) * 2 + (h)) * HTB)
#define PG8_SB(b, h) ((4 + (b) * 2 + (h)) * HTB)
#define PG8_STAGE(bufoff, gbase, voff) do { _Pragma("unroll") for (int _i = 0; _i < 2; ++_i) \
        __builtin_amdgcn_global_load_lds((const unsigned*)((const char*)(gbase) + (voff)[_i]), (PG8_LAS unsigned*)(lds + (bufoff) + ldsw + _i * 8192), 16, 0, 0); } while (0)
#define PG8_LDA(dst, b, h) do { if constexpr (F8) { _Pragma("unroll") for (int m = 0; m < 4; ++m) dst##8[m] = __builtin_shufflevector(*(const PG8_LAS v4i32*)(lds + PG8_SA(b, h) + aoff + m * 2048), *(const PG8_LAS v4i32*)(lds + PG8_SA(b, h) + aoff + m * 2048 + 1024), 0, 1, 2, 3, 4, 5, 6, 7); } \
        else { _Pragma("unroll") for (int m = 0; m < 4; ++m) _Pragma("unroll") for (int k = 0; k < 2; ++k) dst[m][k] = *(const PG8_LAS bf16x8*)(lds + PG8_SA(b, h) + aoff + m * 2048 + k * 1024); } } while (0)
#define PG8_LDB(dst, b, h) do { if constexpr (F8) { _Pragma("unroll") for (int n = 0; n < 2; ++n) dst##8[n] = __builtin_shufflevector(*(const PG8_LAS v4i32*)(lds + PG8_SB(b, h) + boff + n * 2048), *(const PG8_LAS v4i32*)(lds + PG8_SB(b, h) + boff + n * 2048 + 1024), 0, 1, 2, 3, 4, 5, 6, 7); } \
        else { _Pragma("unroll") for (int n = 0; n < 2; ++n) _Pragma("unroll") for (int k = 0; k < 2; ++k) dst[n][k] = *(const PG8_LAS bf16x8*)(lds + PG8_SB(b, h) + boff + n * 2048 + k * 1024); } } while (0)
#define PG8_MMA(ai, bj, At, Bt) do { __builtin_amdgcn_s_setprio(1); if constexpr (F8) { \
        _Pragma("unroll") for (int m = 0; m < 4; ++m) _Pragma("unroll") for (int n = 0; n < 2; ++n) \
            asm volatile("v_mfma_scale_f32_16x16x128_f8f6f4 %0, %1, %2, %0, %3, %3 op_sel_hi:[0,0,0]" : "+v"(acc[ai][bj][m][n]) : "v"(Bt##8[n]), "v"(At##8[m]), "v"(f8scale)); \
    } else { _Pragma("unroll") for (int m = 0; m < 4; ++m) _Pragma("unroll") for (int n = 0; n < 2; ++n) _Pragma("unroll") for (int k = 0; k < 2; ++k) \
        acc[ai][bj][m][n] = __builtin_amdgcn_mfma_f32_16x16x32_bf16(Bt[n][k], At[m][k], acc[ai][bj][m][n], 0, 0, 0); } __builtin_amdgcn_s_setprio(0); } while (0)
#define PG8_WAIT_V(n) asm volatile("s_waitcnt vmcnt(" #n ")" ::: "memory")
#define PG8_WAIT_L(n) asm volatile("s_waitcnt lgkmcnt(" #n ")" ::: "memory")
#define PG8_BAR __builtin_amdgcn_s_barrier()
#define PG8_SCHED __builtin_amdgcn_sched_barrier(0)
    Unit cur, nxt; int ui = 0;
    if (!S.next(0, cur)) return;
    f32x4 acc[2][2][4][2];
#pragma unroll
    for (int a = 0; a < 2; ++a)
#pragma unroll
        for (int b = 0; b < 2; ++b)
#pragma unroll
            for (int m = 0; m < 4; ++m)
#pragma unroll
                for (int n = 0; n < 2; ++n) acc[a][b][m][n] = (f32x4){0.f, 0.f, 0.f, 0.f};
    bf16x8 At[4][2], B0[2][2], B1[2][2]; v8i32 At8[4], B08[2], B18[2]; const int f8scale = 0x7f7f7f7f;
    const char* cA = (const char*)g.A + (size_t)cur.pm * tstep; const char* cB = (const char*)g.Bt + (size_t)cur.pn * tstep;
    S.a_ready(cur);
    if constexpr (SP2) {
        PG8_STAGE(PG8_SB(0, 0), cB, voffB); PG8_STAGE(PG8_SB(0, 1), cB + hstep, voffB); PG8_STAGE(PG8_SA(0, 0), cA, voffA); PG8_STAGE(PG8_SA(0, 1), cA + hstep, voffA);
        if (wr == 1) PG8_BAR;
        PG8_WAIT_V(2); PG8_BAR;
        PG8_STAGE(PG8_SB(1, 0), cB + kstep, voffB); PG8_STAGE(PG8_SA(1, 0), cA + kstep, voffA); PG8_STAGE(PG8_SB(1, 1), cB + hstep + kstep, voffB);
        PG8_WAIT_V(6); PG8_BAR;
    } else {
        PG8_STAGE(PG8_SB(0, 0), cB, voffB); PG8_STAGE(PG8_SA(0, 0), cA, voffA); PG8_STAGE(PG8_SB(0, 1), cB + hstep, voffB); PG8_STAGE(PG8_SA(0, 1), cA + hstep, voffA);
        if (wr == 1) PG8_BAR;
        PG8_WAIT_V(4); PG8_BAR;
        PG8_STAGE(PG8_SB(1, 0), cB + kstep, voffB); PG8_STAGE(PG8_SA(1, 0), cA + kstep, voffA); PG8_STAGE(PG8_SB(1, 1), cB + hstep + kstep, voffB);
        PG8_WAIT_V(6); PG8_BAR;
    }
    for (;;) {
        const bool has_next = S.next(ui + 1, nxt);
        const char* nA = has_next ? (const char*)g.A + (size_t)nxt.pm * tstep : cA; const char* nB = has_next ? (const char*)g.Bt + (size_t)nxt.pn * tstep : cB;
        for (int t = 0; t < nt; t += 2) {
            const bool last = (t == nt - 2);
            const char* a1 = cA + (size_t)(t + 1) * kstep;
            const char* a2 = last ? nA : cA + (size_t)(t + 2) * kstep; const char* b2 = last ? nB : cB + (size_t)(t + 2) * kstep;
            const char* a3 = a2 + kstep; const char* b3 = b2 + kstep;
            if (last && has_next) S.a_ready(nxt);
            if constexpr (SP2) {
            PG8_LDB(B0, 0, 0); PG8_LDB(B1, 0, 1); PG8_SCHED; PG8_LDA(At, 0, 0); PG8_STAGE(PG8_SA(1, 1), a1 + hstep, voffA);
            PG8_WAIT_V(8); PG8_WAIT_L(0); PG8_BAR; PG8_MMA(0, 0, At, B0); PG8_MMA(0, 1, At, B1); PG8_BAR; PG8_SCHED;
            PG8_LDA(At, 0, 1); PG8_STAGE(PG8_SB(0, 0), b2, voffB); PG8_STAGE(PG8_SB(0, 1), b2 + hstep, voffB); PG8_STAGE(PG8_SA(0, 0), a2, voffA);
            PG8_WAIT_V(8); PG8_WAIT_L(0); PG8_BAR; PG8_MMA(1, 0, At, B0); PG8_MMA(1, 1, At, B1); PG8_BAR; PG8_SCHED;
            PG8_LDB(B0, 1, 0); PG8_LDB(B1, 1, 1); PG8_SCHED; PG8_LDA(At, 1, 0); PG8_STAGE(PG8_SA(0, 1), a2 + hstep, voffA);
            PG8_WAIT_V(8); PG8_WAIT_L(0); PG8_BAR; PG8_MMA(0, 0, At, B0); PG8_MMA(0, 1, At, B1); PG8_BAR; PG8_SCHED;
            PG8_LDA(At, 1, 1); PG8_STAGE(PG8_SB(1, 0), b3, voffB); PG8_STAGE(PG8_SB(1, 1), b3 + hstep, voffB); PG8_STAGE(PG8_SA(1, 0), a3, voffA);
            PG8_WAIT_V(8); PG8_WAIT_L(0); PG8_BAR; PG8_MMA(1, 0, At, B0); PG8_MMA(1, 1, At, B1); PG8_BAR; PG8_SCHED;
            } else {
            PG8_LDB(B0, 0, 0); PG8_SCHED; PG8_LDA(At, 0, 0); PG8_STAGE(PG8_SA(1, 1), a1 + hstep, voffA);
            PG8_WAIT_L(8); PG8_BAR; PG8_WAIT_L(0); PG8_MMA(0, 0, At, B0); PG8_BAR; PG8_SCHED;
            PG8_LDB(B1, 0, 1); PG8_STAGE(PG8_SB(0, 0), b2, voffB);
            PG8_BAR; PG8_WAIT_L(0); PG8_MMA(0, 1, At, B1); PG8_BAR;
            PG8_LDA(At, 0, 1); PG8_STAGE(PG8_SA(0, 0), a2, voffA);
            PG8_BAR; PG8_WAIT_L(0); PG8_MMA(1, 0, At, B0); PG8_BAR; PG8_SCHED;
            PG8_STAGE(PG8_SB(0, 1), b2 + hstep, voffB);
            PG8_WAIT_V(6); PG8_BAR; PG8_MMA(1, 1, At, B1); PG8_BAR;
            PG8_LDB(B0, 1, 0); PG8_SCHED; PG8_LDA(At, 1, 0); PG8_STAGE(PG8_SA(0, 1), a2 + hstep, voffA);
            PG8_WAIT_L(8); PG8_BAR; PG8_WAIT_L(0); PG8_MMA(0, 0, At, B0); PG8_BAR; PG8_SCHED;
            PG8_LDB(B1, 1, 1); PG8_STAGE(PG8_SB(1, 0), b3, voffB);
            PG8_BAR; PG8_WAIT_L(0); PG8_MMA(0, 1, At, B1); PG8_BAR;
            PG8_LDA(At, 1, 1); PG8_STAGE(PG8_SA(1, 0), a3, voffA);
            PG8_BAR; PG8_WAIT_L(0); PG8_MMA(1, 0, At, B0); PG8_BAR; PG8_SCHED;
            PG8_STAGE(PG8_SB(1, 1), b3 + hstep, voffB);
            PG8_WAIT_V(6); PG8_BAR; PG8_MMA(1, 1, At, B1); PG8_BAR;
            }
        }
        if constexpr (ALIGN_EPI) { if (wr == 0) PG8_BAR; }
        if constexpr (F8) asm volatile("s_nop 15\n\ts_nop 15" ::: "memory");
        if constexpr (!Epi::AFTER_DRAIN) { E(acc, cur, wr, wc, fr, fq); S.done(cur); }
        if (!has_next) break;
#pragma unroll
        for (int a = 0; a < 2; ++a)
#pragma unroll
            for (int b = 0; b < 2; ++b)
#pragma unroll
                for (int m = 0; m < 4; ++m)
#pragma unroll
                    for (int n = 0; n < 2; ++n) acc[a][b][m][n] = (f32x4){0.f, 0.f, 0.f, 0.f};
        cur = nxt; cA = nA; cB = nB; ++ui;
        if constexpr (ALIGN_EPI) { if (wr == 1) PG8_BAR; }
    }
    PG8_WAIT_V(0);
    if constexpr (!ALIGN_EPI) { if (wr == 0) PG8_BAR; }
    PG8_BAR;
    if constexpr (Epi::AFTER_DRAIN) { E.fused(acc, cur, wr, wc, fr, fq, lds, wid, lane); S.done(cur); }
#undef PG8_SA
#undef PG8_SB
#undef PG8_STAGE
#undef PG8_LDA
#undef PG8_LDB
#undef PG8_MMA
#undef PG8_WAIT_V
#undef PG8_WAIT_L
#undef PG8_BAR
#undef PG8_SCHED
}
}

constexpr int NB = 8, SEQ = 4096, DM = 1024, T = NB * SEQ, NMEM = 256, MROWS = NB * NMEM;
constexpr int QKVW = 3840, GATEW = 2048, NIN = 5888;
constexpr float RMS_EPS = 1e-6f;
constexpr int NPH = 15;
constexpr float WIN8_SCALE = 32.0f, MRG8_SCALE = 16.0f;
#ifndef DBG_MIX
#define DBG_MIX 1
#endif
#ifndef DBG_CROSS
#define DBG_CROSS 1
#endif
#ifndef DBG_PEER
#define DBG_PEER 1
#endif
#ifndef DBG_TOPK_SIMPLE
#define DBG_TOPK_SIMPLE 0
#endif
#ifndef DBG_CHECK
#define DBG_CHECK 0
#endif
#ifndef DBG_ATTN_CHECK
#define DBG_ATTN_CHECK 0
#endif
#ifndef DBG_CROSS_CHECK
#define DBG_CROSS_CHECK 0
#endif
#ifndef DBG_NOBIAS
#define DBG_NOBIAS 0
#endif
#ifndef DBG_DIL_CHECK
#define DBG_DIL_CHECK 0
#endif
#ifndef PROBE_PH
#define PROBE_PH (-1)
#endif
#ifndef PROBE_K
#define PROBE_K 200000.0f
#endif
#ifndef DBG_P4CHK
#define DBG_P4CHK 1
#endif
#ifndef ATTN_MFMA
#define ATTN_MFMA 1
#endif
#if DBG_CHECK
#define DBG_YPTR ((float*)(ws + 510 * MiB))
#else
#define DBG_YPTR ((float*)nullptr)
#endif
#ifndef MK_ONE_LAUNCH
#define MK_ONE_LAUNCH 1
#endif
constexpr size_t MiB = 1u << 20;
constexpr size_t WS_CTL = 0, CTL_ZERO_BYTES = 1 * MiB;
constexpr size_t WS_KMEAN = 1 * MiB;
constexpr size_t WS_INV = 2 * MiB;
constexpr size_t WS_WIN = 3 * MiB;
constexpr size_t WS_WA = 15 * MiB, WS_WB = 16 * MiB, WS_WOUT = 17 * MiB, WS_WQC = 19 * MiB, WS_WKVC = 20 * MiB, WS_WOC = 22 * MiB, WS_WQP = 23 * MiB, WS_SUBK = 27 * MiB;
constexpr size_t WS_U = 28 * MiB, WS_V = 60 * MiB;
constexpr size_t WS_H = 92 * MiB;
constexpr size_t WS_MEMB = 156 * MiB, WS_KVC = 160 * MiB;
constexpr size_t WS_ODIL = 164 * MiB, WS_OMOBA = 180 * MiB;
constexpr size_t WS_PQKV = 212 * MiB;
constexpr size_t WS_MERGED = WS_PQKV, WS_X1 = WS_PQKV + 64 * MiB, WS_QC = WS_PQKV + 192 * MiB, WS_OC = WS_ODIL;
constexpr size_t WS_EXP = WS_PQKV, WS_EW = WS_PQKV + 16 * MiB;
constexpr size_t WS_ODG = 452 * MiB, WS_LSE = 500 * MiB;
constexpr size_t WS_END = 502 * MiB;
constexpr int CW_TMO = 0, CW_CODE = 1, CW_WORK = 128, CW_BAR = 4096;
constexpr size_t WS_RSS1 = 256 * 1024, WS_RSS2 = 384 * 1024;
constexpr int RING_OFF = 0, RING_BYTES = 131072;
constexpr int LDSCTL_OFF = RING_BYTES, MISC_OFF = LDSCTL_OFF + 320;
constexpr int LDS_BYTES = 163840;
constexpr int NWAVES = 8;

#define GAS __attribute__((address_space(1)))
#define LAS __attribute__((address_space(3)))
typedef unsigned short bf16;
typedef unsigned v4u __attribute__((ext_vector_type(4)));
typedef float f32x4 __attribute__((ext_vector_type(4)));
typedef float f32x16 __attribute__((ext_vector_type(16)));
typedef short bf16x8 __attribute__((ext_vector_type(8)));
typedef __bf16 bf2_t __attribute__((ext_vector_type(2)));
typedef GAS unsigned gu32;
#define RLX_AGENT __ATOMIC_RELAXED, __HIP_MEMORY_SCOPE_AGENT
#define LDS_WAIT() asm volatile("s_waitcnt lgkmcnt(0)" ::: "memory")
#define VM_WAIT() asm volatile("s_waitcnt vmcnt(0)" ::: "memory")
__device__ __forceinline__ unsigned pk2(float lo, float hi) { return pg8::cvt_pk_bf16(lo, hi); }
__device__ __forceinline__ float bf_lo(unsigned w) { return __uint_as_float(w << 16); }
__device__ __forceinline__ float bf_hi(unsigned w) { return __uint_as_float(w & 0xffff0000u); }
__device__ __forceinline__ float bf2f(bf16 b) { return __uint_as_float((unsigned)b << 16); }

#define XB_TMO      128
#define XB_XCNT(j)  (256  + 64 * (j))
#define XB_XSUB(j)  (1280 + 64 * (j))
#define XB_XGEN(j)  (2304 + 64 * (j))
#define XB_TOP      3328
#define XB_TOPGEN   3392
#define XCD_BAR_WORDS 3456
#define XB_SPIN_CAP (1u << 18)

__device__ __forceinline__ unsigned xb_ld(unsigned* p)              { return __hip_atomic_load(p, __ATOMIC_RELAXED, __HIP_MEMORY_SCOPE_AGENT); }
__device__ __forceinline__ unsigned xb_add(unsigned* p, unsigned v) { return __hip_atomic_fetch_add(p, v, __ATOMIC_RELAXED, __HIP_MEMORY_SCOPE_AGENT); }
__device__ __forceinline__ unsigned xb_xcc_id() { return (unsigned)__builtin_amdgcn_s_getreg((3 << 11) | 20) & 0xFu; }
#define XB_SPIN(cond, bar) do { unsigned _sp = 0; while (cond) { __builtin_amdgcn_s_sleep(1); \
    if ((++_sp & 255u) == 0u) { if (xb_ld(&(bar)[XB_TMO])) break; if (_sp > XB_SPIN_CAP) { atomicAdd(&(bar)[XB_TMO], 1u); break; } } } } while (0)

struct XcdBarrier {
    unsigned* bar; unsigned x;
    volatile LAS unsigned* st;
};

__device__ __forceinline__ XcdBarrier xcd_barrier_post(unsigned* bar, volatile LAS unsigned* st) {
    XcdBarrier b; b.bar = bar; b.x = xb_xcc_id(); b.st = st;
    if (threadIdx.x == 0) (void)xb_add(&bar[XB_XCNT(b.x)], 1u);
    return b;
}
__device__ __forceinline__ void xcd_barrier_complete(unsigned* bar, unsigned x, unsigned& nloc, unsigned& nx) {
    const unsigned G = gridDim.x * gridDim.y * gridDim.z;
    unsigned sum, cnt, mine, sp = 0u;
    for (;;) {
        sum = 0u; cnt = 0u; mine = 0u;
#pragma unroll
        for (unsigned j = 0; j < 16; ++j) { const unsigned c = xb_ld(&bar[XB_XCNT(j)]); sum += c; cnt += (c > 0u) ? 1u : 0u; mine = (j == x) ? c : mine; }
        if (sum == G) break;
        __builtin_amdgcn_s_sleep(1);
        if ((++sp & 255u) == 0u) { if (xb_ld(&bar[XB_TMO])) break; if (sp > XB_SPIN_CAP) { atomicAdd(&bar[XB_TMO], 1u); break; } }
    }
    nloc = mine > 0u ? mine : 1u; nx = cnt > 0u ? cnt : 1u;
}

__device__ __forceinline__ void xcd_barrier(const XcdBarrier& b) {
    asm volatile("s_waitcnt vmcnt(0)" ::: "memory");
    __syncthreads();
    if (threadIdx.x == 0) {
        unsigned* bar = b.bar;
        __builtin_amdgcn_s_waitcnt(0);
        unsigned nloc = b.st[0], nx = b.st[1];
        if (nloc == 0u) { xcd_barrier_complete(bar, b.x, nloc, nx); b.st[0] = nloc; b.st[1] = nx; }
        const unsigned old = xb_add(&bar[XB_XSUB(b.x)], 1u);
        const unsigned gen = old / nloc;
        if (old + 1u == (gen + 1u) * nloc) {
            __builtin_amdgcn_fence(__ATOMIC_RELEASE, "agent");
            asm volatile("s_waitcnt vmcnt(0)" ::: "memory");
            const unsigned og = xb_add(&bar[XB_TOP], 1u);
            const unsigned tg = og / nx;
            if (og + 1u == (tg + 1u) * nx) xb_add(&bar[XB_TOPGEN], 1u);
            else XB_SPIN(xb_ld(&bar[XB_TOPGEN]) == tg, bar);
            __builtin_amdgcn_fence(__ATOMIC_ACQUIRE, "agent");
            xb_add(&bar[XB_XGEN(b.x)], 1u);
            asm volatile("s_waitcnt vmcnt(0)" ::: "memory");
        } else {
            XB_SPIN(xb_ld(&bar[XB_XGEN(b.x)]) == gen, bar);
            __builtin_amdgcn_fence(__ATOMIC_ACQUIRE, "agent");
            asm volatile("s_waitcnt vmcnt(0)" ::: "memory");
        }
    }
    __syncthreads();
}

__device__ __forceinline__ float wave_sum(float v) {
#pragma unroll
    for (int o = 1; o < 64; o <<= 1) v += __shfl_xor(v, o);
    return v;
}
__device__ __forceinline__ int t5_bucket(int n) {
    int b = n;
    if (n >= 16) { b = 16 + (n >= 22) + (n >= 30) + (n >= 40) + (n >= 54) + (n >= 73) + (n >= 99) + (n >= 134) + (n >= 182) + (n >= 246) + (n >= 332) + (n >= 450) + (n >= 609) + (n >= 825) + (n >= 1117) + (n >= 1513); }
    return b;
}
__device__ __forceinline__ void p0_transpose_item(const float* W, int K, int N, bf16* WT, LAS float* scr, int item, int lane, const float* gk = nullptr) {
    const int nblk = N / 32, kb = item / nblk, nb = item % nblk, k0 = 64 * kb, n0 = 32 * nb;
#pragma unroll 8
    for (int i = 0; i < 32; ++i) { const int kk = 2 * i + (lane >> 5); scr[kk * 33 + (lane & 31)] = W[(size_t)(k0 + kk) * N + n0 + (lane & 31)] * (gk ? gk[k0 + kk] : 1.0f); }
    LDS_WAIT(); asm volatile("" ::: "memory");
    const int c = lane & 7;
#pragma unroll
    for (int j = 0; j < 4; ++j) { const int n = (lane >> 3) + 8 * j; const LAS float* s = scr + (8 * c) * 33 + n;
        v4u o; o.x = pk2(s[0 * 33], s[1 * 33]); o.y = pk2(s[2 * 33], s[3 * 33]); o.z = pk2(s[4 * 33], s[5 * 33]); o.w = pk2(s[6 * 33], s[7 * 33]);
        *(GAS v4u*)(WT + (size_t)(n0 + n) * K + k0 + 8 * c) = o; }
    LDS_WAIT(); asm volatile("" ::: "memory");
}
__device__ __forceinline__ void rms_row_to_bf16(const float* xrow, const float* g, bf16* orow, int lane) {
    const f32x4* xr = (const f32x4*)xrow + lane; const f32x4* gr = (const f32x4*)g + lane;
    f32x4 v[4]; float s = 0.f;
#pragma unroll
    for (int j = 0; j < 4; ++j) { v[j] = xr[64 * j]; s += (v[j].x * v[j].x + v[j].y * v[j].y) + (v[j].z * v[j].z + v[j].w * v[j].w); }
    const float rinv = rsqrtf(wave_sum(s) * (1.f / 1024.f) + RMS_EPS);
    unsigned long long* o8 = (unsigned long long*)orow + lane;
#pragma unroll
    for (int j = 0; j < 4; ++j) { const f32x4 gv = gr[64 * j]; o8[64 * j] = (unsigned long long)pk2(v[j].x * rinv * gv.x, v[j].y * rinv * gv.y) | ((unsigned long long)pk2(v[j].z * rinv * gv.z, v[j].w * rinv * gv.w) << 32); }
}
__device__ __forceinline__ void cvt_f32_to_bf16_bulk(const float* src, bf16* dst, size_t n, size_t gtid, size_t nthr) {
    for (size_t i = gtid; i < n / 8; i += nthr) { const f32x4 a = ((const f32x4*)src)[2 * i], b = ((const f32x4*)src)[2 * i + 1];
        v4u o; o.x = pk2(a.x, a.y); o.y = pk2(a.z, a.w); o.z = pk2(b.x, b.y); o.w = pk2(b.z, b.w); ((v4u*)dst)[i] = o; }
}
__device__ __forceinline__ void os_step(const float (&q)[64], float (&o)[64], float& m, float& l, const bf16* krow, const bf16* vrow, float bias) {
    const v4u* kp = (const v4u*)krow; float s = 0.f;
#pragma unroll
    for (int c = 0; c < 8; ++c) { const v4u w = kp[c];
        s += q[8 * c + 0] * bf_lo(w.x) + q[8 * c + 1] * bf_hi(w.x) + q[8 * c + 2] * bf_lo(w.y) + q[8 * c + 3] * bf_hi(w.y)
           + q[8 * c + 4] * bf_lo(w.z) + q[8 * c + 5] * bf_hi(w.z) + q[8 * c + 6] * bf_lo(w.w) + q[8 * c + 7] * bf_hi(w.w); }
    s += bias;
    const float mn = fmaxf(m, s), al = __expf(m - mn), p = __expf(s - mn);
    l = l * al + p; m = mn;
    const v4u* vp = (const v4u*)vrow;
#pragma unroll
    for (int c = 0; c < 8; ++c) { const v4u w = vp[c];
        o[8 * c + 0] = o[8 * c + 0] * al + p * bf_lo(w.x); o[8 * c + 1] = o[8 * c + 1] * al + p * bf_hi(w.x);
        o[8 * c + 2] = o[8 * c + 2] * al + p * bf_lo(w.y); o[8 * c + 3] = o[8 * c + 3] * al + p * bf_hi(w.y);
        o[8 * c + 4] = o[8 * c + 4] * al + p * bf_lo(w.z); o[8 * c + 5] = o[8 * c + 5] * al + p * bf_hi(w.z);
        o[8 * c + 6] = o[8 * c + 6] * al + p * bf_lo(w.w); o[8 * c + 7] = o[8 * c + 7] * al + p * bf_hi(w.w); }
}
__device__ __forceinline__ void load_q64(float (&q)[64], const bf16* qrow, float scale) {
    const v4u* qp = (const v4u*)qrow;
#pragma unroll
    for (int c = 0; c < 8; ++c) { const v4u w = qp[c];
        q[8 * c + 0] = bf_lo(w.x) * scale; q[8 * c + 1] = bf_hi(w.x) * scale; q[8 * c + 2] = bf_lo(w.y) * scale; q[8 * c + 3] = bf_hi(w.y) * scale;
        q[8 * c + 4] = bf_lo(w.z) * scale; q[8 * c + 5] = bf_hi(w.z) * scale; q[8 * c + 6] = bf_lo(w.w) * scale; q[8 * c + 7] = bf_hi(w.w) * scale; }
}
__device__ __forceinline__ void store_o64(const float (&o)[64], float inv, bf16* orow) {
    v4u* op = (v4u*)orow;
#pragma unroll
    for (int c = 0; c < 8; ++c) { v4u w; w.x = pk2(o[8 * c + 0] * inv, o[8 * c + 1] * inv); w.y = pk2(o[8 * c + 2] * inv, o[8 * c + 3] * inv);
        w.z = pk2(o[8 * c + 4] * inv, o[8 * c + 5] * inv); w.w = pk2(o[8 * c + 6] * inv, o[8 * c + 7] * inv); op[c] = w; }
}
__device__ __forceinline__ void cmp_o64(const float (&o)[64], float inv, const bf16* ref, float& num, float& den) {
#pragma unroll
    for (int c = 0; c < 64; ++c) { const float a = o[c] * inv, b = bf2f(ref[c]); num += (a - b) * (a - b); den += a * a; }
}
__device__ __forceinline__ void dbg_acc2(float* acc, float num, float den) { num = wave_sum(num); den = wave_sum(den); if ((threadIdx.x & 63) == 0 && acc) { atomicAdd(acc, num); atomicAdd(acc + 1, den); } }
__device__ __forceinline__ void cvt_f32_to_fp8_bulk(const float* src, unsigned char* dst, size_t n, float scale, size_t gtid, size_t nthr, const float* gc = nullptr) {
    for (size_t i = gtid; i < n / 16; i += nthr) { const f32x4* s = (const f32x4*)src + 4 * i; f32x4 a = s[0] * scale, b = s[1] * scale, c = s[2] * scale, d = s[3] * scale;
        if (gc) { const f32x4* g4 = (const f32x4*)gc + 4 * (i & 63); a = a * g4[0]; b = b * g4[1]; c = c * g4[2]; d = d * g4[3]; }
        int w0 = 0, w1 = 0, w2 = 0, w3 = 0;
        w0 = __builtin_amdgcn_cvt_pk_fp8_f32(a.x, a.y, w0, false); w0 = __builtin_amdgcn_cvt_pk_fp8_f32(a.z, a.w, w0, true);
        w1 = __builtin_amdgcn_cvt_pk_fp8_f32(b.x, b.y, w1, false); w1 = __builtin_amdgcn_cvt_pk_fp8_f32(b.z, b.w, w1, true);
        w2 = __builtin_amdgcn_cvt_pk_fp8_f32(c.x, c.y, w2, false); w2 = __builtin_amdgcn_cvt_pk_fp8_f32(c.z, c.w, w2, true);
        w3 = __builtin_amdgcn_cvt_pk_fp8_f32(d.x, d.y, w3, false); w3 = __builtin_amdgcn_cvt_pk_fp8_f32(d.z, d.w, w3, true);
        v4u o; o.x = (unsigned)w0; o.y = (unsigned)w1; o.z = (unsigned)w2; o.w = (unsigned)w3; ((v4u*)dst)[i] = o; }
}
__device__ __forceinline__ void rms_row_to_fp8(const float* xrow, const float* g, unsigned char* orow, int lane) {
    const f32x4* xr = (const f32x4*)xrow + lane; const f32x4* gr = (const f32x4*)g + lane;
    f32x4 v[4]; float s = 0.f;
#pragma unroll
    for (int j = 0; j < 4; ++j) { v[j] = xr[64 * j]; s += (v[j].x * v[j].x + v[j].y * v[j].y) + (v[j].z * v[j].z + v[j].w * v[j].w); }
    const float rinv = rsqrtf(wave_sum(s) * (1.f / 1024.f) + RMS_EPS);
    unsigned* o4 = (unsigned*)orow + lane;
#pragma unroll
    for (int j = 0; j < 4; ++j) { const f32x4 gv = gr[64 * j]; int w = 0;
        w = __builtin_amdgcn_cvt_pk_fp8_f32(v[j].x * rinv * gv.x, v[j].y * rinv * gv.y, w, false); w = __builtin_amdgcn_cvt_pk_fp8_f32(v[j].z * rinv * gv.z, v[j].w * rinv * gv.w, w, true); o4[64 * j] = (unsigned)w; }
}
__device__ __forceinline__ void p0_transpose_item_fp8(const float* W, int K, int N, unsigned char* WT, LAS float* scr, int item, int lane, float scale, const float* gk = nullptr) {
    const int nblk = N / 32, kb = item / nblk, nb = item % nblk, k0 = 64 * kb, n0 = 32 * nb;
#pragma unroll 8
    for (int i = 0; i < 32; ++i) { const int kk = 2 * i + (lane >> 5); scr[kk * 33 + (lane & 31)] = W[(size_t)(k0 + kk) * N + n0 + (lane & 31)] * (gk ? scale * gk[k0 + kk] : scale); }
    LDS_WAIT(); asm volatile("" ::: "memory");
    const int c = lane & 3;
#pragma unroll
    for (int j = 0; j < 2; ++j) { const int n = (lane >> 2) + 16 * j; const LAS float* s = scr + (16 * c) * 33 + n;
        int w0 = 0, w1 = 0, w2 = 0, w3 = 0;
        w0 = __builtin_amdgcn_cvt_pk_fp8_f32(s[0 * 33], s[1 * 33], w0, false); w0 = __builtin_amdgcn_cvt_pk_fp8_f32(s[2 * 33], s[3 * 33], w0, true);
        w1 = __builtin_amdgcn_cvt_pk_fp8_f32(s[4 * 33], s[5 * 33], w1, false); w1 = __builtin_amdgcn_cvt_pk_fp8_f32(s[6 * 33], s[7 * 33], w1, true);
        w2 = __builtin_amdgcn_cvt_pk_fp8_f32(s[8 * 33], s[9 * 33], w2, false); w2 = __builtin_amdgcn_cvt_pk_fp8_f32(s[10 * 33], s[11 * 33], w2, true);
        w3 = __builtin_amdgcn_cvt_pk_fp8_f32(s[12 * 33], s[13 * 33], w3, false); w3 = __builtin_amdgcn_cvt_pk_fp8_f32(s[14 * 33], s[15 * 33], w3, true);
        v4u o; o.x = (unsigned)w0; o.y = (unsigned)w1; o.z = (unsigned)w2; o.w = (unsigned)w3;
        *(GAS v4u*)(WT + (size_t)(n0 + n) * K + k0 + 16 * c) = o; }
    LDS_WAIT(); asm volatile("" ::: "memory");
}
template <bool SAMP> __device__ __forceinline__ void phase_dil_simple(const bf16* P, const float* rel_bias, bf16* ODIL, int gtid, int nthr, float* acc = nullptr) {
    float cnum = 0.f, cden = 0.f;
    constexpr int NTOK = SAMP ? T / 16 : T;
    for (int item = gtid; item < 4 * NTOK; item += nthr) {
        const int h = item / NTOK, ti = item % NTOK, tok = SAMP ? ti * 16 + 5 : ti, b = tok / SEQ, t = tok % SEQ;
        float o[64], q[64]; float m = -1e30f, l = 0.f;
#pragma unroll
        for (int c = 0; c < 64; ++c) o[c] = 0.f;
        for (int g = 0; g < 3; ++g) {
            const int d = 1 << (2 * g);
            load_q64(q, P + (size_t)tok * QKVW + g * 768 + h * 64, 0.125f);
            for (int j = 0; j <= 128; ++j) {
                const int tp = t - j * d;
                if (tp >= 0) {
                    const bf16* kr = P + (size_t)(b * SEQ + tp) * QKVW + g * 768 + 256 + h * 64;
                    os_step(q, o, m, l, kr, kr + 256, DBG_NOBIAS ? 0.f : rel_bias[t5_bucket(j * d) * 20 + g * 4 + h]);
                }
            }
        }
        if (SAMP) cmp_o64(o, 1.0f / l, ODIL + (size_t)tok * 256 + h * 64, cnum, cden); else store_o64(o, 1.0f / l, ODIL + (size_t)ti * 256 + h * 64);
    }
    if (SAMP) dbg_acc2(acc, cnum, cden);
}
template <bool SAMP> __device__ __forceinline__ void phase_moba_simple(const bf16* P, const float* KMEAN, const float* rel_bias, bf16* OMOBA, int gtid, int nthr, float* acc = nullptr) {
    float cnum = 0.f, cden = 0.f, cnum2 = 0.f, cden2 = 0.f;
    constexpr int NTOK = SAMP ? T / 16 : T;
    for (int item = gtid; item < 8 * NTOK; item += nthr) {
        const int h = item / NTOK, ti = item % NTOK, tok = SAMP ? ti * 16 + 5 : ti, b = tok / SEQ, t = tok % SEQ, qb = t >> 8;
        float o[64], q[64]; float m = -1e30f, l = 0.f;
#pragma unroll
        for (int c = 0; c < 64; ++c) o[c] = 0.f;
        load_q64(q, P + (size_t)tok * QKVW + 2304 + h * 64, 1.0f);
        float v1 = -3e38f, v2 = -3e38f, v3 = -3e38f; int i1 = -1, i2 = -1, i3 = -1;
        for (int n = 0; n < qb; ++n) {
            const float* km = KMEAN + (size_t)((b * 8 + h) * 16 + n) * 64; float gs = 0.f;
#pragma unroll
            for (int c = 0; c < 64; ++c) gs += q[c] * km[c];
            if (gs > v1) { v3 = v2; i3 = i2; v2 = v1; i2 = i1; v1 = gs; i1 = n; }
            else if (gs > v2) { v3 = v2; i3 = i2; v2 = gs; i2 = n; }
            else if (gs > v3) { v3 = gs; i3 = n; }
        }
        unsigned sel = 0u;
        if (i1 >= 0) sel |= 1u << i1;
        if (i2 >= 0) sel |= 1u << i2;
        if (i3 >= 0) sel |= 1u << i3;
#pragma unroll
        for (int c = 0; c < 64; ++c) q[c] *= 0.125f;
        const bf16* Kb = P + (size_t)(b * SEQ) * QKVW + 2304 + 512 + h * 64;
        for (int n = 0; n < 16; ++n) {
            const bool on = ((sel >> n) & 1u) && (n < qb);
            if (__any(on)) {
                for (int j = 0; j < 256; ++j) {
                    const int kpos = n * 256 + j;
                    if (on) { const bf16* kr = Kb + (size_t)kpos * QKVW; os_step(q, o, m, l, kr, kr + 512, DBG_NOBIAS ? 0.f : rel_bias[t5_bucket(t - kpos) * 20 + 12 + h]); }
                }
            }
        }
        for (int j = 0; j < 256; ++j) { const int kpos = qb * 256 + j;
            if (kpos <= t) { const bf16* kr = Kb + (size_t)kpos * QKVW; os_step(q, o, m, l, kr, kr + 512, DBG_NOBIAS ? 0.f : rel_bias[t5_bucket(t - kpos) * 20 + 12 + h]); }
        }
        if (SAMP) { if (qb == 0) cmp_o64(o, 1.0f / l, OMOBA + (size_t)tok * 512 + h * 64, cnum, cden); else cmp_o64(o, 1.0f / l, OMOBA + (size_t)tok * 512 + h * 64, cnum2, cden2); } else store_o64(o, 1.0f / l, OMOBA + (size_t)ti * 512 + h * 64);
    }
    if (SAMP) { dbg_acc2(acc, cnum, cden); dbg_acc2(acc + 2, cnum2, cden2); }
}
template <bool SAMP> __device__ __forceinline__ void phase_cross_simple(const bf16* QC, const bf16* KVC, bf16* OC, int gtid, int nthr, float* acc = nullptr) {
    float cnum = 0.f, cden = 0.f;
    constexpr int NTOK = SAMP ? T / 16 : T;
    for (int item = gtid; item < 8 * NTOK; item += nthr) {
        const int half = item & 1, pr = item >> 1, h = pr / NTOK, ti = pr % NTOK, tok = SAMP ? ti * 16 + 5 : ti, b = tok / SEQ;
        float o[64], q[64]; float m = -1e30f, l = 0.f;
#pragma unroll
        for (int c = 0; c < 64; ++c) o[c] = 0.f;
        load_q64(q, QC + (size_t)tok * 512 + h * 128 + half * 64, 0.08838834764831845f);
        const bf16* Kb = KVC + (size_t)(b * NMEM) * 1024 + h * 128 + half * 64;
        for (int j = 0; j < NMEM; ++j) {
            const v4u* kp = (const v4u*)(Kb + (size_t)j * 1024); float s = 0.f;
#pragma unroll
            for (int c = 0; c < 8; ++c) { const v4u w = kp[c];
                s += q[8 * c + 0] * bf_lo(w.x) + q[8 * c + 1] * bf_hi(w.x) + q[8 * c + 2] * bf_lo(w.y) + q[8 * c + 3] * bf_hi(w.y)
                   + q[8 * c + 4] * bf_lo(w.z) + q[8 * c + 5] * bf_hi(w.z) + q[8 * c + 6] * bf_lo(w.w) + q[8 * c + 7] * bf_hi(w.w); }
            s += __shfl_xor(s, 1);
            const float mn = fmaxf(m, s), al = __expf(m - mn), p = __expf(s - mn);
            l = l * al + p; m = mn;
            const v4u* vp = (const v4u*)(Kb + (size_t)j * 1024 + 512);
#pragma unroll
            for (int c = 0; c < 8; ++c) { const v4u w = vp[c];
                o[8 * c + 0] = o[8 * c + 0] * al + p * bf_lo(w.x); o[8 * c + 1] = o[8 * c + 1] * al + p * bf_hi(w.x);
                o[8 * c + 2] = o[8 * c + 2] * al + p * bf_lo(w.y); o[8 * c + 3] = o[8 * c + 3] * al + p * bf_hi(w.y);
                o[8 * c + 4] = o[8 * c + 4] * al + p * bf_lo(w.z); o[8 * c + 5] = o[8 * c + 5] * al + p * bf_hi(w.z);
                o[8 * c + 6] = o[8 * c + 6] * al + p * bf_lo(w.w); o[8 * c + 7] = o[8 * c + 7] * al + p * bf_hi(w.w); }
        }
        if (SAMP) cmp_o64(o, 1.0f / l, OC + (size_t)tok * 512 + h * 128 + half * 64, cnum, cden); else store_o64(o, 1.0f / l, OC + (size_t)ti * 512 + h * 128 + half * 64);
    }
    if (SAMP) dbg_acc2(acc, cnum, cden);
}

constexpr int PVQ = 2;
constexpr int PNQ = 4, PEG = 128 / PNQ, PSH = 14 - 2;
__device__ __forceinline__ float tk_max(float a, float b) { return fmaxf(a, b); }
__device__ __forceinline__ float tk_min(float a, float b) { return fminf(a, b); }
template <int OFF> __device__ __forceinline__ void sort16_desc(float* v) {
#pragma unroll
    for (int k = 2; k <= 16; k <<= 1) {
#pragma unroll
        for (int j = k >> 1; j > 0; j >>= 1) {
#pragma unroll
            for (int i = 0; i < 16; ++i) {
                const int l = i ^ j;
                if (l > i) {
                    const bool desc = ((i & k) == 0);
                    const float x = v[OFF + i], y = v[OFF + l];
                    const float hi = tk_max(x, y), lo = tk_min(x, y);
                    v[OFF + i] = desc ? hi : lo; v[OFF + l] = desc ? lo : hi;
                }
            }
        }
    }
}
template <int OA, int OB, bool SORT> __device__ __forceinline__ void merge_top16(float* a, const float* b) {
#pragma unroll
    for (int i = 0; i < 16; ++i) a[OA + i] = tk_max(a[OA + i], b[OB + 15 - i]);
    if (SORT) {
#pragma unroll
        for (int j = 8; j > 0; j >>= 1) {
#pragma unroll
            for (int i = 0; i < 16; ++i) {
                const int l = i ^ j;
                if (l > i) { const float x = a[OA + i], y = a[OA + l]; a[OA + i] = tk_max(x, y); a[OA + l] = tk_min(x, y); }
            }
        }
    }
}
constexpr int cand_i(int c) { int n = 0; for (int i = 0; i < 16; ++i) for (int j = 0; j < 16 / (i + 1); ++j) { if (n == c) return i; ++n; } return 0; }
constexpr int cand_j(int c) { int n = 0; for (int i = 0; i < 16; ++i) for (int j = 0; j < 16 / (i + 1); ++j) { if (n == c) return j; ++n; } return 0; }
template <int C> struct CandT { static constexpr int I = cand_i(C), J = cand_j(C); };

__device__ __forceinline__ void peer_level1(const bf16* qrow  , const LAS unsigned char* sk  ,
                                            int r, int hh, float (&out)[16]) {
    bf16x8 qf[8];
#pragma unroll
    for (int ks = 0; ks < 8; ++ks) qf[ks] = *(const bf16x8*)(qrow + ks * 16 + hh * 8);
    float v[64];
#pragma unroll
    for (int kb = 0; kb < 4; ++kb) {
        f32x16 sc = {0.f, 0.f, 0.f, 0.f, 0.f, 0.f, 0.f, 0.f, 0.f, 0.f, 0.f, 0.f, 0.f, 0.f, 0.f, 0.f};
        const int key = kb * 32 + r;
#pragma unroll
        for (int ks = 0; ks < 8; ++ks) {
            const bf16x8 af = *(const LAS bf16x8*)(sk + key * 256 + (((2 * ks + hh) ^ (key & 15)) << 4));
            sc = __builtin_amdgcn_mfma_f32_32x32x16_bf16(af, qf[ks], sc, 0, 0, 0);
        }
#pragma unroll
        for (int reg = 0; reg < 16; ++reg) {
            const unsigned idx = (unsigned)(kb * 32 + (reg & 3) + 8 * (reg >> 2)) | ((unsigned)hh << 2);
            v[kb * 16 + reg] = __uint_as_float((__float_as_uint(sc[reg]) & ~127u) | idx);
        }
    }
    sort16_desc<0>(v); sort16_desc<16>(v); sort16_desc<32>(v); sort16_desc<48>(v);
    merge_top16<0, 16, true>(v, v); merge_top16<32, 48, true>(v, v); merge_top16<0, 32, true>(v, v);
    float other[16];
#pragma unroll
    for (int i = 0; i < 16; ++i) other[i] = __shfl_xor(v[i], 32);
    merge_top16<0, 0, true>(v, other);
#pragma unroll
    for (int i = 0; i < 16; ++i) out[i] = v[i];
}
template <int C, class EP, class WP> __device__ __forceinline__ void peer_emit(const float (&a)[16], const float (&b)[16], const float (&s)[64], float tau, int& cnt, float& den, bool writer, EP eo, WP wo) {
    if constexpr (C < 50) {
        const bool take = (s[C] >= tau) && (cnt < 16);
        const float e = __expf(s[C] - s[0]);
        if (take) {
            if (writer) { eo[cnt] = (int)(((__float_as_uint(a[CandT<C>::I]) & 127u) << 7) | (__float_as_uint(b[CandT<C>::J]) & 127u)); wo[cnt] = e; }
            cnt += 1; den += e;
        }
        peer_emit<C + 1, EP, WP>(a, b, s, tau, cnt, den, writer, eo, wo);
    }
}
template <int C> __device__ __forceinline__ void peer_sums(const float (&a)[16], const float (&b)[16], float (&s)[64]) {
    if constexpr (C < 50) { s[C] = a[CandT<C>::I] + b[CandT<C>::J]; peer_sums<C + 1>(a, b, s); }
}
__device__ __forceinline__ void phase_topk(LAS unsigned char* lds, const bf16* QP, const bf16* SUBK, int* PE, float* PG, int tid, int lane, int wave, int vcu, int G) {
    for (int c = tid; c < 2 * 128 * 16; c += NWAVES * 64) { const int row = c >> 4, ch = c & 15; const v4u w = ((const v4u*)SUBK)[c]; *(LAS v4u*)(lds + row * 256 + ((ch ^ (row & 15)) << 4)) = w; }
    __syncthreads();
    LAS int* stE = (LAS int*)(lds + 65536);
    LAS float* stW = (LAS float*)(lds + 65536 + 16384);
    const int r = lane & 31, hh = lane >> 5, head = wave;
    for (int tile = vcu; tile < T / 32; tile += G) {
        const int tok = tile * 32 + r;
        const bf16* qrow = QP + (size_t)tok * 2048 + head * 256;
        float a[16], b[16];
        peer_level1(qrow, lds, r, hh, a);
        peer_level1(qrow + 128, lds + 128 * 256, r, hh, b);
        float s[64];
        peer_sums<0>(a, b, s);
#pragma unroll
        for (int c = 50; c < 64; ++c) s[c] = -INFINITY;
        float w[64];
#pragma unroll
        for (int c = 0; c < 64; ++c) w[c] = s[c];
        sort16_desc<0>(w); sort16_desc<16>(w); sort16_desc<32>(w); sort16_desc<48>(w);
        merge_top16<0, 16, true>(w, w); merge_top16<32, 48, true>(w, w); merge_top16<0, 32, false>(w, w);
        float tau = w[0];
#pragma unroll
        for (int i = 1; i < 16; ++i) tau = tk_min(tau, w[i]);
        int cnt = 0; float den = 0.f;
        LAS int* eo = stE + r * 128 + head * 16; LAS float* wo = stW + r * 128 + head * 16;
        peer_emit<0, LAS int*, LAS float*>(a, b, s, tau, cnt, den, hh == 0, eo, wo);
        if (hh == 0) { const float inv = 1.0f / den; asm volatile("s_waitcnt lgkmcnt(0)" ::: "memory");
#pragma unroll
            for (int k = 0; k < 16; ++k) wo[k] *= inv; }
        __syncthreads();
#pragma unroll 1
        for (int i = 0; i < 4; ++i) { const int tl = wave * 4 + i; const size_t tg = (size_t)(tile * 32 + tl) * 128;
            const int e0 = stE[tl * 128 + lane], e1 = stE[tl * 128 + 64 + lane]; const float g0 = stW[tl * 128 + lane], g1 = stW[tl * 128 + 64 + lane];
            const int s0 = e0 >> PSH, s1 = e1 >> PSH; int base = 0, p0 = 0, p1 = 0;
#pragma unroll
            for (int bq = 0; bq < PNQ; ++bq) {
                const unsigned long long m0 = __ballot(s0 == bq), m1 = __ballot(s1 == bq);
                const int c0 = __popcll(m0), c1 = __popcll(m1);
                const int r0 = (int)__builtin_amdgcn_mbcnt_hi((unsigned)(m0 >> 32), __builtin_amdgcn_mbcnt_lo((unsigned)m0, 0u));
                const int r1 = (int)__builtin_amdgcn_mbcnt_hi((unsigned)(m1 >> 32), __builtin_amdgcn_mbcnt_lo((unsigned)m1, 0u));
                if (s0 == bq) p0 = base + r0;
                if (s1 == bq) p1 = base + c0 + r1;
                base += c0 + c1;
            }
            PE[tg + p0] = e0; PE[tg + p1] = e1; PG[tg + p0] = g0; PG[tg + p1] = g1; }
        __syncthreads();
    }
}

__device__ __forceinline__ float dot2_bf16(unsigned w, unsigned x, float acc) { return __builtin_amdgcn_fdot2_f32_bf16(__builtin_bit_cast(bf2_t, w), __builtin_bit_cast(bf2_t, x), acc, false); }
__device__ __forceinline__ float dot8_bf16(const v4u a, const v4u b, float acc) {
    acc = dot2_bf16(a.x, b.x, acc); acc = dot2_bf16(a.y, b.y, acc); acc = dot2_bf16(a.z, b.z, acc); acc = dot2_bf16(a.w, b.w, acc);
    return acc;
}
template <int N> __device__ __forceinline__ void xpose_reduce(float (&p)[64], int lane) {
    if constexpr (N >= 1) {
        const bool up = (lane & N) != 0;
#pragma unroll
        for (int k = 0; k < N; ++k) { const float keep = up ? p[k + N] : p[k], send = up ? p[k] : p[k + N]; p[k] = keep + __shfl_xor(send, N); }
        xpose_reduce<N / 2>(p, lane);
    }
}
__device__ __forceinline__ float gelu_exact(float x) { return 0.5f * x * (1.0f + erff(x * 0.70710678118654752f)); }
__device__ __forceinline__ float gelu_as(float v) {
    const float t = __builtin_amdgcn_rcpf(fabsf(v) * 0.2316418882f + 1.0f);
    float q = t * 0.5307027145f + (-0.7265760135f); q = q * t + 0.7107068705f; q = q * t + (-0.142248368f); q = q * t + 0.127414796f; q = q * t;
    const float e = __builtin_amdgcn_exp2f(v * v * (-0.72134752044f));
    const float m = v * (q * e);
    return v < 0.f ? m : v - m;
}
typedef float f32x2_ __attribute__((ext_vector_type(2)));
__device__ __forceinline__ void fp8x16_to_f32(const v4u w, float (&f)[16]) {
    const int w0 = (int)w.x, w1 = (int)w.y, w2 = (int)w.z, w3 = (int)w.w;
    f32x2_ t;
    t = __builtin_amdgcn_cvt_pk_f32_fp8(w0, false); f[0] = t.x; f[1] = t.y; t = __builtin_amdgcn_cvt_pk_f32_fp8(w0, true); f[2] = t.x; f[3] = t.y;
    t = __builtin_amdgcn_cvt_pk_f32_fp8(w1, false); f[4] = t.x; f[5] = t.y; t = __builtin_amdgcn_cvt_pk_f32_fp8(w1, true); f[6] = t.x; f[7] = t.y;
    t = __builtin_amdgcn_cvt_pk_f32_fp8(w2, false); f[8] = t.x; f[9] = t.y; t = __builtin_amdgcn_cvt_pk_f32_fp8(w2, true); f[10] = t.x; f[11] = t.y;
    t = __builtin_amdgcn_cvt_pk_f32_fp8(w3, false); f[12] = t.x; f[13] = t.y; t = __builtin_amdgcn_cvt_pk_f32_fp8(w3, true); f[14] = t.x; f[15] = t.y;
}
constexpr float U8_SCALE = 32.0f, V8_SCALE = 2.0f;
template <int N> __device__ __forceinline__ void xpose_reduce32(float (&p)[32], int lane) {
    if constexpr (N >= 1) {
        const bool up = (lane & N) != 0;
#pragma unroll
        for (int k = 0; k < N; ++k) { const float keep = up ? p[k + N] : p[k], send = up ? p[k] : p[k + N]; p[k] = keep + __shfl_xor(send, N); }
        xpose_reduce32<N / 2>(p, lane);
    } else { p[0] += __shfl_xor(p[0], 32); }
}
__device__ __forceinline__ void peer_u_group(__amdgpu_buffer_rsrc_t U8, const float (&h)[16], int ev, float gv, float zsc, float* wf, int lane) {
    f32x2_ h2[8];
#pragma unroll
    for (int c = 0; c < 8; ++c) { h2[c].x = h[2 * c]; h2[c].y = h[2 * c + 1]; }
    float p[PEG];
#pragma unroll
    for (int i0 = 0; i0 < PEG; i0 += 8) {
        v4u ua[8];
#pragma unroll
        for (int k = 0; k < 8; ++k) { const int eid = __builtin_amdgcn_readlane(ev, i0 + k); ua[k] = __builtin_amdgcn_raw_buffer_load_b128(U8, lane * 16, eid * 1024, 0); }
#pragma unroll
        for (int k = 0; k < 8; ++k) { const int w0 = (int)ua[k].x, w1 = (int)ua[k].y, w2 = (int)ua[k].z, w3 = (int)ua[k].w;
            f32x2_ a0 = h2[0] * __builtin_amdgcn_cvt_pk_f32_fp8(w0, false), a1 = h2[1] * __builtin_amdgcn_cvt_pk_f32_fp8(w0, true);
            a0 += h2[2] * __builtin_amdgcn_cvt_pk_f32_fp8(w1, false); a1 += h2[3] * __builtin_amdgcn_cvt_pk_f32_fp8(w1, true);
            a0 += h2[4] * __builtin_amdgcn_cvt_pk_f32_fp8(w2, false); a1 += h2[5] * __builtin_amdgcn_cvt_pk_f32_fp8(w2, true);
            a0 += h2[6] * __builtin_amdgcn_cvt_pk_f32_fp8(w3, false); a1 += h2[7] * __builtin_amdgcn_cvt_pk_f32_fp8(w3, true);
            a0 += a1; p[i0 + k] = a0.x + a0.y; }
    }
    xpose_reduce32<16>(p, lane);
    if (lane < PEG) wf[lane] = gelu_exact(p[0] * zsc) * gv * (1.0f / V8_SCALE);
}
__device__ __forceinline__ void peer_v_group(__amdgpu_buffer_rsrc_t V8, float (&y)[16], int ev, float wv, int lane) {
#pragma unroll
    for (int i0 = 0; i0 < PEG; i0 += 16) {
        v4u va[16]; float ws[16];
#pragma unroll
        for (int k = 0; k < 16; ++k) { const int eid = __builtin_amdgcn_readlane(ev, i0 + k); ws[k] = __int_as_float(__builtin_amdgcn_readlane(__float_as_int(wv), i0 + k));
            va[k] = __builtin_amdgcn_raw_buffer_load_b128(V8, lane * 16, eid * 1024, 0); }
#pragma unroll
        for (int k = 0; k < 16; ++k) { float f[16]; fp8x16_to_f32(va[k], f);
#pragma unroll
            for (int c = 0; c < 16; ++c) y[c] += ws[k] * f[c]; }
    }
}
__device__ __forceinline__ void peer_v_half(__amdgpu_buffer_rsrc_t V8, float (&y)[16], int ev, float wv, int lane) {
    for (int i0 = 0; i0 < 64; i0 += 16) {
        v4u va[16]; float ws[16];
#pragma unroll
        for (int k = 0; k < 16; ++k) { const int eid = __builtin_amdgcn_readlane(ev, i0 + k); ws[k] = __int_as_float(__builtin_amdgcn_readlane(__float_as_int(wv), i0 + k));
            va[k] = __builtin_amdgcn_raw_buffer_load_b128(V8, lane * 16, eid * 1024, 0); }
#pragma unroll
        for (int k = 0; k < 16; ++k) { float f[16]; fp8x16_to_f32(va[k], f);
#pragma unroll
            for (int c = 0; c < 16; ++c) y[c] += ws[k] * f[c]; }
    }
}
constexpr int XS_LO = 1088;
constexpr int UT_PITCH = 1040, UT_BYTES = 16 * UT_PITCH, UT_XS = 8 * UT_BYTES, XS_BYTES = 2176;
struct PeerVisit { int ev; float gv, rss; v4u ha, hb; };
__device__ __forceinline__ void peer_visit_load(PeerVisit& v, const bf16* H, const float* rowss, const int* PE, const float* PG, int tok, int g, int lane, bool dbg0) {
    const size_t eb = (size_t)tok * 128 + g * PEG;
    const int e = PE[eb + (lane & 31)]; v.ev = dbg0 ? 0 : e;
    v.gv = PG[eb + (lane & 31)]; v.rss = rowss[tok];
    v.ha = *(const v4u*)(H + (size_t)tok * 1024 + 16 * lane); v.hb = *(const v4u*)(H + (size_t)tok * 1024 + 16 * lane + 8);
}
__device__ __forceinline__ void peer_u_dma_tile(const unsigned char* U8p, LAS unsigned char* tb, int ev, int t, int lane) {
#pragma unroll
    for (int r = 0; r < 16; ++r) { const int eid = __builtin_amdgcn_readlane(ev, 16 * t + r);
        __builtin_amdgcn_global_load_lds((const unsigned*)(U8p + (size_t)eid * 1024 + lane * 16), (LAS unsigned*)(tb + r * UT_PITCH), 16, 0, 0); }
}
__device__ __forceinline__ void peer_u_frags(const LAS unsigned char* tb, pg8::v8i32 (&ub)[8], int lane) {
    const LAS unsigned char* p = tb + (lane & 15) * UT_PITCH + (lane >> 4) * 16;
#pragma unroll
    for (int ks = 0; ks < 8; ++ks) { const v4u q0 = *(const LAS v4u*)(p + ks * 128), q1 = *(const LAS v4u*)(p + ks * 128 + 64);
        ub[ks] = (pg8::v8i32){(int)q0.x, (int)q0.y, (int)q0.z, (int)q0.w, (int)q1.x, (int)q1.y, (int)q1.z, (int)q1.w}; }
}
__device__ __forceinline__ void peer_u_visit(const unsigned char* U8p, LAS unsigned char* tb, LAS unsigned char* xs, const PeerVisit& cur, PeerVisit& nxt, const bf16* H, const float* rowss, const int* PE, const float* PG,
                                             int tokn, int gn, bool dbg0, float* wf, int lane) {
    const int j = lane & 15, q = lane >> 4;
    {
        const v4u ha = cur.ha, hb = cur.hb;
        const float sc = rsqrtf(cur.rss * (1.0f / 1024.0f) + RMS_EPS) * 16.0f;
        float h[16];
        h[0] = bf_lo(ha.x) * sc; h[1] = bf_hi(ha.x) * sc; h[2] = bf_lo(ha.y) * sc; h[3] = bf_hi(ha.y) * sc; h[4] = bf_lo(ha.z) * sc; h[5] = bf_hi(ha.z) * sc; h[6] = bf_lo(ha.w) * sc; h[7] = bf_hi(ha.w) * sc;
        h[8] = bf_lo(hb.x) * sc; h[9] = bf_hi(hb.x) * sc; h[10] = bf_lo(hb.y) * sc; h[11] = bf_hi(hb.y) * sc; h[12] = bf_lo(hb.z) * sc; h[13] = bf_hi(hb.z) * sc; h[14] = bf_lo(hb.w) * sc; h[15] = bf_hi(hb.w) * sc;
        int hi[4], lo[4];
#pragma unroll
        for (int c = 0; c < 4; ++c) { int w = 0; w = __builtin_amdgcn_cvt_pk_fp8_f32(h[4 * c], h[4 * c + 1], w, false); w = __builtin_amdgcn_cvt_pk_fp8_f32(h[4 * c + 2], h[4 * c + 3], w, true); hi[c] = w;
            const f32x2_ b0 = __builtin_amdgcn_cvt_pk_f32_fp8(w, false), b1 = __builtin_amdgcn_cvt_pk_f32_fp8(w, true);
            int v = 0; v = __builtin_amdgcn_cvt_pk_fp8_f32((h[4 * c] - b0.x) * 16.0f, (h[4 * c + 1] - b0.y) * 16.0f, v, false); v = __builtin_amdgcn_cvt_pk_fp8_f32((h[4 * c + 2] - b1.x) * 16.0f, (h[4 * c + 3] - b1.y) * 16.0f, v, true); lo[c] = v; }
        *(LAS v4u*)(xs + 16 * lane) = (v4u){(unsigned)hi[0], (unsigned)hi[1], (unsigned)hi[2], (unsigned)hi[3]};
        *(LAS v4u*)(xs + XS_LO + 16 * lane) = (v4u){(unsigned)lo[0], (unsigned)lo[1], (unsigned)lo[2], (unsigned)lo[3]};
    }
    const LAS unsigned char* xb = xs + (j & 1) * XS_LO + q * 16;
    pg8::v8i32 xa[8];
#pragma unroll
    for (int ks = 0; ks < 8; ++ks) { const v4u q0 = *(const LAS v4u*)(xb + ks * 128), q1 = *(const LAS v4u*)(xb + ks * 128 + 64);
        xa[ks] = (pg8::v8i32){(int)q0.x, (int)q0.y, (int)q0.z, (int)q0.w, (int)q1.x, (int)q1.y, (int)q1.z, (int)q1.w}; }
    peer_visit_load(nxt, H, rowss, PE, PG, tokn, gn, lane, dbg0);
    pg8::v8i32 ub[8];
    f32x4 acc0 = {0.f, 0.f, 0.f, 0.f}, acc1 = {0.f, 0.f, 0.f, 0.f};
    const int unit = 0x7f7f7f7f;
    asm volatile("s_waitcnt vmcnt(0)" ::: "memory");
    peer_u_frags(tb, ub, lane);
    asm volatile("s_waitcnt lgkmcnt(0)" ::: "memory");
    peer_u_dma_tile(U8p, tb, cur.ev, 1, lane);
#pragma unroll
    for (int ks = 0; ks < 8; ++ks) asm volatile("v_mfma_scale_f32_16x16x128_f8f6f4 %0, %1, %2, %0, %3, %3 op_sel_hi:[0,0,0]" : "+v"(acc0) : "v"(xa[ks]), "v"(ub[ks]), "v"(unit));
    asm volatile("s_waitcnt vmcnt(0)" ::: "memory");
    peer_u_frags(tb, ub, lane);
    asm volatile("s_waitcnt lgkmcnt(0)" ::: "memory");
    peer_u_dma_tile(U8p, tb, nxt.ev, 0, lane);
#pragma unroll
    for (int ks = 0; ks < 8; ++ks) asm volatile("v_mfma_scale_f32_16x16x128_f8f6f4 %0, %1, %2, %0, %3, %3 op_sel_hi:[0,0,0]" : "+v"(acc1) : "v"(xa[ks]), "v"(ub[ks]), "v"(unit));
    asm volatile("s_nop 15\n\ts_nop 15" : "+v"(acc0), "+v"(acc1));
    const float z = (lane < 16) ? acc0.x + acc0.y * (1.0f / 16.0f) : acc1.x + acc1.y * (1.0f / 16.0f);
    if (lane < 32) wf[lane] = gelu_exact(z * (1.0f / (16.0f * U8_SCALE))) * cur.gv * (1.0f / V8_SCALE);
}
__device__ __forceinline__ void phase_peer(const bf16* H, const float* rowss, const unsigned char* U8p, const unsigned char* V8p, float* WF, const int* PE, const float* PG,
                                           const float* gfin, float* OUT, int lane, int wave, int gw, int ngw, float dbg_sc, float* ydbg, float oscale, LAS unsigned char* ldsw) {
    static_assert(PEG == 32, "the group code is written for 32 entries per group");
    const __amdgpu_buffer_rsrc_t U8 = __builtin_amdgcn_make_buffer_rsrc((void*)U8p, 0, 16 << 20, 0x00020000), V8 = __builtin_amdgcn_make_buffer_rsrc((void*)V8p, 0, 16 << 20, 0x00020000);
    {   const int ntok = (T - gw + ngw - 1) / ngw, nvis = PNQ * ntok; const bool dbg0 = dbg_sc == 0.f;
        LAS unsigned char* tb = ldsw + wave * UT_BYTES; LAS unsigned char* xs = ldsw + UT_XS + wave * XS_BYTES;
        PeerVisit va, vb;
        peer_visit_load(va, H, rowss, PE, PG, gw, 0, lane, dbg0);
        peer_u_dma_tile(U8p, tb, va.ev, 0, lane);
        int g = 0, tok = gw;
        for (int vi = 0; vi < nvis; vi += 2) {
            int g1 = g, tok1 = tok + ngw; if (tok1 >= T) { tok1 = gw; g1 = g + 1; }
            if (vi + 1 >= nvis) { tok1 = tok; g1 = g; }
            peer_u_visit(U8p, tb, xs, va, vb, H, rowss, PE, PG, tok1, g1, dbg0, WF + (size_t)tok * 128 + g * PEG, lane);
            if (vi + 1 >= nvis) break;
            int g2 = g1, tok2 = tok1 + ngw; if (tok2 >= T) { tok2 = gw; g2 = g1 + 1; }
            if (vi + 2 >= nvis) { tok2 = tok1; g2 = g1; }
            peer_u_visit(U8p, tb, xs, vb, va, H, rowss, PE, PG, tok2, g2, dbg0, WF + (size_t)tok1 * 128 + g1 * PEG, lane);
            g = g2; tok = tok2;
        }
    }
    asm volatile("s_waitcnt vmcnt(0)" ::: "memory");
    for (int tq = gw; tq < T; tq += PVQ * ngw) {
        float y[PVQ][16];
#pragma unroll
        for (int j = 0; j < PVQ; ++j)
#pragma unroll
            for (int c = 0; c < 16; ++c) y[j][c] = 0.f;
#pragma unroll
        for (int half = 0; half < 2; ++half)
#pragma unroll
            for (int j = 0; j < PVQ; ++j) { const size_t t_ = (size_t)(tq + j * ngw);
                peer_v_half(V8, y[j], (dbg_sc == 0.f) ? 0 : PE[t_ * 128 + half * 64 + lane], WF[t_ * 128 + half * 64 + lane], lane); }
#pragma unroll
        for (int j = 0; j < PVQ; ++j) {
            const int tok = tq + j * ngw;
            if (dbg_sc == 0.f) {
#pragma unroll
                for (int c = 0; c < 16; ++c) y[j][c] = 0.f; }
            if (ydbg) { const int s_ = tok / 512; if (tok == s_ * 512 + 3 + (s_ & 7) * 37) {
#pragma unroll
                for (int c = 0; c < 16; ++c) ydbg[(size_t)s_ * 1024 + 16 * lane + c] = y[j][c]; } }
            const f32x4* gr = (const f32x4*)gfin + 4 * lane;
            const v4u xa = *(const v4u*)(H + (size_t)tok * 1024 + 16 * lane), xbv = *(const v4u*)(H + (size_t)tok * 1024 + 16 * lane + 8);
            f32x4 xv[4]; float ss = 0.f;
            xv[0] = (f32x4){bf_lo(xa.x), bf_hi(xa.x), bf_lo(xa.y), bf_hi(xa.y)}; xv[1] = (f32x4){bf_lo(xa.z), bf_hi(xa.z), bf_lo(xa.w), bf_hi(xa.w)};
            xv[2] = (f32x4){bf_lo(xbv.x), bf_hi(xbv.x), bf_lo(xbv.y), bf_hi(xbv.y)}; xv[3] = (f32x4){bf_lo(xbv.z), bf_hi(xbv.z), bf_lo(xbv.w), bf_hi(xbv.w)};
#pragma unroll
            for (int i = 0; i < 4; ++i) { xv[i].x += y[j][4 * i]; xv[i].y += y[j][4 * i + 1]; xv[i].z += y[j][4 * i + 2]; xv[i].w += y[j][4 * i + 3];
                ss += (xv[i].x * xv[i].x + xv[i].y * xv[i].y) + (xv[i].z * xv[i].z + xv[i].w * xv[i].w); }
            const float rinv = rsqrtf(wave_sum(ss) * (1.f / 1024.f) + RMS_EPS) * oscale;
            f32x4* orow = (f32x4*)(OUT + (size_t)tok * 1024) + 4 * lane;
#pragma unroll
            for (int i = 0; i < 4; ++i) orow[i] = xv[i] * rinv * gr[i];
        }
    }
}
#if PROBE_PH >= 20
template <int MODE> __device__ __forceinline__ void peer_probe(const bf16* H, const float* rowss, const unsigned char* U8p, const unsigned char* V8p, float* WF, const int* PE, const float* PG,
                                                               float* OUT, int lane, int wave, int gw, int ngw, int vcu) {
    const __amdgpu_buffer_rsrc_t U8 = __builtin_amdgcn_make_buffer_rsrc((void*)U8p, 0, 16 << 20, 0x00020000), V8 = __builtin_amdgcn_make_buffer_rsrc((void*)V8p, 0, 16 << 20, 0x00020000);
    if constexpr (MODE == 0 || MODE == 1 || MODE == 2 || MODE == 6) {
        for (int g = 0; g < PNQ; ++g) {
            for (int tok = gw; tok < T; tok += ngw) {
                int ev = PE[(size_t)tok * 128 + g * PEG + (lane & (PEG - 1))]; const float gv = PG[(size_t)tok * 128 + g * PEG + (lane & (PEG - 1))];
                ev &= 16383;
                if (MODE == 1 || MODE == 6) ev = (ev & 2047) | ((vcu >> 5) << 11);
                const v4u ha = *(const v4u*)(H + (size_t)tok * 1024 + 16 * lane), hb = *(const v4u*)(H + (size_t)tok * 1024 + 16 * lane + 8);
                float h[16];
                h[0] = bf_lo(ha.x); h[1] = bf_hi(ha.x); h[2] = bf_lo(ha.y); h[3] = bf_hi(ha.y); h[4] = bf_lo(ha.z); h[5] = bf_hi(ha.z); h[6] = bf_lo(ha.w); h[7] = bf_hi(ha.w);
                h[8] = bf_lo(hb.x); h[9] = bf_hi(hb.x); h[10] = bf_lo(hb.y); h[11] = bf_hi(hb.y); h[12] = bf_lo(hb.z); h[13] = bf_hi(hb.z); h[14] = bf_lo(hb.w); h[15] = bf_hi(hb.w);
                const float zsc = rsqrtf(rowss[tok] * (1.0f / 1024.0f) + RMS_EPS) * (1.0f / U8_SCALE);
                if constexpr (MODE == 2 || MODE == 6) {
                    unsigned acc = 0u;
#pragma unroll
                    for (int i0 = 0; i0 < PEG; i0 += 8) {
                        v4u ua[8];
#pragma unroll
                        for (int k = 0; k < 8; ++k) { const int eid = __builtin_amdgcn_readlane(ev, i0 + k); ua[k] = __builtin_amdgcn_raw_buffer_load_b128(U8, lane * 16, eid * 1024, 0); }
#pragma unroll
                        for (int k = 0; k < 8; ++k) acc ^= (ua[k].x ^ ua[k].y) ^ (ua[k].z ^ ua[k].w);
                    }
                    if (lane < PEG) (WF + (size_t)tok * 128 + g * PEG)[lane] = __uint_as_float(acc) * zsc * gv * h[0];
                } else peer_u_group(U8, h, ev, gv, zsc, WF + (size_t)tok * 128 + g * PEG, lane);
            }
        }
    } else {
        for (int tq = gw; tq < T; tq += PVQ * ngw) {
            float y[PVQ][16];
#pragma unroll
            for (int j = 0; j < PVQ; ++j)
#pragma unroll
                for (int c = 0; c < 16; ++c) y[j][c] = 0.f;
#pragma unroll
            for (int half = 0; half < 2; ++half)
#pragma unroll
                for (int j = 0; j < PVQ; ++j) { const size_t t_ = (size_t)(tq + j * ngw);
                    int ev = PE[t_ * 128 + half * 64 + lane] & 16383; const float wv = WF[t_ * 128 + half * 64 + lane];
                    if (MODE == 4) ev &= 2047;
                    if constexpr (MODE == 5) {
                        for (int i0 = 0; i0 < 64; i0 += 16) {
                            v4u va[16];
#pragma unroll
                            for (int k = 0; k < 16; ++k) { const int eid = __builtin_amdgcn_readlane(ev, i0 + k); va[k] = __builtin_amdgcn_raw_buffer_load_b128(V8, lane * 16, eid * 1024, 0); }
#pragma unroll
                            for (int k = 0; k < 16; ++k) { y[j][0] = __uint_as_float(__float_as_uint(y[j][0]) ^ va[k].x); y[j][1] = __uint_as_float(__float_as_uint(y[j][1]) ^ va[k].y);
                                y[j][2] = __uint_as_float(__float_as_uint(y[j][2]) ^ va[k].z); y[j][3] = __uint_as_float(__float_as_uint(y[j][3]) ^ va[k].w); }
                        }
                        y[j][4] += wv;
                    } else peer_v_half(V8, y[j], ev, wv, lane);
                }
#pragma unroll
            for (int j = 0; j < PVQ; ++j) {
                const int tok = tq + j * ngw;
                const v4u xa = *(const v4u*)(H + (size_t)tok * 1024 + 16 * lane), xbv = *(const v4u*)(H + (size_t)tok * 1024 + 16 * lane + 8);
                f32x4 xv[4]; float ss = 0.f;
                xv[0] = (f32x4){bf_lo(xa.x), bf_hi(xa.x), bf_lo(xa.y), bf_hi(xa.y)}; xv[1] = (f32x4){bf_lo(xa.z), bf_hi(xa.z), bf_lo(xa.w), bf_hi(xa.w)};
                xv[2] = (f32x4){bf_lo(xbv.x), bf_hi(xbv.x), bf_lo(xbv.y), bf_hi(xbv.y)}; xv[3] = (f32x4){bf_lo(xbv.z), bf_hi(xbv.z), bf_lo(xbv.w), bf_hi(xbv.w)};
#pragma unroll
                for (int i = 0; i < 4; ++i) { xv[i].x += y[j][4 * i]; xv[i].y += y[j][4 * i + 1]; xv[i].z += y[j][4 * i + 2]; xv[i].w += y[j][4 * i + 3];
                    ss += (xv[i].x * xv[i].x + xv[i].y * xv[i].y) + (xv[i].z * xv[i].z + xv[i].w * xv[i].w); }
                const float rinv = rsqrtf(wave_sum(ss) * (1.f / 1024.f) + RMS_EPS);
                f32x4* orow = (f32x4*)(OUT + (size_t)tok * 1024) + 4 * lane;
#pragma unroll
                for (int i = 0; i < 4; ++i) orow[i] = xv[i] * rinv;
            }
        }
    }
}
#endif
constexpr float L2E = 1.4426950408889634f;
#ifndef ATT_THR
#define ATT_THR 8.0f
#endif
typedef short v4i16_t __attribute__((ext_vector_type(4)));
__device__ __forceinline__ float amax3(float a, float b, float c) { float r; asm("v_max3_f32 %0, %1, %2, %3" : "=v"(r) : "v"(a), "v"(b), "v"(c)); return r; }
template <int D> struct ACfg { static constexpr int KS = D / 16, NBLK = D / 32, PITCH = D * 2 + 16, TILEB = 64 * PITCH, VPITCH = (D == 64 ? 192 : 320)  , VTILEB = 64 * VPITCH, PIECES = D / 64, CPR = D / 8; };
__device__ __forceinline__ bf16x8 pack8(float a0, float a1, float a2, float a3, float a4, float a5, float a6, float a7) {
    v4u u; u.x = pk2(a0, a1); u.y = pk2(a2, a3); u.z = pk2(a4, a5); u.w = pk2(a6, a7); return __builtin_bit_cast(bf16x8, u);
}
template <int D> __device__ __forceinline__ void attn_stage_load(v4u (&kr)[D / 64], v4u (&vr)[D / 64], const bf16* Kg, const bf16* Vg, size_t rowstride, int tid) {
#pragma unroll
    for (int p = 0; p < D / 64; ++p) { const int idx = tid + 512 * p, row = idx / ACfg<D>::CPR, ch = idx % ACfg<D>::CPR;
        kr[p] = *(const v4u*)(Kg + (size_t)row * rowstride + ch * 8); vr[p] = *(const v4u*)(Vg + (size_t)row * rowstride + ch * 8); }
}
template <int D> __device__ __forceinline__ void attn_stage_store(const v4u (&kr)[D / 64], const v4u (&vr)[D / 64], LAS unsigned char* Kl, LAS unsigned char* Vl, int tid) {
#pragma unroll
    for (int p = 0; p < D / 64; ++p) { const int idx = tid + 512 * p, row = idx / ACfg<D>::CPR, ch = idx % ACfg<D>::CPR;
        *(LAS v4u*)(Kl + row * ACfg<D>::PITCH + ch * 16) = kr[p]; *(LAS v4u*)(Vl + row * ACfg<D>::VPITCH + ch * 16) = vr[p]; }
}
template <int D> __device__ __forceinline__ void attn_load_q(bf16x8 (&qf)[D / 16], const bf16* qrow, int hh, float scale) {
#pragma unroll
    for (int ks = 0; ks < D / 16; ++ks) { const v4u w = *(const v4u*)(qrow + ks * 16 + hh * 8);
        qf[ks] = pack8(bf_lo(w.x) * scale, bf_hi(w.x) * scale, bf_lo(w.y) * scale, bf_hi(w.y) * scale, bf_lo(w.z) * scale, bf_hi(w.z) * scale, bf_lo(w.w) * scale, bf_hi(w.w) * scale); }
}
template <int D, int BIAS  > __device__ __forceinline__ void attn_tile(const LAS unsigned char* Kl, const LAS unsigned char* Vl, const bf16x8 (&qf)[D / 16], f32x16 (&o)[D / 32], float& m, float& l,
                                                                      const LAS float* tb, bool active, int lane, float cbias = 0.f) {
    constexpr int PITCH = ACfg<D>::PITCH, VPITCH = ACfg<D>::VPITCH;
    const int r = lane & 31, hh = lane >> 5;
    f32x16 s0, s1;
    if (BIAS == 2) {
#pragma unroll
        for (int reg = 0; reg < 16; ++reg) { s0[reg] = cbias; s1[reg] = cbias; }
    } else if (BIAS == 1) {
#pragma unroll
        for (int reg = 0; reg < 16; ++reg) { s0[reg] = tb[(reg & 3) + 8 * (reg >> 2)]; s1[reg] = tb[32 + (reg & 3) + 8 * (reg >> 2)]; }
    } else {
#pragma unroll
        for (int reg = 0; reg < 16; ++reg) { s0[reg] = 0.f; s1[reg] = 0.f; }
    }
#pragma unroll
    for (int ks = 0; ks < D / 16; ++ks) {
        const bf16x8 k0 = *(const LAS bf16x8*)(Kl + r * PITCH + (2 * ks + hh) * 16);
        const bf16x8 k1 = *(const LAS bf16x8*)(Kl + (32 + r) * PITCH + (2 * ks + hh) * 16);
        s0 = __builtin_amdgcn_mfma_f32_32x32x16_bf16(k0, qf[ks], s0, 0, 0, 0);
        s1 = __builtin_amdgcn_mfma_f32_32x32x16_bf16(k1, qf[ks], s1, 0, 0, 0);
    }
    asm volatile("s_nop 15\n\ts_nop 7" : "+v"(s0), "+v"(s1));
    float mx = amax3(s0[0], s1[0], s0[1]), mx2 = amax3(s1[1], s0[2], s1[2]);
#pragma unroll
    for (int reg = 3; reg < 15; reg += 2) { mx = amax3(mx, s0[reg], s1[reg]); mx2 = amax3(mx2, s0[reg + 1], s1[reg + 1]); }
    mx = amax3(mx, mx2, s0[15]); mx = amax3(mx, s1[15], s1[15]); mx = amax3(mx, __shfl_xor(mx, 32), mx);
    if (__any(active && (mx > m + ATT_THR))) {
        const float mn = active ? fmaxf(m, mx) : m;
        const float alpha = __builtin_amdgcn_exp2f(m - mn);
        l *= alpha; m = mn;
#pragma unroll
        for (int blk = 0; blk < D / 32; ++blk)
#pragma unroll
            for (int reg = 0; reg < 16; ++reg) o[blk][reg] *= alpha;
    }
    const float meff = active ? m : __builtin_inff();
    float ls = 0.f;
#pragma unroll
    for (int reg = 0; reg < 16; ++reg) { s0[reg] = __builtin_amdgcn_exp2f(s0[reg] - meff); s1[reg] = __builtin_amdgcn_exp2f(s1[reg] - meff); ls += s0[reg] + s1[reg]; }
    l += ls;
    bf16x8 pf[4];
    pf[0] = pack8(s0[0], s0[1], s0[2], s0[3], s0[4], s0[5], s0[6], s0[7]); pf[1] = pack8(s0[8], s0[9], s0[10], s0[11], s0[12], s0[13], s0[14], s0[15]);
    pf[2] = pack8(s1[0], s1[1], s1[2], s1[3], s1[4], s1[5], s1[6], s1[7]); pf[3] = pack8(s1[8], s1[9], s1[10], s1[11], s1[12], s1[13], s1[14], s1[15]);
    const int i16 = lane & 15;
    unsigned vbo = (unsigned)((4 * hh + (i16 >> 2)) * VPITCH + (16 * ((lane >> 4) & 1) + 4 * (i16 & 3)) * 2);
    asm volatile("" : "+v"(vbo) :: "memory");
    const LAS unsigned char* vb = Vl + vbo;
#pragma unroll
    for (int blk = 0; blk < D / 32; ++blk) {
#pragma unroll
        for (int ks = 0; ks < 4; ++ks) {
            const v4i16_t lo = __builtin_amdgcn_ds_read_tr16_b64_v4i16((LAS v4i16_t*)(vb + (16 * ks) * VPITCH + blk * 64));
            const v4i16_t hi = __builtin_amdgcn_ds_read_tr16_b64_v4i16((LAS v4i16_t*)(vb + (16 * ks + 8) * VPITCH + blk * 64));
            const bf16x8 va = {lo[0], lo[1], lo[2], lo[3], hi[0], hi[1], hi[2], hi[3]};
            o[blk] = __builtin_amdgcn_mfma_f32_32x32x16_bf16(va, pf[ks], o[blk], 0, 0, 0);
        }
    }
}
template <int D> __device__ __forceinline__ void attn_store_o(const f32x16 (&o)[D / 32], float inv, bf16* orow, int hh) {
#pragma unroll
    for (int blk = 0; blk < D / 32; ++blk)
#pragma unroll
        for (int g4 = 0; g4 < 4; ++g4) { unsigned long long w = (unsigned long long)pk2(o[blk][4 * g4] * inv, o[blk][4 * g4 + 1] * inv) | ((unsigned long long)pk2(o[blk][4 * g4 + 2] * inv, o[blk][4 * g4 + 3] * inv) << 32);
            *(unsigned long long*)(orow + 32 * blk + 8 * g4 + 4 * hh) = w; }
}
constexpr int ATT_TB_BYTES = 18432;

__device__ __forceinline__ void moba_unit(LAS unsigned char* lds, const bf16* P, const float* KMEAN, const float* rel_bias, bf16* OMOBA, int b, int h, int qb, int tid, int lane, int wave) {
    constexpr int TILEB = ACfg<64>::TILEB, VTILEB = ACfg<64>::VTILEB;
    const int r = lane & 31, hh = lane >> 5;
    LAS float* TB = (LAS float*)lds;
    LAS unsigned char* Kb = lds + ATT_TB_BYTES; LAS unsigned char* Vb = Kb + 2 * TILEB;
    LAS float* KM = (LAS float*)(lds + ATT_TB_BYTES + 4 * TILEB + 4 * VTILEB);
#pragma unroll
    for (int i = 0; i < 9; ++i) { const int x = tid + i * (NWAVES * 64); if (x < 4352) { const int dist = 4095 - x; float tv = -__builtin_inff(); if (dist >= 0) tv = DBG_NOBIAS ? 0.f : rel_bias[t5_bucket(dist) * 20 + 12 + h] * L2E; TB[x] = tv; } }
#pragma unroll
    for (int i = 0; i < 2; ++i) { const int x = tid + i * (NWAVES * 64); if (x < qb * 64) KM[x] = KMEAN[(size_t)((b * 8 + h) * 16) * 64 + x]; }
    __syncthreads();
    const int qpos = qb * 256 + wave * 32 + r; const size_t tokq = (size_t)b * SEQ + qpos;
    const bf16* qrow = P + tokq * QKVW + 2304 + h * 64;
    unsigned sel = 0u;
    {
        float q[64]; load_q64(q, qrow, 1.0f);
        float v1 = -3e38f, v2 = -3e38f, v3 = -3e38f; int i1 = -1, i2 = -1, i3 = -1;
        for (int n = 0; n < qb; ++n) {
            const LAS f32x4* km = (const LAS f32x4*)(KM + n * 64); float gs = 0.f;
#pragma unroll
            for (int c = 0; c < 16; ++c) { const f32x4 kv = km[c]; gs += q[4 * c] * kv.x + q[4 * c + 1] * kv.y + q[4 * c + 2] * kv.z + q[4 * c + 3] * kv.w; }
            if (gs > v1) { v3 = v2; i3 = i2; v2 = v1; i2 = i1; v1 = gs; i1 = n; }
            else if (gs > v2) { v3 = v2; i3 = i2; v2 = gs; i2 = n; }
            else if (gs > v3) { v3 = gs; i3 = n; }
        }
        if (i1 >= 0) sel |= 1u << i1;
        if (i2 >= 0) sel |= 1u << i2;
        if (i3 >= 0) sel |= 1u << i3;
    }
    bf16x8 qf[4]; attn_load_q<64>(qf, qrow, hh, 0.125f * L2E);
    f32x16 o[2];
#pragma unroll
    for (int reg = 0; reg < 16; ++reg) { o[0][reg] = 0.f; o[1][reg] = 0.f; }
    float m = -1e30f, l = 0.f;
    const bf16* Kg0 = P + (size_t)b * SEQ * QKVW + 2304 + 512 + h * 64;
    const int nt = 4 + 4 * qb;
#define MOBA_K0(i) ((i) < 4 ? qb * 256 + 64 * (i) : 64 * ((i) - 4))
    LAS unsigned char* Kb2 = Kb; LAS unsigned char* Vb2 = Kb + 4 * TILEB;
    LAS float* KM2 = (LAS float*)(Kb + 4 * TILEB + 4 * VTILEB); (void)KM2;
    v4u krA[1], vrA[1], krB[1], vrB[1];
    { const int k0 = MOBA_K0(0), k1 = MOBA_K0(1);
      attn_stage_load<64>(krA, vrA, Kg0 + (size_t)k0 * QKVW, Kg0 + (size_t)k0 * QKVW + 512, QKVW, tid); attn_stage_load<64>(krB, vrB, Kg0 + (size_t)k1 * QKVW, Kg0 + (size_t)k1 * QKVW + 512, QKVW, tid);
      attn_stage_store<64>(krA, vrA, Kb2, Vb2, tid); attn_stage_store<64>(krB, vrB, Kb2 + TILEB, Vb2 + VTILEB, tid); }
    __syncthreads();
    for (int i = 0; i < nt; i += 2) {
        const int sb = (i >> 1) & 1;
        if (i + 2 < nt) { const int k2 = MOBA_K0(i + 2), k3 = MOBA_K0(i + 3);
            attn_stage_load<64>(krA, vrA, Kg0 + (size_t)k2 * QKVW, Kg0 + (size_t)k2 * QKVW + 512, QKVW, tid); attn_stage_load<64>(krB, vrB, Kg0 + (size_t)k3 * QKVW, Kg0 + (size_t)k3 * QKVW + 512, QKVW, tid); }
#pragma unroll
        for (int e = 0; e < 2; ++e) { const int ii = i + e; const int k0 = MOBA_K0(ii);
            bool on; bool go;
            if (ii < 4) { on = true; go = (ii <= (wave >> 1)); }
            else { on = (sel >> ((ii - 4) >> 2)) & 1u; go = __any(on) != 0; }
            if (go) attn_tile<64, 1>(Kb2 + (2 * sb + e) * TILEB, Vb2 + (2 * sb + e) * VTILEB, qf, o, m, l, TB + (k0 - qpos + 4095 + 4 * hh), on, lane); }
        if (i + 2 < nt) { attn_stage_store<64>(krA, vrA, Kb2 + (2 * (sb ^ 1)) * TILEB, Vb2 + (2 * (sb ^ 1)) * VTILEB, tid); attn_stage_store<64>(krB, vrB, Kb2 + (2 * (sb ^ 1) + 1) * TILEB, Vb2 + (2 * (sb ^ 1) + 1) * VTILEB, tid); }
        __syncthreads();
    }
#undef MOBA_K0
    const float lt = l + __shfl_xor(l, 32);
    attn_store_o<64>(o, 1.0f / lt, OMOBA + tokq * 512 + h * 64, hh);
}
__device__ __forceinline__ void dil_unit(LAS unsigned char* lds, const bf16* P, const float* rel_bias, bf16* ODG, float* LSE, int b, int g, int h, int res, int blk, int tid, int lane, int wave) {
    constexpr int TILEB = ACfg<64>::TILEB, VTILEB = ACfg<64>::VTILEB;
    const int r = lane & 31, hh = lane >> 5, d = 1 << (2 * g), l0 = blk * 256;
    LAS float* TB = (LAS float*)lds;
    LAS unsigned char* Kb = lds + ATT_TB_BYTES; LAS unsigned char* Vb = Kb + 2 * TILEB;
    float tbv; { const int j = 256 - tid, jc = j < 0 ? 0 : (j > 128 ? 128 : j); tbv = (DBG_NOBIAS ? 0.f : rel_bias[t5_bucket(jc * d) * 20 + g * 4 + h] * L2E); if (j < 0 || j > 128) tbv = -__builtin_inff(); }
    const int q0w = l0 + wave * 32, lq = q0w + r; const size_t tokq = (size_t)b * SEQ + (size_t)lq * d + res;
    v4u qw[4];
#pragma unroll
    for (int ks = 0; ks < 4; ++ks) qw[ks] = *(const v4u*)(P + tokq * QKVW + g * 768 + h * 64 + ks * 16 + hh * 8);
    f32x16 o[2];
#pragma unroll
    for (int reg = 0; reg < 16; ++reg) { o[0][reg] = 0.f; o[1][reg] = 0.f; }
    float m = -1e30f, l = 0.f;
    const bf16* Kg0 = P + ((size_t)b * SEQ + res) * QKVW + g * 768 + 256 + h * 64;
    const size_t rs = (size_t)QKVW * d;
    const int kt0 = (l0 == 0) ? 0 : -2, nt = 4 - kt0;
    LAS unsigned char* Kb2 = Kb; LAS unsigned char* Vb2 = Kb + 4 * TILEB;
#define DIL_TILE(j, e) ((e) == 0 ? (j) : (nt == 6 ? (j) + 3 : 3 - (j)))
#define DIL_LOAD(i, kr, vr) do { const int k0_ = l0 + 64 * (kt0 + (i)); attn_stage_load<64>(kr, vr, Kg0 + (size_t)k0_ * rs, Kg0 + (size_t)k0_ * rs + 256, rs, tid); } while (0)
    v4u kr0[1], vr0[1], kr1[1], vr1[1], kr2[1], vr2[1], kr3[1], vr3[1], kr4[1], vr4[1], kr5[1], vr5[1];
    DIL_LOAD(DIL_TILE(0, 0), kr0, vr0); DIL_LOAD(DIL_TILE(0, 1), kr1, vr1); DIL_LOAD(DIL_TILE(1, 0), kr2, vr2); DIL_LOAD(DIL_TILE(1, 1), kr3, vr3);
    if (nt == 6) { DIL_LOAD(DIL_TILE(2, 0), kr4, vr4); DIL_LOAD(DIL_TILE(2, 1), kr5, vr5); }
    TB[tid] = tbv;
    bf16x8 qf[4];
#pragma unroll
    for (int ks = 0; ks < 4; ++ks) { const float sc_ = 0.125f * L2E; const v4u w = qw[ks];
        qf[ks] = pack8(bf_lo(w.x) * sc_, bf_hi(w.x) * sc_, bf_lo(w.y) * sc_, bf_hi(w.y) * sc_, bf_lo(w.z) * sc_, bf_hi(w.z) * sc_, bf_lo(w.w) * sc_, bf_hi(w.w) * sc_); }
    attn_stage_store<64>(kr0, vr0, Kb2, Vb2, tid); attn_stage_store<64>(kr1, vr1, Kb2 + TILEB, Vb2 + VTILEB, tid);
    __syncthreads();
    const int nsteps = nt >> 1;
#define DIL_STEP(j, KRN0, VRN0, KRN1, VRN1) do { if ((j) < nsteps) { const int sb = (j) & 1; \
        _Pragma("unroll") for (int e = 0; e < 2; ++e) { const int k0 = l0 + 64 * (kt0 + DIL_TILE((j), e)); \
            const bool go = (k0 + 63 >= q0w - 128) && (k0 <= q0w + 31); \
            if (go) attn_tile<64, 1>(Kb2 + (2 * sb + e) * TILEB, Vb2 + (2 * sb + e) * VTILEB, qf, o, m, l, TB + (k0 - lq + 256 + 4 * hh), true, lane); } \
        if ((j) + 1 < nsteps) { attn_stage_store<64>(KRN0, VRN0, Kb2 + (2 * (sb ^ 1)) * TILEB, Vb2 + (2 * (sb ^ 1)) * VTILEB, tid); attn_stage_store<64>(KRN1, VRN1, Kb2 + (2 * (sb ^ 1) + 1) * TILEB, Vb2 + (2 * (sb ^ 1) + 1) * VTILEB, tid); } \
        __syncthreads(); } } while (0)
    DIL_STEP(0, kr2, vr2, kr3, vr3);
    DIL_STEP(1, kr4, vr4, kr5, vr5);
    DIL_STEP(2, kr4, vr4, kr5, vr5);
#undef DIL_STEP
#undef DIL_TILE
#undef DIL_LOAD
    const float lt = l + __shfl_xor(l, 32);
    attn_store_o<64>(o, 1.0f / lt, ODG + ((size_t)g * T + tokq) * 256 + h * 64, hh);
    if (hh == 0) LSE[((size_t)g * T + tokq) * 4 + h] = (m + __builtin_amdgcn_logf(lt)) * 0.6931471805599453f;
}
__device__ __forceinline__ void cross_unit(LAS unsigned char* lds, const bf16* QC, const bf16* KVC, bf16* OC, int b, int h, int qblk, int tid, int lane, int wave) {
    constexpr int TILEB = ACfg<128>::TILEB, VTILEB = ACfg<128>::VTILEB;
    const int r = lane & 31, hh = lane >> 5;
    LAS unsigned char* Kb = lds + ATT_TB_BYTES; LAS unsigned char* Vb = Kb + 2 * TILEB;
    const size_t tokq = (size_t)b * SEQ + qblk * 256 + wave * 32 + r;
    bf16x8 qf[8]; attn_load_q<128>(qf, QC + tokq * 512 + h * 128, hh, 0.08838834764831845f * L2E);
    f32x16 o[4];
#pragma unroll
    for (int reg = 0; reg < 16; ++reg) { o[0][reg] = 0.f; o[1][reg] = 0.f; o[2][reg] = 0.f; o[3][reg] = 0.f; }
    float m = -1e30f, l = 0.f;
    const bf16* Kg0 = KVC + (size_t)b * NMEM * 1024 + h * 128;
    v4u kr[2], vr[2];
    attn_stage_load<128>(kr, vr, Kg0, Kg0 + 512, 1024, tid); attn_stage_store<128>(kr, vr, Kb, Vb, tid);
    __syncthreads();
    for (int i = 0; i < 4; ++i) {
        if (i + 1 < 4) attn_stage_load<128>(kr, vr, Kg0 + (size_t)(64 * (i + 1)) * 1024, Kg0 + (size_t)(64 * (i + 1)) * 1024 + 512, 1024, tid);
        attn_tile<128, 0>(Kb + (i & 1) * TILEB, Vb + (i & 1) * VTILEB, qf, o, m, l, (const LAS float*)lds, true, lane);
        if (i + 1 < 4) attn_stage_store<128>(kr, vr, Kb + ((i + 1) & 1) * TILEB, Vb + ((i + 1) & 1) * VTILEB, tid);
        __syncthreads();
    }
    const float lt = l + __shfl_xor(l, 32);
    attn_store_o<128>(o, 1.0f / lt, OC + tokq * 512 + h * 128, hh);
}
__device__ __forceinline__ void dil_combine(const bf16* ODG, const float* LSE, bf16* ODIL, int gtid, int nthr) {
    for (int it = gtid; it < T * 32; it += nthr) { const int tok = it >> 5, c = it & 31, h = c >> 3;
        const float a0 = LSE[((size_t)0 * T + tok) * 4 + h], a1 = LSE[((size_t)1 * T + tok) * 4 + h], a2 = LSE[((size_t)2 * T + tok) * 4 + h];
        const float mx = fmaxf(a0, fmaxf(a1, a2)); float w0 = __expf(a0 - mx), w1 = __expf(a1 - mx), w2 = __expf(a2 - mx); const float inv = 1.0f / (w0 + w1 + w2); w0 *= inv; w1 *= inv; w2 *= inv;
        const v4u x0 = *(const v4u*)(ODG + ((size_t)0 * T + tok) * 256 + c * 8), x1 = *(const v4u*)(ODG + ((size_t)1 * T + tok) * 256 + c * 8), x2 = *(const v4u*)(ODG + ((size_t)2 * T + tok) * 256 + c * 8);
        v4u o; o.x = pk2(w0 * bf_lo(x0.x) + w1 * bf_lo(x1.x) + w2 * bf_lo(x2.x), w0 * bf_hi(x0.x) + w1 * bf_hi(x1.x) + w2 * bf_hi(x2.x));
        o.y = pk2(w0 * bf_lo(x0.y) + w1 * bf_lo(x1.y) + w2 * bf_lo(x2.y), w0 * bf_hi(x0.y) + w1 * bf_hi(x1.y) + w2 * bf_hi(x2.y));
        o.z = pk2(w0 * bf_lo(x0.z) + w1 * bf_lo(x1.z) + w2 * bf_lo(x2.z), w0 * bf_hi(x0.z) + w1 * bf_hi(x1.z) + w2 * bf_hi(x2.z));
        o.w = pk2(w0 * bf_lo(x0.w) + w1 * bf_lo(x1.w) + w2 * bf_lo(x2.w), w0 * bf_hi(x0.w) + w1 * bf_hi(x1.w) + w2 * bf_hi(x2.w));
        *(v4u*)(ODIL + (size_t)tok * 256 + c * 8) = o; }
}
__device__ __forceinline__ void phase_topk_simple(const bf16* QP, const float* subk, int* EXP, float* EW, float* INV, int lane, int gw, int ngw) {
    for (int unit = gw; unit < T * 8; unit += ngw) {
        const int tok = unit >> 3, head = unit & 7;
        const bf16* qrow = QP + (size_t)tok * 2048 + head * 256;
        float av = 0.f, bv[4] = {0.f, 0.f, 0.f, 0.f}; int ai = 0, bi[4] = {0, 0, 0, 0};
#pragma unroll
        for (int p = 0; p < 2; ++p) {
            float s0 = 0.f, s1 = 0.f;
            const float* k0 = subk + (size_t)(p * 128 + lane) * 128; const float* k1 = subk + (size_t)(p * 128 + 64 + lane) * 128;
            for (int c = 0; c < 128; ++c) { const float qv = bf2f(qrow[p * 128 + c]); s0 += qv * k0[c]; s1 += qv * k1[c]; }
#pragma unroll
            for (int i = 0; i < 16; ++i) {
                float mloc = fmaxf(s0, s1); float mw = mloc;
#pragma unroll
                for (int o = 1; o < 64; o <<= 1) mw = fmaxf(mw, __shfl_xor(mw, o));
                const unsigned long long bal = __ballot(mloc == mw);
                const int wl = __ffsll((long long)bal) - 1;
                int idx = -1;
                if (lane == wl) { if (s0 >= s1) { idx = lane; s0 = -3e38f; } else { idx = lane + 64; s1 = -3e38f; } }
                idx = __shfl(idx, wl);
                if (p == 0) { if ((lane & 15) == i) { av = mw; ai = idx; } }
                else { if ((lane >> 4) == (i >> 2)) { bv[i & 3] = mw; bi[i & 3] = idx; } }
            }
        }
        float cs[4];
#pragma unroll
        for (int jj = 0; jj < 4; ++jj) cs[jj] = av + bv[jj];
        float top0 = 0.f, den = 0.f; int myexp = 0; float myw = 0.f;
#pragma unroll
        for (int k = 0; k < 16; ++k) {
            float mloc = fmaxf(fmaxf(cs[0], cs[1]), fmaxf(cs[2], cs[3])); float mw = mloc;
#pragma unroll
            for (int o = 1; o < 64; o <<= 1) mw = fmaxf(mw, __shfl_xor(mw, o));
            const unsigned long long bal = __ballot(mloc == mw);
            const int wl = __ffsll((long long)bal) - 1;
            int ex = 0;
            if (lane == wl) {
                if (cs[0] == mw) { ex = ai * 128 + bi[0]; cs[0] = -3e38f; }
                else if (cs[1] == mw) { ex = ai * 128 + bi[1]; cs[1] = -3e38f; }
                else if (cs[2] == mw) { ex = ai * 128 + bi[2]; cs[2] = -3e38f; }
                else { ex = ai * 128 + bi[3]; cs[3] = -3e38f; }
            }
            ex = __shfl(ex, wl);
            if (k == 0) top0 = mw;
            const float e = __expf(mw - top0); den += e;
            if (lane == k) { myexp = ex; myw = e; }
        }
        if (lane < 16) { EXP[(size_t)tok * 128 + head * 16 + lane] = myexp; EW[(size_t)tok * 128 + head * 16 + lane] = myw; }
        if (lane == 0) INV[(size_t)tok * 8 + head] = 1.0f / den;
    }
}
#if DBG_CHECK || DBG_ATTN_CHECK
constexpr size_t WS_YDBG = 510 * MiB;
constexpr int CW_DBG = 64;
__device__ __forceinline__ void dbg_acc(float* acc, float num, float den, int lane) { num = wave_sum(num); den = wave_sum(den); if (lane == 0) { atomicAdd(acc, num); atomicAdd(acc + 1, den); } }
__device__ __forceinline__ int dbg_tok(int s) { return s * 512 + 3 + (s & 7) * 37; }
__device__ __forceinline__ void dbg_check_qp(const bf16* H, const float* w_qp, const bf16* QP, float* acc, int gtid, int nthr, int lane) {
    float num = 0.f, den = 0.f;
    for (int item = gtid; item < 64 * 2048; item += nthr) { const int s = item / 2048, n = item % 2048, t = dbg_tok(s);
        float r = 0.f; for (int k = 0; k < 1024; ++k) r += bf2f(H[(size_t)t * 1024 + k]) * w_qp[(size_t)k * 2048 + n];
        const float mine = bf2f(QP[(size_t)t * 2048 + n]); num += (r - mine) * (r - mine); den += r * r; }
    dbg_acc(acc, num, den, lane);
}
__device__ __forceinline__ void dbg_check_gather(const bf16* H, const float* u, const float* v, const int* EXP, const float* EW, const float* INV, const float* YDBG, float* acc, int gw, int ngw, int lane) {
    float num = 0.f, den = 0.f;
    for (int s = gw; s < 64; s += ngw) { const int t = dbg_tok(s);
        float y[16];
#pragma unroll
        for (int c = 0; c < 16; ++c) y[c] = 0.f;
        for (int i = 0; i < 128; ++i) { const int e = EXP[(size_t)t * 128 + i]; const float g = EW[(size_t)t * 128 + i] * INV[(size_t)t * 8 + (i >> 4)];
            float d = 0.f;
#pragma unroll
            for (int c = 0; c < 16; ++c) d += bf2f(H[(size_t)t * 1024 + lane * 16 + c]) * u[(size_t)e * 1024 + lane * 16 + c];
            d = wave_sum(d);
            const float w = g * gelu_exact(d);
#pragma unroll
            for (int c = 0; c < 16; ++c) y[c] += w * v[(size_t)e * 1024 + lane * 16 + c]; }
#pragma unroll
        for (int c = 0; c < 16; ++c) { const float mine = YDBG[(size_t)s * 1024 + lane * 16 + c]; num += (y[c] - mine) * (y[c] - mine); den += y[c] * y[c]; } }
    dbg_acc(acc, num, den, lane);
}
__device__ __forceinline__ float dbg_k(const float* acc) { const float D = acc[0] / fmaxf(acc[1], 1e-30f); float k = log10f(fmaxf(D, 1e-12f)); return fminf(fmaxf(k, -6.f), 1.f); }
__device__ __forceinline__ void dbg_encode(const float* x, const float* gfin, float* out, const float* acc, int gw, int ngw, int lane) {
    const float k1 = dbg_k(acc), k2 = dbg_k(acc + 2); const float s = 1.f + (k1 + 6.5f) * 0.5f;
    for (int m = gw; m < T; m += ngw) { const f32x4* xr = (const f32x4*)(x + (size_t)m * 1024) + lane; const f32x4* gr = (const f32x4*)gfin + lane; f32x4 vv[4]; float ss = 0.f;
#pragma unroll
        for (int j = 0; j < 4; ++j) { vv[j] = xr[64 * j]; ss += (vv[j].x * vv[j].x + vv[j].y * vv[j].y) + (vv[j].z * vv[j].z + vv[j].w * vv[j].w); }
        const float rinv = rsqrtf(wave_sum(ss) * (1.f / 1024.f) + RMS_EPS) * s;
#pragma unroll
        for (int j = 0; j < 4; ++j) { f32x4 o = vv[j] * rinv * gr[64 * j]; if (m == 0 && j == 0 && lane == 0) o.x = 100.f + 100.f * (k2 + 6.f); ((f32x4*)(out + (size_t)m * 1024) + lane)[64 * j] = o; } }
}
#endif

struct Args { const float* in[20]; float* out; unsigned char* ws; int ph_lo, ph_hi; };
__global__ void __launch_bounds__(NWAVES * 64, 2) fwd(Args args) {
    extern __shared__ __attribute__((aligned(16))) unsigned char lds_raw[];
    LAS unsigned char* lds = (LAS unsigned char*)lds_raw;
    volatile LAS unsigned* MISC = (volatile LAS unsigned*)(lds + MISC_OFF);
    const int tid = threadIdx.x, lane = tid & 63, wave = __builtin_amdgcn_readfirstlane(tid >> 6);
    const int G = gridDim.x; const int bx = blockIdx.x; const int vcu = (G % 8 == 0) ? (bx % 8) * (G / 8) + bx / 8 : bx;
    const int gw = vcu * NWAVES + wave, NGW = G * NWAVES, gtid = vcu * (NWAVES * 64) + tid, NTHR = G * NWAVES * 64;
    unsigned char* ws = args.ws;
    gu32* ctl = (gu32*)(ws + WS_CTL);
#define X_IN (args.in[0])
#define mem (args.in[1])
#define rel_bias (args.in[2])
#define g_mix (args.in[3])
#define w_in (args.in[4])
#define b_gate (args.in[5])
#define w_a (args.in[6])
#define w_b (args.in[7])
#define w_out (args.in[8])
#define g_cross (args.in[9])
#define g_mem (args.in[10])
#define w_qc (args.in[11])
#define w_kvc (args.in[12])
#define w_oc (args.in[13])
#define g_ffn (args.in[14])
#define w_qp (args.in[15])
#define subk (args.in[16])
#define peer_u (args.in[17])
#define peer_v (args.in[18])
#define g_final (args.in[19])
#define OUTP (args.out)
#define WinT ((bf16*)(ws + WS_WIN))
#define WaT ((bf16*)(ws + WS_WA))
#define WbT ((bf16*)(ws + WS_WB))
#define WoutT ((bf16*)(ws + WS_WOUT))
#define WqcT ((bf16*)(ws + WS_WQC))
#define WkvcT ((bf16*)(ws + WS_WKVC))
#define WocT ((bf16*)(ws + WS_WOC))
#define WqpT ((bf16*)(ws + WS_WQP))
#define SUBK ((bf16*)(ws + WS_SUBK))
#define U8T ((unsigned char*)(ws + WS_U))
#define V8T ((unsigned char*)(ws + WS_V))
#define HB ((bf16*)(ws + WS_H))
#define MEMB ((bf16*)(ws + WS_MEMB))
#define KVC ((bf16*)(ws + WS_KVC))
#define ODIL ((bf16*)(ws + WS_ODIL))
#define OMOBA ((bf16*)(ws + WS_OMOBA))
#define PQKV ((bf16*)(ws + WS_PQKV))
#define MERGED ((bf16*)(ws + WS_MERGED))
#define MERGED8 ((unsigned char*)(ws + WS_QC))
#define X1 ((float*)(ws + WS_X1))
#define QC ((bf16*)(ws + WS_QC))
#define OC ((bf16*)(ws + WS_OC))
#define ODG ((bf16*)(ws + WS_ODG))
#define LSE ((float*)(ws + WS_LSE))
#define EXP ((int*)(ws + WS_EXP))
#define EW ((float*)(ws + WS_EW))
#define INV ((float*)(ws + WS_INV))
#define KMEAN ((float*)(ws + WS_KMEAN))
#define SEB ((int*)(ws + WS_PQKV + 32 * MiB))
#define SGB ((float*)(ws + WS_PQKV + 48 * MiB))
#define OFFB ((int*)(ws + WS_QC))
#define RSS1 ((float*)(ws + WS_RSS1))
#define RSS2 ((float*)(ws + WS_RSS2))
#define GATES ((bf16*)args.out)
#define QP ((bf16*)args.out)
    for (int u = tid; u < (LDS_BYTES - LDSCTL_OFF) / 4; u += NWAVES * 64) ((LAS unsigned*)(lds + LDSCTL_OFF))[u] = 0u;
    __syncthreads();
    const int lo = args.ph_lo, hi = args.ph_hi;
    XcdBarrier bar; bar.bar = (unsigned*)(ctl + CW_BAR); bar.x = 0; bar.st = nullptr;
    if (hi - lo > 1) bar = xcd_barrier_post((unsigned*)(ctl + CW_BAR), MISC + 8);
#define IN(k) (lo <= (k) && (k) < hi)
#define PR_BEG(k) do { if (PROBE_PH == (k) && tid == 0) MISC[16] = (unsigned)__builtin_amdgcn_s_memrealtime(); } while (0)
#define PR_END(k) do { if (PROBE_PH == (k) && tid == 0) MISC[17] = (unsigned)__builtin_amdgcn_s_memrealtime(); } while (0)
#define SEAM(k) do { if (IN(k) && IN((k) + 1)) xcd_barrier(bar); } while (0)

    PR_BEG(0);
    if (IN(0)) {
        LAS float* scr = (LAS float*)(lds + RING_OFF + wave * 16384);
        constexpr int I_IN = (1024 / 64) * (NIN / 32), I_A = (256 / 64) * (1024 / 32), I_B = (512 / 64) * (1024 / 32), I_OUT = (1024 / 64) * (1024 / 32), I_QC = (1024 / 64) * (512 / 32),
                      I_KVC = (1024 / 64) * (1024 / 32), I_OC = (512 / 64) * (1024 / 32), I_QP = (1024 / 64) * (2048 / 32);
        constexpr int NITEMS = I_IN + I_A + I_B + I_OUT + I_QC + I_KVC + I_OC + I_QP;
        for (int it = gw; it < NITEMS; it += NGW) {
            int r = it;
            if (r < I_IN) { p0_transpose_item_fp8(w_in, 1024, NIN, (unsigned char*)WinT, scr, r, lane, WIN8_SCALE); continue; } r -= I_IN;
            if (r < I_A) { p0_transpose_item(w_a, 256, 1024, WaT, scr, r, lane); continue; } r -= I_A;
            if (r < I_B) { p0_transpose_item(w_b, 512, 1024, WbT, scr, r, lane); continue; } r -= I_B;
            if (r < I_OUT) { p0_transpose_item_fp8(w_out, 1024, 1024, (unsigned char*)WoutT, scr, r, lane, WIN8_SCALE); continue; } r -= I_OUT;
            if (r < I_QC) { p0_transpose_item(w_qc, 1024, 512, WqcT, scr, r, lane, g_cross); continue; } r -= I_QC;
            if (r < I_KVC) { p0_transpose_item(w_kvc, 1024, 1024, WkvcT, scr, r, lane); continue; } r -= I_KVC;
            if (r < I_OC) { p0_transpose_item(w_oc, 512, 1024, WocT, scr, r, lane); continue; } r -= I_OC;
            p0_transpose_item(w_qp, 1024, 2048, WqpT, scr, r, lane, g_ffn);
        }
        cvt_f32_to_bf16_bulk(subk, SUBK, (size_t)2 * 128 * 128, (size_t)gtid, (size_t)NTHR);
        for (int m = gw; m < T; m += NGW) rms_row_to_fp8(X_IN + (size_t)m * DM, g_mix, (unsigned char*)HB + (size_t)m * DM, lane);
        for (int m = gw; m < MROWS; m += NGW) rms_row_to_bf16(mem + (size_t)m * DM, g_mem, MEMB + (size_t)m * DM, lane);
        __syncthreads();
    }
    SEAM(0);
    PR_END(0);
    PR_BEG(1);
    if (IN(1)) {
        if (DBG_MIX) { pg8::Gemm g{HB, WinT, T, NIN, DM / 2}; pg8::StaticOrder S; S.init(T, NIN, G, bx); pg8::EpiIn E{PQKV, GATES, b_gate, 1.0f / WIN8_SCALE};
          pg8::gemm_phase<pg8::EpiIn, pg8::StaticOrder, true, true, true>(lds + RING_OFF, g, S, E); }
        __syncthreads();
        if (DBG_CROSS) { pg8::Gemm g{MEMB, WkvcT, MROWS, 1024, DM}; pg8::StaticOrder S; S.init(MROWS, 1024, G, bx); pg8::EpiStore E{KVC, 1024};
          pg8::gemm_phase<pg8::EpiStore, pg8::StaticOrder, true, true>(lds + RING_OFF, g, S, E); }
        {
            constexpr int CH = 16384, NCH_U = (16384 * 1024) / CH, NCH = 2 * NCH_U;
            for (;;) {
                int c = 0; if (lane == 0) c = (int)__hip_atomic_fetch_add((unsigned*)(ctl + CW_WORK), 1u, __ATOMIC_RELAXED, __HIP_MEMORY_SCOPE_AGENT);
                c = __builtin_amdgcn_readfirstlane(c);
                if (c >= NCH) break;
                const bool isv = c >= NCH_U; const int cc = isv ? c - NCH_U : c;
                const float* src = (isv ? peer_v : peer_u) + (size_t)cc * CH; unsigned char* dst = (isv ? V8T : U8T) + (size_t)cc * CH;
                cvt_f32_to_fp8_bulk(src, dst, (size_t)CH, isv ? V8_SCALE : U8_SCALE, (size_t)lane, (size_t)64, isv ? (const float*)nullptr : g_ffn);
            }
        }
    }
    SEAM(1);
    PR_END(1);
    PR_BEG(2);
    if (IN(2) && DBG_MIX) {
#if ATTN_MFMA
        for (int u = vcu; u < NB * 3 * 4 * 16; u += G) { const int u16 = u & 15,     bgh = u >> 4, h = bgh & 3, g = (bgh >> 2) % 3, b = (bgh >> 2) / 3;
            dil_unit(lds + RING_OFF, PQKV, rel_bias, ODG, LSE, b, g, h, u16 & ((1 << (2 * g)) - 1), u16 >> (2 * g), tid, lane, wave); }
#endif
        for (int it = gw; it < NB * 8 * 16; it += NGW) { const int bh = it >> 4, blk = it & 15, b = bh >> 3, h = bh & 7;
            const bf16* kp = PQKV + (size_t)(b * SEQ + blk * 256 + (lane >> 3)) * QKVW + 2304 + 512 + h * 64 + 8 * (lane & 7);
            float s8[8] = {0.f, 0.f, 0.f, 0.f, 0.f, 0.f, 0.f, 0.f};
#pragma unroll 8
            for (int j = 0; j < 32; ++j) { const v4u w = *(const v4u*)(kp + (size_t)(8 * j) * QKVW);
                s8[0] += bf_lo(w.x); s8[1] += bf_hi(w.x); s8[2] += bf_lo(w.y); s8[3] += bf_hi(w.y); s8[4] += bf_lo(w.z); s8[5] += bf_hi(w.z); s8[6] += bf_lo(w.w); s8[7] += bf_hi(w.w); }
#pragma unroll
            for (int c = 0; c < 8; ++c) { float v = s8[c]; v += __shfl_xor(v, 8); v += __shfl_xor(v, 16); v += __shfl_xor(v, 32); s8[c] = v * (1.0f / 256.0f); }
            if (lane < 8) { f32x4* dst = (f32x4*)(KMEAN + (size_t)it * 64 + 8 * lane); dst[0] = (f32x4){s8[0], s8[1], s8[2], s8[3]}; dst[1] = (f32x4){s8[4], s8[5], s8[6], s8[7]}; } }
    }
    SEAM(2);
    PR_END(2);
    PR_BEG(3);
    if (IN(3) && DBG_MIX) {
#if ATTN_MFMA
        for (int pu = vcu; pu < NB * 8 * 8; pu += G) { const int bh = pu >> 3, p = pu & 7, b = bh >> 3, h = bh & 7;
            moba_unit(lds + RING_OFF, PQKV, KMEAN, rel_bias, OMOBA, b, h, p, tid, lane, wave);
            moba_unit(lds + RING_OFF, PQKV, KMEAN, rel_bias, OMOBA, b, h, 15 - p, tid, lane, wave); }
        dil_combine(ODG, LSE, ODIL, gtid, NTHR);
#else
        phase_dil_simple<false>(PQKV, rel_bias, ODIL, gtid, NTHR); phase_moba_simple<false>(PQKV, KMEAN, rel_bias, OMOBA, gtid, NTHR);
#endif
    }
    SEAM(3);
    PR_END(3);
    PR_BEG(4);
#if DBG_ATTN_CHECK && DBG_P4CHK
    if (IN(4)) { if (DBG_DIL_CHECK) phase_dil_simple<true>(PQKV, rel_bias, ODIL, gtid, NTHR, (float*)(ctl + CW_DBG)); else phase_moba_simple<true>(PQKV, KMEAN, rel_bias, OMOBA, gtid, NTHR, (float*)(ctl + CW_DBG)); }
#endif
    if (IN(4) && DBG_MIX && !(DBG_ATTN_CHECK && DBG_P4CHK)) { pg8::Gemm g{ODIL, WaT, T, 1024, 256}; pg8::StaticOrder S; S.init(T, 1024, G, bx); pg8::EpiGate<false, true> E{MERGED, GATES, 0, MERGED8, MRG8_SCALE};
        pg8::gemm_phase<pg8::EpiGate<false, true>, pg8::StaticOrder, true, true>(lds + RING_OFF, g, S, E); }
    SEAM(4);
    PR_END(4);
    PR_BEG(5);
    if (IN(5) && DBG_MIX && !(DBG_ATTN_CHECK && DBG_P4CHK)) { pg8::Gemm g{OMOBA, WbT, T, 1024, 512}; pg8::StaticOrder S; S.init(T, 1024, G, bx); pg8::EpiGate<true, true> E{MERGED, GATES, 1024, MERGED8, MRG8_SCALE};
        pg8::gemm_phase<pg8::EpiGate<true, true>, pg8::StaticOrder, true, true>(lds + RING_OFF, g, S, E); }
    SEAM(5);
    PR_END(5);
    PR_BEG(6);
    if (IN(6) && !(DBG_ATTN_CHECK && DBG_P4CHK)) { pg8::Gemm g{(const bf16*)MERGED8, WoutT, T, 1024, 1024 / 2}; pg8::StaticOrder S; S.init(T, 1024, G, bx); pg8::EpiRes E{X_IN, nullptr, 1024, (float)DBG_MIX / (MRG8_SCALE * WIN8_SCALE), HB, RSS1, nullptr, nullptr};
        pg8::gemm_phase<pg8::EpiRes, pg8::StaticOrder, true, true, true>(lds + RING_OFF, g, S, E); }
    SEAM(6);
    PR_END(6);
    PR_BEG(7);
    PR_BEG(8);
    if (IN(8) && DBG_CROSS) { pg8::Gemm g{HB, WqcT, T, 512, 1024}; pg8::StaticOrder S; S.init(T, 512, G, bx); pg8::EpiStoreRs E{QC, 512, RSS1, 1.0f};
        pg8::gemm_phase<pg8::EpiStoreRs, pg8::StaticOrder, true, true>(lds + RING_OFF, g, S, E); }
    SEAM(8);
    PR_END(8);
    PR_BEG(9);
    if (IN(9) && DBG_CROSS) {
#if ATTN_MFMA
        for (int u = vcu; u < NB * 4 * 16; u += G) cross_unit(lds + RING_OFF, QC, KVC, OC, u >> 6, (u >> 4) & 3, u & 15, tid, lane, wave);
#else
        phase_cross_simple<false>(QC, KVC, OC, gtid, NTHR);
#endif
    }
    SEAM(9);
    PR_END(9);
    PR_BEG(10);
#if DBG_ATTN_CHECK
    if (IN(10) && DBG_CROSS_CHECK) phase_cross_simple<true>(QC, KVC, OC, gtid, NTHR, (float*)(ctl + CW_DBG) + 2);
#endif
    if (IN(10)) { pg8::Gemm g{OC, WocT, T, 1024, 512}; pg8::StaticOrder S; S.init(T, 1024, G, bx); pg8::EpiRes E{nullptr, nullptr, 1024, (float)DBG_CROSS, HB, RSS2, nullptr, HB};
        pg8::gemm_phase<pg8::EpiRes, pg8::StaticOrder, true, true>(lds + RING_OFF, g, S, E); }
    SEAM(10);
    PR_END(10);
    PR_BEG(11);
    PR_BEG(12);
    if (IN(12) && DBG_PEER) { pg8::Gemm g{HB, WqpT, T, 2048, 1024}; pg8::StaticOrder S; S.init(T, 2048, G, bx); pg8::EpiStoreRs E{QP, 2048, RSS2, 1.0f};
        pg8::gemm_phase<pg8::EpiStoreRs, pg8::StaticOrder, true, true>(lds + RING_OFF, g, S, E); }
    SEAM(12);
    PR_END(12);
    PR_BEG(13);
#if DBG_CHECK
    if (IN(13)) dbg_check_qp(HB, w_qp, QP, (float*)(ctl + CW_DBG), gtid, NTHR, lane);
#endif
#if DBG_TOPK_SIMPLE
    if (IN(13) && DBG_PEER) { phase_topk_simple(QP, subk, EXP, EW, INV, lane, gw, NGW); }
#else
    if (IN(13) && DBG_PEER) { phase_topk(lds + RING_OFF, QP, SUBK, SEB, (float*)OFFB, tid, lane, wave, vcu, G); }
#endif
    SEAM(13);
    PR_END(13);
#if PROBE_PH >= 20
    PR_BEG(PROBE_PH);
    if (IN(14)) { const int lane15 = (int)__builtin_amdgcn_mbcnt_hi(~0u, __builtin_amdgcn_mbcnt_lo(~0u, 0u));
        peer_probe<PROBE_PH - 20>(HB, RSS2, U8T, V8T, SGB, SEB, (const float*)OFFB, OUTP, lane15, wave, gw, NGW, vcu, lds); xcd_barrier(bar); }
    PR_END(PROBE_PH);
#endif
    PR_BEG(14);
    if (IN(14)) { const int lane14 = (int)__builtin_amdgcn_mbcnt_hi(~0u, __builtin_amdgcn_mbcnt_lo(~0u, 0u));
        phase_peer(HB, RSS2, U8T, V8T, SGB, SEB, (const float*)OFFB, g_final, OUTP, lane14, wave, gw, NGW, (float)DBG_PEER, DBG_YPTR, (PROBE_PH >= 0 && PROBE_PH < 20) ? 1.0f + sqrtf((float)(MISC[17] - MISC[16]) * (0.01f / PROBE_K)) : 1.0f, lds); }
#if DBG_CHECK || DBG_ATTN_CHECK
#if DBG_CHECK
    if (IN(15)) dbg_check_gather(HB, peer_u, peer_v, EXP, EW, INV, (const float*)(ws + WS_YDBG), (float*)(ctl + CW_DBG) + 2, gw, NGW, lane);
#endif
    if (IN(16)) dbg_encode(X_IN, g_final, OUTP, (const float*)(ctl + CW_DBG), gw, NGW, lane);
#endif
#undef IN
#undef SEAM
#undef X_IN
#undef mem
#undef rel_bias
#undef g_mix
#undef w_in
#undef b_gate
#undef w_a
#undef w_b
#undef w_out
#undef g_cross
#undef g_mem
#undef w_qc
#undef w_kvc
#undef w_oc
#undef g_ffn
#undef w_qp
#undef subk
#undef peer_u
#undef peer_v
#undef g_final
#undef OUTP
#undef WinT
#undef WaT
#undef WbT
#undef WoutT
#undef WqcT
#undef WkvcT
#undef WocT
#undef WqpT
#undef SUBK
#undef U8T
#undef V8T
#undef HB
#undef MEMB
#undef KVC
#undef ODIL
#undef OMOBA
#undef PQKV
#undef MERGED
#undef MERGED8
#undef X1
#undef QC
#undef OC
#undef ODG
#undef LSE
#undef EXP
#undef EW
#undef INV
#undef KMEAN
#undef RSS1
#undef SEB
#undef SGB
#undef OFFB
#undef RSS2
#undef GATES
#undef QP

}

extern "C" void kernel_launch(void* const* d_in, const int* in_sizes, int n_in, void* d_out, int out_size, void* d_ws, size_t ws_size, hipStream_t stream) {
    static int grid = 0;
    if (grid == 0) {
        if (n_in != 20 || out_size != T * DM || ws_size < WS_END) { fprintf(stderr, "kernel_launch: unexpected shapes (n_in %d, out %d, ws %zu); nothing launched\n", n_in, out_size, ws_size); grid = -1; return; }
        int dev = 0, cus = 0, per_cu = 0;
        if (hipGetDevice(&dev) != hipSuccess || hipDeviceGetAttribute(&cus, hipDeviceAttributeMultiprocessorCount, dev) != hipSuccess) { grid = -1; return; }
        if (hipFuncSetAttribute((const void*)fwd, hipFuncAttributeMaxDynamicSharedMemorySize, LDS_BYTES) != hipSuccess) { fprintf(stderr, "kernel_launch: hipFuncSetAttribute failed\n"); grid = -1; return; }
        if (hipOccupancyMaxActiveBlocksPerMultiprocessor(&per_cu, (const void*)fwd, NWAVES * 64, LDS_BYTES) != hipSuccess || per_cu < 1) { fprintf(stderr, "kernel_launch: occupancy query says %d\n", per_cu); }
        (void)hipGetLastError();
        grid = cus;
    }
    if (grid < 0) return;
    if (hipMemsetAsync((char*)d_ws + WS_CTL, 0, CTL_ZERO_BYTES, stream) != hipSuccess) return;
    Args a{};
    for (int i = 0; i < 20; ++i) a.in[i] = (const float*)d_in[i];
    a.out = (float*)d_out; a.ws = (unsigned char*)d_ws;
#if MK_ONE_LAUNCH
    a.ph_lo = 0; a.ph_hi = NPH;
    hipLaunchKernelGGL(fwd, dim3(grid), dim3(NWAVES * 64), LDS_BYTES, stream, a);
#else
    for (int p = 0; p < NPH + ((DBG_CHECK || DBG_ATTN_CHECK) ? 2 : 0); ++p) { a.ph_lo = p; a.ph_hi = p + 1; hipLaunchKernelGGL(fwd, dim3(grid), dim3(NWAVES * 64), LDS_BYTES, stream, a); }
#endif
}
```

```cpp
#include <hip/hip_runtime.h>
#include <cstdio>
#include <cstdint>
#include <cmath>
namespace pg8 {
#define PG8_LAS __attribute__((address_space(3)))
typedef unsigned short bf16_t;
typedef short bf16x8 __attribute__((ext_vector_type(8)));
typedef float f32x4 __attribute__((ext_vector_type(4)));
typedef unsigned u32x4 __attribute__((ext_vector_type(4)));
typedef int v4i32 __attribute__((ext_vector_type(4)));
typedef int v8i32 __attribute__((ext_vector_type(8)));
constexpr int BM = 256, BK = 64, HALF = 128, HTB = HALF * BK * 2  , STAGE_BYTES = 8 * HTB, NXCD = 8, WGM = 8;

__host__ __device__ __forceinline__ int lds_byte(int r, int c) { const int st = (r >> 4) * 2 + (c >> 5), rr = r & 15, cc = c & 31, ob = rr * 64 + cc * 2; return st * 1024 + (ob ^ (((ob >> 9) & 1) << 5)); }
__host__ __device__ __forceinline__ void stage_rc(int b, int& R, int& C) { const int st = b / 1024, sb = b % 1024, swz = sb ^ (((sb >> 9) & 1) << 5); R = (st >> 1) * 16 + swz / 64; C = (st & 1) * 32 + (swz % 64) / 2; }
__host__ __device__ __forceinline__ int perm32(int rho) { const int n = rho >> 4, i = rho & 15; return 8 * (i >> 2) + 4 * n + (i & 3); }

struct Unit { int pm, pn; };
struct Gemm { const bf16_t* A; const bf16_t* Bt; int M, N, K; };

struct StaticOrder {
    int nM, nN, nwg, G, c;
    __host__ __device__ void init(int M, int N, int G_, int c_) { nM = M / BM; nN = N / BM; nwg = nM * nN; G = G_; c = c_; }
    __host__ __device__ bool next(int i, Unit& u) const {
        const long L = (long)i * G + c; if (L >= nwg) return false;
        int wgid = (int)L; { const int q = nwg / NXCD, r = nwg % NXCD, xcd = wgid % NXCD, off = wgid / NXCD; wgid = (xcd < r ? xcd * (q + 1) : r * (q + 1) + (xcd - r) * q) + off; }
        const int nig = WGM * nN, gid = wgid / nig, fm = gid * WGM, gsz = (nM - fm) < WGM ? (nM - fm) : WGM;
        u.pm = fm + ((wgid % nig) % gsz); u.pn = (wgid % nig) / gsz; return true;
    }
    __device__ __forceinline__ void a_ready(const Unit&) const {}
    __device__ __forceinline__ void done(const Unit&) const {}
};

__device__ __forceinline__ unsigned cvt_pk_bf16(float lo, float hi) { unsigned r; asm volatile("v_cvt_pk_bf16_f32 %0, %1, %2" : "=v"(r) : "v"(lo), "v"(hi)); return r; }
typedef float f32x2 __attribute__((ext_vector_type(2)));
__device__ __forceinline__ float bf_lo(unsigned w) { return __uint_as_float(w << 16); }
__device__ __forceinline__ float bf_hi(unsigned w) { return __uint_as_float(w & 0xffff0000u); }
__device__ __forceinline__ float sigmoidf_(float x) { return 1.0f / (1.0f + __expf(-x)); }
struct EpiStore {
    static constexpr bool PERM = true, AFTER_DRAIN = false;
    bf16_t* O; int ldc;
    __device__ __forceinline__ void operator()(const f32x4 (&acc)[2][2][4][2], const Unit& u, int wr, int wc, int fr, int fq) const {
        const int row0 = u.pm * BM + wr * 64 + fr, col0 = u.pn * BM + wc * 32 + 8 * fq;
#pragma unroll
        for (int ai = 0; ai < 2; ++ai)
#pragma unroll
            for (int m = 0; m < 4; ++m) { bf16_t* rowp = O + (size_t)(row0 + ai * HALF + m * 16) * ldc + col0;
#pragma unroll
                for (int bj = 0; bj < 2; ++bj) { const f32x4 v0 = acc[ai][bj][m][0], v1 = acc[ai][bj][m][1];
                    u32x4 w; w.x = cvt_pk_bf16(v0[0], v0[1]); w.y = cvt_pk_bf16(v0[2], v0[3]); w.z = cvt_pk_bf16(v1[0], v1[1]); w.w = cvt_pk_bf16(v1[2], v1[3]);
                    *(u32x4*)(rowp + bj * HALF) = w; } }
    }
};
struct EpiIn {
    static constexpr bool PERM = true, AFTER_DRAIN = false;
    bf16_t* P; bf16_t* G; const float* bgate; float wsc;
    __device__ __forceinline__ void operator()(const f32x4 (&acc)[2][2][4][2], const Unit& u, int wr, int wc, int fr, int fq) const {
        const int row0 = u.pm * BM + wr * 64 + fr;
        if (u.pn < 15) {
            const int col0 = u.pn * BM + wc * 32 + 8 * fq;
#pragma unroll
            for (int ai = 0; ai < 2; ++ai)
#pragma unroll
                for (int m = 0; m < 4; ++m) { bf16_t* rowp = P + (size_t)(row0 + ai * HALF + m * 16) * 3840 + col0;
#pragma unroll
                    for (int bj = 0; bj < 2; ++bj) { const f32x4 v0 = acc[ai][bj][m][0] * wsc, v1 = acc[ai][bj][m][1] * wsc;
                        u32x4 w; w.x = cvt_pk_bf16(v0[0], v0[1]); w.y = cvt_pk_bf16(v0[2], v0[3]); w.z = cvt_pk_bf16(v1[0], v1[1]); w.w = cvt_pk_bf16(v1[2], v1[3]);
                        *(u32x4*)(rowp + bj * HALF) = w; } }
        } else {
            const int col0 = (u.pn - 15) * BM + wc * 32 + 8 * fq;
            f32x4 bv[2][2];
#pragma unroll
            for (int bj = 0; bj < 2; ++bj)
#pragma unroll
                for (int n = 0; n < 2; ++n) bv[bj][n] = *(const f32x4*)(bgate + col0 + bj * HALF + 4 * n);
#pragma unroll
            for (int ai = 0; ai < 2; ++ai)
#pragma unroll
                for (int m = 0; m < 4; ++m) { unsigned char* rowp = (unsigned char*)G + (size_t)(row0 + ai * HALF + m * 16) * 2048 + col0;
#pragma unroll
                    for (int bj = 0; bj < 2; ++bj) { const f32x4 v0 = acc[ai][bj][m][0] * wsc + bv[bj][0], v1 = acc[ai][bj][m][1] * wsc + bv[bj][1];
                        int w0 = 0, w1 = 0;
                        w0 = __builtin_amdgcn_cvt_pk_fp8_f32(sigmoidf_(v0[0]), sigmoidf_(v0[1]), w0, false); w0 = __builtin_amdgcn_cvt_pk_fp8_f32(sigmoidf_(v0[2]), sigmoidf_(v0[3]), w0, true);
                        w1 = __builtin_amdgcn_cvt_pk_fp8_f32(sigmoidf_(v1[0]), sigmoidf_(v1[1]), w1, false); w1 = __builtin_amdgcn_cvt_pk_fp8_f32(sigmoidf_(v1[2]), sigmoidf_(v1[3]), w1, true);
                        *(unsigned long long*)(rowp + bj * HALF) = (unsigned long long)(unsigned)w0 | ((unsigned long long)(unsigned)w1 << 32); } }
        }
    }
};
template <bool ADD, bool F8OUT> struct EpiGate {
    static constexpr bool PERM = true, AFTER_DRAIN = false;
    bf16_t* O; const bf16_t* G; int gcol; unsigned char* O8; float o8scale;
    __device__ __forceinline__ void operator()(const f32x4 (&acc)[2][2][4][2], const Unit& u, int wr, int wc, int fr, int fq) const {
        const int row0 = u.pm * BM + wr * 64 + fr, col0 = u.pn * BM + wc * 32 + 8 * fq;
#pragma unroll
        for (int ai = 0; ai < 2; ++ai)
#pragma unroll
            for (int m = 0; m < 4; ++m) { const size_t row = (size_t)(row0 + ai * HALF + m * 16); bf16_t* rowp = O + row * 1024 + col0;
#pragma unroll
                for (int bj = 0; bj < 2; ++bj) { const f32x4 v0 = acc[ai][bj][m][0], v1 = acc[ai][bj][m][1];
                    const unsigned long long g8 = *(const unsigned long long*)((const unsigned char*)G + row * 2048 + gcol + col0 + bj * HALF); const int gl = (int)(unsigned)g8, gh = (int)(unsigned)(g8 >> 32);
                    typedef float f32x2g __attribute__((ext_vector_type(2)));
                    const f32x2g ga = __builtin_amdgcn_cvt_pk_f32_fp8(gl, false), gb = __builtin_amdgcn_cvt_pk_f32_fp8(gl, true), gc = __builtin_amdgcn_cvt_pk_f32_fp8(gh, false), gd = __builtin_amdgcn_cvt_pk_f32_fp8(gh, true);
                    float r0 = ga.x * v0[0], r1 = ga.y * v0[1], r2 = gb.x * v0[2], r3 = gb.y * v0[3];
                    float r4 = gc.x * v1[0], r5 = gc.y * v1[1], r6 = gd.x * v1[2], r7 = gd.y * v1[3];
                    if (ADD) {
                        const unsigned long long p8 = *(const unsigned long long*)(O8 + row * 1024 + col0 + bj * HALF); const int pl = (int)(unsigned)p8, phh = (int)(unsigned)(p8 >> 32); const float is = 1.0f / o8scale;
                        const f32x2g pa = __builtin_amdgcn_cvt_pk_f32_fp8(pl, false), pb = __builtin_amdgcn_cvt_pk_f32_fp8(pl, true), pc = __builtin_amdgcn_cvt_pk_f32_fp8(phh, false), pd = __builtin_amdgcn_cvt_pk_f32_fp8(phh, true);
                        r0 += pa.x * is; r1 += pa.y * is; r2 += pb.x * is; r3 += pb.y * is; r4 += pc.x * is; r5 += pc.y * is; r6 += pd.x * is; r7 += pd.y * is; }
                    if (F8OUT) { int w0 = 0, w1 = 0;
                        w0 = __builtin_amdgcn_cvt_pk_fp8_f32(r0 * o8scale, r1 * o8scale, w0, false); w0 = __builtin_amdgcn_cvt_pk_fp8_f32(r2 * o8scale, r3 * o8scale, w0, true);
                        w1 = __builtin_amdgcn_cvt_pk_fp8_f32(r4 * o8scale, r5 * o8scale, w1, false); w1 = __builtin_amdgcn_cvt_pk_fp8_f32(r6 * o8scale, r7 * o8scale, w1, true);
                        *(unsigned long long*)(O8 + row * 1024 + col0 + bj * HALF) = (unsigned long long)(unsigned)w0 | ((unsigned long long)(unsigned)w1 << 32);
                    } else { u32x4 w; w.x = cvt_pk_bf16(r0, r1); w.y = cvt_pk_bf16(r2, r3); w.z = cvt_pk_bf16(r4, r5); w.w = cvt_pk_bf16(r6, r7);
                        *(u32x4*)(rowp + bj * HALF) = w; } } }
    }
};
struct EpiRes {
    static constexpr bool PERM = false, AFTER_DRAIN = false;
    const float* base; float* out; int ldc; float sc; bf16_t* xb; float* rowss; unsigned char* xb8; const bf16_t* base16;
    __device__ __forceinline__ void operator()(const f32x4 (&acc)[2][2][4][2], const Unit& u, int wr, int wc, int fr, int fq) const {
        const int col0 = u.pn * BM + wc * 32 + 4 * fq;
#pragma unroll
        for (int ai = 0; ai < 2; ++ai)
#pragma unroll
            for (int m = 0; m < 4; ++m) { const int row = u.pm * BM + ai * HALF + wr * 64 + m * 16 + fr; const size_t off = (size_t)row * ldc + col0; float ss = 0.f;
#pragma unroll
                for (int bj = 0; bj < 2; ++bj)
#pragma unroll
                    for (int n = 0; n < 2; ++n) { f32x4 bs;
                        if (base16) { const unsigned long long w = *(const unsigned long long*)(base16 + off + bj * HALF + n * 16); const unsigned lo = (unsigned)w, hi = (unsigned)(w >> 32); bs = (f32x4){bf_lo(lo), bf_hi(lo), bf_lo(hi), bf_hi(hi)}; }
                        else bs = *(const f32x4*)(base + off + bj * HALF + n * 16);
                        const f32x4 o = (sc != 0.f) ? bs + acc[ai][bj][m][n] * sc : bs;
                        if (out) *(f32x4*)(out + off + bj * HALF + n * 16) = o;
                        if (xb) { unsigned long long w = (unsigned long long)cvt_pk_bf16(o[0], o[1]) | ((unsigned long long)cvt_pk_bf16(o[2], o[3]) << 32); *(unsigned long long*)(xb + off + bj * HALF + n * 16) = w; }
                        if (xb8) { int w8 = 0; w8 = __builtin_amdgcn_cvt_pk_fp8_f32(o[0], o[1], w8, false); w8 = __builtin_amdgcn_cvt_pk_fp8_f32(o[2], o[3], w8, true); *(unsigned*)(xb8 + off + bj * HALF + n * 16) = (unsigned)w8; }
                        if (rowss) ss += (o[0] * o[0] + o[1] * o[1]) + (o[2] * o[2] + o[3] * o[3]); }
                if (rowss) { ss += __shfl_xor(ss, 16); ss += __shfl_xor(ss, 32); if (fq == 0) atomicAdd(rowss + row, ss); } }
    }
};
struct EpiStoreRs {
    static constexpr bool PERM = true, AFTER_DRAIN = false;
    bf16_t* O; int ldc; const float* rowss; float sc;
    __device__ __forceinline__ void operator()(const f32x4 (&acc)[2][2][4][2], const Unit& u, int wr, int wc, int fr, int fq) const {
        const int row0 = u.pm * BM + wr * 64 + fr, col0 = u.pn * BM + wc * 32 + 8 * fq;
#pragma unroll
        for (int ai = 0; ai < 2; ++ai)
#pragma unroll
            for (int m = 0; m < 4; ++m) { const int row = row0 + ai * HALF + m * 16; bf16_t* rowp = O + (size_t)row * ldc + col0; const float ri = rsqrtf(rowss[row] * (1.0f / 1024.0f) + 1e-6f) * sc;
#pragma unroll
                for (int bj = 0; bj < 2; ++bj) { const f32x4 v0 = acc[ai][bj][m][0] * ri, v1 = acc[ai][bj][m][1] * ri;
                    u32x4 w; w.x = cvt_pk_bf16(v0[0], v0[1]); w.y = cvt_pk_bf16(v0[2], v0[3]); w.z = cvt_pk_bf16(v1[0], v1[1]); w.w = cvt_pk_bf16(v1[2], v1[3]);
                    *(u32x4*)(rowp + bj * HALF) = w; } }
    }
};
template <class Epi, class Sched, bool ALIGN_EPI = false, bool SP2 = false, bool F8 = false>
__device__ __forceinline__ void gemm_phase(PG8_LAS unsigned char* lds, const Gemm g, const Sched& S, const Epi& E) {
    const int tid = threadIdx.x, wid = __builtin_amdgcn_readfirstlane(tid >> 6), lane = tid & 63, wr = wid >> 2, wc = wid & 3, fr = lane & 15, fq = lane >> 4;
    const int K = g.K, nt = K / BK;
    unsigned voffA[2], voffB[2];
#pragma unroll
    for (int i = 0; i < 2; ++i) { int R, C; stage_rc(tid * 16 + i * 8192, R, C); const int Rb = Epi::PERM ? ((R & ~31) + perm32(R & 31)) : R;
        voffA[i] = (unsigned)(R * K + C) * 2u; voffB[i] = (unsigned)(Rb * K + C) * 2u; }
    const size_t kstep = (size_t)(BK * 2);
    const size_t hstep = (size_t)HALF * K * 2;
    const size_t tstep = 2 * hstep;
    const unsigned ldsw = (unsigned)wid * 1024u;
    const int aoff = lds_byte(wr * 64 + fr, fq * 8), boff = lds_byte(wc * 32 + fr, fq * 8);
#define PG8_SA(b, h) (((b) * 2 + (h)) * HTB)
#define PG8_SB(b, h) ((4 + (b) * 2 + (h)) * HTB)
#define PG8_STAGE(bufoff, gbase, voff) do { _Pragma("unroll") for (int _i = 0; _i < 2; ++_i) \
        __builtin_amdgcn_global_load_lds((const unsigned*)((const char*)(gbase) + (voff)[_i]), (PG8_LAS unsigned*)(lds + (bufoff) + ldsw + _i * 8192), 16, 0, 0); } while (0)
#define PG8_LDA(dst, b, h) do { if constexpr (F8) { _Pragma("unroll") for (int m = 0; m < 4; ++m) dst##8[m] = __builtin_shufflevector(*(const PG8_LAS v4i32*)(lds + PG8_SA(b, h) + aoff + m * 2048), *(const PG8_LAS v4i32*)(lds + PG8_SA(b, h) + aoff + m * 2048 + 1024), 0, 1, 2, 3, 4, 5, 6, 7); } \
        else { _Pragma("unroll") for (int m = 0; m < 4; ++m) _Pragma("unroll") for (int k = 0; k < 2; ++k) dst[m][k] = *(const PG8_LAS bf16x8*)(lds + PG8_SA(b, h) + aoff + m * 2048 + k * 1024); } } while (0)
#define PG8_LDB(dst, b, h) do { if constexpr (F8) { _Pragma("unroll") for (int n = 0; n < 2; ++n) dst##8[n] = __builtin_shufflevector(*(const PG8_LAS v4i32*)(lds + PG8_SB(b, h) + boff + n * 2048), *(const PG8_LAS v4i32*)(lds + PG8_SB(b, h) + boff + n * 2048 + 1024), 0, 1, 2, 3, 4, 5, 6, 7); } \
        else { _Pragma("unroll") for (int n = 0; n < 2; ++n) _Pragma("unroll") for (int k = 0; k < 2; ++k) dst[n][k] = *(const PG8_LAS bf16x8*)(lds + PG8_SB(b, h) + boff + n * 2048 + k * 1024); } } while (0)
#define PG8_MMA(ai, bj, At, Bt) do { __builtin_amdgcn_s_setprio(1); if constexpr (F8) { \
        _Pragma("unroll") for (int m = 0; m < 4; ++m) _Pragma("unroll") for (int n = 0; n < 2; ++n) \
            asm volatile("v_mfma_scale_f32_16x16x128_f8f6f4 %0, %1, %2, %0, %3, %3 op_sel_hi:[0,0,0]" : "+v"(acc[ai][bj][m][n]) : "v"(Bt##8[n]), "v"(At##8[m]), "v"(f8scale)); \
    } else { _Pragma("unroll") for (int m = 0; m < 4; ++m) _Pragma("unroll") for (int n = 0; n < 2; ++n) _Pragma("unroll") for (int k = 0; k < 2; ++k) \
        acc[ai][bj][m][n] = __builtin_amdgcn_mfma_f32_16x16x32_bf16(Bt[n][k], At[m][k], acc[ai][bj][m][n], 0, 0, 0); } __builtin_amdgcn_s_setprio(0); } while (0)
#define PG8_WAIT_V(n) asm volatile("s_waitcnt vmcnt(" #n ")" ::: "memory")
#define PG8_WAIT_L(n) asm volatile("s_waitcnt lgkmcnt(" #n ")" ::: "memory")
#define PG8_BAR __builtin_amdgcn_s_barrier()
#define PG8_SCHED __builtin_amdgcn_sched_barrier(0)
    Unit cur, nxt; int ui = 0;
    if (!S.next(0, cur)) return;
    f32x4 acc[2][2][4][2];
#pragma unroll
    for (int a = 0; a < 2; ++a)
#pragma unroll
        for (int b = 0; b < 2; ++b)
#pragma unroll
            for (int m = 0; m < 4; ++m)
#pragma unroll
                for (int n = 0; n < 2; ++n) acc[a][b][m][n] = (f32x4){0.f, 0.f, 0.f, 0.f};
    bf16x8 At[4][2], B0[2][2], B1[2][2]; v8i32 At8[4], B08[2], B18[2]; const int f8scale = 0x7f7f7f7f;
    const char* cA = (const char*)g.A + (size_t)cur.pm * tstep; const char* cB = (const char*)g.Bt + (size_t)cur.pn * tstep;
    S.a_ready(cur);
    if constexpr (SP2) {
        PG8_STAGE(PG8_SB(0, 0), cB, voffB); PG8_STAGE(PG8_SB(0, 1), cB + hstep, voffB); PG8_STAGE(PG8_SA(0, 0), cA, voffA); PG8_STAGE(PG8_SA(0, 1), cA + hstep, voffA);
        if (wr == 1) PG8_BAR;
        PG8_WAIT_V(2); PG8_BAR;
        PG8_STAGE(PG8_SB(1, 0), cB + kstep, voffB); PG8_STAGE(PG8_SA(1, 0), cA + kstep, voffA); PG8_STAGE(PG8_SB(1, 1), cB + hstep + kstep, voffB);
        PG8_WAIT_V(6); PG8_BAR;
    } else {
        PG8_STAGE(PG8_SB(0, 0), cB, voffB); PG8_STAGE(PG8_SA(0, 0), cA, voffA); PG8_STAGE(PG8_SB(0, 1), cB + hstep, voffB); PG8_STAGE(PG8_SA(0, 1), cA + hstep, voffA);
        if (wr == 1) PG8_BAR;
        PG8_WAIT_V(4); PG8_BAR;
        PG8_STAGE(PG8_SB(1, 0), cB + kstep, voffB); PG8_STAGE(PG8_SA(1, 0), cA + kstep, voffA); PG8_STAGE(PG8_SB(1, 1), cB + hstep + kstep, voffB);
        PG8_WAIT_V(6); PG8_BAR;
    }
    for (;;) {
        const bool has_next = S.next(ui + 1, nxt);
        const char* nA = has_next ? (const char*)g.A + (size_t)nxt.pm * tstep : cA; const char* nB = has_next ? (const char*)g.Bt + (size_t)nxt.pn * tstep : cB;
        for (int t = 0; t < nt; t += 2) {
            const bool last = (t == nt - 2);
            const char* a1 = cA + (size_t)(t + 1) * kstep;
            const char* a2 = last ? nA : cA + (size_t)(t + 2) * kstep; const char* b2 = last ? nB : cB + (size_t)(t + 2) * kstep;
            const char* a3 = a2 + kstep; const char* b3 = b2 + kstep;
            if (last && has_next) S.a_ready(nxt);
            if constexpr (SP2) {
            PG8_LDB(B0, 0, 0); PG8_LDB(B1, 0, 1); PG8_SCHED; PG8_LDA(At, 0, 0); PG8_STAGE(PG8_SA(1, 1), a1 + hstep, voffA);
            PG8_WAIT_V(8); PG8_WAIT_L(0); PG8_BAR; PG8_MMA(0, 0, At, B0); PG8_MMA(0, 1, At, B1); PG8_BAR; PG8_SCHED;
            PG8_LDA(At, 0, 1); PG8_STAGE(PG8_SB(0, 0), b2, voffB); PG8_STAGE(PG8_SB(0, 1), b2 + hstep, voffB); PG8_STAGE(PG8_SA(0, 0), a2, voffA);
            PG8_WAIT_V(8); PG8_WAIT_L(0); PG8_BAR; PG8_MMA(1, 0, At, B0); PG8_MMA(1, 1, At, B1); PG8_BAR; PG8_SCHED;
            PG8_LDB(B0, 1, 0); PG8_LDB(B1, 1, 1); PG8_SCHED; PG8_LDA(At, 1, 0); PG8_STAGE(PG8_SA(0, 1), a2 + hstep, voffA);
            PG8_WAIT_V(8); PG8_WAIT_L(0); PG8_BAR; PG8_MMA(0, 0, At, B0); PG8_MMA(0, 1, At, B1); PG8_BAR; PG8_SCHED;
            PG8_LDA(At, 1, 1); PG8_STAGE(PG8_SB(1, 0), b3, voffB); PG8_STAGE(PG8_SB(1, 1), b3 + hstep, voffB); PG8_STAGE(PG8_SA(1, 0), a3, voffA);
            PG8_WAIT_V(8); PG8_WAIT_L(0); PG8_BAR; PG8_MMA(1, 0, At, B0); PG8_MMA(1, 1, At, B1); PG8_BAR; PG8_SCHED;
            } else {
            PG8_LDB(B0, 0, 0); PG8_SCHED; PG8_LDA(At, 0, 0); PG8_STAGE(PG8_SA(1, 1), a1 + hstep, voffA);
            PG8_WAIT_L(8); PG8_BAR; PG8_WAIT_L(0); PG8_MMA(0, 0, At, B0); PG8_BAR; PG8_SCHED;
            PG8_LDB(B1, 0, 1); PG8_STAGE(PG8_SB(0, 0), b2, voffB);
            PG8_BAR; PG8_WAIT_L(0); PG8_MMA(0, 1, At, B1); PG8_BAR;
            PG8_LDA(At, 0, 1); PG8_STAGE(PG8_SA(0, 0), a2, voffA);
            PG8_BAR; PG8_WAIT_L(0); PG8_MMA(1, 0, At, B0); PG8_BAR; PG8_SCHED;
            PG8_STAGE(PG8_SB(0, 1), b2 + hstep, voffB);
            PG8_WAIT_V(6); PG8_BAR; PG8_MMA(1, 1, At, B1); PG8_BAR;
            PG8_LDB(B0, 1, 0); PG8_SCHED; PG8_LDA(At, 1, 0); PG8_STAGE(PG8_SA(0, 1), a2 + hstep, voffA);
            PG8_WAIT_L(8); PG8_BAR; PG8_WAIT_L(0); PG8_MMA(0, 0, At, B0); PG8_BAR; PG8_SCHED;
            PG8_LDB(B1, 1, 1); PG8_STAGE(PG8_SB(1, 0), b3, voffB);
            PG8_BAR; PG8_WAIT_L(0); PG8_MMA(0, 1, At, B1); PG8_BAR;
            PG8_LDA(At, 1, 1); PG8_STAGE(PG8_SA(1, 0), a3, voffA);
            PG8_BAR; PG8_WAIT_L(0); PG8_MMA(1, 0, At, B0); PG8_BAR; PG8_SCHED;
            PG8_STAGE(PG8_SB(1, 1), b3 + hstep, voffB);
            PG8_WAIT_V(6); PG8_BAR; PG8_MMA(1, 1, At, B1); PG8_BAR;
            }
        }
        if constexpr (ALIGN_EPI) { if (wr == 0) PG8_BAR; }
        if constexpr (F8) asm volatile("s_nop 15\n\ts_nop 15" ::: "memory");
        if constexpr (!Epi::AFTER_DRAIN) { E(acc, cur, wr, wc, fr, fq); S.done(cur); }
        if (!has_next) break;
#pragma unroll
        for (int a = 0; a < 2; ++a)
#pragma unroll
            for (int b = 0; b < 2; ++b)
#pragma unroll
                for (int m = 0; m < 4; ++m)
#pragma unroll
                    for (int n = 0; n < 2; ++n) acc[a][b][m][n] = (f32x4){0.f, 0.f, 0.f, 0.f};
        cur = nxt; cA = nA; cB = nB; ++ui;
        if constexpr (ALIGN_EPI) { if (wr == 1) PG8_BAR; }
    }
    PG8_WAIT_V(0);
    if constexpr (!ALIGN_EPI) { if (wr == 0) PG8_BAR; }
    PG8_BAR;
    if constexpr (Epi::AFTER_DRAIN) { E.fused(acc, cur, wr, wc, fr, fq, lds, wid, lane); S.done(cur); }
#undef PG8_SA
#undef PG8_SB
#undef PG8_STAGE
#undef PG8_LDA
#undef PG8_LDB
#undef PG8_MMA
#undef PG8_WAIT_V
#undef PG8_WAIT_L
#undef PG8_BAR
#undef PG8_SCHED
}
}

constexpr int NB = 8, SEQ = 4096, DM = 1024, T = NB * SEQ, NMEM = 256, MROWS = NB * NMEM;
constexpr int QKVW = 3840, GATEW = 2048, NIN = 5888;
constexpr float RMS_EPS = 1e-6f;
constexpr int NPH = 15;
constexpr float WIN8_SCALE = 32.0f, MRG8_SCALE = 16.0f;
#ifndef DBG_MIX
#define DBG_MIX 1
#endif
#ifndef DBG_CROSS
#define DBG_CROSS 1
#endif
#ifndef DBG_PEER
#define DBG_PEER 1
#endif
#ifndef DBG_TOPK_SIMPLE
#define DBG_TOPK_SIMPLE 0
#endif
#ifndef DBG_CHECK
#define DBG_CHECK 0
#endif
#ifndef DBG_ATTN_CHECK
#define DBG_ATTN_CHECK 0
#endif
#ifndef DBG_CROSS_CHECK
#define DBG_CROSS_CHECK 0
#endif
#ifndef DBG_NOBIAS
#define DBG_NOBIAS 0
#endif
#ifndef DBG_DIL_CHECK
#define DBG_DIL_CHECK 0
#endif
#ifndef PROBE_PH
#define PROBE_PH (-1)
#endif
#ifndef PROBE_K
#define PROBE_K 200000.0f
#endif
#ifndef DBG_P4CHK
#define DBG_P4CHK 1
#endif
#ifndef ATTN_MFMA
#define ATTN_MFMA 1
#endif
#if DBG_CHECK
#define DBG_YPTR ((float*)(ws + 510 * MiB))
#else
#define DBG_YPTR ((float*)nullptr)
#endif
#ifndef MK_ONE_LAUNCH
#define MK_ONE_LAUNCH 1
#endif
constexpr size_t MiB = 1u << 20;
constexpr size_t WS_CTL = 0, CTL_ZERO_BYTES = 1 * MiB;
constexpr size_t WS_KMEAN = 1 * MiB;
constexpr size_t WS_INV = 2 * MiB;
constexpr size_t WS_WIN = 3 * MiB;
constexpr size_t WS_WA = 15 * MiB, WS_WB = 16 * MiB, WS_WOUT = 17 * MiB, WS_WQC = 19 * MiB, WS_WKVC = 20 * MiB, WS_WOC = 22 * MiB, WS_WQP = 23 * MiB, WS_SUBK = 27 * MiB;
constexpr size_t WS_U = 28 * MiB, WS_V = 60 * MiB;
constexpr size_t WS_H = 92 * MiB;
constexpr size_t WS_MEMB = 156 * MiB, WS_KVC = 160 * MiB;
constexpr size_t WS_ODIL = 164 * MiB, WS_OMOBA = 180 * MiB;
constexpr size_t WS_PQKV = 212 * MiB;
constexpr size_t WS_MERGED = WS_PQKV, WS_X1 = WS_PQKV + 64 * MiB, WS_QC = WS_PQKV + 192 * MiB, WS_OC = WS_ODIL;
constexpr size_t WS_EXP = WS_PQKV, WS_EW = WS_PQKV + 16 * MiB;
constexpr size_t WS_ODG = 452 * MiB, WS_LSE = 500 * MiB;
constexpr size_t WS_END = 502 * MiB;
constexpr int CW_TMO = 0, CW_CODE = 1, CW_WORK = 128, CW_BAR = 4096;
constexpr size_t WS_RSS1 = 256 * 1024, WS_RSS2 = 384 * 1024;
constexpr int RING_OFF = 0, RING_BYTES = 131072;
constexpr int LDSCTL_OFF = RING_BYTES, MISC_OFF = LDSCTL_OFF + 320;
constexpr int LDS_BYTES = 163840;
constexpr int NWAVES = 8;

#define GAS __attribute__((address_space(1)))
#define LAS __attribute__((address_space(3)))
typedef unsigned short bf16;
typedef unsigned v4u __attribute__((ext_vector_type(4)));
typedef float f32x4 __attribute__((ext_vector_type(4)));
typedef float f32x16 __attribute__((ext_vector_type(16)));
typedef short bf16x8 __attribute__((ext_vector_type(8)));
typedef __bf16 bf2_t __attribute__((ext_vector_type(2)));
typedef GAS unsigned gu32;
#define RLX_AGENT __ATOMIC_RELAXED, __HIP_MEMORY_SCOPE_AGENT
#define LDS_WAIT() asm volatile("s_waitcnt lgkmcnt(0)" ::: "memory")
#define VM_WAIT() asm volatile("s_waitcnt vmcnt(0)" ::: "memory")
__device__ __forceinline__ unsigned pk2(float lo, float hi) { return pg8::cvt_pk_bf16(lo, hi); }
__device__ __forceinline__ float bf_lo(unsigned w) { return __uint_as_float(w << 16); }
__device__ __forceinline__ float bf_hi(unsigned w) { return __uint_as_float(w & 0xffff0000u); }
__device__ __forceinline__ float bf2f(bf16 b) { return __uint_as_float((unsigned)b << 16); }

#define XB_TMO      128
#define XB_XCNT(j)  (256  + 64 * (j))
#define XB_XSUB(j)  (1280 + 64 * (j))
#define XB_XGEN(j)  (2304 + 64 * (j))
#define XB_TOP      3328
#define XB_TOPGEN   3392
#define XCD_BAR_WORDS 3456
#define XB_SPIN_CAP (1u << 18)

__device__ __forceinline__ unsigned xb_ld(unsigned* p)              { return __hip_atomic_load(p, __ATOMIC_RELAXED, __HIP_MEMORY_SCOPE_AGENT); }
__device__ __forceinline__ unsigned xb_add(unsigned* p, unsigned v) { return __hip_atomic_fetch_add(p, v, __ATOMIC_RELAXED, __HIP_MEMORY_SCOPE_AGENT); }
__device__ __forceinline__ unsigned xb_xcc_id() { return (unsigned)__builtin_amdgcn_s_getreg((3 << 11) | 20) & 0xFu; }
#define XB_SPIN(cond, bar) do { unsigned _sp = 0; while (cond) { __builtin_amdgcn_s_sleep(1); \
    if ((++_sp & 255u) == 0u) { if (xb_ld(&(bar)[XB_TMO])) break; if (_sp > XB_SPIN_CAP) { atomicAdd(&(bar)[XB_TMO], 1u); break; } } } } while (0)

struct XcdBarrier {
    unsigned* bar; unsigned x;
    volatile LAS unsigned* st;
};

__device__ __forceinline__ XcdBarrier xcd_barrier_post(unsigned* bar, volatile LAS unsigned* st) {
    XcdBarrier b; b.bar = bar; b.x = xb_xcc_id(); b.st = st;
    if (threadIdx.x == 0) (void)xb_add(&bar[XB_XCNT(b.x)], 1u);
    return b;
}
__device__ __forceinline__ void xcd_barrier_complete(unsigned* bar, unsigned x, unsigned& nloc, unsigned& nx) {
    const unsigned G = gridDim.x * gridDim.y * gridDim.z;
    unsigned sum, cnt, mine, sp = 0u;
    for (;;) {
        sum = 0u; cnt = 0u; mine = 0u;
#pragma unroll
        for (unsigned j = 0; j < 16; ++j) { const unsigned c = xb_ld(&bar[XB_XCNT(j)]); sum += c; cnt += (c > 0u) ? 1u : 0u; mine = (j == x) ? c : mine; }
        if (sum == G) break;
        __builtin_amdgcn_s_sleep(1);
        if ((++sp & 255u) == 0u) { if (xb_ld(&bar[XB_TMO])) break; if (sp > XB_SPIN_CAP) { atomicAdd(&bar[XB_TMO], 1u); break; } }
    }
    nloc = mine > 0u ? mine : 1u; nx = cnt > 0u ? cnt : 1u;
}

__device__ __forceinline__ void xcd_barrier(const XcdBarrier& b) {
    asm volatile("s_waitcnt vmcnt(0)" ::: "memory");
    __syncthreads();
    if (threadIdx.x == 0) {
        unsigned* bar = b.bar;
        __builtin_amdgcn_s_waitcnt(0);
        unsigned nloc = b.st[0], nx = b.st[1];
        if (nloc == 0u) { xcd_barrier_complete(bar, b.x, nloc, nx); b.st[0] = nloc; b.st[1] = nx; }
        const unsigned old = xb_add(&bar[XB_XSUB(b.x)], 1u);
        const unsigned gen = old / nloc;
        if (old + 1u == (gen + 1u) * nloc) {
            __builtin_amdgcn_fence(__ATOMIC_RELEASE, "agent");
            asm volatile("s_waitcnt vmcnt(0)" ::: "memory");
            const unsigned og = xb_add(&bar[XB_TOP], 1u);
            const unsigned tg = og / nx;
            if (og + 1u == (tg + 1u) * nx) xb_add(&bar[XB_TOPGEN], 1u);
            else XB_SPIN(xb_ld(&bar[XB_TOPGEN]) == tg, bar);
            __builtin_amdgcn_fence(__ATOMIC_ACQUIRE, "agent");
            xb_add(&bar[XB_XGEN(b.x)], 1u);
            asm volatile("s_waitcnt vmcnt(0)" ::: "memory");
        } else {
            XB_SPIN(xb_ld(&bar[XB_XGEN(b.x)]) == gen, bar);
            __builtin_amdgcn_fence(__ATOMIC_ACQUIRE, "agent");
            asm volatile("s_waitcnt vmcnt(0)" ::: "memory");
        }
    }
    __syncthreads();
}

__device__ __forceinline__ float wave_sum(float v) {
#pragma unroll
    for (int o = 1; o < 64; o <<= 1) v += __shfl_xor(v, o);
    return v;
}
__device__ __forceinline__ int t5_bucket(int n) {
    int b = n;
    if (n >= 16) { b = 16 + (n >= 22) + (n >= 30) + (n >= 40) + (n >= 54) + (n >= 73) + (n >= 99) + (n >= 134) + (n >= 182) + (n >= 246) + (n >= 332) + (n >= 450) + (n >= 609) + (n >= 825) + (n >= 1117) + (n >= 1513); }
    return b;
}
__device__ __forceinline__ void p0_transpose_item(const float* W, int K, int N, bf16* WT, LAS float* scr, int item, int lane, const float* gk = nullptr) {
    const int nblk = N / 32, kb = item / nblk, nb = item % nblk, k0 = 64 * kb, n0 = 32 * nb;
#pragma unroll 8
    for (int i = 0; i < 32; ++i) { const int kk = 2 * i + (lane >> 5); scr[kk * 33 + (lane & 31)] = W[(size_t)(k0 + kk) * N + n0 + (lane & 31)] * (gk ? gk[k0 + kk] : 1.0f); }
    LDS_WAIT(); asm volatile("" ::: "memory");
    const int c = lane & 7;
#pragma unroll
    for (int j = 0; j < 4; ++j) { const int n = (lane >> 3) + 8 * j; const LAS float* s = scr + (8 * c) * 33 + n;
        v4u o; o.x = pk2(s[0 * 33], s[1 * 33]); o.y = pk2(s[2 * 33], s[3 * 33]); o.z = pk2(s[4 * 33], s[5 * 33]); o.w = pk2(s[6 * 33], s[7 * 33]);
        *(GAS v4u*)(WT + (size_t)(n0 + n) * K + k0 + 8 * c) = o; }
    LDS_WAIT(); asm volatile("" ::: "memory");
}
__device__ __forceinline__ void rms_row_to_bf16(const float* xrow, const float* g, bf16* orow, int lane) {
    const f32x4* xr = (const f32x4*)xrow + lane; const f32x4* gr = (const f32x4*)g + lane;
    f32x4 v[4]; float s = 0.f;
#pragma unroll
    for (int j = 0; j < 4; ++j) { v[j] = xr[64 * j]; s += (v[j].x * v[j].x + v[j].y * v[j].y) + (v[j].z * v[j].z + v[j].w * v[j].w); }
    const float rinv = rsqrtf(wave_sum(s) * (1.f / 1024.f) + RMS_EPS);
    unsigned long long* o8 = (unsigned long long*)orow + lane;
#pragma unroll
    for (int j = 0; j < 4; ++j) { const f32x4 gv = gr[64 * j]; o8[64 * j] = (unsigned long long)pk2(v[j].x * rinv * gv.x, v[j].y * rinv * gv.y) | ((unsigned long long)pk2(v[j].z * rinv * gv.z, v[j].w * rinv * gv.w) << 32); }
}
__device__ __forceinline__ void cvt_f32_to_bf16_bulk(const float* src, bf16* dst, size_t n, size_t gtid, size_t nthr) {
    for (size_t i = gtid; i < n / 8; i += nthr) { const f32x4 a = ((const f32x4*)src)[2 * i], b = ((const f32x4*)src)[2 * i + 1];
        v4u o; o.x = pk2(a.x, a.y); o.y = pk2(a.z, a.w); o.z = pk2(b.x, b.y); o.w = pk2(b.z, b.w); ((v4u*)dst)[i] = o; }
}
__device__ __forceinline__ void os_step(const float (&q)[64], float (&o)[64], float& m, float& l, const bf16* krow, const bf16* vrow, float bias) {
    const v4u* kp = (const v4u*)krow; float s = 0.f;
#pragma unroll
    for (int c = 0; c < 8; ++c) { const v4u w = kp[c];
        s += q[8 * c + 0] * bf_lo(w.x) + q[8 * c + 1] * bf_hi(w.x) + q[8 * c + 2] * bf_lo(w.y) + q[8 * c + 3] * bf_hi(w.y)
           + q[8 * c + 4] * bf_lo(w.z) + q[8 * c + 5] * bf_hi(w.z) + q[8 * c + 6] * bf_lo(w.w) + q[8 * c + 7] * bf_hi(w.w); }
    s += bias;
    const float mn = fmaxf(m, s), al = __expf(m - mn), p = __expf(s - mn);
    l = l * al + p; m = mn;
    const v4u* vp = (const v4u*)vrow;
#pragma unroll
    for (int c = 0; c < 8; ++c) { const v4u w = vp[c];
        o[8 * c + 0] = o[8 * c + 0] * al + p * bf_lo(w.x); o[8 * c + 1] = o[8 * c + 1] * al + p * bf_hi(w.x);
        o[8 * c + 2] = o[8 * c + 2] * al + p * bf_lo(w.y); o[8 * c + 3] = o[8 * c + 3] * al + p * bf_hi(w.y);
        o[8 * c + 4] = o[8 * c + 4] * al + p * bf_lo(w.z); o[8 * c + 5] = o[8 * c + 5] * al + p * bf_hi(w.z);
        o[8 * c + 6] = o[8 * c + 6] * al + p * bf_lo(w.w); o[8 * c + 7] = o[8 * c + 7] * al + p * bf_hi(w.w); }
}
__device__ __forceinline__ void load_q64(float (&q)[64], const bf16* qrow, float scale) {
    const v4u* qp = (const v4u*)qrow;
#pragma unroll
    for (int c = 0; c < 8; ++c) { const v4u w = qp[c];
        q[8 * c + 0] = bf_lo(w.x) * scale; q[8 * c + 1] = bf_hi(w.x) * scale; q[8 * c + 2] = bf_lo(w.y) * scale; q[8 * c + 3] = bf_hi(w.y) * scale;
        q[8 * c + 4] = bf_lo(w.z) * scale; q[8 * c + 5] = bf_hi(w.z) * scale; q[8 * c + 6] = bf_lo(w.w) * scale; q[8 * c + 7] = bf_hi(w.w) * scale; }
}
__device__ __forceinline__ void store_o64(const float (&o)[64], float inv, bf16* orow) {
    v4u* op = (v4u*)orow;
#pragma unroll
    for (int c = 0; c < 8; ++c) { v4u w; w.x = pk2(o[8 * c + 0] * inv, o[8 * c + 1] * inv); w.y = pk2(o[8 * c + 2] * inv, o[8 * c + 3] * inv);
        w.z = pk2(o[8 * c + 4] * inv, o[8 * c + 5] * inv); w.w = pk2(o[8 * c + 6] * inv, o[8 * c + 7] * inv); op[c] = w; }
}
__device__ __forceinline__ void cmp_o64(const float (&o)[64], float inv, const bf16* ref, float& num, float& den) {
#pragma unroll
    for (int c = 0; c < 64; ++c) { const float a = o[c] * inv, b = bf2f(ref[c]); num += (a - b) * (a - b); den += a * a; }
}
__device__ __forceinline__ void dbg_acc2(float* acc, float num, float den) { num = wave_sum(num); den = wave_sum(den); if ((threadIdx.x & 63) == 0 && acc) { atomicAdd(acc, num); atomicAdd(acc + 1, den); } }
__device__ __forceinline__ void cvt_f32_to_fp8_bulk(const float* src, unsigned char* dst, size_t n, float scale, size_t gtid, size_t nthr, const float* gc = nullptr) {
    for (size_t i = gtid; i < n / 16; i += nthr) { const f32x4* s = (const f32x4*)src + 4 * i; f32x4 a = s[0] * scale, b = s[1] * scale, c = s[2] * scale, d = s[3] * scale;
        if (gc) { const f32x4* g4 = (const f32x4*)gc + 4 * (i & 63); a = a * g4[0]; b = b * g4[1]; c = c * g4[2]; d = d * g4[3]; }
        int w0 = 0, w1 = 0, w2 = 0, w3 = 0;
        w0 = __builtin_amdgcn_cvt_pk_fp8_f32(a.x, a.y, w0, false); w0 = __builtin_amdgcn_cvt_pk_fp8_f32(a.z, a.w, w0, true);
        w1 = __builtin_amdgcn_cvt_pk_fp8_f32(b.x, b.y, w1, false); w1 = __builtin_amdgcn_cvt_pk_fp8_f32(b.z, b.w, w1, true);
        w2 = __builtin_amdgcn_cvt_pk_fp8_f32(c.x, c.y, w2, false); w2 = __builtin_amdgcn_cvt_pk_fp8_f32(c.z, c.w, w2, true);
        w3 = __builtin_amdgcn_cvt_pk_fp8_f32(d.x, d.y, w3, false); w3 = __builtin_amdgcn_cvt_pk_fp8_f32(d.z, d.w, w3, true);
        v4u o; o.x = (unsigned)w0; o.y = (unsigned)w1; o.z = (unsigned)w2; o.w = (unsigned)w3; ((v4u*)dst)[i] = o; }
}
__device__ __forceinline__ void rms_row_to_fp8(const float* xrow, const float* g, unsigned char* orow, int lane) {
    const f32x4* xr = (const f32x4*)xrow + lane; const f32x4* gr = (const f32x4*)g + lane;
    f32x4 v[4]; float s = 0.f;
#pragma unroll
    for (int j = 0; j < 4; ++j) { v[j] = xr[64 * j]; s += (v[j].x * v[j].x + v[j].y * v[j].y) + (v[j].z * v[j].z + v[j].w * v[j].w); }
    const float rinv = rsqrtf(wave_sum(s) * (1.f / 1024.f) + RMS_EPS);
    unsigned* o4 = (unsigned*)orow + lane;
#pragma unroll
    for (int j = 0; j < 4; ++j) { const f32x4 gv = gr[64 * j]; int w = 0;
        w = __builtin_amdgcn_cvt_pk_fp8_f32(v[j].x * rinv * gv.x, v[j].y * rinv * gv.y, w, false); w = __builtin_amdgcn_cvt_pk_fp8_f32(v[j].z * rinv * gv.z, v[j].w * rinv * gv.w, w, true); o4[64 * j] = (unsigned)w; }
}
__device__ __forceinline__ void p0_transpose_item_fp8(const float* W, int K, int N, unsigned char* WT, LAS float* scr, int item, int lane, float scale, const float* gk = nullptr) {
    const int nblk = N / 32, kb = item / nblk, nb = item % nblk, k0 = 64 * kb, n0 = 32 * nb;
#pragma unroll 8
    for (int i = 0; i < 32; ++i) { const int kk = 2 * i + (lane >> 5); scr[kk * 33 + (lane & 31)] = W[(size_t)(k0 + kk) * N + n0 + (lane & 31)] * (gk ? scale * gk[k0 + kk] : scale); }
    LDS_WAIT(); asm volatile("" ::: "memory");
    const int c = lane & 3;
#pragma unroll
    for (int j = 0; j < 2; ++j) { const int n = (lane >> 2) + 16 * j; const LAS float* s = scr + (16 * c) * 33 + n;
        int w0 = 0, w1 = 0, w2 = 0, w3 = 0;
        w0 = __builtin_amdgcn_cvt_pk_fp8_f32(s[0 * 33], s[1 * 33], w0, false); w0 = __builtin_amdgcn_cvt_pk_fp8_f32(s[2 * 33], s[3 * 33], w0, true);
        w1 = __builtin_amdgcn_cvt_pk_fp8_f32(s[4 * 33], s[5 * 33], w1, false); w1 = __builtin_amdgcn_cvt_pk_fp8_f32(s[6 * 33], s[7 * 33], w1, true);
        w2 = __builtin_amdgcn_cvt_pk_fp8_f32(s[8 * 33], s[9 * 33], w2, false); w2 = __builtin_amdgcn_cvt_pk_fp8_f32(s[10 * 33], s[11 * 33], w2, true);
        w3 = __builtin_amdgcn_cvt_pk_fp8_f32(s[12 * 33], s[13 * 33], w3, false); w3 = __builtin_amdgcn_cvt_pk_fp8_f32(s[14 * 33], s[15 * 33], w3, true);
        v4u o; o.x = (unsigned)w0; o.y = (unsigned)w1; o.z = (unsigned)w2; o.w = (unsigned)w3;
        *(GAS v4u*)(WT + (size_t)(n0 + n) * K + k0 + 16 * c) = o; }
    LDS_WAIT(); asm volatile("" ::: "memory");
}
template <bool SAMP> __device__ __forceinline__ void phase_dil_simple(const bf16* P, const float* rel_bias, bf16* ODIL, int gtid, int nthr, float* acc = nullptr) {
    float cnum = 0.f, cden = 0.f;
    constexpr int NTOK = SAMP ? T / 16 : T;
    for (int item = gtid; item < 4 * NTOK; item += nthr) {
        const int h = item / NTOK, ti = item % NTOK, tok = SAMP ? ti * 16 + 5 : ti, b = tok / SEQ, t = tok % SEQ;
        float o[64], q[64]; float m = -1e30f, l = 0.f;
#pragma unroll
        for (int c = 0; c < 64; ++c) o[c] = 0.f;
        for (int g = 0; g < 3; ++g) {
            const int d = 1 << (2 * g);
            load_q64(q, P + (size_t)tok * QKVW + g * 768 + h * 64, 0.125f);
            for (int j = 0; j <= 128; ++j) {
                const int tp = t - j * d;
                if (tp >= 0) {
                    const bf16* kr = P + (size_t)(b * SEQ + tp) * QKVW + g * 768 + 256 + h * 64;
                    os_step(q, o, m, l, kr, kr + 256, DBG_NOBIAS ? 0.f : rel_bias[t5_bucket(j * d) * 20 + g * 4 + h]);
                }
            }
        }
        if (SAMP) cmp_o64(o, 1.0f / l, ODIL + (size_t)tok * 256 + h * 64, cnum, cden); else store_o64(o, 1.0f / l, ODIL + (size_t)ti * 256 + h * 64);
    }
    if (SAMP) dbg_acc2(acc, cnum, cden);
}
template <bool SAMP> __device__ __forceinline__ void phase_moba_simple(const bf16* P, const float* KMEAN, const float* rel_bias, bf16* OMOBA, int gtid, int nthr, float* acc = nullptr) {
    float cnum = 0.f, cden = 0.f, cnum2 = 0.f, cden2 = 0.f;
    constexpr int NTOK = SAMP ? T / 16 : T;
    for (int item = gtid; item < 8 * NTOK; item += nthr) {
        const int h = item / NTOK, ti = item % NTOK, tok = SAMP ? ti * 16 + 5 : ti, b = tok / SEQ, t = tok % SEQ, qb = t >> 8;
        float o[64], q[64]; float m = -1e30f, l = 0.f;
#pragma unroll
        for (int c = 0; c < 64; ++c) o[c] = 0.f;
        load_q64(q, P + (size_t)tok * QKVW + 2304 + h * 64, 1.0f);
        float v1 = -3e38f, v2 = -3e38f, v3 = -3e38f; int i1 = -1, i2 = -1, i3 = -1;
        for (int n = 0; n < qb; ++n) {
            const float* km = KMEAN + (size_t)((b * 8 + h) * 16 + n) * 64; float gs = 0.f;
#pragma unroll
            for (int c = 0; c < 64; ++c) gs += q[c] * km[c];
            if (gs > v1) { v3 = v2; i3 = i2; v2 = v1; i2 = i1; v1 = gs; i1 = n; }
            else if (gs > v2) { v3 = v2; i3 = i2; v2 = gs; i2 = n; }
            else if (gs > v3) { v3 = gs; i3 = n; }
        }
        unsigned sel = 0u;
        if (i1 >= 0) sel |= 1u << i1;
        if (i2 >= 0) sel |= 1u << i2;
        if (i3 >= 0) sel |= 1u << i3;
#pragma unroll
        for (int c = 0; c < 64; ++c) q[c] *= 0.125f;
        const bf16* Kb = P + (size_t)(b * SEQ) * QKVW + 2304 + 512 + h * 64;
        for (int n = 0; n < 16; ++n) {
            const bool on = ((sel >> n) & 1u) && (n < qb);
            if (__any(on)) {
                for (int j = 0; j < 256; ++j) {
                    const int kpos = n * 256 + j;
                    if (on) { const bf16* kr = Kb + (size_t)kpos * QKVW; os_step(q, o, m, l, kr, kr + 512, DBG_NOBIAS ? 0.f : rel_bias[t5_bucket(t - kpos) * 20 + 12 + h]); }
                }
            }
        }
        for (int j = 0; j < 256; ++j) { const int kpos = qb * 256 + j;
            if (kpos <= t) { const bf16* kr = Kb + (size_t)kpos * QKVW; os_step(q, o, m, l, kr, kr + 512, DBG_NOBIAS ? 0.f : rel_bias[t5_bucket(t - kpos) * 20 + 12 + h]); }
        }
        if (SAMP) { if (qb == 0) cmp_o64(o, 1.0f / l, OMOBA + (size_t)tok * 512 + h * 64, cnum, cden); else cmp_o64(o, 1.0f / l, OMOBA + (size_t)tok * 512 + h * 64, cnum2, cden2); } else store_o64(o, 1.0f / l, OMOBA + (size_t)ti * 512 + h * 64);
    }
    if (SAMP) { dbg_acc2(acc, cnum, cden); dbg_acc2(acc + 2, cnum2, cden2); }
}
template <bool SAMP> __device__ __forceinline__ void phase_cross_simple(const bf16* QC, const bf16* KVC, bf16* OC, int gtid, int nthr, float* acc = nullptr) {
    float cnum = 0.f, cden = 0.f;
    constexpr int NTOK = SAMP ? T / 16 : T;
    for (int item = gtid; item < 8 * NTOK; item += nthr) {
        const int half = item & 1, pr = item >> 1, h = pr / NTOK, ti = pr % NTOK, tok = SAMP ? ti * 16 + 5 : ti, b = tok / SEQ;
        float o[64], q[64]; float m = -1e30f, l = 0.f;
#pragma unroll
        for (int c = 0; c < 64; ++c) o[c] = 0.f;
        load_q64(q, QC + (size_t)tok * 512 + h * 128 + half * 64, 0.08838834764831845f);
        const bf16* Kb = KVC + (size_t)(b * NMEM) * 1024 + h * 128 + half * 64;
        for (int j = 0; j < NMEM; ++j) {
            const v4u* kp = (const v4u*)(Kb + (size_t)j * 1024); float s = 0.f;
#pragma unroll
            for (int c = 0; c < 8; ++c) { const v4u w = kp[c];
                s += q[8 * c + 0] * bf_lo(w.x) + q[8 * c + 1] * bf_hi(w.x) + q[8 * c + 2] * bf_lo(w.y) + q[8 * c + 3] * bf_hi(w.y)
                   + q[8 * c + 4] * bf_lo(w.z) + q[8 * c + 5] * bf_hi(w.z) + q[8 * c + 6] * bf_lo(w.w) + q[8 * c + 7] * bf_hi(w.w); }
            s += __shfl_xor(s, 1);
            const float mn = fmaxf(m, s), al = __expf(m - mn), p = __expf(s - mn);
            l = l * al + p; m = mn;
            const v4u* vp = (const v4u*)(Kb + (size_t)j * 1024 + 512);
#pragma unroll
            for (int c = 0; c < 8; ++c) { const v4u w = vp[c];
                o[8 * c + 0] = o[8 * c + 0] * al + p * bf_lo(w.x); o[8 * c + 1] = o[8 * c + 1] * al + p * bf_hi(w.x);
                o[8 * c + 2] = o[8 * c + 2] * al + p * bf_lo(w.y); o[8 * c + 3] = o[8 * c + 3] * al + p * bf_hi(w.y);
                o[8 * c + 4] = o[8 * c + 4] * al + p * bf_lo(w.z); o[8 * c + 5] = o[8 * c + 5] * al + p * bf_hi(w.z);
                o[8 * c + 6] = o[8 * c + 6] * al + p * bf_lo(w.w); o[8 * c + 7] = o[8 * c + 7] * al + p * bf_hi(w.w); }
        }
        if (SAMP) cmp_o64(o, 1.0f / l, OC + (size_t)tok * 512 + h * 128 + half * 64, cnum, cden); else store_o64(o, 1.0f / l, OC + (size_t)ti * 512 + h * 128 + half * 64);
    }
    if (SAMP) dbg_acc2(acc, cnum, cden);
}

constexpr int PVQ = 2;
constexpr int PNQ = 4, PEG = 128 / PNQ, PSH = 14 - 2;
__device__ __forceinline__ float tk_max(float a, float b) { return fmaxf(a, b); }
__device__ __forceinline__ float tk_min(float a, float b) { return fminf(a, b); }
template <int OFF> __device__ __forceinline__ void sort16_desc(float* v) {
#pragma unroll
    for (int k = 2; k <= 16; k <<= 1) {
#pragma unroll
        for (int j = k >> 1; j > 0; j >>= 1) {
#pragma unroll
            for (int i = 0; i < 16; ++i) {
                const int l = i ^ j;
                if (l > i) {
                    const bool desc = ((i & k) == 0);
                    const float x = v[OFF + i], y = v[OFF + l];
                    const float hi = tk_max(x, y), lo = tk_min(x, y);
                    v[OFF + i] = desc ? hi : lo; v[OFF + l] = desc ? lo : hi;
                }
            }
        }
    }
}
template <int OA, int OB, bool SORT> __device__ __forceinline__ void merge_top16(float* a, const float* b) {
#pragma unroll
    for (int i = 0; i < 16; ++i) a[OA + i] = tk_max(a[OA + i], b[OB + 15 - i]);
    if (SORT) {
#pragma unroll
        for (int j = 8; j > 0; j >>= 1) {
#pragma unroll
            for (int i = 0; i < 16; ++i) {
                const int l = i ^ j;
                if (l > i) { const float x = a[OA + i], y = a[OA + l]; a[OA + i] = tk_max(x, y); a[OA + l] = tk_min(x, y); }
            }
        }
    }
}
constexpr int cand_i(int c) { int n = 0; for (int i = 0; i < 16; ++i) for (int j = 0; j < 16 / (i + 1); ++j) { if (n == c) return i; ++n; } return 0; }
constexpr int cand_j(int c) { int n = 0; for (int i = 0; i < 16; ++i) for (int j = 0; j < 16 / (i + 1); ++j) { if (n == c) return j; ++n; } return 0; }
template <int C> struct CandT { static constexpr int I = cand_i(C), J = cand_j(C); };

__device__ __forceinline__ void peer_level1(const bf16* qrow  , const LAS unsigned char* sk  ,
                                            int r, int hh, float (&out)[16]) {
    bf16x8 qf[8];
#pragma unroll
    for (int ks = 0; ks < 8; ++ks) qf[ks] = *(const bf16x8*)(qrow + ks * 16 + hh * 8);
    float v[64];
#pragma unroll
    for (int kb = 0; kb < 4; ++kb) {
        f32x16 sc = {0.f, 0.f, 0.f, 0.f, 0.f, 0.f, 0.f, 0.f, 0.f, 0.f, 0.f, 0.f, 0.f, 0.f, 0.f, 0.f};
        const int key = kb * 32 + r;
#pragma unroll
        for (int ks = 0; ks < 8; ++ks) {
            const bf16x8 af = *(const LAS bf16x8*)(sk + key * 256 + (((2 * ks + hh) ^ (key & 15)) << 4));
            sc = __builtin_amdgcn_mfma_f32_32x32x16_bf16(af, qf[ks], sc, 0, 0, 0);
        }
#pragma unroll
        for (int reg = 0; reg < 16; ++reg) {
            const unsigned idx = (unsigned)(kb * 32 + (reg & 3) + 8 * (reg >> 2)) | ((unsigned)hh << 2);
            v[kb * 16 + reg] = __uint_as_float((__float_as_uint(sc[reg]) & ~127u) | idx);
        }
    }
    sort16_desc<0>(v); sort16_desc<16>(v); sort16_desc<32>(v); sort16_desc<48>(v);
    merge_top16<0, 16, true>(v, v); merge_top16<32, 48, true>(v, v); merge_top16<0, 32, true>(v, v);
    float other[16];
#pragma unroll
    for (int i = 0; i < 16; ++i) other[i] = __shfl_xor(v[i], 32);
    merge_top16<0, 0, true>(v, other);
#pragma unroll
    for (int i = 0; i < 16; ++i) out[i] = v[i];
}
template <int C, class EP, class WP> __device__ __forceinline__ void peer_emit(const float (&a)[16], const float (&b)[16], const float (&s)[64], float tau, int& cnt, float& den, bool writer, EP eo, WP wo) {
    if constexpr (C < 50) {
        const bool take = (s[C] >= tau) && (cnt < 16);
        const float e = __expf(s[C] - s[0]);
        if (take) {
            if (writer) { eo[cnt] = (int)(((__float_as_uint(a[CandT<C>::I]) & 127u) << 7) | (__float_as_uint(b[CandT<C>::J]) & 127u)); wo[cnt] = e; }
            cnt += 1; den += e;
        }
        peer_emit<C + 1, EP, WP>(a, b, s, tau, cnt, den, writer, eo, wo);
    }
}
template <int C> __device__ __forceinline__ void peer_sums(const float (&a)[16], const float (&b)[16], float (&s)[64]) {
    if constexpr (C < 50) { s[C] = a[CandT<C>::I] + b[CandT<C>::J]; peer_sums<C + 1>(a, b, s); }
}
__device__ __forceinline__ void phase_topk(LAS unsigned char* lds, const bf16* QP, const bf16* SUBK, int* PE, float* PG, int tid, int lane, int wave, int vcu, int G) {
    for (int c = tid; c < 2 * 128 * 16; c += NWAVES * 64) { const int row = c >> 4, ch = c & 15; const v4u w = ((const v4u*)SUBK)[c]; *(LAS v4u*)(lds + row * 256 + ((ch ^ (row & 15)) << 4)) = w; }
    __syncthreads();
    LAS int* stE = (LAS int*)(lds + 65536);
    LAS float* stW = (LAS float*)(lds + 65536 + 16384);
    const int r = lane & 31, hh = lane >> 5, head = wave;
    for (int tile = vcu; tile < T / 32; tile += G) {
        const int tok = tile * 32 + r;
        const bf16* qrow = QP + (size_t)tok * 2048 + head * 256;
        float a[16], b[16];
        peer_level1(qrow, lds, r, hh, a);
        peer_level1(qrow + 128, lds + 128 * 256, r, hh, b);
        float s[64];
        peer_sums<0>(a, b, s);
#pragma unroll
        for (int c = 50; c < 64; ++c) s[c] = -INFINITY;
        float w[64];
#pragma unroll
        for (int c = 0; c < 64; ++c) w[c] = s[c];
        sort16_desc<0>(w); sort16_desc<16>(w); sort16_desc<32>(w); sort16_desc<48>(w);
        merge_top16<0, 16, true>(w, w); merge_top16<32, 48, true>(w, w); merge_top16<0, 32, false>(w, w);
        float tau = w[0];
#pragma unroll
        for (int i = 1; i < 16; ++i) tau = tk_min(tau, w[i]);
        int cnt = 0; float den = 0.f;
        LAS int* eo = stE + r * 128 + head * 16; LAS float* wo = stW + r * 128 + head * 16;
        peer_emit<0, LAS int*, LAS float*>(a, b, s, tau, cnt, den, hh == 0, eo, wo);
        if (hh == 0) { const float inv = 1.0f / den; asm volatile("s_waitcnt lgkmcnt(0)" ::: "memory");
#pragma unroll
            for (int k = 0; k < 16; ++k) wo[k] *= inv; }
        __syncthreads();
#pragma unroll 1
        for (int i = 0; i < 4; ++i) { const int tl = wave * 4 + i; const size_t tg = (size_t)(tile * 32 + tl) * 128;
            const int e0 = stE[tl * 128 + lane], e1 = stE[tl * 128 + 64 + lane]; const float g0 = stW[tl * 128 + lane], g1 = stW[tl * 128 + 64 + lane];
            const int s0 = e0 >> PSH, s1 = e1 >> PSH; int base = 0, p0 = 0, p1 = 0;
#pragma unroll
            for (int bq = 0; bq < PNQ; ++bq) {
                const unsigned long long m0 = __ballot(s0 == bq), m1 = __ballot(s1 == bq);
                const int c0 = __popcll(m0), c1 = __popcll(m1);
                const int r0 = (int)__builtin_amdgcn_mbcnt_hi((unsigned)(m0 >> 32), __builtin_amdgcn_mbcnt_lo((unsigned)m0, 0u));
                const int r1 = (int)__builtin_amdgcn_mbcnt_hi((unsigned)(m1 >> 32), __builtin_amdgcn_mbcnt_lo((unsigned)m1, 0u));
                if (s0 == bq) p0 = base + r0;
                if (s1 == bq) p1 = base + c0 + r1;
                base += c0 + c1;
            }
            PE[tg + p0] = e0; PE[tg + p1] = e1; PG[tg + p0] = g0; PG[tg + p1] = g1; }
        __syncthreads();
    }
}

__device__ __forceinline__ float dot2_bf16(unsigned w, unsigned x, float acc) { return __builtin_amdgcn_fdot2_f32_bf16(__builtin_bit_cast(bf2_t, w), __builtin_bit_cast(bf2_t, x), acc, false); }
__device__ __forceinline__ float dot8_bf16(const v4u a, const v4u b, float acc) {
    acc = dot2_bf16(a.x, b.x, acc); acc = dot2_bf16(a.y, b.y, acc); acc = dot2_bf16(a.z, b.z, acc); acc = dot2_bf16(a.w, b.w, acc);
    return acc;
}
template <int N> __device__ __forceinline__ void xpose_reduce(float (&p)[64], int lane) {
    if constexpr (N >= 1) {
        const bool up = (lane & N) != 0;
#pragma unroll
        for (int k = 0; k < N; ++k) { const float keep = up ? p[k + N] : p[k], send = up ? p[k] : p[k + N]; p[k] = keep + __shfl_xor(send, N); }
        xpose_reduce<N / 2>(p, lane);
    }
}
__device__ __forceinline__ float gelu_exact(float x) { return 0.5f * x * (1.0f + erff(x * 0.70710678118654752f)); }
__device__ __forceinline__ float gelu_as(float v) {
    const float t = __builtin_amdgcn_rcpf(fabsf(v) * 0.2316418882f + 1.0f);
    float q = t * 0.5307027145f + (-0.7265760135f); q = q * t + 0.7107068705f; q = q * t + (-0.142248368f); q = q * t + 0.127414796f; q = q * t;
    const float e = __builtin_amdgcn_exp2f(v * v * (-0.72134752044f));
    const float m = v * (q * e);
    return v < 0.f ? m : v - m;
}
typedef float f32x2_ __attribute__((ext_vector_type(2)));
__device__ __forceinline__ void fp8x16_to_f32(const v4u w, float (&f)[16]) {
    const int w0 = (int)w.x, w1 = (int)w.y, w2 = (int)w.z, w3 = (int)w.w;
    f32x2_ t;
    t = __builtin_amdgcn_cvt_pk_f32_fp8(w0, false); f[0] = t.x; f[1] = t.y; t = __builtin_amdgcn_cvt_pk_f32_fp8(w0, true); f[2] = t.x; f[3] = t.y;
    t = __builtin_amdgcn_cvt_pk_f32_fp8(w1, false); f[4] = t.x; f[5] = t.y; t = __builtin_amdgcn_cvt_pk_f32_fp8(w1, true); f[6] = t.x; f[7] = t.y;
    t = __builtin_amdgcn_cvt_pk_f32_fp8(w2, false); f[8] = t.x; f[9] = t.y; t = __builtin_amdgcn_cvt_pk_f32_fp8(w2, true); f[10] = t.x; f[11] = t.y;
    t = __builtin_amdgcn_cvt_pk_f32_fp8(w3, false); f[12] = t.x; f[13] = t.y; t = __builtin_amdgcn_cvt_pk_f32_fp8(w3, true); f[14] = t.x; f[15] = t.y;
}
constexpr float U8_SCALE = 32.0f, V8_SCALE = 2.0f;
template <int N> __device__ __forceinline__ void xpose_reduce32(float (&p)[32], int lane) {
    if constexpr (N >= 1) {
        const bool up = (lane & N) != 0;
#pragma unroll
        for (int k = 0; k < N; ++k) { const float keep = up ? p[k + N] : p[k], send = up ? p[k] : p[k + N]; p[k] = keep + __shfl_xor(send, N); }
        xpose_reduce32<N / 2>(p, lane);
    } else { p[0] += __shfl_xor(p[0], 32); }
}
__device__ __forceinline__ void peer_u_group(__amdgpu_buffer_rsrc_t U8, const float (&h)[16], int ev, float gv, float zsc, float* wf, int lane) {
    f32x2_ h2[8];
#pragma unroll
    for (int c = 0; c < 8; ++c) { h2[c].x = h[2 * c]; h2[c].y = h[2 * c + 1]; }
    float p[PEG];
#pragma unroll
    for (int i0 = 0; i0 < PEG; i0 += 8) {
        v4u ua[8];
#pragma unroll
        for (int k = 0; k < 8; ++k) { const int eid = __builtin_amdgcn_readlane(ev, i0 + k); ua[k] = __builtin_amdgcn_raw_buffer_load_b128(U8, lane * 16, eid * 1024, 0); }
#pragma unroll
        for (int k = 0; k < 8; ++k) { const int w0 = (int)ua[k].x, w1 = (int)ua[k].y, w2 = (int)ua[k].z, w3 = (int)ua[k].w;
            f32x2_ a0 = h2[0] * __builtin_amdgcn_cvt_pk_f32_fp8(w0, false), a1 = h2[1] * __builtin_amdgcn_cvt_pk_f32_fp8(w0, true);
            a0 += h2[2] * __builtin_amdgcn_cvt_pk_f32_fp8(w1, false); a1 += h2[3] * __builtin_amdgcn_cvt_pk_f32_fp8(w1, true);
            a0 += h2[4] * __builtin_amdgcn_cvt_pk_f32_fp8(w2, false); a1 += h2[5] * __builtin_amdgcn_cvt_pk_f32_fp8(w2, true);
            a0 += h2[6] * __builtin_amdgcn_cvt_pk_f32_fp8(w3, false); a1 += h2[7] * __builtin_amdgcn_cvt_pk_f32_fp8(w3, true);
            a0 += a1; p[i0 + k] = a0.x + a0.y; }
    }
    xpose_reduce32<16>(p, lane);
    if (lane < PEG) wf[lane] = gelu_exact(p[0] * zsc) * gv * (1.0f / V8_SCALE);
}
__device__ __forceinline__ void peer_v_group(__amdgpu_buffer_rsrc_t V8, float (&y)[16], int ev, float wv, int lane) {
#pragma unroll
    for (int i0 = 0; i0 < PEG; i0 += 16) {
        v4u va[16]; float ws[16];
#pragma unroll
        for (int k = 0; k < 16; ++k) { const int eid = __builtin_amdgcn_readlane(ev, i0 + k); ws[k] = __int_as_float(__builtin_amdgcn_readlane(__float_as_int(wv), i0 + k));
            va[k] = __builtin_amdgcn_raw_buffer_load_b128(V8, lane * 16, eid * 1024, 0); }
#pragma unroll
        for (int k = 0; k < 16; ++k) { float f[16]; fp8x16_to_f32(va[k], f);
#pragma unroll
            for (int c = 0; c < 16; ++c) y[c] += ws[k] * f[c]; }
    }
}
__device__ __forceinline__ void peer_v_half(__amdgpu_buffer_rsrc_t V8, float (&y)[16], int ev, float wv, int lane) {
    for (int i0 = 0; i0 < 64; i0 += 16) {
        v4u va[16]; float ws[16];
#pragma unroll
        for (int k = 0; k < 16; ++k) { const int eid = __builtin_amdgcn_readlane(ev, i0 + k); ws[k] = __int_as_float(__builtin_amdgcn_readlane(__float_as_int(wv), i0 + k));
            va[k] = __builtin_amdgcn_raw_buffer_load_b128(V8, lane * 16, eid * 1024, 0); }
#pragma unroll
        for (int k = 0; k < 16; ++k) { float f[16]; fp8x16_to_f32(va[k], f);
#pragma unroll
            for (int c = 0; c < 16; ++c) y[c] += ws[k] * f[c]; }
    }
}
constexpr int XS_LO = 1088;
constexpr int UT_PITCH = 1040, UT_BYTES = 16 * UT_PITCH, UT_XS = 8 * UT_BYTES, XS_BYTES = 2176;
struct PeerVisit { int ev; float gv, rss; v4u ha, hb; };
__device__ __forceinline__ void peer_visit_load(PeerVisit& v, const bf16* H, const float* rowss, const int* PE, const float* PG, int tok, int g, int lane, bool dbg0) {
    const size_t eb = (size_t)tok * 128 + g * PEG;
    const int e = PE[eb + (lane & 31)]; v.ev = dbg0 ? 0 : e;
    v.gv = PG[eb + (lane & 31)]; v.rss = rowss[tok];
    v.ha = *(const v4u*)(H + (size_t)tok * 1024 + 16 * lane); v.hb = *(const v4u*)(H + (size_t)tok * 1024 + 16 * lane + 8);
}
__device__ __forceinline__ void peer_u_dma_tile(__amdgpu_buffer_rsrc_t U8, LAS unsigned char* tb, int ev, int t, int lane) {
#pragma unroll
    for (int r = 0; r < 16; ++r) { const int eid = __builtin_amdgcn_readlane(ev, 16 * t + r);
        __builtin_amdgcn_raw_ptr_buffer_load_lds(U8, (LAS unsigned*)(tb + r * UT_PITCH), 16, lane * 16, eid * 1024, 0, 0); }
}
__device__ __forceinline__ void peer_u_frags(const LAS unsigned char* tb, pg8::v8i32 (&ub)[8], int lane) {
    const LAS unsigned char* p = tb + (lane & 15) * UT_PITCH + (lane >> 4) * 16;
#pragma unroll
    for (int ks = 0; ks < 8; ++ks) { const v4u q0 = *(const LAS v4u*)(p + ks * 128), q1 = *(const LAS v4u*)(p + ks * 128 + 64);
        ub[ks] = (pg8::v8i32){(int)q0.x, (int)q0.y, (int)q0.z, (int)q0.w, (int)q1.x, (int)q1.y, (int)q1.z, (int)q1.w}; }
}
__device__ __forceinline__ void peer_u_visit(__amdgpu_buffer_rsrc_t U8, LAS unsigned char* tb, LAS unsigned char* xs, const PeerVisit& cur, PeerVisit& nxt, const bf16* H, const float* rowss, const int* PE, const float* PG,
                                             int tokn, int gn, bool dbg0, float* wf, int lane) {
    const int j = lane & 15, q = lane >> 4;
    {
        const v4u ha = cur.ha, hb = cur.hb;
        const float sc = rsqrtf(cur.rss * (1.0f / 1024.0f) + RMS_EPS) * 16.0f;
        float h[16];
        h[0] = bf_lo(ha.x) * sc; h[1] = bf_hi(ha.x) * sc; h[2] = bf_lo(ha.y) * sc; h[3] = bf_hi(ha.y) * sc; h[4] = bf_lo(ha.z) * sc; h[5] = bf_hi(ha.z) * sc; h[6] = bf_lo(ha.w) * sc; h[7] = bf_hi(ha.w) * sc;
        h[8] = bf_lo(hb.x) * sc; h[9] = bf_hi(hb.x) * sc; h[10] = bf_lo(hb.y) * sc; h[11] = bf_hi(hb.y) * sc; h[12] = bf_lo(hb.z) * sc; h[13] = bf_hi(hb.z) * sc; h[14] = bf_lo(hb.w) * sc; h[15] = bf_hi(hb.w) * sc;
        int hi[4], lo[4];
#pragma unroll
        for (int c = 0; c < 4; ++c) { int w = 0; w = __builtin_amdgcn_cvt_pk_fp8_f32(h[4 * c], h[4 * c + 1], w, false); w = __builtin_amdgcn_cvt_pk_fp8_f32(h[4 * c + 2], h[4 * c + 3], w, true); hi[c] = w;
            const f32x2_ b0 = __builtin_amdgcn_cvt_pk_f32_fp8(w, false), b1 = __builtin_amdgcn_cvt_pk_f32_fp8(w, true);
            int v = 0; v = __builtin_amdgcn_cvt_pk_fp8_f32((h[4 * c] - b0.x) * 16.0f, (h[4 * c + 1] - b0.y) * 16.0f, v, false); v = __builtin_amdgcn_cvt_pk_fp8_f32((h[4 * c + 2] - b1.x) * 16.0f, (h[4 * c + 3] - b1.y) * 16.0f, v, true); lo[c] = v; }
        *(LAS v4u*)(xs + 16 * lane) = (v4u){(unsigned)hi[0], (unsigned)hi[1], (unsigned)hi[2], (unsigned)hi[3]};
        *(LAS v4u*)(xs + XS_LO + 16 * lane) = (v4u){(unsigned)lo[0], (unsigned)lo[1], (unsigned)lo[2], (unsigned)lo[3]};
    }
    const LAS unsigned char* xb = xs + (j & 1) * XS_LO + q * 16;
    pg8::v8i32 xa[8];
#pragma unroll
    for (int ks = 0; ks < 8; ++ks) { const v4u q0 = *(const LAS v4u*)(xb + ks * 128), q1 = *(const LAS v4u*)(xb + ks * 128 + 64);
        xa[ks] = (pg8::v8i32){(int)q0.x, (int)q0.y, (int)q0.z, (int)q0.w, (int)q1.x, (int)q1.y, (int)q1.z, (int)q1.w}; }
    peer_visit_load(nxt, H, rowss, PE, PG, tokn, gn, lane, dbg0);
    pg8::v8i32 ub[8];
    f32x4 acc0 = {0.f, 0.f, 0.f, 0.f}, acc1 = {0.f, 0.f, 0.f, 0.f};
    const int unit = 0x7f7f7f7f;
    asm volatile("s_waitcnt vmcnt(0)" ::: "memory");
    peer_u_frags(tb, ub, lane);
    asm volatile("s_waitcnt lgkmcnt(0)" ::: "memory");
    peer_u_dma_tile(U8, tb, cur.ev, 1, lane);
#pragma unroll
    for (int ks = 0; ks < 8; ++ks) asm volatile("v_mfma_scale_f32_16x16x128_f8f6f4 %0, %1, %2, %0, %3, %3 op_sel_hi:[0,0,0]" : "+v"(acc0) : "v"(xa[ks]), "v"(ub[ks]), "v"(unit));
    asm volatile("s_waitcnt vmcnt(0)" ::: "memory");
    peer_u_frags(tb, ub, lane);
    asm volatile("s_waitcnt lgkmcnt(0)" ::: "memory");
    peer_u_dma_tile(U8, tb, nxt.ev, 0, lane);
#pragma unroll
    for (int ks = 0; ks < 8; ++ks) asm volatile("v_mfma_scale_f32_16x16x128_f8f6f4 %0, %1, %2, %0, %3, %3 op_sel_hi:[0,0,0]" : "+v"(acc1) : "v"(xa[ks]), "v"(ub[ks]), "v"(unit));
    asm volatile("s_nop 15\n\ts_nop 15" : "+v"(acc0), "+v"(acc1));
    const float z = (lane < 16) ? acc0.x + acc0.y * (1.0f / 16.0f) : acc1.x + acc1.y * (1.0f / 16.0f);
    if (lane < 32) wf[lane] = gelu_exact(z * (1.0f / (16.0f * U8_SCALE))) * cur.gv * (1.0f / V8_SCALE);
}
__device__ __forceinline__ void phase_peer(const bf16* H, const float* rowss, const unsigned char* U8p, const unsigned char* V8p, float* WF, const int* PE, const float* PG,
                                           const float* gfin, float* OUT, int lane, int wave, int gw, int ngw, float dbg_sc, float* ydbg, float oscale, LAS unsigned char* ldsw) {
    static_assert(PEG == 32, "the group code is written for 32 entries per group");
    const __amdgpu_buffer_rsrc_t U8 = __builtin_amdgcn_make_buffer_rsrc((void*)U8p, 0, 16 << 20, 0x00020000), V8 = __builtin_amdgcn_make_buffer_rsrc((void*)V8p, 0, 16 << 20, 0x00020000);
    {   const int ntok = (T - gw + ngw - 1) / ngw, nvis = PNQ * ntok; const bool dbg0 = dbg_sc == 0.f;
        LAS unsigned char* tb = ldsw + wave * UT_BYTES; LAS unsigned char* xs = ldsw + UT_XS + wave * XS_BYTES;
        PeerVisit va, vb;
        peer_visit_load(va, H, rowss, PE, PG, gw, 0, lane, dbg0);
        peer_u_dma_tile(U8, tb, va.ev, 0, lane);
        int g = 0, tok = gw;
        for (int vi = 0; vi < nvis; vi += 2) {
            int g1 = g, tok1 = tok + ngw; if (tok1 >= T) { tok1 = gw; g1 = g + 1; }
            if (vi + 1 >= nvis) { tok1 = tok; g1 = g; }
            peer_u_visit(U8, tb, xs, va, vb, H, rowss, PE, PG, tok1, g1, dbg0, WF + (size_t)tok * 128 + g * PEG, lane);
            if (vi + 1 >= nvis) break;
            int g2 = g1, tok2 = tok1 + ngw; if (tok2 >= T) { tok2 = gw; g2 = g1 + 1; }
            if (vi + 2 >= nvis) { tok2 = tok1; g2 = g1; }
            peer_u_visit(U8, tb, xs, vb, va, H, rowss, PE, PG, tok2, g2, dbg0, WF + (size_t)tok1 * 128 + g1 * PEG, lane);
            g = g2; tok = tok2;
        }
    }
    asm volatile("s_waitcnt vmcnt(0)" ::: "memory");
    for (int tq = gw; tq < T; tq += PVQ * ngw) {
        float y[PVQ][16];
#pragma unroll
        for (int j = 0; j < PVQ; ++j)
#pragma unroll
            for (int c = 0; c < 16; ++c) y[j][c] = 0.f;
#pragma unroll
        for (int half = 0; half < 2; ++half)
#pragma unroll
            for (int j = 0; j < PVQ; ++j) { const size_t t_ = (size_t)(tq + j * ngw);
                peer_v_half(V8, y[j], (dbg_sc == 0.f) ? 0 : PE[t_ * 128 + half * 64 + lane], WF[t_ * 128 + half * 64 + lane], lane); }
#pragma unroll
        for (int j = 0; j < PVQ; ++j) {
            const int tok = tq + j * ngw;
            if (dbg_sc == 0.f) {
#pragma unroll
                for (int c = 0; c < 16; ++c) y[j][c] = 0.f; }
            if (ydbg) { const int s_ = tok / 512; if (tok == s_ * 512 + 3 + (s_ & 7) * 37) {
#pragma unroll
                for (int c = 0; c < 16; ++c) ydbg[(size_t)s_ * 1024 + 16 * lane + c] = y[j][c]; } }
            const f32x4* gr = (const f32x4*)gfin + 4 * lane;
            const v4u xa = *(const v4u*)(H + (size_t)tok * 1024 + 16 * lane), xbv = *(const v4u*)(H + (size_t)tok * 1024 + 16 * lane + 8);
            f32x4 xv[4]; float ss = 0.f;
            xv[0] = (f32x4){bf_lo(xa.x), bf_hi(xa.x), bf_lo(xa.y), bf_hi(xa.y)}; xv[1] = (f32x4){bf_lo(xa.z), bf_hi(xa.z), bf_lo(xa.w), bf_hi(xa.w)};
            xv[2] = (f32x4){bf_lo(xbv.x), bf_hi(xbv.x), bf_lo(xbv.y), bf_hi(xbv.y)}; xv[3] = (f32x4){bf_lo(xbv.z), bf_hi(xbv.z), bf_lo(xbv.w), bf_hi(xbv.w)};
#pragma unroll
            for (int i = 0; i < 4; ++i) { xv[i].x += y[j][4 * i]; xv[i].y += y[j][4 * i + 1]; xv[i].z += y[j][4 * i + 2]; xv[i].w += y[j][4 * i + 3];
                ss += (xv[i].x * xv[i].x + xv[i].y * xv[i].y) + (xv[i].z * xv[i].z + xv[i].w * xv[i].w); }
            const float rinv = rsqrtf(wave_sum(ss) * (1.f / 1024.f) + RMS_EPS) * oscale;
            f32x4* orow = (f32x4*)(OUT + (size_t)tok * 1024) + 4 * lane;
#pragma unroll
            for (int i = 0; i < 4; ++i) orow[i] = xv[i] * rinv * gr[i];
        }
    }
}
#if PROBE_PH >= 20
template <int MODE> __device__ __forceinline__ void peer_probe(const bf16* H, const float* rowss, const unsigned char* U8p, const unsigned char* V8p, float* WF, const int* PE, const float* PG,
                                                               float* OUT, int lane, int wave, int gw, int ngw, int vcu) {
    const __amdgpu_buffer_rsrc_t U8 = __builtin_amdgcn_make_buffer_rsrc((void*)U8p, 0, 16 << 20, 0x00020000), V8 = __builtin_amdgcn_make_buffer_rsrc((void*)V8p, 0, 16 << 20, 0x00020000);
    if constexpr (MODE == 0 || MODE == 1 || MODE == 2 || MODE == 6) {
        for (int g = 0; g < PNQ; ++g) {
            for (int tok = gw; tok < T; tok += ngw) {
                int ev = PE[(size_t)tok * 128 + g * PEG + (lane & (PEG - 1))]; const float gv = PG[(size_t)tok * 128 + g * PEG + (lane & (PEG - 1))];
                ev &= 16383;
                if (MODE == 1 || MODE == 6) ev = (ev & 2047) | ((vcu >> 5) << 11);
                const v4u ha = *(const v4u*)(H + (size_t)tok * 1024 + 16 * lane), hb = *(const v4u*)(H + (size_t)tok * 1024 + 16 * lane + 8);
                float h[16];
                h[0] = bf_lo(ha.x); h[1] = bf_hi(ha.x); h[2] = bf_lo(ha.y); h[3] = bf_hi(ha.y); h[4] = bf_lo(ha.z); h[5] = bf_hi(ha.z); h[6] = bf_lo(ha.w); h[7] = bf_hi(ha.w);
                h[8] = bf_lo(hb.x); h[9] = bf_hi(hb.x); h[10] = bf_lo(hb.y); h[11] = bf_hi(hb.y); h[12] = bf_lo(hb.z); h[13] = bf_hi(hb.z); h[14] = bf_lo(hb.w); h[15] = bf_hi(hb.w);
                const float zsc = rsqrtf(rowss[tok] * (1.0f / 1024.0f) + RMS_EPS) * (1.0f / U8_SCALE);
                if constexpr (MODE == 2 || MODE == 6) {
                    unsigned acc = 0u;
#pragma unroll
                    for (int i0 = 0; i0 < PEG; i0 += 8) {
                        v4u ua[8];
#pragma unroll
                        for (int k = 0; k < 8; ++k) { const int eid = __builtin_amdgcn_readlane(ev, i0 + k); ua[k] = __builtin_amdgcn_raw_buffer_load_b128(U8, lane * 16, eid * 1024, 0); }
#pragma unroll
                        for (int k = 0; k < 8; ++k) acc ^= (ua[k].x ^ ua[k].y) ^ (ua[k].z ^ ua[k].w);
                    }
                    if (lane < PEG) (WF + (size_t)tok * 128 + g * PEG)[lane] = __uint_as_float(acc) * zsc * gv * h[0];
                } else peer_u_group(U8, h, ev, gv, zsc, WF + (size_t)tok * 128 + g * PEG, lane);
            }
        }
    } else {
        for (int tq = gw; tq < T; tq += PVQ * ngw) {
            float y[PVQ][16];
#pragma unroll
            for (int j = 0; j < PVQ; ++j)
#pragma unroll
                for (int c = 0; c < 16; ++c) y[j][c] = 0.f;
#pragma unroll
            for (int half = 0; half < 2; ++half)
#pragma unroll
                for (int j = 0; j < PVQ; ++j) { const size_t t_ = (size_t)(tq + j * ngw);
                    int ev = PE[t_ * 128 + half * 64 + lane] & 16383; const float wv = WF[t_ * 128 + half * 64 + lane];
                    if (MODE == 4) ev &= 2047;
                    if constexpr (MODE == 5) {
                        for (int i0 = 0; i0 < 64; i0 += 16) {
                            v4u va[16];
#pragma unroll
                            for (int k = 0; k < 16; ++k) { const int eid = __builtin_amdgcn_readlane(ev, i0 + k); va[k] = __builtin_amdgcn_raw_buffer_load_b128(V8, lane * 16, eid * 1024, 0); }
#pragma unroll
                            for (int k = 0; k < 16; ++k) { y[j][0] = __uint_as_float(__float_as_uint(y[j][0]) ^ va[k].x); y[j][1] = __uint_as_float(__float_as_uint(y[j][1]) ^ va[k].y);
                                y[j][2] = __uint_as_float(__float_as_uint(y[j][2]) ^ va[k].z); y[j][3] = __uint_as_float(__float_as_uint(y[j][3]) ^ va[k].w); }
                        }
                        y[j][4] += wv;
                    } else peer_v_half(V8, y[j], ev, wv, lane);
                }
#pragma unroll
            for (int j = 0; j < PVQ; ++j) {
                const int tok = tq + j * ngw;
                const v4u xa = *(const v4u*)(H + (size_t)tok * 1024 + 16 * lane), xbv = *(const v4u*)(H + (size_t)tok * 1024 + 16 * lane + 8);
                f32x4 xv[4]; float ss = 0.f;
                xv[0] = (f32x4){bf_lo(xa.x), bf_hi(xa.x), bf_lo(xa.y), bf_hi(xa.y)}; xv[1] = (f32x4){bf_lo(xa.z), bf_hi(xa.z), bf_lo(xa.w), bf_hi(xa.w)};
                xv[2] = (f32x4){bf_lo(xbv.x), bf_hi(xbv.x), bf_lo(xbv.y), bf_hi(xbv.y)}; xv[3] = (f32x4){bf_lo(xbv.z), bf_hi(xbv.z), bf_lo(xbv.w), bf_hi(xbv.w)};
#pragma unroll
                for (int i = 0; i < 4; ++i) { xv[i].x += y[j][4 * i]; xv[i].y += y[j][4 * i + 1]; xv[i].z += y[j][4 * i + 2]; xv[i].w += y[j][4 * i + 3];
                    ss += (xv[i].x * xv[i].x + xv[i].y * xv[i].y) + (xv[i].z * xv[i].z + xv[i].w * xv[i].w); }
                const float rinv = rsqrtf(wave_sum(ss) * (1.f / 1024.f) + RMS_EPS);
                f32x4* orow = (f32x4*)(OUT + (size_t)tok * 1024) + 4 * lane;
#pragma unroll
                for (int i = 0; i < 4; ++i) orow[i] = xv[i] * rinv;
            }
        }
    }
}
#endif
constexpr float L2E = 1.4426950408889634f;
#ifndef ATT_THR
#define ATT_THR 8.0f
#endif
typedef short v4i16_t __attribute__((ext_vector_type(4)));
__device__ __forceinline__ float amax3(float a, float b, float c) { float r; asm("v_max3_f32 %0, %1, %2, %3" : "=v"(r) : "v"(a), "v"(b), "v"(c)); return r; }
template <int D> struct ACfg { static constexpr int KS = D / 16, NBLK = D / 32, PITCH = D * 2 + 16, TILEB = 64 * PITCH, VPITCH = (D == 64 ? 192 : 320)  , VTILEB = 64 * VPITCH, PIECES = D / 64, CPR = D / 8; };
__device__ __forceinline__ bf16x8 pack8(float a0, float a1, float a2, float a3, float a4, float a5, float a6, float a7) {
    v4u u; u.x = pk2(a0, a1); u.y = pk2(a2, a3); u.z = pk2(a4, a5); u.w = pk2(a6, a7); return __builtin_bit_cast(bf16x8, u);
}
template <int D> __device__ __forceinline__ void attn_stage_load(v4u (&kr)[D / 64], v4u (&vr)[D / 64], const bf16* Kg, const bf16* Vg, size_t rowstride, int tid) {
#pragma unroll
    for (int p = 0; p < D / 64; ++p) { const int idx = tid + 512 * p, row = idx / ACfg<D>::CPR, ch = idx % ACfg<D>::CPR;
        kr[p] = *(const v4u*)(Kg + (size_t)row * rowstride + ch * 8); vr[p] = *(const v4u*)(Vg + (size_t)row * rowstride + ch * 8); }
}
template <int D> __device__ __forceinline__ void attn_stage_store(const v4u (&kr)[D / 64], const v4u (&vr)[D / 64], LAS unsigned char* Kl, LAS unsigned char* Vl, int tid) {
#pragma unroll
    for (int p = 0; p < D / 64; ++p) { const int idx = tid + 512 * p, row = idx / ACfg<D>::CPR, ch = idx % ACfg<D>::CPR;
        *(LAS v4u*)(Kl + row * ACfg<D>::PITCH + ch * 16) = kr[p]; *(LAS v4u*)(Vl + row * ACfg<D>::VPITCH + ch * 16) = vr[p]; }
}
template <int D> __device__ __forceinline__ void attn_load_q(bf16x8 (&qf)[D / 16], const bf16* qrow, int hh, float scale) {
#pragma unroll
    for (int ks = 0; ks < D / 16; ++ks) { const v4u w = *(const v4u*)(qrow + ks * 16 + hh * 8);
        qf[ks] = pack8(bf_lo(w.x) * scale, bf_hi(w.x) * scale, bf_lo(w.y) * scale, bf_hi(w.y) * scale, bf_lo(w.z) * scale, bf_hi(w.z) * scale, bf_lo(w.w) * scale, bf_hi(w.w) * scale); }
}
template <int D, int BIAS  > __device__ __forceinline__ void attn_tile(const LAS unsigned char* Kl, const LAS unsigned char* Vl, const bf16x8 (&qf)[D / 16], f32x16 (&o)[D / 32], float& m, float& l,
                                                                      const LAS float* tb, bool active, int lane, float cbias = 0.f) {
    constexpr int PITCH = ACfg<D>::PITCH, VPITCH = ACfg<D>::VPITCH;
    const int r = lane & 31, hh = lane >> 5;
    f32x16 s0, s1;
    if (BIAS == 2) {
#pragma unroll
        for (int reg = 0; reg < 16; ++reg) { s0[reg] = cbias; s1[reg] = cbias; }
    } else if (BIAS == 1) {
#pragma unroll
        for (int reg = 0; reg < 16; ++reg) { s0[reg] = tb[(reg & 3) + 8 * (reg >> 2)]; s1[reg] = tb[32 + (reg & 3) + 8 * (reg >> 2)]; }
    } else {
#pragma unroll
        for (int reg = 0; reg < 16; ++reg) { s0[reg] = 0.f; s1[reg] = 0.f; }
    }
#pragma unroll
    for (int ks = 0; ks < D / 16; ++ks) {
        const bf16x8 k0 = *(const LAS bf16x8*)(Kl + r * PITCH + (2 * ks + hh) * 16);
        const bf16x8 k1 = *(const LAS bf16x8*)(Kl + (32 + r) * PITCH + (2 * ks + hh) * 16);
        s0 = __builtin_amdgcn_mfma_f32_32x32x16_bf16(k0, qf[ks], s0, 0, 0, 0);
        s1 = __builtin_amdgcn_mfma_f32_32x32x16_bf16(k1, qf[ks], s1, 0, 0, 0);
    }
    asm volatile("s_nop 15\n\ts_nop 7" : "+v"(s0), "+v"(s1));
    float mx = amax3(s0[0], s1[0], s0[1]), mx2 = amax3(s1[1], s0[2], s1[2]);
#pragma unroll
    for (int reg = 3; reg < 15; reg += 2) { mx = amax3(mx, s0[reg], s1[reg]); mx2 = amax3(mx2, s0[reg + 1], s1[reg + 1]); }
    mx = amax3(mx, mx2, s0[15]); mx = amax3(mx, s1[15], s1[15]); mx = amax3(mx, __shfl_xor(mx, 32), mx);
    if (__any(active && (mx > m + ATT_THR))) {
        const float mn = active ? fmaxf(m, mx) : m;
        const float alpha = __builtin_amdgcn_exp2f(m - mn);
        l *= alpha; m = mn;
#pragma unroll
        for (int blk = 0; blk < D / 32; ++blk)
#pragma unroll
            for (int reg = 0; reg < 16; ++reg) o[blk][reg] *= alpha;
    }
    const float meff = active ? m : __builtin_inff();
    float ls = 0.f;
#pragma unroll
    for (int reg = 0; reg < 16; ++reg) { s0[reg] = __builtin_amdgcn_exp2f(s0[reg] - meff); s1[reg] = __builtin_amdgcn_exp2f(s1[reg] - meff); ls += s0[reg] + s1[reg]; }
    l += ls;
    bf16x8 pf[4];
    pf[0] = pack8(s0[0], s0[1], s0[2], s0[3], s0[4], s0[5], s0[6], s0[7]); pf[1] = pack8(s0[8], s0[9], s0[10], s0[11], s0[12], s0[13], s0[14], s0[15]);
    pf[2] = pack8(s1[0], s1[1], s1[2], s1[3], s1[4], s1[5], s1[6], s1[7]); pf[3] = pack8(s1[8], s1[9], s1[10], s1[11], s1[12], s1[13], s1[14], s1[15]);
    const int i16 = lane & 15;
    unsigned vbo = (unsigned)((4 * hh + (i16 >> 2)) * VPITCH + (16 * ((lane >> 4) & 1) + 4 * (i16 & 3)) * 2);
    asm volatile("" : "+v"(vbo) :: "memory");
    const LAS unsigned char* vb = Vl + vbo;
#pragma unroll
    for (int blk = 0; blk < D / 32; ++blk) {
#pragma unroll
        for (int ks = 0; ks < 4; ++ks) {
            const v4i16_t lo = __builtin_amdgcn_ds_read_tr16_b64_v4i16((LAS v4i16_t*)(vb + (16 * ks) * VPITCH + blk * 64));
            const v4i16_t hi = __builtin_amdgcn_ds_read_tr16_b64_v4i16((LAS v4i16_t*)(vb + (16 * ks + 8) * VPITCH + blk * 64));
            const bf16x8 va = {lo[0], lo[1], lo[2], lo[3], hi[0], hi[1], hi[2], hi[3]};
            o[blk] = __builtin_amdgcn_mfma_f32_32x32x16_bf16(va, pf[ks], o[blk], 0, 0, 0);
        }
    }
}
template <int D> __device__ __forceinline__ void attn_store_o(const f32x16 (&o)[D / 32], float inv, bf16* orow, int hh) {
#pragma unroll
    for (int blk = 0; blk < D / 32; ++blk)
#pragma unroll
        for (int g4 = 0; g4 < 4; ++g4) { unsigned long long w = (unsigned long long)pk2(o[blk][4 * g4] * inv, o[blk][4 * g4 + 1] * inv) | ((unsigned long long)pk2(o[blk][4 * g4 + 2] * inv, o[blk][4 * g4 + 3] * inv) << 32);
            *(unsigned long long*)(orow + 32 * blk + 8 * g4 + 4 * hh) = w; }
}
constexpr int ATT_TB_BYTES = 18432;

__device__ __forceinline__ void moba_unit(LAS unsigned char* lds, const bf16* P, const float* KMEAN, const float* rel_bias, bf16* OMOBA, int b, int h, int qb, int tid, int lane, int wave) {
    constexpr int TILEB = ACfg<64>::TILEB, VTILEB = ACfg<64>::VTILEB;
    const int r = lane & 31, hh = lane >> 5;
    LAS float* TB = (LAS float*)lds;
    LAS unsigned char* Kb = lds + ATT_TB_BYTES; LAS unsigned char* Vb = Kb + 2 * TILEB;
    LAS float* KM = (LAS float*)(lds + ATT_TB_BYTES + 4 * TILEB + 4 * VTILEB);
#pragma unroll
    for (int i = 0; i < 9; ++i) { const int x = tid + i * (NWAVES * 64); if (x < 4352) { const int dist = 4095 - x; float tv = -__builtin_inff(); if (dist >= 0) tv = DBG_NOBIAS ? 0.f : rel_bias[t5_bucket(dist) * 20 + 12 + h] * L2E; TB[x] = tv; } }
#pragma unroll
    for (int i = 0; i < 2; ++i) { const int x = tid + i * (NWAVES * 64); if (x < qb * 64) KM[x] = KMEAN[(size_t)((b * 8 + h) * 16) * 64 + x]; }
    __syncthreads();
    const int qpos = qb * 256 + wave * 32 + r; const size_t tokq = (size_t)b * SEQ + qpos;
    const bf16* qrow = P + tokq * QKVW + 2304 + h * 64;
    unsigned sel = 0u;
    {
        float q[64]; load_q64(q, qrow, 1.0f);
        float v1 = -3e38f, v2 = -3e38f, v3 = -3e38f; int i1 = -1, i2 = -1, i3 = -1;
        for (int n = 0; n < qb; ++n) {
            const LAS f32x4* km = (const LAS f32x4*)(KM + n * 64); float gs = 0.f;
#pragma unroll
            for (int c = 0; c < 16; ++c) { const f32x4 kv = km[c]; gs += q[4 * c] * kv.x + q[4 * c + 1] * kv.y + q[4 * c + 2] * kv.z + q[4 * c + 3] * kv.w; }
            if (gs > v1) { v3 = v2; i3 = i2; v2 = v1; i2 = i1; v1 = gs; i1 = n; }
            else if (gs > v2) { v3 = v2; i3 = i2; v2 = gs; i2 = n; }
            else if (gs > v3) { v3 = gs; i3 = n; }
        }
        if (i1 >= 0) sel |= 1u << i1;
        if (i2 >= 0) sel |= 1u << i2;
        if (i3 >= 0) sel |= 1u << i3;
    }
    bf16x8 qf[4]; attn_load_q<64>(qf, qrow, hh, 0.125f * L2E);
    f32x16 o[2];
#pragma unroll
    for (int reg = 0; reg < 16; ++reg) { o[0][reg] = 0.f; o[1][reg] = 0.f; }
    float m = -1e30f, l = 0.f;
    const bf16* Kg0 = P + (size_t)b * SEQ * QKVW + 2304 + 512 + h * 64;
    const int nt = 4 + 4 * qb;
#define MOBA_K0(i) ((i) < 4 ? qb * 256 + 64 * (i) : 64 * ((i) - 4))
    LAS unsigned char* Kb2 = Kb; LAS unsigned char* Vb2 = Kb + 4 * TILEB;
    LAS float* KM2 = (LAS float*)(Kb + 4 * TILEB + 4 * VTILEB); (void)KM2;
    v4u krA[1], vrA[1], krB[1], vrB[1];
    { const int k0 = MOBA_K0(0), k1 = MOBA_K0(1);
      attn_stage_load<64>(krA, vrA, Kg0 + (size_t)k0 * QKVW, Kg0 + (size_t)k0 * QKVW + 512, QKVW, tid); attn_stage_load<64>(krB, vrB, Kg0 + (size_t)k1 * QKVW, Kg0 + (size_t)k1 * QKVW + 512, QKVW, tid);
      attn_stage_store<64>(krA, vrA, Kb2, Vb2, tid); attn_stage_store<64>(krB, vrB, Kb2 + TILEB, Vb2 + VTILEB, tid); }
    __syncthreads();
    for (int i = 0; i < nt; i += 2) {
        const int sb = (i >> 1) & 1;
        if (i + 2 < nt) { const int k2 = MOBA_K0(i + 2), k3 = MOBA_K0(i + 3);
            attn_stage_load<64>(krA, vrA, Kg0 + (size_t)k2 * QKVW, Kg0 + (size_t)k2 * QKVW + 512, QKVW, tid); attn_stage_load<64>(krB, vrB, Kg0 + (size_t)k3 * QKVW, Kg0 + (size_t)k3 * QKVW + 512, QKVW, tid); }
#pragma unroll
        for (int e = 0; e < 2; ++e) { const int ii = i + e; const int k0 = MOBA_K0(ii);
            bool on; bool go;
            if (ii < 4) { on = true; go = (ii <= (wave >> 1)); }
            else { on = (sel >> ((ii - 4) >> 2)) & 1u; go = __any(on) != 0; }
            if (go) attn_tile<64, 1>(Kb2 + (2 * sb + e) * TILEB, Vb2 + (2 * sb + e) * VTILEB, qf, o, m, l, TB + (k0 - qpos + 4095 + 4 * hh), on, lane); }
        if (i + 2 < nt) { attn_stage_store<64>(krA, vrA, Kb2 + (2 * (sb ^ 1)) * TILEB, Vb2 + (2 * (sb ^ 1)) * VTILEB, tid); attn_stage_store<64>(krB, vrB, Kb2 + (2 * (sb ^ 1) + 1) * TILEB, Vb2 + (2 * (sb ^ 1) + 1) * VTILEB, tid); }
        __syncthreads();
    }
#undef MOBA_K0
    const float lt = l + __shfl_xor(l, 32);
    attn_store_o<64>(o, 1.0f / lt, OMOBA + tokq * 512 + h * 64, hh);
}
__device__ __forceinline__ void dil_unit(LAS unsigned char* lds, const bf16* P, const float* rel_bias, bf16* ODG, float* LSE, int b, int g, int h, int res, int blk, int tid, int lane, int wave) {
    constexpr int TILEB = ACfg<64>::TILEB, VTILEB = ACfg<64>::VTILEB;
    const int r = lane & 31, hh = lane >> 5, d = 1 << (2 * g), l0 = blk * 256;
    LAS float* TB = (LAS float*)lds;
    LAS unsigned char* Kb = lds + ATT_TB_BYTES; LAS unsigned char* Vb = Kb + 2 * TILEB;
    float tbv; { const int j = 256 - tid, jc = j < 0 ? 0 : (j > 128 ? 128 : j); tbv = (DBG_NOBIAS ? 0.f : rel_bias[t5_bucket(jc * d) * 20 + g * 4 + h] * L2E); if (j < 0 || j > 128) tbv = -__builtin_inff(); }
    const int q0w = l0 + wave * 32, lq = q0w + r; const size_t tokq = (size_t)b * SEQ + (size_t)lq * d + res;
    v4u qw[4];
#pragma unroll
    for (int ks = 0; ks < 4; ++ks) qw[ks] = *(const v4u*)(P + tokq * QKVW + g * 768 + h * 64 + ks * 16 + hh * 8);
    f32x16 o[2];
#pragma unroll
    for (int reg = 0; reg < 16; ++reg) { o[0][reg] = 0.f; o[1][reg] = 0.f; }
    float m = -1e30f, l = 0.f;
    const bf16* Kg0 = P + ((size_t)b * SEQ + res) * QKVW + g * 768 + 256 + h * 64;
    const size_t rs = (size_t)QKVW * d;
    const int kt0 = (l0 == 0) ? 0 : -2, nt = 4 - kt0;
    LAS unsigned char* Kb2 = Kb; LAS unsigned char* Vb2 = Kb + 4 * TILEB;
#define DIL_TILE(j, e) ((e) == 0 ? (j) : (nt == 6 ? (j) + 3 : 3 - (j)))
#define DIL_LOAD(i, kr, vr) do { const int k0_ = l0 + 64 * (kt0 + (i)); attn_stage_load<64>(kr, vr, Kg0 + (size_t)k0_ * rs, Kg0 + (size_t)k0_ * rs + 256, rs, tid); } while (0)
    v4u kr0[1], vr0[1], kr1[1], vr1[1], kr2[1], vr2[1], kr3[1], vr3[1], kr4[1], vr4[1], kr5[1], vr5[1];
    DIL_LOAD(DIL_TILE(0, 0), kr0, vr0); DIL_LOAD(DIL_TILE(0, 1), kr1, vr1); DIL_LOAD(DIL_TILE(1, 0), kr2, vr2); DIL_LOAD(DIL_TILE(1, 1), kr3, vr3);
    if (nt == 6) { DIL_LOAD(DIL_TILE(2, 0), kr4, vr4); DIL_LOAD(DIL_TILE(2, 1), kr5, vr5); }
    TB[tid] = tbv;
    bf16x8 qf[4];
#pragma unroll
    for (int ks = 0; ks < 4; ++ks) { const float sc_ = 0.125f * L2E; const v4u w = qw[ks];
        qf[ks] = pack8(bf_lo(w.x) * sc_, bf_hi(w.x) * sc_, bf_lo(w.y) * sc_, bf_hi(w.y) * sc_, bf_lo(w.z) * sc_, bf_hi(w.z) * sc_, bf_lo(w.w) * sc_, bf_hi(w.w) * sc_); }
    attn_stage_store<64>(kr0, vr0, Kb2, Vb2, tid); attn_stage_store<64>(kr1, vr1, Kb2 + TILEB, Vb2 + VTILEB, tid);
    __syncthreads();
    const int nsteps = nt >> 1;
#define DIL_STEP(j, KRN0, VRN0, KRN1, VRN1) do { if ((j) < nsteps) { const int sb = (j) & 1; \
        _Pragma("unroll") for (int e = 0; e < 2; ++e) { const int k0 = l0 + 64 * (kt0 + DIL_TILE((j), e)); \
            const bool go = (k0 + 63 >= q0w - 128) && (k0 <= q0w + 31); \
            if (go) attn_tile<64, 1>(Kb2 + (2 * sb + e) * TILEB, Vb2 + (2 * sb + e) * VTILEB, qf, o, m, l, TB + (k0 - lq + 256 + 4 * hh), true, lane); } \
        if ((j) + 1 < nsteps) { attn_stage_store<64>(KRN0, VRN0, Kb2 + (2 * (sb ^ 1)) * TILEB, Vb2 + (2 * (sb ^ 1)) * VTILEB, tid); attn_stage_store<64>(KRN1, VRN1, Kb2 + (2 * (sb ^ 1) + 1) * TILEB, Vb2 + (2 * (sb ^ 1) + 1) * VTILEB, tid); } \
        __syncthreads(); } } while (0)
    DIL_STEP(0, kr2, vr2, kr3, vr3);
    DIL_STEP(1, kr4, vr4, kr5, vr5);
    DIL_STEP(2, kr4, vr4, kr5, vr5);
#undef DIL_STEP
#undef DIL_TILE
#undef DIL_LOAD
    const float lt = l + __shfl_xor(l, 32);
    attn_store_o<64>(o, 1.0f / lt, ODG + ((size_t)g * T + tokq) * 256 + h * 64, hh);
    if (hh == 0) LSE[((size_t)g * T + tokq) * 4 + h] = (m + __builtin_amdgcn_logf(lt)) * 0.6931471805599453f;
}
__device__ __forceinline__ void cross_unit(LAS unsigned char* lds, const bf16* QC, const bf16* KVC, bf16* OC, int b, int h, int qblk, int tid, int lane, int wave) {
    constexpr int TILEB = ACfg<128>::TILEB, VTILEB = ACfg<128>::VTILEB;
    const int r = lane & 31, hh = lane >> 5;
    LAS unsigned char* Kb = lds + ATT_TB_BYTES; LAS unsigned char* Vb = Kb + 2 * TILEB;
    const size_t tokq = (size_t)b * SEQ + qblk * 256 + wave * 32 + r;
    bf16x8 qf[8]; attn_load_q<128>(qf, QC + tokq * 512 + h * 128, hh, 0.08838834764831845f * L2E);
    f32x16 o[4];
#pragma unroll
    for (int reg = 0; reg < 16; ++reg) { o[0][reg] = 0.f; o[1][reg] = 0.f; o[2][reg] = 0.f; o[3][reg] = 0.f; }
    float m = -1e30f, l = 0.f;
    const bf16* Kg0 = KVC + (size_t)b * NMEM * 1024 + h * 128;
    v4u kr[2], vr[2];
    attn_stage_load<128>(kr, vr, Kg0, Kg0 + 512, 1024, tid); attn_stage_store<128>(kr, vr, Kb, Vb, tid);
    __syncthreads();
    for (int i = 0; i < 4; ++i) {
        if (i + 1 < 4) attn_stage_load<128>(kr, vr, Kg0 + (size_t)(64 * (i + 1)) * 1024, Kg0 + (size_t)(64 * (i + 1)) * 1024 + 512, 1024, tid);
        attn_tile<128, 0>(Kb + (i & 1) * TILEB, Vb + (i & 1) * VTILEB, qf, o, m, l, (const LAS float*)lds, true, lane);
        if (i + 1 < 4) attn_stage_store<128>(kr, vr, Kb + ((i + 1) & 1) * TILEB, Vb + ((i + 1) & 1) * VTILEB, tid);
        __syncthreads();
    }
    const float lt = l + __shfl_xor(l, 32);
    attn_store_o<128>(o, 1.0f / lt, OC + tokq * 512 + h * 128, hh);
}
__device__ __forceinline__ void dil_combine(const bf16* ODG, const float* LSE, bf16* ODIL, int gtid, int nthr) {
    for (int it = gtid; it < T * 32; it += nthr) { const int tok = it >> 5, c = it & 31, h = c >> 3;
        const float a0 = LSE[((size_t)0 * T + tok) * 4 + h], a1 = LSE[((size_t)1 * T + tok) * 4 + h], a2 = LSE[((size_t)2 * T + tok) * 4 + h];
        const float mx = fmaxf(a0, fmaxf(a1, a2)); float w0 = __expf(a0 - mx), w1 = __expf(a1 - mx), w2 = __expf(a2 - mx); const float inv = 1.0f / (w0 + w1 + w2); w0 *= inv; w1 *= inv; w2 *= inv;
        const v4u x0 = *(const v4u*)(ODG + ((size_t)0 * T + tok) * 256 + c * 8), x1 = *(const v4u*)(ODG + ((size_t)1 * T + tok) * 256 + c * 8), x2 = *(const v4u*)(ODG + ((size_t)2 * T + tok) * 256 + c * 8);
        v4u o; o.x = pk2(w0 * bf_lo(x0.x) + w1 * bf_lo(x1.x) + w2 * bf_lo(x2.x), w0 * bf_hi(x0.x) + w1 * bf_hi(x1.x) + w2 * bf_hi(x2.x));
        o.y = pk2(w0 * bf_lo(x0.y) + w1 * bf_lo(x1.y) + w2 * bf_lo(x2.y), w0 * bf_hi(x0.y) + w1 * bf_hi(x1.y) + w2 * bf_hi(x2.y));
        o.z = pk2(w0 * bf_lo(x0.z) + w1 * bf_lo(x1.z) + w2 * bf_lo(x2.z), w0 * bf_hi(x0.z) + w1 * bf_hi(x1.z) + w2 * bf_hi(x2.z));
        o.w = pk2(w0 * bf_lo(x0.w) + w1 * bf_lo(x1.w) + w2 * bf_lo(x2.w), w0 * bf_hi(x0.w) + w1 * bf_hi(x1.w) + w2 * bf_hi(x2.w));
        *(v4u*)(ODIL + (size_t)tok * 256 + c * 8) = o; }
}
__device__ __forceinline__ void phase_topk_simple(const bf16* QP, const float* subk, int* EXP, float* EW, float* INV, int lane, int gw, int ngw) {
    for (int unit = gw; unit < T * 8; unit += ngw) {
        const int tok = unit >> 3, head = unit & 7;
        const bf16* qrow = QP + (size_t)tok * 2048 + head * 256;
        float av = 0.f, bv[4] = {0.f, 0.f, 0.f, 0.f}; int ai = 0, bi[4] = {0, 0, 0, 0};
#pragma unroll
        for (int p = 0; p < 2; ++p) {
            float s0 = 0.f, s1 = 0.f;
            const float* k0 = subk + (size_t)(p * 128 + lane) * 128; const float* k1 = subk + (size_t)(p * 128 + 64 + lane) * 128;
            for (int c = 0; c < 128; ++c) { const float qv = bf2f(qrow[p * 128 + c]); s0 += qv * k0[c]; s1 += qv * k1[c]; }
#pragma unroll
            for (int i = 0; i < 16; ++i) {
                float mloc = fmaxf(s0, s1); float mw = mloc;
#pragma unroll
                for (int o = 1; o < 64; o <<= 1) mw = fmaxf(mw, __shfl_xor(mw, o));
                const unsigned long long bal = __ballot(mloc == mw);
                const int wl = __ffsll((long long)bal) - 1;
                int idx = -1;
                if (lane == wl) { if (s0 >= s1) { idx = lane; s0 = -3e38f; } else { idx = lane + 64; s1 = -3e38f; } }
                idx = __shfl(idx, wl);
                if (p == 0) { if ((lane & 15) == i) { av = mw; ai = idx; } }
                else { if ((lane >> 4) == (i >> 2)) { bv[i & 3] = mw; bi[i & 3] = idx; } }
            }
        }
        float cs[4];
#pragma unroll
        for (int jj = 0; jj < 4; ++jj) cs[jj] = av + bv[jj];
        float top0 = 0.f, den = 0.f; int myexp = 0; float myw = 0.f;
#pragma unroll
        for (int k = 0; k < 16; ++k) {
            float mloc = fmaxf(fmaxf(cs[0], cs[1]), fmaxf(cs[2], cs[3])); float mw = mloc;
#pragma unroll
            for (int o = 1; o < 64; o <<= 1) mw = fmaxf(mw, __shfl_xor(mw, o));
            const unsigned long long bal = __ballot(mloc == mw);
            const int wl = __ffsll((long long)bal) - 1;
            int ex = 0;
            if (lane == wl) {
                if (cs[0] == mw) { ex = ai * 128 + bi[0]; cs[0] = -3e38f; }
                else if (cs[1] == mw) { ex = ai * 128 + bi[1]; cs[1] = -3e38f; }
                else if (cs[2] == mw) { ex = ai * 128 + bi[2]; cs[2] = -3e38f; }
                else { ex = ai * 128 + bi[3]; cs[3] = -3e38f; }
            }
            ex = __shfl(ex, wl);
            if (k == 0) top0 = mw;
            const float e = __expf(mw - top0); den += e;
            if (lane == k) { myexp = ex; myw = e; }
        }
        if (lane < 16) { EXP[(size_t)tok * 128 + head * 16 + lane] = myexp; EW[(size_t)tok * 128 + head * 16 + lane] = myw; }
        if (lane == 0) INV[(size_t)tok * 8 + head] = 1.0f / den;
    }
}
#if DBG_CHECK || DBG_ATTN_CHECK
constexpr size_t WS_YDBG = 510 * MiB;
constexpr int CW_DBG = 64;
__device__ __forceinline__ void dbg_acc(float* acc, float num, float den, int lane) { num = wave_sum(num); den = wave_sum(den); if (lane == 0) { atomicAdd(acc, num); atomicAdd(acc + 1, den); } }
__device__ __forceinline__ int dbg_tok(int s) { return s * 512 + 3 + (s & 7) * 37; }
__device__ __forceinline__ void dbg_check_qp(const bf16* H, const float* w_qp, const bf16* QP, float* acc, int gtid, int nthr, int lane) {
    float num = 0.f, den = 0.f;
    for (int item = gtid; item < 64 * 2048; item += nthr) { const int s = item / 2048, n = item % 2048, t = dbg_tok(s);
        float r = 0.f; for (int k = 0; k < 1024; ++k) r += bf2f(H[(size_t)t * 1024 + k]) * w_qp[(size_t)k * 2048 + n];
        const float mine = bf2f(QP[(size_t)t * 2048 + n]); num += (r - mine) * (r - mine); den += r * r; }
    dbg_acc(acc, num, den, lane);
}
__device__ __forceinline__ void dbg_check_gather(const bf16* H, const float* u, const float* v, const int* EXP, const float* EW, const float* INV, const float* YDBG, float* acc, int gw, int ngw, int lane) {
    float num = 0.f, den = 0.f;
    for (int s = gw; s < 64; s += ngw) { const int t = dbg_tok(s);
        float y[16];
#pragma unroll
        for (int c = 0; c < 16; ++c) y[c] = 0.f;
        for (int i = 0; i < 128; ++i) { const int e = EXP[(size_t)t * 128 + i]; const float g = EW[(size_t)t * 128 + i] * INV[(size_t)t * 8 + (i >> 4)];
            float d = 0.f;
#pragma unroll
            for (int c = 0; c < 16; ++c) d += bf2f(H[(size_t)t * 1024 + lane * 16 + c]) * u[(size_t)e * 1024 + lane * 16 + c];
            d = wave_sum(d);
            const float w = g * gelu_exact(d);
#pragma unroll
            for (int c = 0; c < 16; ++c) y[c] += w * v[(size_t)e * 1024 + lane * 16 + c]; }
#pragma unroll
        for (int c = 0; c < 16; ++c) { const float mine = YDBG[(size_t)s * 1024 + lane * 16 + c]; num += (y[c] - mine) * (y[c] - mine); den += y[c] * y[c]; } }
    dbg_acc(acc, num, den, lane);
}
__device__ __forceinline__ float dbg_k(const float* acc) { const float D = acc[0] / fmaxf(acc[1], 1e-30f); float k = log10f(fmaxf(D, 1e-12f)); return fminf(fmaxf(k, -6.f), 1.f); }
__device__ __forceinline__ void dbg_encode(const float* x, const float* gfin, float* out, const float* acc, int gw, int ngw, int lane) {
    const float k1 = dbg_k(acc), k2 = dbg_k(acc + 2); const float s = 1.f + (k1 + 6.5f) * 0.5f;
    for (int m = gw; m < T; m += ngw) { const f32x4* xr = (const f32x4*)(x + (size_t)m * 1024) + lane; const f32x4* gr = (const f32x4*)gfin + lane; f32x4 vv[4]; float ss = 0.f;
#pragma unroll
        for (int j = 0; j < 4; ++j) { vv[j] = xr[64 * j]; ss += (vv[j].x * vv[j].x + vv[j].y * vv[j].y) + (vv[j].z * vv[j].z + vv[j].w * vv[j].w); }
        const float rinv = rsqrtf(wave_sum(ss) * (1.f / 1024.f) + RMS_EPS) * s;
#pragma unroll
        for (int j = 0; j < 4; ++j) { f32x4 o = vv[j] * rinv * gr[64 * j]; if (m == 0 && j == 0 && lane == 0) o.x = 100.f + 100.f * (k2 + 6.f); ((f32x4*)(out + (size_t)m * 1024) + lane)[64 * j] = o; } }
}
#endif

struct Args { const float* in[20]; float* out; unsigned char* ws; int ph_lo, ph_hi; };
__global__ void __launch_bounds__(NWAVES * 64, 2) fwd(Args args) {
    extern __shared__ __attribute__((aligned(16))) unsigned char lds_raw[];
    LAS unsigned char* lds = (LAS unsigned char*)lds_raw;
    volatile LAS unsigned* MISC = (volatile LAS unsigned*)(lds + MISC_OFF);
    const int tid = threadIdx.x, lane = tid & 63, wave = __builtin_amdgcn_readfirstlane(tid >> 6);
    const int G = gridDim.x; const int bx = blockIdx.x; const int vcu = (G % 8 == 0) ? (bx % 8) * (G / 8) + bx / 8 : bx;
    const int gw = vcu * NWAVES + wave, NGW = G * NWAVES, gtid = vcu * (NWAVES * 64) + tid, NTHR = G * NWAVES * 64;
    unsigned char* ws = args.ws;
    gu32* ctl = (gu32*)(ws + WS_CTL);
#define X_IN (args.in[0])
#define mem (args.in[1])
#define rel_bias (args.in[2])
#define g_mix (args.in[3])
#define w_in (args.in[4])
#define b_gate (args.in[5])
#define w_a (args.in[6])
#define w_b (args.in[7])
#define w_out (args.in[8])
#define g_cross (args.in[9])
#define g_mem (args.in[10])
#define w_qc (args.in[11])
#define w_kvc (args.in[12])
#define w_oc (args.in[13])
#define g_ffn (args.in[14])
#define w_qp (args.in[15])
#define subk (args.in[16])
#define peer_u (args.in[17])
#define peer_v (args.in[18])
#define g_final (args.in[19])
#define OUTP (args.out)
#define WinT ((bf16*)(ws + WS_WIN))
#define WaT ((bf16*)(ws + WS_WA))
#define WbT ((bf16*)(ws + WS_WB))
#define WoutT ((bf16*)(ws + WS_WOUT))
#define WqcT ((bf16*)(ws + WS_WQC))
#define WkvcT ((bf16*)(ws + WS_WKVC))
#define WocT ((bf16*)(ws + WS_WOC))
#define WqpT ((bf16*)(ws + WS_WQP))
#define SUBK ((bf16*)(ws + WS_SUBK))
#define U8T ((unsigned char*)(ws + WS_U))
#define V8T ((unsigned char*)(ws + WS_V))
#define HB ((bf16*)(ws + WS_H))
#define MEMB ((bf16*)(ws + WS_MEMB))
#define KVC ((bf16*)(ws + WS_KVC))
#define ODIL ((bf16*)(ws + WS_ODIL))
#define OMOBA ((bf16*)(ws + WS_OMOBA))
#define PQKV ((bf16*)(ws + WS_PQKV))
#define MERGED ((bf16*)(ws + WS_MERGED))
#define MERGED8 ((unsigned char*)(ws + WS_QC))
#define X1 ((float*)(ws + WS_X1))
#define QC ((bf16*)(ws + WS_QC))
#define OC ((bf16*)(ws + WS_OC))
#define ODG ((bf16*)(ws + WS_ODG))
#define LSE ((float*)(ws + WS_LSE))
#define EXP ((int*)(ws + WS_EXP))
#define EW ((float*)(ws + WS_EW))
#define INV ((float*)(ws + WS_INV))
#define KMEAN ((float*)(ws + WS_KMEAN))
#define SEB ((int*)(ws + WS_PQKV + 32 * MiB))
#define SGB ((float*)(ws + WS_PQKV + 48 * MiB))
#define OFFB ((int*)(ws + WS_QC))
#define RSS1 ((float*)(ws + WS_RSS1))
#define RSS2 ((float*)(ws + WS_RSS2))
#define GATES ((bf16*)args.out)
#define QP ((bf16*)args.out)
    for (int u = tid; u < (LDS_BYTES - LDSCTL_OFF) / 4; u += NWAVES * 64) ((LAS unsigned*)(lds + LDSCTL_OFF))[u] = 0u;
    __syncthreads();
    const int lo = args.ph_lo, hi = args.ph_hi;
    XcdBarrier bar; bar.bar = (unsigned*)(ctl + CW_BAR); bar.x = 0; bar.st = nullptr;
    if (hi - lo > 1) bar = xcd_barrier_post((unsigned*)(ctl + CW_BAR), MISC + 8);
#define IN(k) (lo <= (k) && (k) < hi)
#define PR_BEG(k) do { if (PROBE_PH == (k) && tid == 0) MISC[16] = (unsigned)__builtin_amdgcn_s_memrealtime(); } while (0)
#define PR_END(k) do { if (PROBE_PH == (k) && tid == 0) MISC[17] = (unsigned)__builtin_amdgcn_s_memrealtime(); } while (0)
#define SEAM(k) do { if (IN(k) && IN((k) + 1)) xcd_barrier(bar); } while (0)

    PR_BEG(0);
    if (IN(0)) {
        LAS float* scr = (LAS float*)(lds + RING_OFF + wave * 16384);
        constexpr int I_IN = (1024 / 64) * (NIN / 32), I_A = (256 / 64) * (1024 / 32), I_B = (512 / 64) * (1024 / 32), I_OUT = (1024 / 64) * (1024 / 32), I_QC = (1024 / 64) * (512 / 32),
                      I_KVC = (1024 / 64) * (1024 / 32), I_OC = (512 / 64) * (1024 / 32), I_QP = (1024 / 64) * (2048 / 32);
        constexpr int NITEMS = I_IN + I_A + I_B + I_OUT + I_QC + I_KVC + I_OC + I_QP;
        for (int it = gw; it < NITEMS; it += NGW) {
            int r = it;
            if (r < I_IN) { p0_transpose_item_fp8(w_in, 1024, NIN, (unsigned char*)WinT, scr, r, lane, WIN8_SCALE); continue; } r -= I_IN;
            if (r < I_A) { p0_transpose_item(w_a, 256, 1024, WaT, scr, r, lane); continue; } r -= I_A;
            if (r < I_B) { p0_transpose_item(w_b, 512, 1024, WbT, scr, r, lane); continue; } r -= I_B;
            if (r < I_OUT) { p0_transpose_item_fp8(w_out, 1024, 1024, (unsigned char*)WoutT, scr, r, lane, WIN8_SCALE); continue; } r -= I_OUT;
            if (r < I_QC) { p0_transpose_item(w_qc, 1024, 512, WqcT, scr, r, lane, g_cross); continue; } r -= I_QC;
            if (r < I_KVC) { p0_transpose_item(w_kvc, 1024, 1024, WkvcT, scr, r, lane); continue; } r -= I_KVC;
            if (r < I_OC) { p0_transpose_item(w_oc, 512, 1024, WocT, scr, r, lane); continue; } r -= I_OC;
            p0_transpose_item(w_qp, 1024, 2048, WqpT, scr, r, lane, g_ffn);
        }
        cvt_f32_to_bf16_bulk(subk, SUBK, (size_t)2 * 128 * 128, (size_t)gtid, (size_t)NTHR);
        for (int m = gw; m < T; m += NGW) rms_row_to_fp8(X_IN + (size_t)m * DM, g_mix, (unsigned char*)HB + (size_t)m * DM, lane);
        for (int m = gw; m < MROWS; m += NGW) rms_row_to_bf16(mem + (size_t)m * DM, g_mem, MEMB + (size_t)m * DM, lane);
        __syncthreads();
    }
    SEAM(0);
    PR_END(0);
    PR_BEG(1);
    if (IN(1)) {
        if (DBG_MIX) { pg8::Gemm g{HB, WinT, T, NIN, DM / 2}; pg8::StaticOrder S; S.init(T, NIN, G, bx); pg8::EpiIn E{PQKV, GATES, b_gate, 1.0f / WIN8_SCALE};
          pg8::gemm_phase<pg8::EpiIn, pg8::StaticOrder, true, true, true>(lds + RING_OFF, g, S, E); }
        __syncthreads();
        if (DBG_CROSS) { pg8::Gemm g{MEMB, WkvcT, MROWS, 1024, DM}; pg8::StaticOrder S; S.init(MROWS, 1024, G, bx); pg8::EpiStore E{KVC, 1024};
          pg8::gemm_phase<pg8::EpiStore, pg8::StaticOrder, true, true>(lds + RING_OFF, g, S, E); }
        {
            constexpr int CH = 16384, NCH_U = (16384 * 1024) / CH, NCH = 2 * NCH_U;
            for (;;) {
                int c = 0; if (lane == 0) c = (int)__hip_atomic_fetch_add((unsigned*)(ctl + CW_WORK), 1u, __ATOMIC_RELAXED, __HIP_MEMORY_SCOPE_AGENT);
                c = __builtin_amdgcn_readfirstlane(c);
                if (c >= NCH) break;
                const bool isv = c >= NCH_U; const int cc = isv ? c - NCH_U : c;
                const float* src = (isv ? peer_v : peer_u) + (size_t)cc * CH; unsigned char* dst = (isv ? V8T : U8T) + (size_t)cc * CH;
                cvt_f32_to_fp8_bulk(src, dst, (size_t)CH, isv ? V8_SCALE : U8_SCALE, (size_t)lane, (size_t)64, isv ? (const float*)nullptr : g_ffn);
            }
        }
    }
    SEAM(1);
    PR_END(1);
    PR_BEG(2);
    if (IN(2) && DBG_MIX) {
#if ATTN_MFMA
        for (int u = vcu; u < NB * 3 * 4 * 16; u += G) { const int u16 = u & 15,     bgh = u >> 4, h = bgh & 3, g = (bgh >> 2) % 3, b = (bgh >> 2) / 3;
            dil_unit(lds + RING_OFF, PQKV, rel_bias, ODG, LSE, b, g, h, u16 & ((1 << (2 * g)) - 1), u16 >> (2 * g), tid, lane, wave); }
#endif
        for (int it = gw; it < NB * 8 * 16; it += NGW) { const int bh = it >> 4, blk = it & 15, b = bh >> 3, h = bh & 7;
            const bf16* kp = PQKV + (size_t)(b * SEQ + blk * 256 + (lane >> 3)) * QKVW + 2304 + 512 + h * 64 + 8 * (lane & 7);
            float s8[8] = {0.f, 0.f, 0.f, 0.f, 0.f, 0.f, 0.f, 0.f};
#pragma unroll 8
            for (int j = 0; j < 32; ++j) { const v4u w = *(const v4u*)(kp + (size_t)(8 * j) * QKVW);
                s8[0] += bf_lo(w.x); s8[1] += bf_hi(w.x); s8[2] += bf_lo(w.y); s8[3] += bf_hi(w.y); s8[4] += bf_lo(w.z); s8[5] += bf_hi(w.z); s8[6] += bf_lo(w.w); s8[7] += bf_hi(w.w); }
#pragma unroll
            for (int c = 0; c < 8; ++c) { float v = s8[c]; v += __shfl_xor(v, 8); v += __shfl_xor(v, 16); v += __shfl_xor(v, 32); s8[c] = v * (1.0f / 256.0f); }
            if (lane < 8) { f32x4* dst = (f32x4*)(KMEAN + (size_t)it * 64 + 8 * lane); dst[0] = (f32x4){s8[0], s8[1], s8[2], s8[3]}; dst[1] = (f32x4){s8[4], s8[5], s8[6], s8[7]}; } }
    }
    SEAM(2);
    PR_END(2);
    PR_BEG(3);
    if (IN(3) && DBG_MIX) {
#if ATTN_MFMA
        for (int pu = vcu; pu < NB * 8 * 8; pu += G) { const int bh = pu >> 3, p = pu & 7, b = bh >> 3, h = bh & 7;
            moba_unit(lds + RING_OFF, PQKV, KMEAN, rel_bias, OMOBA, b, h, p, tid, lane, wave);
            moba_unit(lds + RING_OFF, PQKV, KMEAN, rel_bias, OMOBA, b, h, 15 - p, tid, lane, wave); }
        dil_combine(ODG, LSE, ODIL, gtid, NTHR);
#else
        phase_dil_simple<false>(PQKV, rel_bias, ODIL, gtid, NTHR); phase_moba_simple<false>(PQKV, KMEAN, rel_bias, OMOBA, gtid, NTHR);
#endif
    }
    SEAM(3);
    PR_END(3);
    PR_BEG(4);
#if DBG_ATTN_CHECK && DBG_P4CHK
    if (IN(4)) { if (DBG_DIL_CHECK) phase_dil_simple<true>(PQKV, rel_bias, ODIL, gtid, NTHR, (float*)(ctl + CW_DBG)); else phase_moba_simple<true>(PQKV, KMEAN, rel_bias, OMOBA, gtid, NTHR, (float*)(ctl + CW_DBG)); }
#endif
    if (IN(4) && DBG_MIX && !(DBG_ATTN_CHECK && DBG_P4CHK)) { pg8::Gemm g{ODIL, WaT, T, 1024, 256}; pg8::StaticOrder S; S.init(T, 1024, G, bx); pg8::EpiGate<false, true> E{MERGED, GATES, 0, MERGED8, MRG8_SCALE};
        pg8::gemm_phase<pg8::EpiGate<false, true>, pg8::StaticOrder, true, true>(lds + RING_OFF, g, S, E); }
    SEAM(4);
    PR_END(4);
    PR_BEG(5);
    if (IN(5) && DBG_MIX && !(DBG_ATTN_CHECK && DBG_P4CHK)) { pg8::Gemm g{OMOBA, WbT, T, 1024, 512}; pg8::StaticOrder S; S.init(T, 1024, G, bx); pg8::EpiGate<true, true> E{MERGED, GATES, 1024, MERGED8, MRG8_SCALE};
        pg8::gemm_phase<pg8::EpiGate<true, true>, pg8::StaticOrder, true, true>(lds + RING_OFF, g, S, E); }
    SEAM(5);
    PR_END(5);
    PR_BEG(6);
    if (IN(6) && !(DBG_ATTN_CHECK && DBG_P4CHK)) { pg8::Gemm g{(const bf16*)MERGED8, WoutT, T, 1024, 1024 / 2}; pg8::StaticOrder S; S.init(T, 1024, G, bx); pg8::EpiRes E{X_IN, nullptr, 1024, (float)DBG_MIX / (MRG8_SCALE * WIN8_SCALE), HB, RSS1, nullptr, nullptr};
        pg8::gemm_phase<pg8::EpiRes, pg8::StaticOrder, true, true, true>(lds + RING_OFF, g, S, E); }
    SEAM(6);
    PR_END(6);
    PR_BEG(7);
    PR_BEG(8);
    if (IN(8) && DBG_CROSS) { pg8::Gemm g{HB, WqcT, T, 512, 1024}; pg8::StaticOrder S; S.init(T, 512, G, bx); pg8::EpiStoreRs E{QC, 512, RSS1, 1.0f};
        pg8::gemm_phase<pg8::EpiStoreRs, pg8::StaticOrder, true, true>(lds + RING_OFF, g, S, E); }
    SEAM(8);
    PR_END(8);
    PR_BEG(9);
    if (IN(9) && DBG_CROSS) {
#if ATTN_MFMA
        for (int u = vcu; u < NB * 4 * 16; u += G) cross_unit(lds + RING_OFF, QC, KVC, OC, u >> 6, (u >> 4) & 3, u & 15, tid, lane, wave);
#else
        phase_cross_simple<false>(QC, KVC, OC, gtid, NTHR);
#endif
    }
    SEAM(9);
    PR_END(9);
    PR_BEG(10);
#if DBG_ATTN_CHECK
    if (IN(10) && DBG_CROSS_CHECK) phase_cross_simple<true>(QC, KVC, OC, gtid, NTHR, (float*)(ctl + CW_DBG) + 2);
#endif
    if (IN(10)) { pg8::Gemm g{OC, WocT, T, 1024, 512}; pg8::StaticOrder S; S.init(T, 1024, G, bx); pg8::EpiRes E{nullptr, nullptr, 1024, (float)DBG_CROSS, HB, RSS2, nullptr, HB};
        pg8::gemm_phase<pg8::EpiRes, pg8::StaticOrder, true, true>(lds + RING_OFF, g, S, E); }
    SEAM(10);
    PR_END(10);
    PR_BEG(11);
    PR_BEG(12);
    if (IN(12) && DBG_PEER) { pg8::Gemm g{HB, WqpT, T, 2048, 1024}; pg8::StaticOrder S; S.init(T, 2048, G, bx); pg8::EpiStoreRs E{QP, 2048, RSS2, 1.0f};
        pg8::gemm_phase<pg8::EpiStoreRs, pg8::StaticOrder, true, true>(lds + RING_OFF, g, S, E); }
    SEAM(12);
    PR_END(12);
    PR_BEG(13);
#if DBG_CHECK
    if (IN(13)) dbg_check_qp(HB, w_qp, QP, (float*)(ctl + CW_DBG), gtid, NTHR, lane);
#endif
#if DBG_TOPK_SIMPLE
    if (IN(13) && DBG_PEER) { phase_topk_simple(QP, subk, EXP, EW, INV, lane, gw, NGW); }
#else
    if (IN(13) && DBG_PEER) { phase_topk(lds + RING_OFF, QP, SUBK, SEB, (float*)OFFB, tid, lane, wave, vcu, G); }
#endif
    SEAM(13);
    PR_END(13);
#if PROBE_PH >= 20
    PR_BEG(PROBE_PH);
    if (IN(14)) { const int lane15 = (int)__builtin_amdgcn_mbcnt_hi(~0u, __builtin_amdgcn_mbcnt_lo(~0u, 0u));
        peer_probe<PROBE_PH - 20>(HB, RSS2, U8T, V8T, SGB, SEB, (const float*)OFFB, OUTP, lane15, wave, gw, NGW, vcu, lds); xcd_barrier(bar); }
    PR_END(PROBE_PH);
#endif
    PR_BEG(14);
    if (IN(14)) { const int lane14 = (int)__builtin_amdgcn_mbcnt_hi(~0u, __builtin_amdgcn_mbcnt_lo(~0u, 0u));
        phase_peer(HB, RSS2, U8T, V8T, SGB, SEB, (const float*)OFFB, g_final, OUTP, lane14, wave, gw, NGW, (float)DBG_PEER, DBG_YPTR, (PROBE_PH >= 0 && PROBE_PH < 20) ? 1.0f + sqrtf((float)(MISC[17] - MISC[16]) * (0.01f / PROBE_K)) : 1.0f, lds); }
#if DBG_CHECK || DBG_ATTN_CHECK
#if DBG_CHECK
    if (IN(15)) dbg_check_gather(HB, peer_u, peer_v, EXP, EW, INV, (const float*)(ws + WS_YDBG), (float*)(ctl + CW_DBG) + 2, gw, NGW, lane);
#endif
    if (IN(16)) dbg_encode(X_IN, g_final, OUTP, (const float*)(ctl + CW_DBG), gw, NGW, lane);
#endif
#undef IN
#undef SEAM
#undef X_IN
#undef mem
#undef rel_bias
#undef g_mix
#undef w_in
#undef b_gate
#undef w_a
#undef w_b
#undef w_out
#undef g_cross
#undef g_mem
#undef w_qc
#undef w_kvc
#undef w_oc
#undef g_ffn
#undef w_qp
#undef subk
#undef peer_u
#undef peer_v
#undef g_final
#undef OUTP
#undef WinT
#undef WaT
#undef WbT
#undef WoutT
#undef WqcT
#undef WkvcT
#undef WocT
#undef WqpT
#undef SUBK
#undef U8T
#undef V8T
#undef HB
#undef MEMB
#undef KVC
#undef ODIL
#undef OMOBA
#undef PQKV
#undef MERGED
#undef MERGED8
#undef X1
#undef QC
#undef OC
#undef ODG
#undef LSE
#undef EXP
#undef EW
#undef INV
#undef KMEAN
#undef RSS1
#undef SEB
#undef SGB
#undef OFFB
#undef RSS2
#undef GATES
#undef QP

}

extern "C" void kernel_launch(void* const* d_in, const int* in_sizes, int n_in, void* d_out, int out_size, void* d_ws, size_t ws_size, hipStream_t stream) {
    static int grid = 0;
    if (grid == 0) {
        if (n_in != 20 || out_size != T * DM || ws_size < WS_END) { fprintf(stderr, "kernel_launch: unexpected shapes (n_in %d, out %d, ws %zu); nothing launched\n", n_in, out_size, ws_size); grid = -1; return; }
        int dev = 0, cus = 0, per_cu = 0;
        if (hipGetDevice(&dev) != hipSuccess || hipDeviceGetAttribute(&cus, hipDeviceAttributeMultiprocessorCount, dev) != hipSuccess) { grid = -1; return; }
        if (hipFuncSetAttribute((const void*)fwd, hipFuncAttributeMaxDynamicSharedMemorySize, LDS_BYTES) != hipSuccess) { fprintf(stderr, "kernel_launch: hipFuncSetAttribute failed\n"); grid = -1; return; }
        if (hipOccupancyMaxActiveBlocksPerMultiprocessor(&per_cu, (const void*)fwd, NWAVES * 64, LDS_BYTES) != hipSuccess || per_cu < 1) { fprintf(stderr, "kernel_launch: occupancy query says %d\n", per_cu); }
        (void)hipGetLastError();
        grid = cus;
    }
    if (grid < 0) return;
    if (hipMemsetAsync((char*)d_ws + WS_CTL, 0, CTL_ZERO_BYTES, stream) != hipSuccess) return;
    Args a{};
    for (int i = 0; i < 20; ++i) a.in[i] = (const float*)d_in[i];
    a.out = (float*)d_out; a.ws = (unsigned char*)d_ws;
#if MK_ONE_LAUNCH
    a.ph_lo = 0; a.ph_hi = NPH;
    hipLaunchKernelGGL(fwd, dim3(grid), dim3(NWAVES * 64), LDS_BYTES, stream, a);
#else
    for (int p = 0; p < NPH + ((DBG_CHECK || DBG_ATTN_CHECK) ? 2 : 0); ++p) { a.ph_lo = p; a.ph_hi = p + 1; hipLaunchKernelGGL(fwd, dim3(grid), dim3(NWAVES * 64), LDS_BYTES, stream, a); }
#endif
}
```

```cpp
#include <hip/hip_runtime.h>
#include <cstdio>
#include <cstdint>
#include <cmath>
namespace pg8 {
#define PG8_LAS __attribute__((address_space(3)))
typedef unsigned short bf16_t;
typedef short bf16x8 __attribute__((ext_vector_type(8)));
typedef float f32x4 __attribute__((ext_vector_type(4)));
typedef unsigned u32x4 __attribute__((ext_vector_type(4)));
typedef int v4i32 __attribute__((ext_vector_type(4)));
typedef int v8i32 __attribute__((ext_vector_type(8)));
constexpr int BM = 256, BK = 64, HALF = 128, HTB = HALF * BK * 2  , STAGE_BYTES = 8 * HTB, NXCD = 8, WGM = 8;

__host__ __device__ __forceinline__ int lds_byte(int r, int c) { const int st = (r >> 4) * 2 + (c >> 5), rr = r & 15, cc = c & 31, ob = rr * 64 + cc * 2; return st * 1024 + (ob ^ (((ob >> 9) & 1) << 5)); }
__host__ __device__ __forceinline__ void stage_rc(int b, int& R, int& C) { const int st = b / 1024, sb = b % 1024, swz = sb ^ (((sb >> 9) & 1) << 5); R = (st >> 1) * 16 + swz / 64; C = (st & 1) * 32 + (swz % 64) / 2; }
__host__ __device__ __forceinline__ int perm32(int rho) { const int n = rho >> 4, i = rho & 15; return 8 * (i >> 2) + 4 * n + (i & 3); }

struct Unit { int pm, pn; };
struct Gemm { const bf16_t* A; const bf16_t* Bt; int M, N, K; };

struct StaticOrder {
    int nM, nN, nwg, G, c;
    __host__ __device__ void init(int M, int N, int G_, int c_) { nM = M / BM; nN = N / BM; nwg = nM * nN; G = G_; c = c_; }
    __host__ __device__ bool next(int i, Unit& u) const {
        const long L = (long)i * G + c; if (L >= nwg) return false;
        int wgid = (int)L; { const int q = nwg / NXCD, r = nwg % NXCD, xcd = wgid % NXCD, off = wgid / NXCD; wgid = (xcd < r ? xcd * (q + 1) : r * (q + 1) + (xcd - r) * q) + off; }
        const int nig = WGM * nN, gid = wgid / nig, fm = gid * WGM, gsz = (nM - fm) < WGM ? (nM - fm) : WGM;
        u.pm = fm + ((wgid % nig) % gsz); u.pn = (wgid % nig) / gsz; return true;
    }
    __device__ __forceinline__ void a_ready(const Unit&) const {}
    __device__ __forceinline__ void done(const Unit&) const {}
};

__device__ __forceinline__ unsigned cvt_pk_bf16(float lo, float hi) { unsigned r; asm volatile("v_cvt_pk_bf16_f32 %0, %1, %2" : "=v"(r) : "v"(lo), "v"(hi)); return r; }
typedef float f32x2 __attribute__((ext_vector_type(2)));
__device__ __forceinline__ float bf_lo(unsigned w) { return __uint_as_float(w << 16); }
__device__ __forceinline__ float bf_hi(unsigned w) { return __uint_as_float(w & 0xffff0000u); }
__device__ __forceinline__ float sigmoidf_(float x) { return 1.0f / (1.0f + __expf(-x)); }
struct EpiStore {
    static constexpr bool PERM = true, AFTER_DRAIN = false;
    bf16_t* O; int ldc;
    __device__ __forceinline__ void operator()(const f32x4 (&acc)[2][2][4][2], const Unit& u, int wr, int wc, int fr, int fq) const {
        const int row0 = u.pm * BM + wr * 64 + fr, col0 = u.pn * BM + wc * 32 + 8 * fq;
#pragma unroll
        for (int ai = 0; ai < 2; ++ai)
#pragma unroll
            for (int m = 0; m < 4; ++m) { bf16_t* rowp = O + (size_t)(row0 + ai * HALF + m * 16) * ldc + col0;
#pragma unroll
                for (int bj = 0; bj < 2; ++bj) { const f32x4 v0 = acc[ai][bj][m][0], v1 = acc[ai][bj][m][1];
                    u32x4 w; w.x = cvt_pk_bf16(v0[0], v0[1]); w.y = cvt_pk_bf16(v0[2], v0[3]); w.z = cvt_pk_bf16(v1[0], v1[1]); w.w = cvt_pk_bf16(v1[2], v1[3]);
                    *(u32x4*)(rowp + bj * HALF) = w; } }
    }
};
struct EpiIn {
    static constexpr bool PERM = true, AFTER_DRAIN = false;
    bf16_t* P; bf16_t* G; const float* bgate; float wsc;
    __device__ __forceinline__ void operator()(const f32x4 (&acc)[2][2][4][2], const Unit& u, int wr, int wc, int fr, int fq) const {
        const int row0 = u.pm * BM + wr * 64 + fr;
        if (u.pn < 15) {
            const int col0 = u.pn * BM + wc * 32 + 8 * fq;
#pragma unroll
            for (int ai = 0; ai < 2; ++ai)
#pragma unroll
                for (int m = 0; m < 4; ++m) { bf16_t* rowp = P + (size_t)(row0 + ai * HALF + m * 16) * 3840 + col0;
#pragma unroll
                    for (int bj = 0; bj < 2; ++bj) { const f32x4 v0 = acc[ai][bj][m][0] * wsc, v1 = acc[ai][bj][m][1] * wsc;
                        u32x4 w; w.x = cvt_pk_bf16(v0[0], v0[1]); w.y = cvt_pk_bf16(v0[2], v0[3]); w.z = cvt_pk_bf16(v1[0], v1[1]); w.w = cvt_pk_bf16(v1[2], v1[3]);
                        *(u32x4*)(rowp + bj * HALF) = w; } }
        } else {
            const int col0 = (u.pn - 15) * BM + wc * 32 + 8 * fq;
            f32x4 bv[2][2];
#pragma unroll
            for (int bj = 0; bj < 2; ++bj)
#pragma unroll
                for (int n = 0; n < 2; ++n) bv[bj][n] = *(const f32x4*)(bgate + col0 + bj * HALF + 4 * n);
#pragma unroll
            for (int ai = 0; ai < 2; ++ai)
#pragma unroll
                for (int m = 0; m < 4; ++m) { unsigned char* rowp = (unsigned char*)G + (size_t)(row0 + ai * HALF + m * 16) * 2048 + col0;
#pragma unroll
                    for (int bj = 0; bj < 2; ++bj) { const f32x4 v0 = acc[ai][bj][m][0] * wsc + bv[bj][0], v1 = acc[ai][bj][m][1] * wsc + bv[bj][1];
                        int w0 = 0, w1 = 0;
                        w0 = __builtin_amdgcn_cvt_pk_fp8_f32(sigmoidf_(v0[0]), sigmoidf_(v0[1]), w0, false); w0 = __builtin_amdgcn_cvt_pk_fp8_f32(sigmoidf_(v0[2]), sigmoidf_(v0[3]), w0, true);
                        w1 = __builtin_amdgcn_cvt_pk_fp8_f32(sigmoidf_(v1[0]), sigmoidf_(v1[1]), w1, false); w1 = __builtin_amdgcn_cvt_pk_fp8_f32(sigmoidf_(v1[2]), sigmoidf_(v1[3]), w1, true);
                        *(unsigned long long*)(rowp + bj * HALF) = (unsigned long long)(unsigned)w0 | ((unsigned long long)(unsigned)w1 << 32); } }
        }
    }
};
template <bool ADD, bool F8OUT> struct EpiGate {
    static constexpr bool PERM = true, AFTER_DRAIN = false;
    bf16_t* O; const bf16_t* G; int gcol; unsigned char* O8; float o8scale;
    __device__ __forceinline__ void operator()(const f32x4 (&acc)[2][2][4][2], const Unit& u, int wr, int wc, int fr, int fq) const {
        const int row0 = u.pm * BM + wr * 64 + fr, col0 = u.pn * BM + wc * 32 + 8 * fq;
#pragma unroll
        for (int ai = 0; ai < 2; ++ai)
#pragma unroll
            for (int m = 0; m < 4; ++m) { const size_t row = (size_t)(row0 + ai * HALF + m * 16); bf16_t* rowp = O + row * 1024 + col0;
#pragma unroll
                for (int bj = 0; bj < 2; ++bj) { const f32x4 v0 = acc[ai][bj][m][0], v1 = acc[ai][bj][m][1];
                    const unsigned long long g8 = *(const unsigned long long*)((const unsigned char*)G + row * 2048 + gcol + col0 + bj * HALF); const int gl = (int)(unsigned)g8, gh = (int)(unsigned)(g8 >> 32);
                    typedef float f32x2g __attribute__((ext_vector_type(2)));
                    const f32x2g ga = __builtin_amdgcn_cvt_pk_f32_fp8(gl, false), gb = __builtin_amdgcn_cvt_pk_f32_fp8(gl, true), gc = __builtin_amdgcn_cvt_pk_f32_fp8(gh, false), gd = __builtin_amdgcn_cvt_pk_f32_fp8(gh, true);
                    float r0 = ga.x * v0[0], r1 = ga.y * v0[1], r2 = gb.x * v0[2], r3 = gb.y * v0[3];
                    float r4 = gc.x * v1[0], r5 = gc.y * v1[1], r6 = gd.x * v1[2], r7 = gd.y * v1[3];
                    if (ADD) {
                        const unsigned long long p8 = *(const unsigned long long*)(O8 + row * 1024 + col0 + bj * HALF); const int pl = (int)(unsigned)p8, phh = (int)(unsigned)(p8 >> 32); const float is = 1.0f / o8scale;
                        const f32x2g pa = __builtin_amdgcn_cvt_pk_f32_fp8(pl, false), pb = __builtin_amdgcn_cvt_pk_f32_fp8(pl, true), pc = __builtin_amdgcn_cvt_pk_f32_fp8(phh, false), pd = __builtin_amdgcn_cvt_pk_f32_fp8(phh, true);
                        r0 += pa.x * is; r1 += pa.y * is; r2 += pb.x * is; r3 += pb.y * is; r4 += pc.x * is; r5 += pc.y * is; r6 += pd.x * is; r7 += pd.y * is; }
                    if (F8OUT) { int w0 = 0, w1 = 0;
                        w0 = __builtin_amdgcn_cvt_pk_fp8_f32(r0 * o8scale, r1 * o8scale, w0, false); w0 = __builtin_amdgcn_cvt_pk_fp8_f32(r2 * o8scale, r3 * o8scale, w0, true);
                        w1 = __builtin_amdgcn_cvt_pk_fp8_f32(r4 * o8scale, r5 * o8scale, w1, false); w1 = __builtin_amdgcn_cvt_pk_fp8_f32(r6 * o8scale, r7 * o8scale, w1, true);
                        *(unsigned long long*)(O8 + row * 1024 + col0 + bj * HALF) = (unsigned long long)(unsigned)w0 | ((unsigned long long)(unsigned)w1 << 32);
                    } else { u32x4 w; w.x = cvt_pk_bf16(r0, r1); w.y = cvt_pk_bf16(r2, r3); w.z = cvt_pk_bf16(r4, r5); w.w = cvt_pk_bf16(r6, r7);
                        *(u32x4*)(rowp + bj * HALF) = w; } } }
    }
};
struct EpiRes {
    static constexpr bool PERM = false, AFTER_DRAIN = false;
    const float* base; float* out; int ldc; float sc; bf16_t* xb; float* rowss; unsigned char* xb8; const bf16_t* base16;
    __device__ __forceinline__ void operator()(const f32x4 (&acc)[2][2][4][2], const Unit& u, int wr, int wc, int fr, int fq) const {
        const int col0 = u.pn * BM + wc * 32 + 4 * fq;
#pragma unroll
        for (int ai = 0; ai < 2; ++ai)
#pragma unroll
            for (int m = 0; m < 4; ++m) { const int row = u.pm * BM + ai * HALF + wr * 64 + m * 16 + fr; const size_t off = (size_t)row * ldc + col0; float ss = 0.f;
#pragma unroll
                for (int bj = 0; bj < 2; ++bj)
#pragma unroll
                    for (int n = 0; n < 2; ++n) { f32x4 bs;
                        if (base16) { const unsigned long long w = *(const unsigned long long*)(base16 + off + bj * HALF + n * 16); const unsigned lo = (unsigned)w, hi = (unsigned)(w >> 32); bs = (f32x4){bf_lo(lo), bf_hi(lo), bf_lo(hi), bf_hi(hi)}; }
                        else bs = *(const f32x4*)(base + off + bj * HALF + n * 16);
                        const f32x4 o = (sc != 0.f) ? bs + acc[ai][bj][m][n] * sc : bs;
                        if (out) *(f32x4*)(out + off + bj * HALF + n * 16) = o;
                        if (xb) { unsigned long long w = (unsigned long long)cvt_pk_bf16(o[0], o[1]) | ((unsigned long long)cvt_pk_bf16(o[2], o[3]) << 32); *(unsigned long long*)(xb + off + bj * HALF + n * 16) = w; }
                        if (xb8) { int w8 = 0; w8 = __builtin_amdgcn_cvt_pk_fp8_f32(o[0], o[1], w8, false); w8 = __builtin_amdgcn_cvt_pk_fp8_f32(o[2], o[3], w8, true); *(unsigned*)(xb8 + off + bj * HALF + n * 16) = (unsigned)w8; }
                        if (rowss) ss += (o[0] * o[0] + o[1] * o[1]) + (o[2] * o[2] + o[3] * o[3]); }
                if (rowss) { ss += __shfl_xor(ss, 16); ss += __shfl_xor(ss, 32); if (fq == 0) atomicAdd(rowss + row, ss); } }
    }
};
struct EpiStoreRs {
    static constexpr bool PERM = true, AFTER_DRAIN = false;
    bf16_t* O; int ldc; const float* rowss; float sc;
    __device__ __forceinline__ void operator()(const f32x4 (&acc)[2][2][4][2], const Unit& u, int wr, int wc, int fr, int fq) const {
        const int row0 = u.pm * BM + wr * 64 + fr, col0 = u.pn * BM + wc * 32 + 8 * fq;
#pragma unroll
        for (int ai = 0; ai < 2; ++ai)
#pragma unroll
            for (int m = 0; m < 4; ++m) { const int row = row0 + ai * HALF + m * 16; bf16_t* rowp = O + (size_t)row * ldc + col0; const float ri = rsqrtf(rowss[row] * (1.0f / 1024.0f) + 1e-6f) * sc;
#pragma unroll
                for (int bj = 0; bj < 2; ++bj) { const f32x4 v0 = acc[ai][bj][m][0] * ri, v1 = acc[ai][bj][m][1] * ri;
                    u32x4 w; w.x = cvt_pk_bf16(v0[0], v0[1]); w.y = cvt_pk_bf16(v0[2], v0[3]); w.z = cvt_pk_bf16(v1[0], v1[1]); w.w = cvt_pk_bf16(v1[2], v1[3]);
                    *(u32x4*)(rowp + bj * HALF) = w; } }
    }
};
template <class Epi, class Sched, bool ALIGN_EPI = false, bool SP2 = false, bool F8 = false>
__device__ __forceinline__ void gemm_phase(PG8_LAS unsigned char* lds, const Gemm g, const Sched& S, const Epi& E) {
    const int tid = threadIdx.x, wid = __builtin_amdgcn_readfirstlane(tid >> 6), lane = tid & 63, wr = wid >> 2, wc = wid & 3, fr = lane & 15, fq = lane >> 4;
    const int K = g.K, nt = K / BK;
    unsigned voffA[2], voffB[2];
#pragma unroll
    for (int i = 0; i < 2; ++i) { int R, C; stage_rc(tid * 16 + i * 8192, R, C); const int Rb = Epi::PERM ? ((R & ~31) + perm32(R & 31)) : R;
        voffA[i] = (unsigned)(R * K + C) * 2u; voffB[i] = (unsigned)(Rb * K + C) * 2u; }
    const size_t kstep = (size_t)(BK * 2);
    const size_t hstep = (size_t)HALF * K * 2;
    const size_t tstep = 2 * hstep;
    const unsigned ldsw = (unsigned)wid * 1024u;
    const int aoff = lds_byte(wr * 64 + fr, fq * 8), boff = lds_byte(wc * 32 + fr, fq * 8);
#define PG8_SA(b, h) (((b) * 2 + (h)) * HTB)
#define PG8_SB(b, h) ((4 + (b) * 2 + (h)) * HTB)
#define PG8_STAGE(bufoff, gbase, voff) do { _Pragma("unroll") for (int _i = 0; _i < 2; ++_i) \
        __builtin_amdgcn_global_load_lds((const unsigned*)((const char*)(gbase) + (voff)[_i]), (PG8_LAS unsigned*)(lds + (bufoff) + ldsw + _i * 8192), 16, 0, 0); } while (0)
#define PG8_LDA(dst, b, h) do { if constexpr (F8) { _Pragma("unroll") for (int m = 0; m < 4; ++m) dst##8[m] = __builtin_shufflevector(*(const PG8_LAS v4i32*)(lds + PG8_SA(b, h) + aoff + m * 2048), *(const PG8_LAS v4i32*)(lds + PG8_SA(b, h) + aoff + m * 2048 + 1024), 0, 1, 2, 3, 4, 5, 6, 7); } \
        else { _Pragma("unroll") for (int m = 0; m < 4; ++m) _Pragma("unroll") for (int k = 0; k < 2; ++k) dst[m][k] = *(const PG8_LAS bf16x8*)(lds + PG8_SA(b, h) + aoff + m * 2048 + k * 1024); } } while (0)
#define PG8_LDB(dst, b, h) do { if constexpr (F8) { _Pragma("unroll") for (int n = 0; n < 2; ++n) dst##8[n] = __builtin_shufflevector(*(const PG8_LAS v4i32*)(lds + PG8_SB(b, h) + boff + n * 2048), *(const PG8_LAS v4i32*)(lds + PG8_SB(b, h) + boff + n * 2048 + 1024), 0, 1, 2, 3, 4, 5, 6, 7); } \
        else { _Pragma("unroll") for (int n = 0; n < 2; ++n) _Pragma("unroll") for (int k = 0; k < 2; ++k) dst[n][k] = *(const PG8_LAS bf16x8*)(lds + PG8_SB(b, h) + boff + n * 2048 + k * 1024); } } while (0)
#define PG8_MMA(ai, bj, At, Bt) do { __builtin_amdgcn_s_setprio(1); if constexpr (F8) { \
        _Pragma("unroll") for (int m = 0; m < 4; ++m) _Pragma("unroll") for (int n = 0; n < 2; ++n) \
            asm volatile("v_mfma_scale_f32_16x16x128_f8f6f4 %0, %1, %2, %0, %3, %3 op_sel_hi:[0,0,0]" : "+v"(acc[ai][bj][m][n]) : "v"(Bt##8[n]), "v"(At##8[m]), "v"(f8scale)); \
    } else { _Pragma("unroll") for (int m = 0; m < 4; ++m) _Pragma("unroll") for (int n = 0; n < 2; ++n) _Pragma("unroll") for (int k = 0; k < 2; ++k) \
        acc[ai][bj][m][n] = __builtin_amdgcn_mfma_f32_16x16x32_bf16(Bt[n][k], At[m][k], acc[ai][bj][m][n], 0, 0, 0); } __builtin_amdgcn_s_setprio(0); } while (0)
#define PG8_WAIT_V(n) asm volatile("s_waitcnt vmcnt(" #n ")" ::: "memory")
#define PG8_WAIT_L(n) asm volatile("s_waitcnt lgkmcnt(" #n ")" ::: "memory")
#define PG8_BAR __builtin_amdgcn_s_barrier()
#define PG8_SCHED __builtin_amdgcn_sched_barrier(0)
    Unit cur, nxt; int ui = 0;
    if (!S.next(0, cur)) return;
    f32x4 acc[2][2][4][2];
#pragma unroll
    for (int a = 0; a < 2; ++a)
#pragma unroll
        for (int b = 0; b < 2; ++b)
#pragma unroll
            for (int m = 0; m < 4; ++m)
#pragma unroll
                for (int n = 0; n < 2; ++n) acc[a][b][m][n] = (f32x4){0.f, 0.f, 0.f, 0.f};
    bf16x8 At[4][2], B0[2][2], B1[2][2]; v8i32 At8[4], B08[2], B18[2]; const int f8scale = 0x7f7f7f7f;
    const char* cA = (const char*)g.A + (size_t)cur.pm * tstep; const char* cB = (const char*)g.Bt + (size_t)cur.pn * tstep;
    S.a_ready(cur);
    if constexpr (SP2) {
        PG8_STAGE(PG8_SB(0, 0), cB, voffB); PG8_STAGE(PG8_SB(0, 1), cB + hstep, voffB); PG8_STAGE(PG8_SA(0, 0), cA, voffA); PG8_STAGE(PG8_SA(0, 1), cA + hstep, voffA);
        if (wr == 1) PG8_BAR;
        PG8_WAIT_V(2); PG8_BAR;
        PG8_STAGE(PG8_SB(1, 0), cB + kstep, voffB); PG8_STAGE(PG8_SA(1, 0), cA + kstep, voffA); PG8_STAGE(PG8_SB(1, 1), cB + hstep + kstep, voffB);
        PG8_WAIT_V(6); PG8_BAR;
    } else {
        PG8_STAGE(PG8_SB(0, 0), cB, voffB); PG8_STAGE(PG8_SA(0, 0), cA, voffA); PG8_STAGE(PG8_SB(0, 1), cB + hstep, voffB); PG8_STAGE(PG8_SA(0, 1), cA + hstep, voffA);
        if (wr == 1) PG8_BAR;
        PG8_WAIT_V(4); PG8_BAR;
        PG8_STAGE(PG8_SB(1, 0), cB + kstep, voffB); PG8_STAGE(PG8_SA(1, 0), cA + kstep, voffA); PG8_STAGE(PG8_SB(1, 1), cB + hstep + kstep, voffB);
        PG8_WAIT_V(6); PG8_BAR;
    }
    for (;;) {
        const bool has_next = S.next(ui + 1, nxt);
        const char* nA = has_next ? (const char*)g.A + (size_t)nxt.pm * tstep : cA; const char* nB = has_next ? (const char*)g.Bt + (size_t)nxt.pn * tstep : cB;
        for (int t = 0; t < nt; t += 2) {
            const bool last = (t == nt - 2);
            const char* a1 = cA + (size_t)(t + 1) * kstep;
            const char* a2 = last ? nA : cA + (size_t)(t + 2) * kstep; const char* b2 = last ? nB : cB + (size_t)(t + 2) * kstep;
            const char* a3 = a2 + kstep; const char* b3 = b2 + kstep;
            if (last && has_next) S.a_ready(nxt);
            if constexpr (SP2) {
            PG8_LDB(B0, 0, 0); PG8_LDB(B1, 0, 1); PG8_SCHED; PG8_LDA(At, 0, 0); PG8_STAGE(PG8_SA(1, 1), a1 + hstep, voffA);
            PG8_WAIT_V(8); PG8_WAIT_L(0); PG8_BAR; PG8_MMA(0, 0, At, B0); PG8_MMA(0, 1, At, B1); PG8_BAR; PG8_SCHED;
            PG8_LDA(At, 0, 1); PG8_STAGE(PG8_SB(0, 0), b2, voffB); PG8_STAGE(PG8_SB(0, 1), b2 + hstep, voffB); PG8_STAGE(PG8_SA(0, 0), a2, voffA);
            PG8_WAIT_V(8); PG8_WAIT_L(0); PG8_BAR; PG8_MMA(1, 0, At, B0); PG8_MMA(1, 1, At, B1); PG8_BAR; PG8_SCHED;
            PG8_LDB(B0, 1, 0); PG8_LDB(B1, 1, 1); PG8_SCHED; PG8_LDA(At, 1, 0); PG8_STAGE(PG8_SA(0, 1), a2 + hstep, voffA);
            PG8_WAIT_V(8); PG8_WAIT_L(0); PG8_BAR; PG8_MMA(0, 0, At, B0); PG8_MMA(0, 1, At, B1); PG8_BAR; PG8_SCHED;
            PG8_LDA(At, 1, 1); PG8_STAGE(PG8_SB(1, 0), b3, voffB); PG8_STAGE(PG8_SB(1, 1), b3 + hstep, voffB); PG8_STAGE(PG8_SA(1, 0), a3, voffA);
            PG8_WAIT_V(8); PG8_WAIT_L(0); PG8_BAR; PG8_MMA(1, 0, At, B0); PG8_MMA(1, 1, At, B1); PG8_BAR; PG8_SCHED;
            } else {
            PG8_LDB(B0, 0, 0); PG8_SCHED; PG8_LDA(At, 0, 0); PG8_STAGE(PG8_SA(1, 1), a1 + hstep, voffA);
            PG8_WAIT_L(8); PG8_BAR; PG8_WAIT_L(0); PG8_MMA(0, 0, At, B0); PG8_BAR; PG8_SCHED;
            PG8_LDB(B1, 0, 1); PG8_STAGE(PG8_SB(0, 0), b2, voffB);
            PG8_BAR; PG8_WAIT_L(0); PG8_MMA(0, 1, At, B1); PG8_BAR;
            PG8_LDA(At, 0, 1); PG8_STAGE(PG8_SA(0, 0), a2, voffA);
            PG8_BAR; PG8_WAIT_L(0); PG8_MMA(1, 0, At, B0); PG8_BAR; PG8_SCHED;
            PG8_STAGE(PG8_SB(0, 1), b2 + hstep, voffB);
            PG8_WAIT_V(6); PG8_BAR; PG8_MMA(1, 1, At, B1); PG8_BAR;
            PG8_LDB(B0, 1, 0); PG8_SCHED; PG8_LDA(At, 1, 0); PG8_STAGE(PG8_SA(0, 1), a2 + hstep, voffA);
            PG8_WAIT_L(8); PG8_BAR; PG8_WAIT_L(0); PG8_MMA(0, 0, At, B0); PG8_BAR; PG8_SCHED;
            PG8_LDB(B1, 1, 1); PG8_STAGE(PG8_SB(1, 0), b3, voffB);
            PG8_BAR; PG8_WAIT_L(0); PG8_MMA(0, 1, At, B1); PG8_BAR;
            PG8_LDA(At, 1, 1); PG8_STAGE(PG8_SA(1, 0), a3, voffA);
            PG8_BAR; PG8_WAIT_L(0); PG8_MMA(1, 0, At, B0); PG8_BAR; PG8_SCHED;
            PG8_STAGE(PG8_SB(1, 1), b3 + hstep, voffB);
            PG8_WAIT_V(6); PG8_BAR; PG8_MMA(1, 1, At, B1); PG8_BAR;
            }
        }
        if constexpr (ALIGN_EPI) { if (wr == 0) PG8_BAR; }
        if constexpr (F8) asm volatile("s_nop 15\n\ts_nop 15" ::: "memory");
        if constexpr (!Epi::AFTER_DRAIN) { E(acc, cur, wr, wc, fr, fq); S.done(cur); }
        if (!has_next) break;
#pragma unroll
        for (int a = 0; a < 2; ++a)
#pragma unroll
            for (int b = 0; b < 2; ++b)
#pragma unroll
                for (int m = 0; m < 4; ++m)
#pragma unroll
                    for (int n = 0; n < 2; ++n) acc[a][b][m][n] = (f32x4){0.f, 0.f, 0.f, 0.f};
        cur = nxt; cA = nA; cB = nB; ++ui;
        if constexpr (ALIGN_EPI) { if (wr == 1) PG8_BAR; }
    }
    PG8_WAIT_V(0);
    if constexpr (!ALIGN_EPI) { if (wr == 0) PG8_BAR; }
    PG8_BAR;
    if constexpr (Epi::AFTER_DRAIN) { E.fused(acc, cur, wr, wc, fr, fq, lds, wid, lane); S.done(cur); }
#undef PG8_SA
#undef PG8_SB
#undef PG8_STAGE
#undef PG8_LDA
#undef PG8_LDB
#undef PG8_MMA
#undef PG8_WAIT_V
#undef PG8_WAIT_L
#undef PG8_BAR
#undef PG8_SCHED
}
}

constexpr int NB = 8, SEQ = 4096, DM = 1024, T = NB * SEQ, NMEM = 256, MROWS = NB * NMEM;
constexpr int QKVW = 3840, GATEW = 2048, NIN = 5888;
constexpr float RMS_EPS = 1e-6f;
constexpr int NPH = 15;
constexpr float WIN8_SCALE = 32.0f, MRG8_SCALE = 16.0f;
#ifndef DBG_MIX
#define DBG_MIX 1
#endif
#ifndef DBG_CROSS
#define DBG_CROSS 1
#endif
#ifndef DBG_PEER
#define DBG_PEER 1
#endif
#ifndef DBG_TOPK_SIMPLE
#define DBG_TOPK_SIMPLE 0
#endif
#ifndef DBG_CHECK
#define DBG_CHECK 0
#endif
#ifndef DBG_ATTN_CHECK
#define DBG_ATTN_CHECK 0
#endif
#ifndef DBG_CROSS_CHECK
#define DBG_CROSS_CHECK 0
#endif
#ifndef DBG_NOBIAS
#define DBG_NOBIAS 0
#endif
#ifndef DBG_DIL_CHECK
#define DBG_DIL_CHECK 0
#endif
#ifndef PROBE_PH
#define PROBE_PH (-1)
#endif
#ifndef PROBE_K
#define PROBE_K 200000.0f
#endif
#ifndef DBG_P4CHK
#define DBG_P4CHK 1
#endif
#ifndef ATTN_MFMA
#define ATTN_MFMA 1
#endif
#if DBG_CHECK
#define DBG_YPTR ((float*)(ws + 510 * MiB))
#else
#define DBG_YPTR ((float*)nullptr)
#endif
#ifndef MK_ONE_LAUNCH
#define MK_ONE_LAUNCH 1
#endif
constexpr size_t MiB = 1u << 20;
constexpr size_t WS_CTL = 0, CTL_ZERO_BYTES = 1 * MiB;
constexpr size_t WS_KMEAN = 1 * MiB;
constexpr size_t WS_INV = 2 * MiB;
constexpr size_t WS_WIN = 3 * MiB;
constexpr size_t WS_WA = 15 * MiB, WS_WB = 16 * MiB, WS_WOUT = 17 * MiB, WS_WQC = 19 * MiB, WS_WKVC = 20 * MiB, WS_WOC = 22 * MiB, WS_WQP = 23 * MiB, WS_SUBK = 27 * MiB;
constexpr size_t WS_U = 28 * MiB, WS_V = 60 * MiB;
constexpr size_t WS_H = 92 * MiB;
constexpr size_t WS_MEMB = 156 * MiB, WS_KVC = 160 * MiB;
constexpr size_t WS_ODIL = 164 * MiB, WS_OMOBA = 180 * MiB;
constexpr size_t WS_PQKV = 212 * MiB;
constexpr size_t WS_MERGED = WS_PQKV, WS_X1 = WS_PQKV + 64 * MiB, WS_QC = WS_PQKV + 192 * MiB, WS_OC = WS_ODIL;
constexpr size_t WS_EXP = WS_PQKV, WS_EW = WS_PQKV + 16 * MiB;
constexpr size_t WS_ODG = 452 * MiB, WS_LSE = 500 * MiB;
constexpr size_t WS_END = 502 * MiB;
constexpr int CW_TMO = 0, CW_CODE = 1, CW_WORK = 128, CW_BAR = 4096;
constexpr size_t WS_RSS1 = 256 * 1024, WS_RSS2 = 384 * 1024;
constexpr int RING_OFF = 0, RING_BYTES = 131072;
constexpr int LDSCTL_OFF = RING_BYTES, MISC_OFF = LDSCTL_OFF + 320;
constexpr int LDS_BYTES = 163840;
constexpr int NWAVES = 8;

#define GAS __attribute__((address_space(1)))
#define LAS __attribute__((address_space(3)))
typedef unsigned short bf16;
typedef unsigned v4u __attribute__((ext_vector_type(4)));
typedef float f32x4 __attribute__((ext_vector_type(4)));
typedef float f32x16 __attribute__((ext_vector_type(16)));
typedef short bf16x8 __attribute__((ext_vector_type(8)));
typedef __bf16 bf2_t __attribute__((ext_vector_type(2)));
typedef GAS unsigned gu32;
#define RLX_AGENT __ATOMIC_RELAXED, __HIP_MEMORY_SCOPE_AGENT
#define LDS_WAIT() asm volatile("s_waitcnt lgkmcnt(0)" ::: "memory")
#define VM_WAIT() asm volatile("s_waitcnt vmcnt(0)" ::: "memory")
__device__ __forceinline__ unsigned pk2(float lo, float hi) { return pg8::cvt_pk_bf16(lo, hi); }
__device__ __forceinline__ float bf_lo(unsigned w) { return __uint_as_float(w << 16); }
__device__ __forceinline__ float bf_hi(unsigned w) { return __uint_as_float(w & 0xffff0000u); }
__device__ __forceinline__ float bf2f(bf16 b) { return __uint_as_float((unsigned)b << 16); }

#define XB_TMO      128
#define XB_XCNT(j)  (256  + 64 * (j))
#define XB_XSUB(j)  (1280 + 64 * (j))
#define XB_XGEN(j)  (2304 + 64 * (j))
#define XB_TOP      3328
#define XB_TOPGEN   3392
#define XCD_BAR_WORDS 3456
#define XB_SPIN_CAP (1u << 18)

__device__ __forceinline__ unsigned xb_ld(unsigned* p)              { return __hip_atomic_load(p, __ATOMIC_RELAXED, __HIP_MEMORY_SCOPE_AGENT); }
__device__ __forceinline__ unsigned xb_add(unsigned* p, unsigned v) { return __hip_atomic_fetch_add(p, v, __ATOMIC_RELAXED, __HIP_MEMORY_SCOPE_AGENT); }
__device__ __forceinline__ unsigned xb_xcc_id() { return (unsigned)__builtin_amdgcn_s_getreg((3 << 11) | 20) & 0xFu; }
#define XB_SPIN(cond, bar) do { unsigned _sp = 0; while (cond) { __builtin_amdgcn_s_sleep(1); \
    if ((++_sp & 255u) == 0u) { if (xb_ld(&(bar)[XB_TMO])) break; if (_sp > XB_SPIN_CAP) { atomicAdd(&(bar)[XB_TMO], 1u); break; } } } } while (0)

struct XcdBarrier {
    unsigned* bar; unsigned x;
    volatile LAS unsigned* st;
};

__device__ __forceinline__ XcdBarrier xcd_barrier_post(unsigned* bar, volatile LAS unsigned* st) {
    XcdBarrier b; b.bar = bar; b.x = xb_xcc_id(); b.st = st;
    if (threadIdx.x == 0) (void)xb_add(&bar[XB_XCNT(b.x)], 1u);
    return b;
}
__device__ __forceinline__ void xcd_barrier_complete(unsigned* bar, unsigned x, unsigned& nloc, unsigned& nx) {
    const unsigned G = gridDim.x * gridDim.y * gridDim.z;
    unsigned sum, cnt, mine, sp = 0u;
    for (;;) {
        sum = 0u; cnt = 0u; mine = 0u;
#pragma unroll
        for (unsigned j = 0; j < 16; ++j) { const unsigned c = xb_ld(&bar[XB_XCNT(j)]); sum += c; cnt += (c > 0u) ? 1u : 0u; mine = (j == x) ? c : mine; }
        if (sum == G) break;
        __builtin_amdgcn_s_sleep(1);
        if ((++sp & 255u) == 0u) { if (xb_ld(&bar[XB_TMO])) break; if (sp > XB_SPIN_CAP) { atomicAdd(&bar[XB_TMO], 1u); break; } }
    }
    nloc = mine > 0u ? mine : 1u; nx = cnt > 0u ? cnt : 1u;
}

__device__ __forceinline__ void xcd_barrier(const XcdBarrier& b) {
    asm volatile("s_waitcnt vmcnt(0)" ::: "memory");
    __syncthreads();
    if (threadIdx.x == 0) {
        unsigned* bar = b.bar;
        __builtin_amdgcn_s_waitcnt(0);
        unsigned nloc = b.st[0], nx = b.st[1];
        if (nloc == 0u) { xcd_barrier_complete(bar, b.x, nloc, nx); b.st[0] = nloc; b.st[1] = nx; }
        const unsigned old = xb_add(&bar[XB_XSUB(b.x)], 1u);
        const unsigned gen = old / nloc;
        if (old + 1u == (gen + 1u) * nloc) {
            __builtin_amdgcn_fence(__ATOMIC_RELEASE, "agent");
            asm volatile("s_waitcnt vmcnt(0)" ::: "memory");
            const unsigned og = xb_add(&bar[XB_TOP], 1u);
            const unsigned tg = og / nx;
            if (og + 1u == (tg + 1u) * nx) xb_add(&bar[XB_TOPGEN], 1u);
            else XB_SPIN(xb_ld(&bar[XB_TOPGEN]) == tg, bar);
            __builtin_amdgcn_fence(__ATOMIC_ACQUIRE, "agent");
            xb_add(&bar[XB_XGEN(b.x)], 1u);
            asm volatile("s_waitcnt vmcnt(0)" ::: "memory");
        } else {
            XB_SPIN(xb_ld(&bar[XB_XGEN(b.x)]) == gen, bar);
            __builtin_amdgcn_fence(__ATOMIC_ACQUIRE, "agent");
            asm volatile("s_waitcnt vmcnt(0)" ::: "memory");
        }
    }
    __syncthreads();
}

__device__ __forceinline__ float wave_sum(float v) {
#pragma unroll
    for (int o = 1; o < 64; o <<= 1) v += __shfl_xor(v, o);
    return v;
}
__device__ __forceinline__ int t5_bucket(int n) {
    int b = n;
    if (n >= 16) { b = 16 + (n >= 22) + (n >= 30) + (n >= 40) + (n >= 54) + (n >= 73) + (n >= 99) + (n >= 134) + (n >= 182) + (n >= 246) + (n >= 332) + (n >= 450) + (n >= 609) + (n >= 825) + (n >= 1117) + (n >= 1513); }
    return b;
}
__device__ __forceinline__ void p0_transpose_item(const float* W, int K, int N, bf16* WT, LAS float* scr, int item, int lane, const float* gk = nullptr) {
    const int nblk = N / 32, kb = item / nblk, nb = item % nblk, k0 = 64 * kb, n0 = 32 * nb;
#pragma unroll 8
    for (int i = 0; i < 32; ++i) { const int kk = 2 * i + (lane >> 5); scr[kk * 33 + (lane & 31)] = W[(size_t)(k0 + kk) * N + n0 + (lane & 31)] * (gk ? gk[k0 + kk] : 1.0f); }
    LDS_WAIT(); asm volatile("" ::: "memory");
    const int c = lane & 7;
#pragma unroll
    for (int j = 0; j < 4; ++j) { const int n = (lane >> 3) + 8 * j; const LAS float* s = scr + (8 * c) * 33 + n;
        v4u o; o.x = pk2(s[0 * 33], s[1 * 33]); o.y = pk2(s[2 * 33], s[3 * 33]); o.z = pk2(s[4 * 33], s[5 * 33]); o.w = pk2(s[6 * 33], s[7 * 33]);
        *(GAS v4u*)(WT + (size_t)(n0 + n) * K + k0 + 8 * c) = o; }
    LDS_WAIT(); asm volatile("" ::: "memory");
}
__device__ __forceinline__ void rms_row_to_bf16(const float* xrow, const float* g, bf16* orow, int lane) {
    const f32x4* xr = (const f32x4*)xrow + lane; const f32x4* gr = (const f32x4*)g + lane;
    f32x4 v[4]; float s = 0.f;
#pragma unroll
    for (int j = 0; j < 4; ++j) { v[j] = xr[64 * j]; s += (v[j].x * v[j].x + v[j].y * v[j].y) + (v[j].z * v[j].z + v[j].w * v[j].w); }
    const float rinv = rsqrtf(wave_sum(s) * (1.f / 1024.f) + RMS_EPS);
    unsigned long long* o8 = (unsigned long long*)orow + lane;
#pragma unroll
    for (int j = 0; j < 4; ++j) { const f32x4 gv = gr[64 * j]; o8[64 * j] = (unsigned long long)pk2(v[j].x * rinv * gv.x, v[j].y * rinv * gv.y) | ((unsigned long long)pk2(v[j].z * rinv * gv.z, v[j].w * rinv * gv.w) << 32); }
}
__device__ __forceinline__ void cvt_f32_to_bf16_bulk(const float* src, bf16* dst, size_t n, size_t gtid, size_t nthr) {
    for (size_t i = gtid; i < n / 8; i += nthr) { const f32x4 a = ((const f32x4*)src)[2 * i], b = ((const f32x4*)src)[2 * i + 1];
        v4u o; o.x = pk2(a.x, a.y); o.y = pk2(a.z, a.w); o.z = pk2(b.x, b.y); o.w = pk2(b.z, b.w); ((v4u*)dst)[i] = o; }
}
__device__ __forceinline__ void os_step(const float (&q)[64], float (&o)[64], float& m, float& l, const bf16* krow, const bf16* vrow, float bias) {
    const v4u* kp = (const v4u*)krow; float s = 0.f;
#pragma unroll
    for (int c = 0; c < 8; ++c) { const v4u w = kp[c];
        s += q[8 * c + 0] * bf_lo(w.x) + q[8 * c + 1] * bf_hi(w.x) + q[8 * c + 2] * bf_lo(w.y) + q[8 * c + 3] * bf_hi(w.y)
           + q[8 * c + 4] * bf_lo(w.z) + q[8 * c + 5] * bf_hi(w.z) + q[8 * c + 6] * bf_lo(w.w) + q[8 * c + 7] * bf_hi(w.w); }
    s += bias;
    const float mn = fmaxf(m, s), al = __expf(m - mn), p = __expf(s - mn);
    l = l * al + p; m = mn;
    const v4u* vp = (const v4u*)vrow;
#pragma unroll
    for (int c = 0; c < 8; ++c) { const v4u w = vp[c];
        o[8 * c + 0] = o[8 * c + 0] * al + p * bf_lo(w.x); o[8 * c + 1] = o[8 * c + 1] * al + p * bf_hi(w.x);
        o[8 * c + 2] = o[8 * c + 2] * al + p * bf_lo(w.y); o[8 * c + 3] = o[8 * c + 3] * al + p * bf_hi(w.y);
        o[8 * c + 4] = o[8 * c + 4] * al + p * bf_lo(w.z); o[8 * c + 5] = o[8 * c + 5] * al + p * bf_hi(w.z);
        o[8 * c + 6] = o[8 * c + 6] * al + p * bf_lo(w.w); o[8 * c + 7] = o[8 * c + 7] * al + p * bf_hi(w.w); }
}
__device__ __forceinline__ void load_q64(float (&q)[64], const bf16* qrow, float scale) {
    const v4u* qp = (const v4u*)qrow;
#pragma unroll
    for (int c = 0; c < 8; ++c) { const v4u w = qp[c];
        q[8 * c + 0] = bf_lo(w.x) * scale; q[8 * c + 1] = bf_hi(w.x) * scale; q[8 * c + 2] = bf_lo(w.y) * scale; q[8 * c + 3] = bf_hi(w.y) * scale;
        q[8 * c + 4] = bf_lo(w.z) * scale; q[8 * c + 5] = bf_hi(w.z) * scale; q[8 * c + 6] = bf_lo(w.w) * scale; q[8 * c + 7] = bf_hi(w.w) * scale; }
}
__device__ __forceinline__ void store_o64(const float (&o)[64], float inv, bf16* orow) {
    v4u* op = (v4u*)orow;
#pragma unroll
    for (int c = 0; c < 8; ++c) { v4u w; w.x = pk2(o[8 * c + 0] * inv, o[8 * c + 1] * inv); w.y = pk2(o[8 * c + 2] * inv, o[8 * c + 3] * inv);
        w.z = pk2(o[8 * c + 4] * inv, o[8 * c + 5] * inv); w.w = pk2(o[8 * c + 6] * inv, o[8 * c + 7] * inv); op[c] = w; }
}
__device__ __forceinline__ void cmp_o64(const float (&o)[64], float inv, const bf16* ref, float& num, float& den) {
#pragma unroll
    for (int c = 0; c < 64; ++c) { const float a = o[c] * inv, b = bf2f(ref[c]); num += (a - b) * (a - b); den += a * a; }
}
__device__ __forceinline__ void dbg_acc2(float* acc, float num, float den) { num = wave_sum(num); den = wave_sum(den); if ((threadIdx.x & 63) == 0 && acc) { atomicAdd(acc, num); atomicAdd(acc + 1, den); } }
__device__ __forceinline__ void cvt_f32_to_fp8_bulk(const float* src, unsigned char* dst, size_t n, float scale, size_t gtid, size_t nthr, const float* gc = nullptr) {
    for (size_t i = gtid; i < n / 16; i += nthr) { const f32x4* s = (const f32x4*)src + 4 * i; f32x4 a = s[0] * scale, b = s[1] * scale, c = s[2] * scale, d = s[3] * scale;
        if (gc) { const f32x4* g4 = (const f32x4*)gc + 4 * (i & 63); a = a * g4[0]; b = b * g4[1]; c = c * g4[2]; d = d * g4[3]; }
        int w0 = 0, w1 = 0, w2 = 0, w3 = 0;
        w0 = __builtin_amdgcn_cvt_pk_fp8_f32(a.x, a.y, w0, false); w0 = __builtin_amdgcn_cvt_pk_fp8_f32(a.z, a.w, w0, true);
        w1 = __builtin_amdgcn_cvt_pk_fp8_f32(b.x, b.y, w1, false); w1 = __builtin_amdgcn_cvt_pk_fp8_f32(b.z, b.w, w1, true);
        w2 = __builtin_amdgcn_cvt_pk_fp8_f32(c.x, c.y, w2, false); w2 = __builtin_amdgcn_cvt_pk_fp8_f32(c.z, c.w, w2, true);
        w3 = __builtin_amdgcn_cvt_pk_fp8_f32(d.x, d.y, w3, false); w3 = __builtin_amdgcn_cvt_pk_fp8_f32(d.z, d.w, w3, true);
        v4u o; o.x = (unsigned)w0; o.y = (unsigned)w1; o.z = (unsigned)w2; o.w = (unsigned)w3; ((v4u*)dst)[i] = o; }
}
__device__ __forceinline__ void rms_row_to_fp8(const float* xrow, const float* g, unsigned char* orow, int lane) {
    const f32x4* xr = (const f32x4*)xrow + lane; const f32x4* gr = (const f32x4*)g + lane;
    f32x4 v[4]; float s = 0.f;
#pragma unroll
    for (int j = 0; j < 4; ++j) { v[j] = xr[64 * j]; s += (v[j].x * v[j].x + v[j].y * v[j].y) + (v[j].z * v[j].z + v[j].w * v[j].w); }
    const float rinv = rsqrtf(wave_sum(s) * (1.f / 1024.f) + RMS_EPS);
    unsigned* o4 = (unsigned*)orow + lane;
#pragma unroll
    for (int j = 0; j < 4; ++j) { const f32x4 gv = gr[64 * j]; int w = 0;
        w = __builtin_amdgcn_cvt_pk_fp8_f32(v[j].x * rinv * gv.x, v[j].y * rinv * gv.y, w, false); w = __builtin_amdgcn_cvt_pk_fp8_f32(v[j].z * rinv * gv.z, v[j].w * rinv * gv.w, w, true); o4[64 * j] = (unsigned)w; }
}
__device__ __forceinline__ void p0_transpose_item_fp8(const float* W, int K, int N, unsigned char* WT, LAS float* scr, int item, int lane, float scale, const float* gk = nullptr) {
    const int nblk = N / 32, kb = item / nblk, nb = item % nblk, k0 = 64 * kb, n0 = 32 * nb;
#pragma unroll 8
    for (int i = 0; i < 32; ++i) { const int kk = 2 * i + (lane >> 5); scr[kk * 33 + (lane & 31)] = W[(size_t)(k0 + kk) * N + n0 + (lane & 31)] * (gk ? scale * gk[k0 + kk] : scale); }
    LDS_WAIT(); asm volatile("" ::: "memory");
    const int c = lane & 3;
#pragma unroll
    for (int j = 0; j < 2; ++j) { const int n = (lane >> 2) + 16 * j; const LAS float* s = scr + (16 * c) * 33 + n;
        int w0 = 0, w1 = 0, w2 = 0, w3 = 0;
        w0 = __builtin_amdgcn_cvt_pk_fp8_f32(s[0 * 33], s[1 * 33], w0, false); w0 = __builtin_amdgcn_cvt_pk_fp8_f32(s[2 * 33], s[3 * 33], w0, true);
        w1 = __builtin_amdgcn_cvt_pk_fp8_f32(s[4 * 33], s[5 * 33], w1, false); w1 = __builtin_amdgcn_cvt_pk_fp8_f32(s[6 * 33], s[7 * 33], w1, true);
        w2 = __builtin_amdgcn_cvt_pk_fp8_f32(s[8 * 33], s[9 * 33], w2, false); w2 = __builtin_amdgcn_cvt_pk_fp8_f32(s[10 * 33], s[11 * 33], w2, true);
        w3 = __builtin_amdgcn_cvt_pk_fp8_f32(s[12 * 33], s[13 * 33], w3, false); w3 = __builtin_amdgcn_cvt_pk_fp8_f32(s[14 * 33], s[15 * 33], w3, true);
        v4u o; o.x = (unsigned)w0; o.y = (unsigned)w1; o.z = (unsigned)w2; o.w = (unsigned)w3;
        *(GAS v4u*)(WT + (size_t)(n0 + n) * K + k0 + 16 * c) = o; }
    LDS_WAIT(); asm volatile("" ::: "memory");
}
template <bool SAMP> __device__ __forceinline__ void phase_dil_simple(const bf16* P, const float* rel_bias, bf16* ODIL, int gtid, int nthr, float* acc = nullptr) {
    float cnum = 0.f, cden = 0.f;
    constexpr int NTOK = SAMP ? T / 16 : T;
    for (int item = gtid; item < 4 * NTOK; item += nthr) {
        const int h = item / NTOK, ti = item % NTOK, tok = SAMP ? ti * 16 + 5 : ti, b = tok / SEQ, t = tok % SEQ;
        float o[64], q[64]; float m = -1e30f, l = 0.f;
#pragma unroll
        for (int c = 0; c < 64; ++c) o[c] = 0.f;
        for (int g = 0; g < 3; ++g) {
            const int d = 1 << (2 * g);
            load_q64(q, P + (size_t)tok * QKVW + g * 768 + h * 64, 0.125f);
            for (int j = 0; j <= 128; ++j) {
                const int tp = t - j * d;
                if (tp >= 0) {
                    const bf16* kr = P + (size_t)(b * SEQ + tp) * QKVW + g * 768 + 256 + h * 64;
                    os_step(q, o, m, l, kr, kr + 256, DBG_NOBIAS ? 0.f : rel_bias[t5_bucket(j * d) * 20 + g * 4 + h]);
                }
            }
        }
        if (SAMP) cmp_o64(o, 1.0f / l, ODIL + (size_t)tok * 256 + h * 64, cnum, cden); else store_o64(o, 1.0f / l, ODIL + (size_t)ti * 256 + h * 64);
    }
    if (SAMP) dbg_acc2(acc, cnum, cden);
}
template <bool SAMP> __device__ __forceinline__ void phase_moba_simple(const bf16* P, const float* KMEAN, const float* rel_bias, bf16* OMOBA, int gtid, int nthr, float* acc = nullptr) {
    float cnum = 0.f, cden = 0.f, cnum2 = 0.f, cden2 = 0.f;
    constexpr int NTOK = SAMP ? T / 16 : T;
    for (int item = gtid; item < 8 * NTOK; item += nthr) {
        const int h = item / NTOK, ti = item % NTOK, tok = SAMP ? ti * 16 + 5 : ti, b = tok / SEQ, t = tok % SEQ, qb = t >> 8;
        float o[64], q[64]; float m = -1e30f, l = 0.f;
#pragma unroll
        for (int c = 0; c < 64; ++c) o[c] = 0.f;
        load_q64(q, P + (size_t)tok * QKVW + 2304 + h * 64, 1.0f);
        float v1 = -3e38f, v2 = -3e38f, v3 = -3e38f; int i1 = -1, i2 = -1, i3 = -1;
        for (int n = 0; n < qb; ++n) {
            const float* km = KMEAN + (size_t)((b * 8 + h) * 16 + n) * 64; float gs = 0.f;
#pragma unroll
            for (int c = 0; c < 64; ++c) gs += q[c] * km[c];
            if (gs > v1) { v3 = v2; i3 = i2; v2 = v1; i2 = i1; v1 = gs; i1 = n; }
            else if (gs > v2) { v3 = v2; i3 = i2; v2 = gs; i2 = n; }
            else if (gs > v3) { v3 = gs; i3 = n; }
        }
        unsigned sel = 0u;
        if (i1 >= 0) sel |= 1u << i1;
        if (i2 >= 0) sel |= 1u << i2;
        if (i3 >= 0) sel |= 1u << i3;
#pragma unroll
        for (int c = 0; c < 64; ++c) q[c] *= 0.125f;
        const bf16* Kb = P + (size_t)(b * SEQ) * QKVW + 2304 + 512 + h * 64;
        for (int n = 0; n < 16; ++n) {
            const bool on = ((sel >> n) & 1u) && (n < qb);
            if (__any(on)) {
                for (int j = 0; j < 256; ++j) {
                    const int kpos = n * 256 + j;
                    if (on) { const bf16* kr = Kb + (size_t)kpos * QKVW; os_step(q, o, m, l, kr, kr + 512, DBG_NOBIAS ? 0.f : rel_bias[t5_bucket(t - kpos) * 20 + 12 + h]); }
                }
            }
        }
        for (int j = 0; j < 256; ++j) { const int kpos = qb * 256 + j;
            if (kpos <= t) { const bf16* kr = Kb + (size_t)kpos * QKVW; os_step(q, o, m, l, kr, kr + 512, DBG_NOBIAS ? 0.f : rel_bias[t5_bucket(t - kpos) * 20 + 12 + h]); }
        }
        if (SAMP) { if (qb == 0) cmp_o64(o, 1.0f / l, OMOBA + (size_t)tok * 512 + h * 64, cnum, cden); else cmp_o64(o, 1.0f / l, OMOBA + (size_t)tok * 512 + h * 64, cnum2, cden2); } else store_o64(o, 1.0f / l, OMOBA + (size_t)ti * 512 + h * 64);
    }
    if (SAMP) { dbg_acc2(acc, cnum, cden); dbg_acc2(acc + 2, cnum2, cden2); }
}
template <bool SAMP> __device__ __forceinline__ void phase_cross_simple(const bf16* QC, const bf16* KVC, bf16* OC, int gtid, int nthr, float* acc = nullptr) {
    float cnum = 0.f, cden = 0.f;
    constexpr int NTOK = SAMP ? T / 16 : T;
    for (int item = gtid; item < 8 * NTOK; item += nthr) {
        const int half = item & 1, pr = item >> 1, h = pr / NTOK, ti = pr % NTOK, tok = SAMP ? ti * 16 + 5 : ti, b = tok / SEQ;
        float o[64], q[64]; float m = -1e30f, l = 0.f;
#pragma unroll
        for (int c = 0; c < 64; ++c) o[c] = 0.f;
        load_q64(q, QC + (size_t)tok * 512 + h * 128 + half * 64, 0.08838834764831845f);
        const bf16* Kb = KVC + (size_t)(b * NMEM) * 1024 + h * 128 + half * 64;
        for (int j = 0; j < NMEM; ++j) {
            const v4u* kp = (const v4u*)(Kb + (size_t)j * 1024); float s = 0.f;
#pragma unroll
            for (int c = 0; c < 8; ++c) { const v4u w = kp[c];
                s += q[8 * c + 0] * bf_lo(w.x) + q[8 * c + 1] * bf_hi(w.x) + q[8 * c + 2] * bf_lo(w.y) + q[8 * c + 3] * bf_hi(w.y)
                   + q[8 * c + 4] * bf_lo(w.z) + q[8 * c + 5] * bf_hi(w.z) + q[8 * c + 6] * bf_lo(w.w) + q[8 * c + 7] * bf_hi(w.w); }
            s += __shfl_xor(s, 1);
            const float mn = fmaxf(m, s), al = __expf(m - mn), p = __expf(s - mn);
            l = l * al + p; m = mn;
            const v4u* vp = (const v4u*)(Kb + (size_t)j * 1024 + 512);
#pragma unroll
            for (int c = 0; c < 8; ++c) { const v4u w = vp[c];
                o[8 * c + 0] = o[8 * c + 0] * al + p * bf_lo(w.x); o[8 * c + 1] = o[8 * c + 1] * al + p * bf_hi(w.x);
                o[8 * c + 2] = o[8 * c + 2] * al + p * bf_lo(w.y); o[8 * c + 3] = o[8 * c + 3] * al + p * bf_hi(w.y);
                o[8 * c + 4] = o[8 * c + 4] * al + p * bf_lo(w.z); o[8 * c + 5] = o[8 * c + 5] * al + p * bf_hi(w.z);
                o[8 * c + 6] = o[8 * c + 6] * al + p * bf_lo(w.w); o[8 * c + 7] = o[8 * c + 7] * al + p * bf_hi(w.w); }
        }
        if (SAMP) cmp_o64(o, 1.0f / l, OC + (size_t)tok * 512 + h * 128 + half * 64, cnum, cden); else store_o64(o, 1.0f / l, OC + (size_t)ti * 512 + h * 128 + half * 64);
    }
    if (SAMP) dbg_acc2(acc, cnum, cden);
}

constexpr int PVQ = 2;
constexpr int PNQ = 4, PEG = 128 / PNQ, PSH = 14 - 2;
__device__ __forceinline__ float tk_max(float a, float b) { return fmaxf(a, b); }
__device__ __forceinline__ float tk_min(float a, float b) { return fminf(a, b); }
template <int OFF> __device__ __forceinline__ void sort16_desc(float* v) {
#pragma unroll
    for (int k = 2; k <= 16; k <<= 1) {
#pragma unroll
        for (int j = k >> 1; j > 0; j >>= 1) {
#pragma unroll
            for (int i = 0; i < 16; ++i) {
                const int l = i ^ j;
                if (l > i) {
                    const bool desc = ((i & k) == 0);
                    const float x = v[OFF + i], y = v[OFF + l];
                    const float hi = tk_max(x, y), lo = tk_min(x, y);
                    v[OFF + i] = desc ? hi : lo; v[OFF + l] = desc ? lo : hi;
                }
            }
        }
    }
}
template <int OA, int OB, bool SORT> __device__ __forceinline__ void merge_top16(float* a, const float* b) {
#pragma unroll
    for (int i = 0; i < 16; ++i) a[OA + i] = tk_max(a[OA + i], b[OB + 15 - i]);
    if (SORT) {
#pragma unroll
        for (int j = 8; j > 0; j >>= 1) {
#pragma unroll
            for (int i = 0; i < 16; ++i) {
                const int l = i ^ j;
                if (l > i) { const float x = a[OA + i], y = a[OA + l]; a[OA + i] = tk_max(x, y); a[OA + l] = tk_min(x, y); }
            }
        }
    }
}
constexpr int cand_i(int c) { int n = 0; for (int i = 0; i < 16; ++i) for (int j = 0; j < 16 / (i + 1); ++j) { if (n == c) return i; ++n; } return 0; }
constexpr int cand_j(int c) { int n = 0; for (int i = 0; i < 16; ++i) for (int j = 0; j < 16 / (i + 1); ++j) { if (n == c) return j; ++n; } return 0; }
template <int C> struct CandT { static constexpr int I = cand_i(C), J = cand_j(C); };

__device__ __forceinline__ void peer_level1(const bf16* qrow  , const LAS unsigned char* sk  ,
                                            int r, int hh, float (&out)[16]) {
    bf16x8 qf[8];
#pragma unroll
    for (int ks = 0; ks < 8; ++ks) qf[ks] = *(const bf16x8*)(qrow + ks * 16 + hh * 8);
    float v[64];
#pragma unroll
    for (int kb = 0; kb < 4; ++kb) {
        f32x16 sc = {0.f, 0.f, 0.f, 0.f, 0.f, 0.f, 0.f, 0.f, 0.f, 0.f, 0.f, 0.f, 0.f, 0.f, 0.f, 0.f};
        const int key = kb * 32 + r;
#pragma unroll
        for (int ks = 0; ks < 8; ++ks) {
            const bf16x8 af = *(const LAS bf16x8*)(sk + key * 256 + (((2 * ks + hh) ^ (key & 15)) << 4));
            sc = __builtin_amdgcn_mfma_f32_32x32x16_bf16(af, qf[ks], sc, 0, 0, 0);
        }
#pragma unroll
        for (int reg = 0; reg < 16; ++reg) {
            const unsigned idx = (unsigned)(kb * 32 + (reg & 3) + 8 * (reg >> 2)) | ((unsigned)hh << 2);
            v[kb * 16 + reg] = __uint_as_float((__float_as_uint(sc[reg]) & ~127u) | idx);
        }
    }
    sort16_desc<0>(v); sort16_desc<16>(v); sort16_desc<32>(v); sort16_desc<48>(v);
    merge_top16<0, 16, true>(v, v); merge_top16<32, 48, true>(v, v); merge_top16<0, 32, true>(v, v);
    float other[16];
#pragma unroll
    for (int i = 0; i < 16; ++i) other[i] = __shfl_xor(v[i], 32);
    merge_top16<0, 0, true>(v, other);
#pragma unroll
    for (int i = 0; i < 16; ++i) out[i] = v[i];
}
template <int C, class EP, class WP> __device__ __forceinline__ void peer_emit(const float (&a)[16], const float (&b)[16], const float (&s)[64], float tau, int& cnt, float& den, bool writer, EP eo, WP wo) {
    if constexpr (C < 50) {
        const bool take = (s[C] >= tau) && (cnt < 16);
        const float e = __expf(s[C] - s[0]);
        if (take) {
            if (writer) { eo[cnt] = (int)(((__float_as_uint(a[CandT<C>::I]) & 127u) << 7) | (__float_as_uint(b[CandT<C>::J]) & 127u)); wo[cnt] = e; }
            cnt += 1; den += e;
        }
        peer_emit<C + 1, EP, WP>(a, b, s, tau, cnt, den, writer, eo, wo);
    }
}
template <int C> __device__ __forceinline__ void peer_sums(const float (&a)[16], const float (&b)[16], float (&s)[64]) {
    if constexpr (C < 50) { s[C] = a[CandT<C>::I] + b[CandT<C>::J]; peer_sums<C + 1>(a, b, s); }
}
__device__ __forceinline__ void phase_topk(LAS unsigned char* lds, const bf16* QP, const bf16* SUBK, int* PE, float* PG, int tid, int lane, int wave, int vcu, int G) {
    for (int c = tid; c < 2 * 128 * 16; c += NWAVES * 64) { const int row = c >> 4, ch = c & 15; const v4u w = ((const v4u*)SUBK)[c]; *(LAS v4u*)(lds + row * 256 + ((ch ^ (row & 15)) << 4)) = w; }
    __syncthreads();
    LAS int* stE = (LAS int*)(lds + 65536);
    LAS float* stW = (LAS float*)(lds + 65536 + 16384);
    const int r = lane & 31, hh = lane >> 5, head = wave;
    for (int tile = vcu; tile < T / 32; tile += G) {
        const int tok = tile * 32 + r;
        const bf16* qrow = QP + (size_t)tok * 2048 + head * 256;
        float a[16], b[16];
        peer_level1(qrow, lds, r, hh, a);
        peer_level1(qrow + 128, lds + 128 * 256, r, hh, b);
        float s[64];
        peer_sums<0>(a, b, s);
#pragma unroll
        for (int c = 50; c < 64; ++c) s[c] = -INFINITY;
        float w[64];
#pragma unroll
        for (int c = 0; c < 64; ++c) w[c] = s[c];
        sort16_desc<0>(w); sort16_desc<16>(w); sort16_desc<32>(w); sort16_desc<48>(w);
        merge_top16<0, 16, true>(w, w); merge_top16<32, 48, true>(w, w); merge_top16<0, 32, false>(w, w);
        float tau = w[0];
#pragma unroll
        for (int i = 1; i < 16; ++i) tau = tk_min(tau, w[i]);
        int cnt = 0; float den = 0.f;
        LAS int* eo = stE + r * 128 + head * 16; LAS float* wo = stW + r * 128 + head * 16;
        peer_emit<0, LAS int*, LAS float*>(a, b, s, tau, cnt, den, hh == 0, eo, wo);
        if (hh == 0) { const float inv = 1.0f / den; asm volatile("s_waitcnt lgkmcnt(0)" ::: "memory");
#pragma unroll
            for (int k = 0; k < 16; ++k) wo[k] *= inv; }
        __syncthreads();
#pragma unroll 1
        for (int i = 0; i < 4; ++i) { const int tl = wave * 4 + i; const size_t tg = (size_t)(tile * 32 + tl) * 128;
            const int e0 = stE[tl * 128 + lane], e1 = stE[tl * 128 + 64 + lane]; const float g0 = stW[tl * 128 + lane], g1 = stW[tl * 128 + 64 + lane];
            const int s0 = e0 >> PSH, s1 = e1 >> PSH; int base = 0, p0 = 0, p1 = 0;
#pragma unroll
            for (int bq = 0; bq < PNQ; ++bq) {
                const unsigned long long m0 = __ballot(s0 == bq), m1 = __ballot(s1 == bq);
                const int c0 = __popcll(m0), c1 = __popcll(m1);
                const int r0 = (int)__builtin_amdgcn_mbcnt_hi((unsigned)(m0 >> 32), __builtin_amdgcn_mbcnt_lo((unsigned)m0, 0u));
                const int r1 = (int)__builtin_amdgcn_mbcnt_hi((unsigned)(m1 >> 32), __builtin_amdgcn_mbcnt_lo((unsigned)m1, 0u));
                if (s0 == bq) p0 = base + r0;
                if (s1 == bq) p1 = base + c0 + r1;
                base += c0 + c1;
            }
            PE[tg + p0] = e0; PE[tg + p1] = e1; PG[tg + p0] = g0; PG[tg + p1] = g1; }
        __syncthreads();
    }
}

__device__ __forceinline__ float dot2_bf16(unsigned w, unsigned x, float acc) { return __builtin_amdgcn_fdot2_f32_bf16(__builtin_bit_cast(bf2_t, w), __builtin_bit_cast(bf2_t, x), acc, false); }
__device__ __forceinline__ float dot8_bf16(const v4u a, const v4u b, float acc) {
    acc = dot2_bf16(a.x, b.x, acc); acc = dot2_bf16(a.y, b.y, acc); acc = dot2_bf16(a.z, b.z, acc); acc = dot2_bf16(a.w, b.w, acc);
    return acc;
}
template <int N> __device__ __forceinline__ void xpose_reduce(float (&p)[64], int lane) {
    if constexpr (N >= 1) {
        const bool up = (lane & N) != 0;
#pragma unroll
        for (int k = 0; k < N; ++k) { const float keep = up ? p[k + N] : p[k], send = up ? p[k] : p[k + N]; p[k] = keep + __shfl_xor(send, N); }
        xpose_reduce<N / 2>(p, lane);
    }
}
__device__ __forceinline__ float gelu_exact(float x) { return 0.5f * x * (1.0f + erff(x * 0.70710678118654752f)); }
__device__ __forceinline__ float gelu_as(float v) {
    const float t = __builtin_amdgcn_rcpf(fabsf(v) * 0.2316418882f + 1.0f);
    float q = t * 0.5307027145f + (-0.7265760135f); q = q * t + 0.7107068705f; q = q * t + (-0.142248368f); q = q * t + 0.127414796f; q = q * t;
    const float e = __builtin_amdgcn_exp2f(v * v * (-0.72134752044f));
    const float m = v * (q * e);
    return v < 0.f ? m : v - m;
}
typedef float f32x2_ __attribute__((ext_vector_type(2)));
__device__ __forceinline__ void fp8x16_to_f32(const v4u w, float (&f)[16]) {
    const int w0 = (int)w.x, w1 = (int)w.y, w2 = (int)w.z, w3 = (int)w.w;
    f32x2_ t;
    t = __builtin_amdgcn_cvt_pk_f32_fp8(w0, false); f[0] = t.x; f[1] = t.y; t = __builtin_amdgcn_cvt_pk_f32_fp8(w0, true); f[2] = t.x; f[3] = t.y;
    t = __builtin_amdgcn_cvt_pk_f32_fp8(w1, false); f[4] = t.x; f[5] = t.y; t = __builtin_amdgcn_cvt_pk_f32_fp8(w1, true); f[6] = t.x; f[7] = t.y;
    t = __builtin_amdgcn_cvt_pk_f32_fp8(w2, false); f[8] = t.x; f[9] = t.y; t = __builtin_amdgcn_cvt_pk_f32_fp8(w2, true); f[10] = t.x; f[11] = t.y;
    t = __builtin_amdgcn_cvt_pk_f32_fp8(w3, false); f[12] = t.x; f[13] = t.y; t = __builtin_amdgcn_cvt_pk_f32_fp8(w3, true); f[14] = t.x; f[15] = t.y;
}
constexpr float U8_SCALE = 32.0f, V8_SCALE = 2.0f;
template <int N> __device__ __forceinline__ void xpose_reduce32(float (&p)[32], int lane) {
    if constexpr (N >= 1) {
        const bool up = (lane & N) != 0;
#pragma unroll
        for (int k = 0; k < N; ++k) { const float keep = up ? p[k + N] : p[k], send = up ? p[k] : p[k + N]; p[k] = keep + __shfl_xor(send, N); }
        xpose_reduce32<N / 2>(p, lane);
    } else { p[0] += __shfl_xor(p[0], 32); }
}
__device__ __forceinline__ void peer_u_group(__amdgpu_buffer_rsrc_t U8, const float (&h)[16], int ev, float gv, float zsc, float* wf, int lane) {
    f32x2_ h2[8];
#pragma unroll
    for (int c = 0; c < 8; ++c) { h2[c].x = h[2 * c]; h2[c].y = h[2 * c + 1]; }
    float p[PEG];
#pragma unroll
    for (int i0 = 0; i0 < PEG; i0 += 8) {
        v4u ua[8];
#pragma unroll
        for (int k = 0; k < 8; ++k) { const int eid = __builtin_amdgcn_readlane(ev, i0 + k); ua[k] = __builtin_amdgcn_raw_buffer_load_b128(U8, lane * 16, eid * 1024, 0); }
#pragma unroll
        for (int k = 0; k < 8; ++k) { const int w0 = (int)ua[k].x, w1 = (int)ua[k].y, w2 = (int)ua[k].z, w3 = (int)ua[k].w;
            f32x2_ a0 = h2[0] * __builtin_amdgcn_cvt_pk_f32_fp8(w0, false), a1 = h2[1] * __builtin_amdgcn_cvt_pk_f32_fp8(w0, true);
            a0 += h2[2] * __builtin_amdgcn_cvt_pk_f32_fp8(w1, false); a1 += h2[3] * __builtin_amdgcn_cvt_pk_f32_fp8(w1, true);
            a0 += h2[4] * __builtin_amdgcn_cvt_pk_f32_fp8(w2, false); a1 += h2[5] * __builtin_amdgcn_cvt_pk_f32_fp8(w2, true);
            a0 += h2[6] * __builtin_amdgcn_cvt_pk_f32_fp8(w3, false); a1 += h2[7] * __builtin_amdgcn_cvt_pk_f32_fp8(w3, true);
            a0 += a1; p[i0 + k] = a0.x + a0.y; }
    }
    xpose_reduce32<16>(p, lane);
    if (lane < PEG) wf[lane] = gelu_exact(p[0] * zsc) * gv * (1.0f / V8_SCALE);
}
__device__ __forceinline__ void peer_v_group(__amdgpu_buffer_rsrc_t V8, float (&y)[16], int ev, float wv, int lane) {
#pragma unroll
    for (int i0 = 0; i0 < PEG; i0 += 16) {
        v4u va[16]; float ws[16];
#pragma unroll
        for (int k = 0; k < 16; ++k) { const int eid = __builtin_amdgcn_readlane(ev, i0 + k); ws[k] = __int_as_float(__builtin_amdgcn_readlane(__float_as_int(wv), i0 + k));
            va[k] = __builtin_amdgcn_raw_buffer_load_b128(V8, lane * 16, eid * 1024, 0); }
#pragma unroll
        for (int k = 0; k < 16; ++k) { float f[16]; fp8x16_to_f32(va[k], f);
#pragma unroll
            for (int c = 0; c < 16; ++c) y[c] += ws[k] * f[c]; }
    }
}
__device__ __forceinline__ void peer_v_half(__amdgpu_buffer_rsrc_t V8, float (&y)[16], int ev, float wv, int lane) {
    for (int i0 = 0; i0 < 64; i0 += 16) {
        v4u va[16]; float ws[16];
#pragma unroll
        for (int k = 0; k < 16; ++k) { const int eid = __builtin_amdgcn_readlane(ev, i0 + k); ws[k] = __int_as_float(__builtin_amdgcn_readlane(__float_as_int(wv), i0 + k));
            va[k] = __builtin_amdgcn_raw_buffer_load_b128(V8, lane * 16, eid * 1024, 0); }
#pragma unroll
        for (int k = 0; k < 16; ++k) { float f[16]; fp8x16_to_f32(va[k], f);
#pragma unroll
            for (int c = 0; c < 16; ++c) y[c] += ws[k] * f[c]; }
    }
}
constexpr int XS_LO = 1088;
constexpr int UT_PITCH = 1040, UT_BYTES = 16 * UT_PITCH, UT_XS = 8 * UT_BYTES, XS_BYTES = 2176;
struct PeerVisit { int ev; float gv, rss; v4u ha, hb; };
__device__ __forceinline__ void peer_visit_load(PeerVisit& v, const bf16* H, const float* rowss, const int* PE, const float* PG, int tok, int g, int lane, bool dbg0) {
    const size_t eb = (size_t)tok * 128 + g * PEG;
    const int e = PE[eb + (lane & 31)]; v.ev = dbg0 ? 0 : e;
    v.gv = PG[eb + (lane & 31)]; v.rss = rowss[tok];
    v.ha = *(const v4u*)(H + (size_t)tok * 1024 + 16 * lane); v.hb = *(const v4u*)(H + (size_t)tok * 1024 + 16 * lane + 8);
}
__device__ __forceinline__ void peer_u_dma_tile(__amdgpu_buffer_rsrc_t U8, LAS unsigned char* tb, int ev, int t, int lane) {
#pragma unroll
    for (int r = 0; r < 16; ++r) { const int eid = __builtin_amdgcn_readlane(ev, 16 * t + r);
        __builtin_amdgcn_raw_ptr_buffer_load_lds(U8, (LAS unsigned*)(tb + r * UT_PITCH), 16, lane * 16, eid * 1024, 0, 0); }
}
__device__ __forceinline__ void peer_u_frags(const LAS unsigned char* tb, pg8::v8i32 (&ub)[8], int lane) {
    const LAS unsigned char* p = tb + (lane & 15) * UT_PITCH + (lane >> 4) * 16;
#pragma unroll
    for (int ks = 0; ks < 8; ++ks) { const v4u q0 = *(const LAS v4u*)(p + ks * 128), q1 = *(const LAS v4u*)(p + ks * 128 + 64);
        ub[ks] = (pg8::v8i32){(int)q0.x, (int)q0.y, (int)q0.z, (int)q0.w, (int)q1.x, (int)q1.y, (int)q1.z, (int)q1.w}; }
}
__device__ __forceinline__ void peer_u_visit(__amdgpu_buffer_rsrc_t U8, LAS unsigned char* tb, LAS unsigned char* xs, const PeerVisit& cur, PeerVisit& nxt, const bf16* H, const float* rowss, const int* PE, const float* PG,
                                             int tokn, int gn, bool dbg0, float* wf, int lane) {
    const int j = lane & 15, q = lane >> 4;
    {
        const v4u ha = cur.ha, hb = cur.hb;
        const float sc = rsqrtf(cur.rss * (1.0f / 1024.0f) + RMS_EPS) * 16.0f;
        float h[16];
        h[0] = bf_lo(ha.x) * sc; h[1] = bf_hi(ha.x) * sc; h[2] = bf_lo(ha.y) * sc; h[3] = bf_hi(ha.y) * sc; h[4] = bf_lo(ha.z) * sc; h[5] = bf_hi(ha.z) * sc; h[6] = bf_lo(ha.w) * sc; h[7] = bf_hi(ha.w) * sc;
        h[8] = bf_lo(hb.x) * sc; h[9] = bf_hi(hb.x) * sc; h[10] = bf_lo(hb.y) * sc; h[11] = bf_hi(hb.y) * sc; h[12] = bf_lo(hb.z) * sc; h[13] = bf_hi(hb.z) * sc; h[14] = bf_lo(hb.w) * sc; h[15] = bf_hi(hb.w) * sc;
        int hi[4], lo[4];
#pragma unroll
        for (int c = 0; c < 4; ++c) { int w = 0; w = __builtin_amdgcn_cvt_pk_fp8_f32(h[4 * c], h[4 * c + 1], w, false); w = __builtin_amdgcn_cvt_pk_fp8_f32(h[4 * c + 2], h[4 * c + 3], w, true); hi[c] = w;
            const f32x2_ b0 = __builtin_amdgcn_cvt_pk_f32_fp8(w, false), b1 = __builtin_amdgcn_cvt_pk_f32_fp8(w, true);
            int v = 0; v = __builtin_amdgcn_cvt_pk_fp8_f32((h[4 * c] - b0.x) * 16.0f, (h[4 * c + 1] - b0.y) * 16.0f, v, false); v = __builtin_amdgcn_cvt_pk_fp8_f32((h[4 * c + 2] - b1.x) * 16.0f, (h[4 * c + 3] - b1.y) * 16.0f, v, true); lo[c] = v; }
        *(LAS v4u*)(xs + 16 * lane) = (v4u){(unsigned)hi[0], (unsigned)hi[1], (unsigned)hi[2], (unsigned)hi[3]};
        *(LAS v4u*)(xs + XS_LO + 16 * lane) = (v4u){(unsigned)lo[0], (unsigned)lo[1], (unsigned)lo[2], (unsigned)lo[3]};
    }
    const LAS unsigned char* xb = xs + (j & 1) * XS_LO + q * 16;
    pg8::v8i32 xa[8];
#pragma unroll
    for (int ks = 0; ks < 8; ++ks) { const v4u q0 = *(const LAS v4u*)(xb + ks * 128), q1 = *(const LAS v4u*)(xb + ks * 128 + 64);
        xa[ks] = (pg8::v8i32){(int)q0.x, (int)q0.y, (int)q0.z, (int)q0.w, (int)q1.x, (int)q1.y, (int)q1.z, (int)q1.w}; }
    peer_visit_load(nxt, H, rowss, PE, PG, tokn, gn, lane, dbg0);
    pg8::v8i32 ub[8];
    f32x4 acc0 = {0.f, 0.f, 0.f, 0.f}, acc1 = {0.f, 0.f, 0.f, 0.f};
    const int unit = 0x7f7f7f7f;
    asm volatile("s_waitcnt vmcnt(0)" ::: "memory");
    peer_u_frags(tb, ub, lane);
    asm volatile("s_waitcnt lgkmcnt(0)" ::: "memory");
    peer_u_dma_tile(U8, tb, cur.ev, 1, lane);
#pragma unroll
    for (int ks = 0; ks < 8; ++ks) asm volatile("v_mfma_scale_f32_16x16x128_f8f6f4 %0, %1, %2, %0, %3, %3 op_sel_hi:[0,0,0]" : "+v"(acc0) : "v"(xa[ks]), "v"(ub[ks]), "v"(unit));
    asm volatile("s_waitcnt vmcnt(0)" ::: "memory");
    peer_u_frags(tb, ub, lane);
    asm volatile("s_waitcnt lgkmcnt(0)" ::: "memory");
    peer_u_dma_tile(U8, tb, nxt.ev, 0, lane);
#pragma unroll
    for (int ks = 0; ks < 8; ++ks) asm volatile("v_mfma_scale_f32_16x16x128_f8f6f4 %0, %1, %2, %0, %3, %3 op_sel_hi:[0,0,0]" : "+v"(acc1) : "v"(xa[ks]), "v"(ub[ks]), "v"(unit));
    asm volatile("s_nop 15\n\ts_nop 15" : "+v"(acc0), "+v"(acc1));
    const float z = (lane < 16) ? acc0.x + acc0.y * (1.0f / 16.0f) : acc1.x + acc1.y * (1.0f / 16.0f);
    if (lane < 32) wf[lane] = gelu_exact(z * (1.0f / (16.0f * U8_SCALE))) * cur.gv * (1.0f / V8_SCALE);
}
constexpr float PV_WSC = 64.0f;
struct PeerVRec { int ev; float w; };
__device__ __forceinline__ void peer_v_rec_load(PeerVRec& v, const float* WF, const int* PE, int tok, int g, int lane, bool dbg0) {
    const size_t eb = (size_t)tok * 128 + g * PEG;
    const int e = PE[eb + (lane & 31)]; v.ev = dbg0 ? 0 : e; v.w = WF[eb + (lane & 31)];
}
__device__ __forceinline__ void peer_v_load8(__amdgpu_buffer_rsrc_t V8, v4u (&L)[8], int ev, int base, int lane) {
#pragma unroll
    for (int r = 0; r < 8; ++r) { const int eid = __builtin_amdgcn_readlane(ev, base + r); L[r] = __builtin_amdgcn_raw_buffer_load_b128(V8, lane * 16, eid * 1024, 0); }
}
__device__ __forceinline__ void peer_v_mma8(const v4u (&L)[8], int w16, int base, int sh_in, int sh_out, unsigned mask0, unsigned mask1, f32x16& acc0, f32x16& acc1) {
#pragma unroll
    for (int r = 0; r < 8; ++r) {
        const unsigned s = (unsigned)__builtin_amdgcn_readlane(w16, base + r);
        const unsigned x = ((s >> sh_in) & 0xffu) << sh_out;
        const unsigned a0 = x & mask0, a1 = x & mask1;
        const long a = (long)(((unsigned long long)a1 << 32) | a0);
        const long b0 = (long)(((unsigned long long)L[r].y << 32) | L[r].x), b1 = (long)(((unsigned long long)L[r].w << 32) | L[r].z);
        acc0 = __builtin_amdgcn_mfma_f32_32x32x16_fp8_fp8(a, b0, acc0, 0, 0, 0);
        acc1 = __builtin_amdgcn_mfma_f32_32x32x16_fp8_fp8(a, b1, acc1, 0, 0, 0);
    }
}
__device__ __forceinline__ void peer_v_finish(float (&y)[16], int tok, int g, LAS unsigned char* pl, const bf16* H, const float* gfin, float* OUT, float* ydbg, bool dbg0, float oscale, int lane) {
    if (g < PNQ - 1) {
        *(LAS v4u*)(pl + 16 * lane) = (v4u){pk2(y[0], y[1]), pk2(y[2], y[3]), pk2(y[4], y[5]), pk2(y[6], y[7])}; *(LAS v4u*)(pl + 1024 + 16 * lane) = (v4u){pk2(y[8], y[9]), pk2(y[10], y[11]), pk2(y[12], y[13]), pk2(y[14], y[15])};
    } else {
        if (dbg0) {
#pragma unroll
            for (int c = 0; c < 16; ++c) y[c] = 0.f; }
        if (ydbg) { const int s_ = tok / 512; if (tok == s_ * 512 + 3 + (s_ & 7) * 37) {
#pragma unroll
            for (int c = 0; c < 16; ++c) ydbg[(size_t)s_ * 1024 + 16 * lane + c] = y[c]; } }
        const f32x4* gr = (const f32x4*)gfin + 4 * lane;
        const v4u xa = *(const v4u*)(H + (size_t)tok * 1024 + 16 * lane), xbv = *(const v4u*)(H + (size_t)tok * 1024 + 16 * lane + 8);
        f32x4 xv[4]; float ss = 0.f;
        xv[0] = (f32x4){bf_lo(xa.x), bf_hi(xa.x), bf_lo(xa.y), bf_hi(xa.y)}; xv[1] = (f32x4){bf_lo(xa.z), bf_hi(xa.z), bf_lo(xa.w), bf_hi(xa.w)};
        xv[2] = (f32x4){bf_lo(xbv.x), bf_hi(xbv.x), bf_lo(xbv.y), bf_hi(xbv.y)}; xv[3] = (f32x4){bf_lo(xbv.z), bf_hi(xbv.z), bf_lo(xbv.w), bf_hi(xbv.w)};
#pragma unroll
        for (int i = 0; i < 4; ++i) { xv[i].x += y[4 * i]; xv[i].y += y[4 * i + 1]; xv[i].z += y[4 * i + 2]; xv[i].w += y[4 * i + 3];
            ss += (xv[i].x * xv[i].x + xv[i].y * xv[i].y) + (xv[i].z * xv[i].z + xv[i].w * xv[i].w); }
        const float rinv = rsqrtf(wave_sum(ss) * (1.f / 1024.f) + RMS_EPS) * oscale;
        f32x4* orow = (f32x4*)(OUT + (size_t)tok * 1024) + 4 * lane;
#pragma unroll
        for (int i = 0; i < 4; ++i) orow[i] = xv[i] * rinv * gr[i];
    }
}
constexpr int PV_TOK = 8;
template <int F> __device__ __forceinline__ void peer_v_pass(__amdgpu_buffer_rsrc_t V8, const bf16* H, const float* WF, const int* PE, const float* gfin, float* OUT, float* ydbg, float oscale, LAS unsigned char* ldsw,
                                                             int lane, int wave, int gw, int ngw, float dbg_sc) {
    const int ntok = (T - gw + ngw - 1) / ngw; const bool dbg0 = dbg_sc == 0.f;
    LAS unsigned char* pbase = ldsw + wave * UT_BYTES;
    static_assert(PV_TOK * 2048 <= UT_BYTES, "the parked sums live in the wave's tile buffer");
    const int m_ = lane & 31, s8_ = (m_ & 3) + 4 * ((m_ >> 3) & 1); const bool nz_ = (lane >> 5) == ((m_ >> 2) & 1);
    const int sh_in = (m_ >> 4) * 8, sh_out = 8 * (s8_ & 3);
    const unsigned mask0 = (nz_ && s8_ < 4) ? 0xffffffffu : 0u, mask1 = (nz_ && s8_ >= 4) ? 0xffffffffu : 0u;
    PeerVRec ra, rb; v4u LA[8], LB[8];
    if (ntok <= 0) return;
    peer_v_rec_load(ra, WF, PE, gw, 0, lane, dbg0); if (F & 1) ra.ev &= 2047;
    peer_v_load8(V8, LA, ra.ev, 0, lane);
    int t0 = 0, g = 0, k = 0;
#define PEER_V_NEXT(T0, G, K, T0N, GN, KN, LAST) do { const int nr_ = (ntok - (T0) < PV_TOK) ? ntok - (T0) : PV_TOK; T0N = (T0); GN = (G); KN = (K) + 1; LAST = false; \
        if (KN >= nr_) { KN = 0; GN = (G) + 1; if (GN >= PNQ) { GN = 0; T0N = (T0) + PV_TOK; if (T0N >= ntok) { T0N = (T0); GN = (G); KN = (K); LAST = true; } } } } while (0)
#define PEER_V_EAT(LL, BASE) do { if constexpr (F & 2) { _Pragma("unroll") for (int r_ = 0; r_ < 8; ++r_) { c0_[r_ & 7] += __uint_as_float(LL[r_].x ^ LL[r_].y); c1_[r_ & 7] += __uint_as_float(LL[r_].z ^ LL[r_].w); } } \
        else peer_v_mma8(LL, w16_, (BASE), sh_in, sh_out, mask0, mask1, c0_, c1_); } while (0)
#define PEER_V_VISIT(CUR, NXT, T0C, GC, KC, T0N, GN, KN) do { \
        const int tokc_ = gw + ((T0C) + (KC)) * ngw, tokn_ = gw + ((T0N) + (KN)) * ngw; LAS unsigned char* pl_ = pbase + (KC) * 2048; \
        peer_v_rec_load(NXT, WF, PE, tokn_, GN, lane, dbg0); if (F & 1) NXT.ev &= 2047; \
        peer_v_load8(V8, LB, CUR.ev, 8, lane); \
        int w16_; { int wq_ = 0; wq_ = __builtin_amdgcn_cvt_pk_fp8_f32(CUR.w * PV_WSC, 0.f, wq_, false); const f32x2_ bk_ = __builtin_amdgcn_cvt_pk_f32_fp8(wq_, false); \
            int lq_ = 0; lq_ = __builtin_amdgcn_cvt_pk_fp8_f32((CUR.w * PV_WSC - bk_.x) * 16.0f, 0.f, lq_, false); w16_ = (wq_ & 0xff) | ((lq_ & 0xff) << 8); } \
        f32x16 c0_, c1_; \
        if ((GC) > 0) { const v4u pa_ = *(const LAS v4u*)(pl_ + 16 * lane), pb_ = *(const LAS v4u*)(pl_ + 1024 + 16 * lane); \
            c0_[0] = bf_lo(pa_.x) * PV_WSC; c0_[1] = bf_hi(pa_.x) * PV_WSC; c0_[2] = bf_lo(pa_.y) * PV_WSC; c0_[3] = bf_hi(pa_.y) * PV_WSC; \
            c0_[4] = bf_lo(pa_.z) * PV_WSC; c0_[5] = bf_hi(pa_.z) * PV_WSC; c0_[6] = bf_lo(pa_.w) * PV_WSC; c0_[7] = bf_hi(pa_.w) * PV_WSC; \
            c1_[0] = bf_lo(pb_.x) * PV_WSC; c1_[1] = bf_hi(pb_.x) * PV_WSC; c1_[2] = bf_lo(pb_.y) * PV_WSC; c1_[3] = bf_hi(pb_.y) * PV_WSC; \
            c1_[4] = bf_lo(pb_.z) * PV_WSC; c1_[5] = bf_hi(pb_.z) * PV_WSC; c1_[6] = bf_lo(pb_.w) * PV_WSC; c1_[7] = bf_hi(pb_.w) * PV_WSC; \
        } else { _Pragma("unroll") for (int r_ = 0; r_ < 8; ++r_) { c0_[r_] = 0.f; c1_[r_] = 0.f; } } \
        _Pragma("unroll") for (int r_ = 8; r_ < 16; ++r_) { c0_[r_] = 0.f; c1_[r_] = 0.f; } \
        PEER_V_EAT(LA, 0);  peer_v_load8(V8, LA, CUR.ev, 16, lane); \
        PEER_V_EAT(LB, 8);  peer_v_load8(V8, LB, CUR.ev, 24, lane); \
        PEER_V_EAT(LA, 16); peer_v_load8(V8, LA, NXT.ev, 0, lane); \
        PEER_V_EAT(LB, 24); \
        float y[16]; \
        _Pragma("unroll") for (int r_ = 0; r_ < 8; ++r_) { y[r_] = (c0_[r_] + c0_[r_ + 8] * (1.0f / 16.0f)) * (1.0f / PV_WSC); y[8 + r_] = (c1_[r_] + c1_[r_ + 8] * (1.0f / 16.0f)) * (1.0f / PV_WSC); } \
        peer_v_finish(y, tokc_, GC, pl_, H, gfin, OUT, ydbg, dbg0, oscale, lane); } while (0)
    for (;;) {
        int t1, g1, k1, t2, g2, k2; bool last1, last2;
        PEER_V_NEXT(t0, g, k, t1, g1, k1, last1);
        PEER_V_VISIT(ra, rb, t0, g, k, t1, g1, k1);
        if (last1) break;
        PEER_V_NEXT(t1, g1, k1, t2, g2, k2, last2);
        PEER_V_VISIT(rb, ra, t1, g1, k1, t2, g2, k2);
        if (last2) break;
        t0 = t2; g = g2; k = k2;
    }
#undef PEER_V_VISIT
#undef PEER_V_EAT
#undef PEER_V_NEXT
}
__device__ __forceinline__ void phase_peer(const bf16* H, const float* rowss, const unsigned char* U8p, const unsigned char* V8p, float* WF, const int* PE, const float* PG,
                                           const float* gfin, float* OUT, int lane, int wave, int gw, int ngw, float dbg_sc, float* ydbg, float oscale, LAS unsigned char* ldsw) {
    static_assert(PEG == 32, "the group code is written for 32 entries per group");
    const __amdgpu_buffer_rsrc_t U8 = __builtin_amdgcn_make_buffer_rsrc((void*)U8p, 0, 16 << 20, 0x00020000), V8 = __builtin_amdgcn_make_buffer_rsrc((void*)V8p, 0, 16 << 20, 0x00020000);
    {   const int ntok = (T - gw + ngw - 1) / ngw, nvis = PNQ * ntok; const bool dbg0 = dbg_sc == 0.f;
        LAS unsigned char* tb = ldsw + wave * UT_BYTES; LAS unsigned char* xs = ldsw + UT_XS + wave * XS_BYTES;
        PeerVisit va, vb;
        peer_visit_load(va, H, rowss, PE, PG, gw, 0, lane, dbg0);
        peer_u_dma_tile(U8, tb, va.ev, 0, lane);
        int g = 0, tok = gw;
        for (int vi = 0; vi < nvis; vi += 2) {
            int g1 = g, tok1 = tok + ngw; if (tok1 >= T) { tok1 = gw; g1 = g + 1; }
            if (vi + 1 >= nvis) { tok1 = tok; g1 = g; }
            peer_u_visit(U8, tb, xs, va, vb, H, rowss, PE, PG, tok1, g1, dbg0, WF + (size_t)tok * 128 + g * PEG, lane);
            if (vi + 1 >= nvis) break;
            int g2 = g1, tok2 = tok1 + ngw; if (tok2 >= T) { tok2 = gw; g2 = g1 + 1; }
            if (vi + 2 >= nvis) { tok2 = tok1; g2 = g1; }
            peer_u_visit(U8, tb, xs, vb, va, H, rowss, PE, PG, tok2, g2, dbg0, WF + (size_t)tok1 * 128 + g1 * PEG, lane);
            g = g2; tok = tok2;
        }
    }
    asm volatile("s_waitcnt vmcnt(0)" ::: "memory");
    peer_v_pass<0>(V8, H, WF, PE, gfin, OUT, ydbg, oscale, ldsw, lane, wave, gw, ngw, dbg_sc);
}
#if PROBE_PH >= 20
template <int MODE> __device__ __forceinline__ void peer_probe(const bf16* H, const float* rowss, const unsigned char* U8p, const unsigned char* V8p, float* WF, const int* PE, const float* PG,
                                                               float* OUT, int lane, int wave, int gw, int ngw, int vcu, LAS unsigned char* ldsp, const float* gfin) {
    const __amdgpu_buffer_rsrc_t U8 = __builtin_amdgcn_make_buffer_rsrc((void*)U8p, 0, 16 << 20, 0x00020000), V8 = __builtin_amdgcn_make_buffer_rsrc((void*)V8p, 0, 16 << 20, 0x00020000);
    if constexpr (MODE >= 20) { peer_v_pass<MODE - 20>(V8, H, WF, PE, gfin, OUT, nullptr, 1.0f, ldsp, lane, wave, gw, ngw, 1.0f); }
    else if constexpr (MODE == 0 || MODE == 1 || MODE == 2 || MODE == 6) {
        for (int g = 0; g < PNQ; ++g) {
            for (int tok = gw; tok < T; tok += ngw) {
                int ev = PE[(size_t)tok * 128 + g * PEG + (lane & (PEG - 1))]; const float gv = PG[(size_t)tok * 128 + g * PEG + (lane & (PEG - 1))];
                ev &= 16383;
                if (MODE == 1 || MODE == 6) ev = (ev & 2047) | ((vcu >> 5) << 11);
                const v4u ha = *(const v4u*)(H + (size_t)tok * 1024 + 16 * lane), hb = *(const v4u*)(H + (size_t)tok * 1024 + 16 * lane + 8);
                float h[16];
                h[0] = bf_lo(ha.x); h[1] = bf_hi(ha.x); h[2] = bf_lo(ha.y); h[3] = bf_hi(ha.y); h[4] = bf_lo(ha.z); h[5] = bf_hi(ha.z); h[6] = bf_lo(ha.w); h[7] = bf_hi(ha.w);
                h[8] = bf_lo(hb.x); h[9] = bf_hi(hb.x); h[10] = bf_lo(hb.y); h[11] = bf_hi(hb.y); h[12] = bf_lo(hb.z); h[13] = bf_hi(hb.z); h[14] = bf_lo(hb.w); h[15] = bf_hi(hb.w);
                const float zsc = rsqrtf(rowss[tok] * (1.0f / 1024.0f) + RMS_EPS) * (1.0f / U8_SCALE);
                if constexpr (MODE == 2 || MODE == 6) {
                    unsigned acc = 0u;
#pragma unroll
                    for (int i0 = 0; i0 < PEG; i0 += 8) {
                        v4u ua[8];
#pragma unroll
                        for (int k = 0; k < 8; ++k) { const int eid = __builtin_amdgcn_readlane(ev, i0 + k); ua[k] = __builtin_amdgcn_raw_buffer_load_b128(U8, lane * 16, eid * 1024, 0); }
#pragma unroll
                        for (int k = 0; k < 8; ++k) acc ^= (ua[k].x ^ ua[k].y) ^ (ua[k].z ^ ua[k].w);
                    }
                    if (lane < PEG) (WF + (size_t)tok * 128 + g * PEG)[lane] = __uint_as_float(acc) * zsc * gv * h[0];
                } else peer_u_group(U8, h, ev, gv, zsc, WF + (size_t)tok * 128 + g * PEG, lane);
            }
        }
    } else {
        for (int tq = gw; tq < T; tq += PVQ * ngw) {
            float y[PVQ][16];
#pragma unroll
            for (int j = 0; j < PVQ; ++j)
#pragma unroll
                for (int c = 0; c < 16; ++c) y[j][c] = 0.f;
#pragma unroll
            for (int half = 0; half < 2; ++half)
#pragma unroll
                for (int j = 0; j < PVQ; ++j) { const size_t t_ = (size_t)(tq + j * ngw);
                    int ev = PE[t_ * 128 + half * 64 + lane] & 16383; const float wv = WF[t_ * 128 + half * 64 + lane];
                    if (MODE == 4) ev &= 2047;
                    if constexpr (MODE == 5) {
                        for (int i0 = 0; i0 < 64; i0 += 16) {
                            v4u va[16];
#pragma unroll
                            for (int k = 0; k < 16; ++k) { const int eid = __builtin_amdgcn_readlane(ev, i0 + k); va[k] = __builtin_amdgcn_raw_buffer_load_b128(V8, lane * 16, eid * 1024, 0); }
#pragma unroll
                            for (int k = 0; k < 16; ++k) { y[j][0] = __uint_as_float(__float_as_uint(y[j][0]) ^ va[k].x); y[j][1] = __uint_as_float(__float_as_uint(y[j][1]) ^ va[k].y);
                                y[j][2] = __uint_as_float(__float_as_uint(y[j][2]) ^ va[k].z); y[j][3] = __uint_as_float(__float_as_uint(y[j][3]) ^ va[k].w); }
                        }
                        y[j][4] += wv;
                    } else peer_v_half(V8, y[j], ev, wv, lane);
                }
#pragma unroll
            for (int j = 0; j < PVQ; ++j) {
                const int tok = tq + j * ngw;
                const v4u xa = *(const v4u*)(H + (size_t)tok * 1024 + 16 * lane), xbv = *(const v4u*)(H + (size_t)tok * 1024 + 16 * lane + 8);
                f32x4 xv[4]; float ss = 0.f;
                xv[0] = (f32x4){bf_lo(xa.x), bf_hi(xa.x), bf_lo(xa.y), bf_hi(xa.y)}; xv[1] = (f32x4){bf_lo(xa.z), bf_hi(xa.z), bf_lo(xa.w), bf_hi(xa.w)};
                xv[2] = (f32x4){bf_lo(xbv.x), bf_hi(xbv.x), bf_lo(xbv.y), bf_hi(xbv.y)}; xv[3] = (f32x4){bf_lo(xbv.z), bf_hi(xbv.z), bf_lo(xbv.w), bf_hi(xbv.w)};
#pragma unroll
                for (int i = 0; i < 4; ++i) { xv[i].x += y[j][4 * i]; xv[i].y += y[j][4 * i + 1]; xv[i].z += y[j][4 * i + 2]; xv[i].w += y[j][4 * i + 3];
                    ss += (xv[i].x * xv[i].x + xv[i].y * xv[i].y) + (xv[i].z * xv[i].z + xv[i].w * xv[i].w); }
                const float rinv = rsqrtf(wave_sum(ss) * (1.f / 1024.f) + RMS_EPS);
                f32x4* orow = (f32x4*)(OUT + (size_t)tok * 1024) + 4 * lane;
#pragma unroll
                for (int i = 0; i < 4; ++i) orow[i] = xv[i] * rinv;
            }
        }
    }
}
#endif
constexpr float L2E = 1.4426950408889634f;
#ifndef ATT_THR
#define ATT_THR 8.0f
#endif
typedef short v4i16_t __attribute__((ext_vector_type(4)));
__device__ __forceinline__ float amax3(float a, float b, float c) { float r; asm("v_max3_f32 %0, %1, %2, %3" : "=v"(r) : "v"(a), "v"(b), "v"(c)); return r; }
template <int D> struct ACfg { static constexpr int KS = D / 16, NBLK = D / 32, PITCH = D * 2 + 16, TILEB = 64 * PITCH, VPITCH = (D == 64 ? 192 : 320)  , VTILEB = 64 * VPITCH, PIECES = D / 64, CPR = D / 8; };
__device__ __forceinline__ bf16x8 pack8(float a0, float a1, float a2, float a3, float a4, float a5, float a6, float a7) {
    v4u u; u.x = pk2(a0, a1); u.y = pk2(a2, a3); u.z = pk2(a4, a5); u.w = pk2(a6, a7); return __builtin_bit_cast(bf16x8, u);
}
template <int D> __device__ __forceinline__ void attn_stage_load(v4u (&kr)[D / 64], v4u (&vr)[D / 64], const bf16* Kg, const bf16* Vg, size_t rowstride, int tid) {
#pragma unroll
    for (int p = 0; p < D / 64; ++p) { const int idx = tid + 512 * p, row = idx / ACfg<D>::CPR, ch = idx % ACfg<D>::CPR;
        kr[p] = *(const v4u*)(Kg + (size_t)row * rowstride + ch * 8); vr[p] = *(const v4u*)(Vg + (size_t)row * rowstride + ch * 8); }
}
template <int D> __device__ __forceinline__ void attn_stage_store(const v4u (&kr)[D / 64], const v4u (&vr)[D / 64], LAS unsigned char* Kl, LAS unsigned char* Vl, int tid) {
#pragma unroll
    for (int p = 0; p < D / 64; ++p) { const int idx = tid + 512 * p, row = idx / ACfg<D>::CPR, ch = idx % ACfg<D>::CPR;
        *(LAS v4u*)(Kl + row * ACfg<D>::PITCH + ch * 16) = kr[p]; *(LAS v4u*)(Vl + row * ACfg<D>::VPITCH + ch * 16) = vr[p]; }
}
template <int D> __device__ __forceinline__ void attn_load_q(bf16x8 (&qf)[D / 16], const bf16* qrow, int hh, float scale) {
#pragma unroll
    for (int ks = 0; ks < D / 16; ++ks) { const v4u w = *(const v4u*)(qrow + ks * 16 + hh * 8);
        qf[ks] = pack8(bf_lo(w.x) * scale, bf_hi(w.x) * scale, bf_lo(w.y) * scale, bf_hi(w.y) * scale, bf_lo(w.z) * scale, bf_hi(w.z) * scale, bf_lo(w.w) * scale, bf_hi(w.w) * scale); }
}
template <int D, int BIAS  > __device__ __forceinline__ void attn_tile(const LAS unsigned char* Kl, const LAS unsigned char* Vl, const bf16x8 (&qf)[D / 16], f32x16 (&o)[D / 32], float& m, float& l,
                                                                      const LAS float* tb, bool active, int lane, float cbias = 0.f) {
    constexpr int PITCH = ACfg<D>::PITCH, VPITCH = ACfg<D>::VPITCH;
    const int r = lane & 31, hh = lane >> 5;
    f32x16 s0, s1;
    if (BIAS == 2) {
#pragma unroll
        for (int reg = 0; reg < 16; ++reg) { s0[reg] = cbias; s1[reg] = cbias; }
    } else if (BIAS == 1) {
#pragma unroll
        for (int reg = 0; reg < 16; ++reg) { s0[reg] = tb[(reg & 3) + 8 * (reg >> 2)]; s1[reg] = tb[32 + (reg & 3) + 8 * (reg >> 2)]; }
    } else {
#pragma unroll
        for (int reg = 0; reg < 16; ++reg) { s0[reg] = 0.f; s1[reg] = 0.f; }
    }
#pragma unroll
    for (int ks = 0; ks < D / 16; ++ks) {
        const bf16x8 k0 = *(const LAS bf16x8*)(Kl + r * PITCH + (2 * ks + hh) * 16);
        const bf16x8 k1 = *(const LAS bf16x8*)(Kl + (32 + r) * PITCH + (2 * ks + hh) * 16);
        s0 = __builtin_amdgcn_mfma_f32_32x32x16_bf16(k0, qf[ks], s0, 0, 0, 0);
        s1 = __builtin_amdgcn_mfma_f32_32x32x16_bf16(k1, qf[ks], s1, 0, 0, 0);
    }
    asm volatile("s_nop 15\n\ts_nop 7" : "+v"(s0), "+v"(s1));
    float mx = amax3(s0[0], s1[0], s0[1]), mx2 = amax3(s1[1], s0[2], s1[2]);
#pragma unroll
    for (int reg = 3; reg < 15; reg += 2) { mx = amax3(mx, s0[reg], s1[reg]); mx2 = amax3(mx2, s0[reg + 1], s1[reg + 1]); }
    mx = amax3(mx, mx2, s0[15]); mx = amax3(mx, s1[15], s1[15]); mx = amax3(mx, __shfl_xor(mx, 32), mx);
    if (__any(active && (mx > m + ATT_THR))) {
        const float mn = active ? fmaxf(m, mx) : m;
        const float alpha = __builtin_amdgcn_exp2f(m - mn);
        l *= alpha; m = mn;
#pragma unroll
        for (int blk = 0; blk < D / 32; ++blk)
#pragma unroll
            for (int reg = 0; reg < 16; ++reg) o[blk][reg] *= alpha;
    }
    const float meff = active ? m : __builtin_inff();
    float ls = 0.f;
#pragma unroll
    for (int reg = 0; reg < 16; ++reg) { s0[reg] = __builtin_amdgcn_exp2f(s0[reg] - meff); s1[reg] = __builtin_amdgcn_exp2f(s1[reg] - meff); ls += s0[reg] + s1[reg]; }
    l += ls;
    bf16x8 pf[4];
    pf[0] = pack8(s0[0], s0[1], s0[2], s0[3], s0[4], s0[5], s0[6], s0[7]); pf[1] = pack8(s0[8], s0[9], s0[10], s0[11], s0[12], s0[13], s0[14], s0[15]);
    pf[2] = pack8(s1[0], s1[1], s1[2], s1[3], s1[4], s1[5], s1[6], s1[7]); pf[3] = pack8(s1[8], s1[9], s1[10], s1[11], s1[12], s1[13], s1[14], s1[15]);
    const int i16 = lane & 15;
    unsigned vbo = (unsigned)((4 * hh + (i16 >> 2)) * VPITCH + (16 * ((lane >> 4) & 1) + 4 * (i16 & 3)) * 2);
    asm volatile("" : "+v"(vbo) :: "memory");
    const LAS unsigned char* vb = Vl + vbo;
#pragma unroll
    for (int blk = 0; blk < D / 32; ++blk) {
#pragma unroll
        for (int ks = 0; ks < 4; ++ks) {
            const v4i16_t lo = __builtin_amdgcn_ds_read_tr16_b64_v4i16((LAS v4i16_t*)(vb + (16 * ks) * VPITCH + blk * 64));
            const v4i16_t hi = __builtin_amdgcn_ds_read_tr16_b64_v4i16((LAS v4i16_t*)(vb + (16 * ks + 8) * VPITCH + blk * 64));
            const bf16x8 va = {lo[0], lo[1], lo[2], lo[3], hi[0], hi[1], hi[2], hi[3]};
            o[blk] = __builtin_amdgcn_mfma_f32_32x32x16_bf16(va, pf[ks], o[blk], 0, 0, 0);
        }
    }
}
template <int D> __device__ __forceinline__ void attn_store_o(const f32x16 (&o)[D / 32], float inv, bf16* orow, int hh) {
#pragma unroll
    for (int blk = 0; blk < D / 32; ++blk)
#pragma unroll
        for (int g4 = 0; g4 < 4; ++g4) { unsigned long long w = (unsigned long long)pk2(o[blk][4 * g4] * inv, o[blk][4 * g4 + 1] * inv) | ((unsigned long long)pk2(o[blk][4 * g4 + 2] * inv, o[blk][4 * g4 + 3] * inv) << 32);
            *(unsigned long long*)(orow + 32 * blk + 8 * g4 + 4 * hh) = w; }
}
constexpr int ATT_TB_BYTES = 18432;

__device__ __forceinline__ void moba_unit(LAS unsigned char* lds, const bf16* P, const float* KMEAN, const float* rel_bias, bf16* OMOBA, int b, int h, int qb, int tid, int lane, int wave) {
    constexpr int TILEB = ACfg<64>::TILEB, VTILEB = ACfg<64>::VTILEB;
    const int r = lane & 31, hh = lane >> 5;
    LAS float* TB = (LAS float*)lds;
    LAS unsigned char* Kb = lds + ATT_TB_BYTES; LAS unsigned char* Vb = Kb + 2 * TILEB;
    LAS float* KM = (LAS float*)(lds + ATT_TB_BYTES + 4 * TILEB + 4 * VTILEB);
#pragma unroll
    for (int i = 0; i < 9; ++i) { const int x = tid + i * (NWAVES * 64); if (x < 4352) { const int dist = 4095 - x; float tv = -__builtin_inff(); if (dist >= 0) tv = DBG_NOBIAS ? 0.f : rel_bias[t5_bucket(dist) * 20 + 12 + h] * L2E; TB[x] = tv; } }
#pragma unroll
    for (int i = 0; i < 2; ++i) { const int x = tid + i * (NWAVES * 64); if (x < qb * 64) KM[x] = KMEAN[(size_t)((b * 8 + h) * 16) * 64 + x]; }
    __syncthreads();
    const int qpos = qb * 256 + wave * 32 + r; const size_t tokq = (size_t)b * SEQ + qpos;
    const bf16* qrow = P + tokq * QKVW + 2304 + h * 64;
    unsigned sel = 0u;
    {
        float q[64]; load_q64(q, qrow, 1.0f);
        float v1 = -3e38f, v2 = -3e38f, v3 = -3e38f; int i1 = -1, i2 = -1, i3 = -1;
        for (int n = 0; n < qb; ++n) {
            const LAS f32x4* km = (const LAS f32x4*)(KM + n * 64); float gs = 0.f;
#pragma unroll
            for (int c = 0; c < 16; ++c) { const f32x4 kv = km[c]; gs += q[4 * c] * kv.x + q[4 * c + 1] * kv.y + q[4 * c + 2] * kv.z + q[4 * c + 3] * kv.w; }
            if (gs > v1) { v3 = v2; i3 = i2; v2 = v1; i2 = i1; v1 = gs; i1 = n; }
            else if (gs > v2) { v3 = v2; i3 = i2; v2 = gs; i2 = n; }
            else if (gs > v3) { v3 = gs; i3 = n; }
        }
        if (i1 >= 0) sel |= 1u << i1;
        if (i2 >= 0) sel |= 1u << i2;
        if (i3 >= 0) sel |= 1u << i3;
    }
    bf16x8 qf[4]; attn_load_q<64>(qf, qrow, hh, 0.125f * L2E);
    f32x16 o[2];
#pragma unroll
    for (int reg = 0; reg < 16; ++reg) { o[0][reg] = 0.f; o[1][reg] = 0.f; }
    float m = -1e30f, l = 0.f;
    const bf16* Kg0 = P + (size_t)b * SEQ * QKVW + 2304 + 512 + h * 64;
    const int nt = 4 + 4 * qb;
#define MOBA_K0(i) ((i) < 4 ? qb * 256 + 64 * (i) : 64 * ((i) - 4))
    LAS unsigned char* Kb2 = Kb; LAS unsigned char* Vb2 = Kb + 4 * TILEB;
    LAS float* KM2 = (LAS float*)(Kb + 4 * TILEB + 4 * VTILEB); (void)KM2;
    v4u krA[1], vrA[1], krB[1], vrB[1];
    { const int k0 = MOBA_K0(0), k1 = MOBA_K0(1);
      attn_stage_load<64>(krA, vrA, Kg0 + (size_t)k0 * QKVW, Kg0 + (size_t)k0 * QKVW + 512, QKVW, tid); attn_stage_load<64>(krB, vrB, Kg0 + (size_t)k1 * QKVW, Kg0 + (size_t)k1 * QKVW + 512, QKVW, tid);
      attn_stage_store<64>(krA, vrA, Kb2, Vb2, tid); attn_stage_store<64>(krB, vrB, Kb2 + TILEB, Vb2 + VTILEB, tid); }
    __syncthreads();
    for (int i = 0; i < nt; i += 2) {
        const int sb = (i >> 1) & 1;
        if (i + 2 < nt) { const int k2 = MOBA_K0(i + 2), k3 = MOBA_K0(i + 3);
            attn_stage_load<64>(krA, vrA, Kg0 + (size_t)k2 * QKVW, Kg0 + (size_t)k2 * QKVW + 512, QKVW, tid); attn_stage_load<64>(krB, vrB, Kg0 + (size_t)k3 * QKVW, Kg0 + (size_t)k3 * QKVW + 512, QKVW, tid); }
#pragma unroll
        for (int e = 0; e < 2; ++e) { const int ii = i + e; const int k0 = MOBA_K0(ii);
            bool on; bool go;
            if (ii < 4) { on = true; go = (ii <= (wave >> 1)); }
            else { on = (sel >> ((ii - 4) >> 2)) & 1u; go = __any(on) != 0; }
            if (go) attn_tile<64, 1>(Kb2 + (2 * sb + e) * TILEB, Vb2 + (2 * sb + e) * VTILEB, qf, o, m, l, TB + (k0 - qpos + 4095 + 4 * hh), on, lane); }
        if (i + 2 < nt) { attn_stage_store<64>(krA, vrA, Kb2 + (2 * (sb ^ 1)) * TILEB, Vb2 + (2 * (sb ^ 1)) * VTILEB, tid); attn_stage_store<64>(krB, vrB, Kb2 + (2 * (sb ^ 1) + 1) * TILEB, Vb2 + (2 * (sb ^ 1) + 1) * VTILEB, tid); }
        __syncthreads();
    }
#undef MOBA_K0
    const float lt = l + __shfl_xor(l, 32);
    attn_store_o<64>(o, 1.0f / lt, OMOBA + tokq * 512 + h * 64, hh);
}
__device__ __forceinline__ void dil_unit(LAS unsigned char* lds, const bf16* P, const float* rel_bias, bf16* ODG, float* LSE, int b, int g, int h, int res, int blk, int tid, int lane, int wave) {
    constexpr int TILEB = ACfg<64>::TILEB, VTILEB = ACfg<64>::VTILEB;
    const int r = lane & 31, hh = lane >> 5, d = 1 << (2 * g), l0 = blk * 256;
    LAS float* TB = (LAS float*)lds;
    LAS unsigned char* Kb = lds + ATT_TB_BYTES; LAS unsigned char* Vb = Kb + 2 * TILEB;
    float tbv; { const int j = 256 - tid, jc = j < 0 ? 0 : (j > 128 ? 128 : j); tbv = (DBG_NOBIAS ? 0.f : rel_bias[t5_bucket(jc * d) * 20 + g * 4 + h] * L2E); if (j < 0 || j > 128) tbv = -__builtin_inff(); }
    const int q0w = l0 + wave * 32, lq = q0w + r; const size_t tokq = (size_t)b * SEQ + (size_t)lq * d + res;
    v4u qw[4];
#pragma unroll
    for (int ks = 0; ks < 4; ++ks) qw[ks] = *(const v4u*)(P + tokq * QKVW + g * 768 + h * 64 + ks * 16 + hh * 8);
    f32x16 o[2];
#pragma unroll
    for (int reg = 0; reg < 16; ++reg) { o[0][reg] = 0.f; o[1][reg] = 0.f; }
    float m = -1e30f, l = 0.f;
    const bf16* Kg0 = P + ((size_t)b * SEQ + res) * QKVW + g * 768 + 256 + h * 64;
    const size_t rs = (size_t)QKVW * d;
    const int kt0 = (l0 == 0) ? 0 : -2, nt = 4 - kt0;
    LAS unsigned char* Kb2 = Kb; LAS unsigned char* Vb2 = Kb + 4 * TILEB;
#define DIL_TILE(j, e) ((e) == 0 ? (j) : (nt == 6 ? (j) + 3 : 3 - (j)))
#define DIL_LOAD(i, kr, vr) do { const int k0_ = l0 + 64 * (kt0 + (i)); attn_stage_load<64>(kr, vr, Kg0 + (size_t)k0_ * rs, Kg0 + (size_t)k0_ * rs + 256, rs, tid); } while (0)
    v4u kr0[1], vr0[1], kr1[1], vr1[1], kr2[1], vr2[1], kr3[1], vr3[1], kr4[1], vr4[1], kr5[1], vr5[1];
    DIL_LOAD(DIL_TILE(0, 0), kr0, vr0); DIL_LOAD(DIL_TILE(0, 1), kr1, vr1); DIL_LOAD(DIL_TILE(1, 0), kr2, vr2); DIL_LOAD(DIL_TILE(1, 1), kr3, vr3);
    if (nt == 6) { DIL_LOAD(DIL_TILE(2, 0), kr4, vr4); DIL_LOAD(DIL_TILE(2, 1), kr5, vr5); }
    TB[tid] = tbv;
    bf16x8 qf[4];
#pragma unroll
    for (int ks = 0; ks < 4; ++ks) { const float sc_ = 0.125f * L2E; const v4u w = qw[ks];
        qf[ks] = pack8(bf_lo(w.x) * sc_, bf_hi(w.x) * sc_, bf_lo(w.y) * sc_, bf_hi(w.y) * sc_, bf_lo(w.z) * sc_, bf_hi(w.z) * sc_, bf_lo(w.w) * sc_, bf_hi(w.w) * sc_); }
    attn_stage_store<64>(kr0, vr0, Kb2, Vb2, tid); attn_stage_store<64>(kr1, vr1, Kb2 + TILEB, Vb2 + VTILEB, tid);
    __syncthreads();
    const int nsteps = nt >> 1;
#define DIL_STEP(j, KRN0, VRN0, KRN1, VRN1) do { if ((j) < nsteps) { const int sb = (j) & 1; \
        _Pragma("unroll") for (int e = 0; e < 2; ++e) { const int k0 = l0 + 64 * (kt0 + DIL_TILE((j), e)); \
            const bool go = (k0 + 63 >= q0w - 128) && (k0 <= q0w + 31); \
            if (go) attn_tile<64, 1>(Kb2 + (2 * sb + e) * TILEB, Vb2 + (2 * sb + e) * VTILEB, qf, o, m, l, TB + (k0 - lq + 256 + 4 * hh), true, lane); } \
        if ((j) + 1 < nsteps) { attn_stage_store<64>(KRN0, VRN0, Kb2 + (2 * (sb ^ 1)) * TILEB, Vb2 + (2 * (sb ^ 1)) * VTILEB, tid); attn_stage_store<64>(KRN1, VRN1, Kb2 + (2 * (sb ^ 1) + 1) * TILEB, Vb2 + (2 * (sb ^ 1) + 1) * VTILEB, tid); } \
        __syncthreads(); } } while (0)
    DIL_STEP(0, kr2, vr2, kr3, vr3);
    DIL_STEP(1, kr4, vr4, kr5, vr5);
    DIL_STEP(2, kr4, vr4, kr5, vr5);
#undef DIL_STEP
#undef DIL_TILE
#undef DIL_LOAD
    const float lt = l + __shfl_xor(l, 32);
    attn_store_o<64>(o, 1.0f / lt, ODG + ((size_t)g * T + tokq) * 256 + h * 64, hh);
    if (hh == 0) LSE[((size_t)g * T + tokq) * 4 + h] = (m + __builtin_amdgcn_logf(lt)) * 0.6931471805599453f;
}
__device__ __forceinline__ void cross_unit(LAS unsigned char* lds, const bf16* QC, const bf16* KVC, bf16* OC, int b, int h, int qblk, int tid, int lane, int wave) {
    constexpr int TILEB = ACfg<128>::TILEB, VTILEB = ACfg<128>::VTILEB;
    const int r = lane & 31, hh = lane >> 5;
    LAS unsigned char* Kb = lds + ATT_TB_BYTES; LAS unsigned char* Vb = Kb + 2 * TILEB;
    const size_t tokq = (size_t)b * SEQ + qblk * 256 + wave * 32 + r;
    bf16x8 qf[8]; attn_load_q<128>(qf, QC + tokq * 512 + h * 128, hh, 0.08838834764831845f * L2E);
    f32x16 o[4];
#pragma unroll
    for (int reg = 0; reg < 16; ++reg) { o[0][reg] = 0.f; o[1][reg] = 0.f; o[2][reg] = 0.f; o[3][reg] = 0.f; }
    float m = -1e30f, l = 0.f;
    const bf16* Kg0 = KVC + (size_t)b * NMEM * 1024 + h * 128;
    v4u kr[2], vr[2];
    attn_stage_load<128>(kr, vr, Kg0, Kg0 + 512, 1024, tid); attn_stage_store<128>(kr, vr, Kb, Vb, tid);
    __syncthreads();
    for (int i = 0; i < 4; ++i) {
        if (i + 1 < 4) attn_stage_load<128>(kr, vr, Kg0 + (size_t)(64 * (i + 1)) * 1024, Kg0 + (size_t)(64 * (i + 1)) * 1024 + 512, 1024, tid);
        attn_tile<128, 0>(Kb + (i & 1) * TILEB, Vb + (i & 1) * VTILEB, qf, o, m, l, (const LAS float*)lds, true, lane);
        if (i + 1 < 4) attn_stage_store<128>(kr, vr, Kb + ((i + 1) & 1) * TILEB, Vb + ((i + 1) & 1) * VTILEB, tid);
        __syncthreads();
    }
    const float lt = l + __shfl_xor(l, 32);
    attn_store_o<128>(o, 1.0f / lt, OC + tokq * 512 + h * 128, hh);
}
__device__ __forceinline__ void dil_combine(const bf16* ODG, const float* LSE, bf16* ODIL, int gtid, int nthr) {
    for (int it = gtid; it < T * 32; it += nthr) { const int tok = it >> 5, c = it & 31, h = c >> 3;
        const float a0 = LSE[((size_t)0 * T + tok) * 4 + h], a1 = LSE[((size_t)1 * T + tok) * 4 + h], a2 = LSE[((size_t)2 * T + tok) * 4 + h];
        const float mx = fmaxf(a0, fmaxf(a1, a2)); float w0 = __expf(a0 - mx), w1 = __expf(a1 - mx), w2 = __expf(a2 - mx); const float inv = 1.0f / (w0 + w1 + w2); w0 *= inv; w1 *= inv; w2 *= inv;
        const v4u x0 = *(const v4u*)(ODG + ((size_t)0 * T + tok) * 256 + c * 8), x1 = *(const v4u*)(ODG + ((size_t)1 * T + tok) * 256 + c * 8), x2 = *(const v4u*)(ODG + ((size_t)2 * T + tok) * 256 + c * 8);
        v4u o; o.x = pk2(w0 * bf_lo(x0.x) + w1 * bf_lo(x1.x) + w2 * bf_lo(x2.x), w0 * bf_hi(x0.x) + w1 * bf_hi(x1.x) + w2 * bf_hi(x2.x));
        o.y = pk2(w0 * bf_lo(x0.y) + w1 * bf_lo(x1.y) + w2 * bf_lo(x2.y), w0 * bf_hi(x0.y) + w1 * bf_hi(x1.y) + w2 * bf_hi(x2.y));
        o.z = pk2(w0 * bf_lo(x0.z) + w1 * bf_lo(x1.z) + w2 * bf_lo(x2.z), w0 * bf_hi(x0.z) + w1 * bf_hi(x1.z) + w2 * bf_hi(x2.z));
        o.w = pk2(w0 * bf_lo(x0.w) + w1 * bf_lo(x1.w) + w2 * bf_lo(x2.w), w0 * bf_hi(x0.w) + w1 * bf_hi(x1.w) + w2 * bf_hi(x2.w));
        *(v4u*)(ODIL + (size_t)tok * 256 + c * 8) = o; }
}
__device__ __forceinline__ void phase_topk_simple(const bf16* QP, const float* subk, int* EXP, float* EW, float* INV, int lane, int gw, int ngw) {
    for (int unit = gw; unit < T * 8; unit += ngw) {
        const int tok = unit >> 3, head = unit & 7;
        const bf16* qrow = QP + (size_t)tok * 2048 + head * 256;
        float av = 0.f, bv[4] = {0.f, 0.f, 0.f, 0.f}; int ai = 0, bi[4] = {0, 0, 0, 0};
#pragma unroll
        for (int p = 0; p < 2; ++p) {
            float s0 = 0.f, s1 = 0.f;
            const float* k0 = subk + (size_t)(p * 128 + lane) * 128; const float* k1 = subk + (size_t)(p * 128 + 64 + lane) * 128;
            for (int c = 0; c < 128; ++c) { const float qv = bf2f(qrow[p * 128 + c]); s0 += qv * k0[c]; s1 += qv * k1[c]; }
#pragma unroll
            for (int i = 0; i < 16; ++i) {
                float mloc = fmaxf(s0, s1); float mw = mloc;
#pragma unroll
                for (int o = 1; o < 64; o <<= 1) mw = fmaxf(mw, __shfl_xor(mw, o));
                const unsigned long long bal = __ballot(mloc == mw);
                const int wl = __ffsll((long long)bal) - 1;
                int idx = -1;
                if (lane == wl) { if (s0 >= s1) { idx = lane; s0 = -3e38f; } else { idx = lane + 64; s1 = -3e38f; } }
                idx = __shfl(idx, wl);
                if (p == 0) { if ((lane & 15) == i) { av = mw; ai = idx; } }
                else { if ((lane >> 4) == (i >> 2)) { bv[i & 3] = mw; bi[i & 3] = idx; } }
            }
        }
        float cs[4];
#pragma unroll
        for (int jj = 0; jj < 4; ++jj) cs[jj] = av + bv[jj];
        float top0 = 0.f, den = 0.f; int myexp = 0; float myw = 0.f;
#pragma unroll
        for (int k = 0; k < 16; ++k) {
            float mloc = fmaxf(fmaxf(cs[0], cs[1]), fmaxf(cs[2], cs[3])); float mw = mloc;
#pragma unroll
            for (int o = 1; o < 64; o <<= 1) mw = fmaxf(mw, __shfl_xor(mw, o));
            const unsigned long long bal = __ballot(mloc == mw);
            const int wl = __ffsll((long long)bal) - 1;
            int ex = 0;
            if (lane == wl) {
                if (cs[0] == mw) { ex = ai * 128 + bi[0]; cs[0] = -3e38f; }
                else if (cs[1] == mw) { ex = ai * 128 + bi[1]; cs[1] = -3e38f; }
                else if (cs[2] == mw) { ex = ai * 128 + bi[2]; cs[2] = -3e38f; }
                else { ex = ai * 128 + bi[3]; cs[3] = -3e38f; }
            }
            ex = __shfl(ex, wl);
            if (k == 0) top0 = mw;
            const float e = __expf(mw - top0); den += e;
            if (lane == k) { myexp = ex; myw = e; }
        }
        if (lane < 16) { EXP[(size_t)tok * 128 + head * 16 + lane] = myexp; EW[(size_t)tok * 128 + head * 16 + lane] = myw; }
        if (lane == 0) INV[(size_t)tok * 8 + head] = 1.0f / den;
    }
}
#if DBG_CHECK || DBG_ATTN_CHECK
constexpr size_t WS_YDBG = 510 * MiB;
constexpr int CW_DBG = 64;
__device__ __forceinline__ void dbg_acc(float* acc, float num, float den, int lane) { num = wave_sum(num); den = wave_sum(den); if (lane == 0) { atomicAdd(acc, num); atomicAdd(acc + 1, den); } }
__device__ __forceinline__ int dbg_tok(int s) { return s * 512 + 3 + (s & 7) * 37; }
__device__ __forceinline__ void dbg_check_qp(const bf16* H, const float* w_qp, const bf16* QP, float* acc, int gtid, int nthr, int lane) {
    float num = 0.f, den = 0.f;
    for (int item = gtid; item < 64 * 2048; item += nthr) { const int s = item / 2048, n = item % 2048, t = dbg_tok(s);
        float r = 0.f; for (int k = 0; k < 1024; ++k) r += bf2f(H[(size_t)t * 1024 + k]) * w_qp[(size_t)k * 2048 + n];
        const float mine = bf2f(QP[(size_t)t * 2048 + n]); num += (r - mine) * (r - mine); den += r * r; }
    dbg_acc(acc, num, den, lane);
}
__device__ __forceinline__ void dbg_check_gather(const bf16* H, const float* u, const float* v, const int* EXP, const float* EW, const float* INV, const float* YDBG, float* acc, int gw, int ngw, int lane) {
    float num = 0.f, den = 0.f;
    for (int s = gw; s < 64; s += ngw) { const int t = dbg_tok(s);
        float y[16];
#pragma unroll
        for (int c = 0; c < 16; ++c) y[c] = 0.f;
        for (int i = 0; i < 128; ++i) { const int e = EXP[(size_t)t * 128 + i]; const float g = EW[(size_t)t * 128 + i] * INV[(size_t)t * 8 + (i >> 4)];
            float d = 0.f;
#pragma unroll
            for (int c = 0; c < 16; ++c) d += bf2f(H[(size_t)t * 1024 + lane * 16 + c]) * u[(size_t)e * 1024 + lane * 16 + c];
            d = wave_sum(d);
            const float w = g * gelu_exact(d);
#pragma unroll
            for (int c = 0; c < 16; ++c) y[c] += w * v[(size_t)e * 1024 + lane * 16 + c]; }
#pragma unroll
        for (int c = 0; c < 16; ++c) { const float mine = YDBG[(size_t)s * 1024 + lane * 16 + c]; num += (y[c] - mine) * (y[c] - mine); den += y[c] * y[c]; } }
    dbg_acc(acc, num, den, lane);
}
__device__ __forceinline__ float dbg_k(const float* acc) { const float D = acc[0] / fmaxf(acc[1], 1e-30f); float k = log10f(fmaxf(D, 1e-12f)); return fminf(fmaxf(k, -6.f), 1.f); }
__device__ __forceinline__ void dbg_encode(const float* x, const float* gfin, float* out, const float* acc, int gw, int ngw, int lane) {
    const float k1 = dbg_k(acc), k2 = dbg_k(acc + 2); const float s = 1.f + (k1 + 6.5f) * 0.5f;
    for (int m = gw; m < T; m += ngw) { const f32x4* xr = (const f32x4*)(x + (size_t)m * 1024) + lane; const f32x4* gr = (const f32x4*)gfin + lane; f32x4 vv[4]; float ss = 0.f;
#pragma unroll
        for (int j = 0; j < 4; ++j) { vv[j] = xr[64 * j]; ss += (vv[j].x * vv[j].x + vv[j].y * vv[j].y) + (vv[j].z * vv[j].z + vv[j].w * vv[j].w); }
        const float rinv = rsqrtf(wave_sum(ss) * (1.f / 1024.f) + RMS_EPS) * s;
#pragma unroll
        for (int j = 0; j < 4; ++j) { f32x4 o = vv[j] * rinv * gr[64 * j]; if (m == 0 && j == 0 && lane == 0) o.x = 100.f + 100.f * (k2 + 6.f); ((f32x4*)(out + (size_t)m * 1024) + lane)[64 * j] = o; } }
}
#endif

struct Args { const float* in[20]; float* out; unsigned char* ws; int ph_lo, ph_hi; };
__global__ void __launch_bounds__(NWAVES * 64, 2) fwd(Args args) {
    extern __shared__ __attribute__((aligned(16))) unsigned char lds_raw[];
    LAS unsigned char* lds = (LAS unsigned char*)lds_raw;
    volatile LAS unsigned* MISC = (volatile LAS unsigned*)(lds + MISC_OFF);
    const int tid = threadIdx.x, lane = tid & 63, wave = __builtin_amdgcn_readfirstlane(tid >> 6);
    const int G = gridDim.x; const int bx = blockIdx.x; const int vcu = (G % 8 == 0) ? (bx % 8) * (G / 8) + bx / 8 : bx;
    const int gw = vcu * NWAVES + wave, NGW = G * NWAVES, gtid = vcu * (NWAVES * 64) + tid, NTHR = G * NWAVES * 64;
    unsigned char* ws = args.ws;
    gu32* ctl = (gu32*)(ws + WS_CTL);
#define X_IN (args.in[0])
#define mem (args.in[1])
#define rel_bias (args.in[2])
#define g_mix (args.in[3])
#define w_in (args.in[4])
#define b_gate (args.in[5])
#define w_a (args.in[6])
#define w_b (args.in[7])
#define w_out (args.in[8])
#define g_cross (args.in[9])
#define g_mem (args.in[10])
#define w_qc (args.in[11])
#define w_kvc (args.in[12])
#define w_oc (args.in[13])
#define g_ffn (args.in[14])
#define w_qp (args.in[15])
#define subk (args.in[16])
#define peer_u (args.in[17])
#define peer_v (args.in[18])
#define g_final (args.in[19])
#define OUTP (args.out)
#define WinT ((bf16*)(ws + WS_WIN))
#define WaT ((bf16*)(ws + WS_WA))
#define WbT ((bf16*)(ws + WS_WB))
#define WoutT ((bf16*)(ws + WS_WOUT))
#define WqcT ((bf16*)(ws + WS_WQC))
#define WkvcT ((bf16*)(ws + WS_WKVC))
#define WocT ((bf16*)(ws + WS_WOC))
#define WqpT ((bf16*)(ws + WS_WQP))
#define SUBK ((bf16*)(ws + WS_SUBK))
#define U8T ((unsigned char*)(ws + WS_U))
#define V8T ((unsigned char*)(ws + WS_V))
#define HB ((bf16*)(ws + WS_H))
#define MEMB ((bf16*)(ws + WS_MEMB))
#define KVC ((bf16*)(ws + WS_KVC))
#define ODIL ((bf16*)(ws + WS_ODIL))
#define OMOBA ((bf16*)(ws + WS_OMOBA))
#define PQKV ((bf16*)(ws + WS_PQKV))
#define MERGED ((bf16*)(ws + WS_MERGED))
#define MERGED8 ((unsigned char*)(ws + WS_QC))
#define X1 ((float*)(ws + WS_X1))
#define QC ((bf16*)(ws + WS_QC))
#define OC ((bf16*)(ws + WS_OC))
#define ODG ((bf16*)(ws + WS_ODG))
#define LSE ((float*)(ws + WS_LSE))
#define EXP ((int*)(ws + WS_EXP))
#define EW ((float*)(ws + WS_EW))
#define INV ((float*)(ws + WS_INV))
#define KMEAN ((float*)(ws + WS_KMEAN))
#define SEB ((int*)(ws + WS_PQKV + 32 * MiB))
#define SGB ((float*)(ws + WS_PQKV + 48 * MiB))
#define OFFB ((int*)(ws + WS_QC))
#define RSS1 ((float*)(ws + WS_RSS1))
#define RSS2 ((float*)(ws + WS_RSS2))
#define GATES ((bf16*)args.out)
#define QP ((bf16*)args.out)
    for (int u = tid; u < (LDS_BYTES - LDSCTL_OFF) / 4; u += NWAVES * 64) ((LAS unsigned*)(lds + LDSCTL_OFF))[u] = 0u;
    __syncthreads();
    const int lo = args.ph_lo, hi = args.ph_hi;
    XcdBarrier bar; bar.bar = (unsigned*)(ctl + CW_BAR); bar.x = 0; bar.st = nullptr;
    if (hi - lo > 1) bar = xcd_barrier_post((unsigned*)(ctl + CW_BAR), MISC + 8);
#define IN(k) (lo <= (k) && (k) < hi)
#define PR_BEG(k) do { if (PROBE_PH == (k) && tid == 0) MISC[16] = (unsigned)__builtin_amdgcn_s_memrealtime(); } while (0)
#define PR_END(k) do { if (PROBE_PH == (k) && tid == 0) MISC[17] = (unsigned)__builtin_amdgcn_s_memrealtime(); } while (0)
#define SEAM(k) do { if (IN(k) && IN((k) + 1)) xcd_barrier(bar); } while (0)

    PR_BEG(0);
    if (IN(0)) {
        LAS float* scr = (LAS float*)(lds + RING_OFF + wave * 16384);
        constexpr int I_IN = (1024 / 64) * (NIN / 32), I_A = (256 / 64) * (1024 / 32), I_B = (512 / 64) * (1024 / 32), I_OUT = (1024 / 64) * (1024 / 32), I_QC = (1024 / 64) * (512 / 32),
                      I_KVC = (1024 / 64) * (1024 / 32), I_OC = (512 / 64) * (1024 / 32), I_QP = (1024 / 64) * (2048 / 32);
        constexpr int NITEMS = I_IN + I_A + I_B + I_OUT + I_QC + I_KVC + I_OC + I_QP;
        for (int it = gw; it < NITEMS; it += NGW) {
            int r = it;
            if (r < I_IN) { p0_transpose_item_fp8(w_in, 1024, NIN, (unsigned char*)WinT, scr, r, lane, WIN8_SCALE); continue; } r -= I_IN;
            if (r < I_A) { p0_transpose_item(w_a, 256, 1024, WaT, scr, r, lane); continue; } r -= I_A;
            if (r < I_B) { p0_transpose_item(w_b, 512, 1024, WbT, scr, r, lane); continue; } r -= I_B;
            if (r < I_OUT) { p0_transpose_item_fp8(w_out, 1024, 1024, (unsigned char*)WoutT, scr, r, lane, WIN8_SCALE); continue; } r -= I_OUT;
            if (r < I_QC) { p0_transpose_item(w_qc, 1024, 512, WqcT, scr, r, lane, g_cross); continue; } r -= I_QC;
            if (r < I_KVC) { p0_transpose_item(w_kvc, 1024, 1024, WkvcT, scr, r, lane); continue; } r -= I_KVC;
            if (r < I_OC) { p0_transpose_item(w_oc, 512, 1024, WocT, scr, r, lane); continue; } r -= I_OC;
            p0_transpose_item(w_qp, 1024, 2048, WqpT, scr, r, lane, g_ffn);
        }
        cvt_f32_to_bf16_bulk(subk, SUBK, (size_t)2 * 128 * 128, (size_t)gtid, (size_t)NTHR);
        for (int m = gw; m < T; m += NGW) rms_row_to_fp8(X_IN + (size_t)m * DM, g_mix, (unsigned char*)HB + (size_t)m * DM, lane);
        for (int m = gw; m < MROWS; m += NGW) rms_row_to_bf16(mem + (size_t)m * DM, g_mem, MEMB + (size_t)m * DM, lane);
        __syncthreads();
    }
    SEAM(0);
    PR_END(0);
    PR_BEG(1);
    if (IN(1)) {
        if (DBG_MIX) { pg8::Gemm g{HB, WinT, T, NIN, DM / 2}; pg8::StaticOrder S; S.init(T, NIN, G, bx); pg8::EpiIn E{PQKV, GATES, b_gate, 1.0f / WIN8_SCALE};
          pg8::gemm_phase<pg8::EpiIn, pg8::StaticOrder, true, true, true>(lds + RING_OFF, g, S, E); }
        __syncthreads();
        if (DBG_CROSS) { pg8::Gemm g{MEMB, WkvcT, MROWS, 1024, DM}; pg8::StaticOrder S; S.init(MROWS, 1024, G, bx); pg8::EpiStore E{KVC, 1024};
          pg8::gemm_phase<pg8::EpiStore, pg8::StaticOrder, true, true>(lds + RING_OFF, g, S, E); }
        {
            constexpr int CH = 16384, NCH_U = (16384 * 1024) / CH, NCH = 2 * NCH_U;
            for (;;) {
                int c = 0; if (lane == 0) c = (int)__hip_atomic_fetch_add((unsigned*)(ctl + CW_WORK), 1u, __ATOMIC_RELAXED, __HIP_MEMORY_SCOPE_AGENT);
                c = __builtin_amdgcn_readfirstlane(c);
                if (c >= NCH) break;
                const bool isv = c >= NCH_U; const int cc = isv ? c - NCH_U : c;
                const float* src = (isv ? peer_v : peer_u) + (size_t)cc * CH; unsigned char* dst = (isv ? V8T : U8T) + (size_t)cc * CH;
                cvt_f32_to_fp8_bulk(src, dst, (size_t)CH, isv ? V8_SCALE : U8_SCALE, (size_t)lane, (size_t)64, isv ? (const float*)nullptr : g_ffn);
            }
        }
    }
    SEAM(1);
    PR_END(1);
    PR_BEG(2);
    if (IN(2) && DBG_MIX) {
#if ATTN_MFMA
        for (int u = vcu; u < NB * 3 * 4 * 16; u += G) { const int u16 = u & 15,     bgh = u >> 4, h = bgh & 3, g = (bgh >> 2) % 3, b = (bgh >> 2) / 3;
            dil_unit(lds + RING_OFF, PQKV, rel_bias, ODG, LSE, b, g, h, u16 & ((1 << (2 * g)) - 1), u16 >> (2 * g), tid, lane, wave); }
#endif
        for (int it = gw; it < NB * 8 * 16; it += NGW) { const int bh = it >> 4, blk = it & 15, b = bh >> 3, h = bh & 7;
            const bf16* kp = PQKV + (size_t)(b * SEQ + blk * 256 + (lane >> 3)) * QKVW + 2304 + 512 + h * 64 + 8 * (lane & 7);
            float s8[8] = {0.f, 0.f, 0.f, 0.f, 0.f, 0.f, 0.f, 0.f};
#pragma unroll 8
            for (int j = 0; j < 32; ++j) { const v4u w = *(const v4u*)(kp + (size_t)(8 * j) * QKVW);
                s8[0] += bf_lo(w.x); s8[1] += bf_hi(w.x); s8[2] += bf_lo(w.y); s8[3] += bf_hi(w.y); s8[4] += bf_lo(w.z); s8[5] += bf_hi(w.z); s8[6] += bf_lo(w.w); s8[7] += bf_hi(w.w); }
#pragma unroll
            for (int c = 0; c < 8; ++c) { float v = s8[c]; v += __shfl_xor(v, 8); v += __shfl_xor(v, 16); v += __shfl_xor(v, 32); s8[c] = v * (1.0f / 256.0f); }
            if (lane < 8) { f32x4* dst = (f32x4*)(KMEAN + (size_t)it * 64 + 8 * lane); dst[0] = (f32x4){s8[0], s8[1], s8[2], s8[3]}; dst[1] = (f32x4){s8[4], s8[5], s8[6], s8[7]}; } }
    }
    SEAM(2);
    PR_END(2);
    PR_BEG(3);
    if (IN(3) && DBG_MIX) {
#if ATTN_MFMA
        for (int pu = vcu; pu < NB * 8 * 8; pu += G) { const int bh = pu >> 3, p = pu & 7, b = bh >> 3, h = bh & 7;
            moba_unit(lds + RING_OFF, PQKV, KMEAN, rel_bias, OMOBA, b, h, p, tid, lane, wave);
            moba_unit(lds + RING_OFF, PQKV, KMEAN, rel_bias, OMOBA, b, h, 15 - p, tid, lane, wave); }
        dil_combine(ODG, LSE, ODIL, gtid, NTHR);
#else
        phase_dil_simple<false>(PQKV, rel_bias, ODIL, gtid, NTHR); phase_moba_simple<false>(PQKV, KMEAN, rel_bias, OMOBA, gtid, NTHR);
#endif
    }
    SEAM(3);
    PR_END(3);
    PR_BEG(4);
#if DBG_ATTN_CHECK && DBG_P4CHK
    if (IN(4)) { if (DBG_DIL_CHECK) phase_dil_simple<true>(PQKV, rel_bias, ODIL, gtid, NTHR, (float*)(ctl + CW_DBG)); else phase_moba_simple<true>(PQKV, KMEAN, rel_bias, OMOBA, gtid, NTHR, (float*)(ctl + CW_DBG)); }
#endif
    if (IN(4) && DBG_MIX && !(DBG_ATTN_CHECK && DBG_P4CHK)) { pg8::Gemm g{ODIL, WaT, T, 1024, 256}; pg8::StaticOrder S; S.init(T, 1024, G, bx); pg8::EpiGate<false, true> E{MERGED, GATES, 0, MERGED8, MRG8_SCALE};
        pg8::gemm_phase<pg8::EpiGate<false, true>, pg8::StaticOrder, true, true>(lds + RING_OFF, g, S, E); }
    SEAM(4);
    PR_END(4);
    PR_BEG(5);
    if (IN(5) && DBG_MIX && !(DBG_ATTN_CHECK && DBG_P4CHK)) { pg8::Gemm g{OMOBA, WbT, T, 1024, 512}; pg8::StaticOrder S; S.init(T, 1024, G, bx); pg8::EpiGate<true, true> E{MERGED, GATES, 1024, MERGED8, MRG8_SCALE};
        pg8::gemm_phase<pg8::EpiGate<true, true>, pg8::StaticOrder, true, true>(lds + RING_OFF, g, S, E); }
    SEAM(5);
    PR_END(5);
    PR_BEG(6);
    if (IN(6) && !(DBG_ATTN_CHECK && DBG_P4CHK)) { pg8::Gemm g{(const bf16*)MERGED8, WoutT, T, 1024, 1024 / 2}; pg8::StaticOrder S; S.init(T, 1024, G, bx); pg8::EpiRes E{X_IN, nullptr, 1024, (float)DBG_MIX / (MRG8_SCALE * WIN8_SCALE), HB, RSS1, nullptr, nullptr};
        pg8::gemm_phase<pg8::EpiRes, pg8::StaticOrder, true, true, true>(lds + RING_OFF, g, S, E); }
    SEAM(6);
    PR_END(6);
    PR_BEG(7);
    PR_BEG(8);
    if (IN(8) && DBG_CROSS) { pg8::Gemm g{HB, WqcT, T, 512, 1024}; pg8::StaticOrder S; S.init(T, 512, G, bx); pg8::EpiStoreRs E{QC, 512, RSS1, 1.0f};
        pg8::gemm_phase<pg8::EpiStoreRs, pg8::StaticOrder, true, true>(lds + RING_OFF, g, S, E); }
    SEAM(8);
    PR_END(8);
    PR_BEG(9);
    if (IN(9) && DBG_CROSS) {
#if ATTN_MFMA
        for (int u = vcu; u < NB * 4 * 16; u += G) cross_unit(lds + RING_OFF, QC, KVC, OC, u >> 6, (u >> 4) & 3, u & 15, tid, lane, wave);
#else
        phase_cross_simple<false>(QC, KVC, OC, gtid, NTHR);
#endif
    }
    SEAM(9);
    PR_END(9);
    PR_BEG(10);
#if DBG_ATTN_CHECK
    if (IN(10) && DBG_CROSS_CHECK) phase_cross_simple<true>(QC, KVC, OC, gtid, NTHR, (float*)(ctl + CW_DBG) + 2);
#endif
    if (IN(10)) { pg8::Gemm g{OC, WocT, T, 1024, 512}; pg8::StaticOrder S; S.init(T, 1024, G, bx); pg8::EpiRes E{nullptr, nullptr, 1024, (float)DBG_CROSS, HB, RSS2, nullptr, HB};
        pg8::gemm_phase<pg8::EpiRes, pg8::StaticOrder, true, true>(lds + RING_OFF, g, S, E); }
    SEAM(10);
    PR_END(10);
    PR_BEG(11);
    PR_BEG(12);
    if (IN(12) && DBG_PEER) { pg8::Gemm g{HB, WqpT, T, 2048, 1024}; pg8::StaticOrder S; S.init(T, 2048, G, bx); pg8::EpiStoreRs E{QP, 2048, RSS2, 1.0f};
        pg8::gemm_phase<pg8::EpiStoreRs, pg8::StaticOrder, true, true>(lds + RING_OFF, g, S, E); }
    SEAM(12);
    PR_END(12);
    PR_BEG(13);
#if DBG_CHECK
    if (IN(13)) dbg_check_qp(HB, w_qp, QP, (float*)(ctl + CW_DBG), gtid, NTHR, lane);
#endif
#if DBG_TOPK_SIMPLE
    if (IN(13) && DBG_PEER) { phase_topk_simple(QP, subk, EXP, EW, INV, lane, gw, NGW); }
#else
    if (IN(13) && DBG_PEER) { phase_topk(lds + RING_OFF, QP, SUBK, SEB, (float*)OFFB, tid, lane, wave, vcu, G); }
#endif
    SEAM(13);
    PR_END(13);
#if PROBE_PH >= 20
    PR_BEG(PROBE_PH);
    if (IN(14)) { const int lane15 = (int)__builtin_amdgcn_mbcnt_hi(~0u, __builtin_amdgcn_mbcnt_lo(~0u, 0u));
        peer_probe<PROBE_PH - 20>(HB, RSS2, U8T, V8T, SGB, SEB, (const float*)OFFB, OUTP, lane15, wave, gw, NGW, vcu, lds, g_final); xcd_barrier(bar); }
    PR_END(PROBE_PH);
#endif
    PR_BEG(14);
    if (IN(14)) { const int lane14 = (int)__builtin_amdgcn_mbcnt_hi(~0u, __builtin_amdgcn_mbcnt_lo(~0u, 0u));
        phase_peer(HB, RSS2, U8T, V8T, SGB, SEB, (const float*)OFFB, g_final, OUTP, lane14, wave, gw, NGW, (float)DBG_PEER, DBG_YPTR, (PROBE_PH >= 0 && PROBE_PH < 20) ? 1.0f + sqrtf((float)(MISC[17] - MISC[16]) * (0.01f / PROBE_K)) : 1.0f, lds); }
#if DBG_CHECK || DBG_ATTN_CHECK
#if DBG_CHECK
    if (IN(15)) dbg_check_gather(HB, peer_u, peer_v, EXP, EW, INV, (const float*)(ws + WS_YDBG), (float*)(ctl + CW_DBG) + 2, gw, NGW, lane);
#endif
    if (IN(16)) dbg_encode(X_IN, g_final, OUTP, (const float*)(ctl + CW_DBG), gw, NGW, lane);
#endif
#undef IN
#undef SEAM
#undef X_IN
#undef mem
#undef rel_bias
#undef g_mix
#undef w_in
#undef b_gate
#undef w_a
#undef w_b
#undef w_out
#undef g_cross
#undef g_mem
#undef w_qc
#undef w_kvc
#undef w_oc
#undef g_ffn
#undef w_qp
#undef subk
#undef peer_u
#undef peer_v
#undef g_final
#undef OUTP
#undef WinT
#undef WaT
#undef WbT
#undef WoutT
#undef WqcT
#undef WkvcT
#undef WocT
#undef WqpT
#undef SUBK
#undef U8T
#undef V8T
#undef HB
#undef MEMB
#undef KVC
#undef ODIL
#undef OMOBA
#undef PQKV
#undef MERGED
#undef MERGED8
#undef X1
#undef QC
#undef OC
#undef ODG
#undef LSE
#undef EXP
#undef EW
#undef INV
#undef KMEAN
#undef RSS1
#undef SEB
#undef SGB
#undef OFFB
#undef RSS2
#undef GATES
#undef QP

}

extern "C" void kernel_launch(void* const* d_in, const int* in_sizes, int n_in, void* d_out, int out_size, void* d_ws, size_t ws_size, hipStream_t stream) {
    static int grid = 0;
    if (grid == 0) {
        if (n_in != 20 || out_size != T * DM || ws_size < WS_END) { fprintf(stderr, "kernel_launch: unexpected shapes (n_in %d, out %d, ws %zu); nothing launched\n", n_in, out_size, ws_size); grid = -1; return; }
        int dev = 0, cus = 0, per_cu = 0;
        if (hipGetDevice(&dev) != hipSuccess || hipDeviceGetAttribute(&cus, hipDeviceAttributeMultiprocessorCount, dev) != hipSuccess) { grid = -1; return; }
        if (hipFuncSetAttribute((const void*)fwd, hipFuncAttributeMaxDynamicSharedMemorySize, LDS_BYTES) != hipSuccess) { fprintf(stderr, "kernel_launch: hipFuncSetAttribute failed\n"); grid = -1; return; }
        if (hipOccupancyMaxActiveBlocksPerMultiprocessor(&per_cu, (const void*)fwd, NWAVES * 64, LDS_BYTES) != hipSuccess || per_cu < 1) { fprintf(stderr, "kernel_launch: occupancy query says %d\n", per_cu); }
        (void)hipGetLastError();
        grid = cus;
    }
    if (grid < 0) return;
    if (hipMemsetAsync((char*)d_ws + WS_CTL, 0, CTL_ZERO_BYTES, stream) != hipSuccess) return;
    Args a{};
    for (int i = 0; i < 20; ++i) a.in[i] = (const float*)d_in[i];
    a.out = (float*)d_out; a.ws = (unsigned char*)d_ws;
#if MK_ONE_LAUNCH
    a.ph_lo = 0; a.ph_hi = NPH;
    hipLaunchKernelGGL(fwd, dim3(grid), dim3(NWAVES * 64), LDS_BYTES, stream, a);
#else
    for (int p = 0; p < NPH + ((DBG_CHECK || DBG_ATTN_CHECK) ? 2 : 0); ++p) { a.ph_lo = p; a.ph_hi = p + 1; hipLaunchKernelGGL(fwd, dim3(grid), dim3(NWAVES * 64), LDS_BYTES, stream, a); }
#endif
}
```

```cpp
#include <hip/hip_runtime.h>
#include <cstdio>
#include <cstdint>
#include <cmath>
namespace pg8 {
#define PG8_LAS __attribute__((address_space(3)))
typedef unsigned short bf16_t;
typedef short bf16x8 __attribute__((ext_vector_type(8)));
typedef float f32x4 __attribute__((ext_vector_type(4)));
typedef unsigned u32x4 __attribute__((ext_vector_type(4)));
typedef int v4i32 __attribute__((ext_vector_type(4)));
typedef int v8i32 __attribute__((ext_vector_type(8)));
constexpr int BM = 256, BK = 64, HALF = 128, HTB = HALF * BK * 2  , STAGE_BYTES = 8 * HTB, NXCD = 8, WGM = 8;

__host__ __device__ __forceinline__ int lds_byte(int r, int c) { const int st = (r >> 4) * 2 + (c >> 5), rr = r & 15, cc = c & 31, ob = rr * 64 + cc * 2; return st * 1024 + (ob ^ (((ob >> 9) & 1) << 5)); }
__host__ __device__ __forceinline__ void stage_rc(int b, int& R, int& C) { const int st = b / 1024, sb = b % 1024, swz = sb ^ (((sb >> 9) & 1) << 5); R = (st >> 1) * 16 + swz / 64; C = (st & 1) * 32 + (swz % 64) / 2; }
__host__ __device__ __forceinline__ int perm32(int rho) { const int n = rho >> 4, i = rho & 15; return 8 * (i >> 2) + 4 * n + (i & 3); }

struct Unit { int pm, pn; };
struct Gemm { const bf16_t* A; const bf16_t* Bt; int M, N, K; };

struct StaticOrder {
    int nM, nN, nwg, G, c;
    __host__ __device__ void init(int M, int N, int G_, int c_) { nM = M / BM; nN = N / BM; nwg = nM * nN; G = G_; c = c_; }
    __host__ __device__ bool next(int i, Unit& u) const {
        const long L = (long)i * G + c; if (L >= nwg) return false;
        int wgid = (int)L; { const int q = nwg / NXCD, r = nwg % NXCD, xcd = wgid % NXCD, off = wgid / NXCD; wgid = (xcd < r ? xcd * (q + 1) : r * (q + 1) + (xcd - r) * q) + off; }
        const int nig = WGM * nN, gid = wgid / nig, fm = gid * WGM, gsz = (nM - fm) < WGM ? (nM - fm) : WGM;
        u.pm = fm + ((wgid % nig) % gsz); u.pn = (wgid % nig) / gsz; return true;
    }
    __device__ __forceinline__ void a_ready(const Unit&) const {}
    __device__ __forceinline__ void done(const Unit&) const {}
};

__device__ __forceinline__ unsigned cvt_pk_bf16(float lo, float hi) { unsigned r; asm volatile("v_cvt_pk_bf16_f32 %0, %1, %2" : "=v"(r) : "v"(lo), "v"(hi)); return r; }
typedef float f32x2 __attribute__((ext_vector_type(2)));
__device__ __forceinline__ float bf_lo(unsigned w) { return __uint_as_float(w << 16); }
__device__ __forceinline__ float bf_hi(unsigned w) { return __uint_as_float(w & 0xffff0000u); }
__device__ __forceinline__ float sigmoidf_(float x) { return 1.0f / (1.0f + __expf(-x)); }
struct EpiStore {
    static constexpr bool PERM = true, AFTER_DRAIN = false;
    bf16_t* O; int ldc;
    __device__ __forceinline__ void operator()(const f32x4 (&acc)[2][2][4][2], const Unit& u, int wr, int wc, int fr, int fq) const {
        const int row0 = u.pm * BM + wr * 64 + fr, col0 = u.pn * BM + wc * 32 + 8 * fq;
#pragma unroll
        for (int ai = 0; ai < 2; ++ai)
#pragma unroll
            for (int m = 0; m < 4; ++m) { bf16_t* rowp = O + (size_t)(row0 + ai * HALF + m * 16) * ldc + col0;
#pragma unroll
                for (int bj = 0; bj < 2; ++bj) { const f32x4 v0 = acc[ai][bj][m][0], v1 = acc[ai][bj][m][1];
                    u32x4 w; w.x = cvt_pk_bf16(v0[0], v0[1]); w.y = cvt_pk_bf16(v0[2], v0[3]); w.z = cvt_pk_bf16(v1[0], v1[1]); w.w = cvt_pk_bf16(v1[2], v1[3]);
                    *(u32x4*)(rowp + bj * HALF) = w; } }
    }
};
struct EpiIn {
    static constexpr bool PERM = true, AFTER_DRAIN = false;
    bf16_t* P; bf16_t* G; const float* bgate; float wsc;
    __device__ __forceinline__ void operator()(const f32x4 (&acc)[2][2][4][2], const Unit& u, int wr, int wc, int fr, int fq) const {
        const int row0 = u.pm * BM + wr * 64 + fr;
        if (u.pn < 15) {
            const int col0 = u.pn * BM + wc * 32 + 8 * fq;
#pragma unroll
            for (int ai = 0; ai < 2; ++ai)
#pragma unroll
                for (int m = 0; m < 4; ++m) { bf16_t* rowp = P + (size_t)(row0 + ai * HALF + m * 16) * 3840 + col0;
#pragma unroll
                    for (int bj = 0; bj < 2; ++bj) { const f32x4 v0 = acc[ai][bj][m][0] * wsc, v1 = acc[ai][bj][m][1] * wsc;
                        u32x4 w; w.x = cvt_pk_bf16(v0[0], v0[1]); w.y = cvt_pk_bf16(v0[2], v0[3]); w.z = cvt_pk_bf16(v1[0], v1[1]); w.w = cvt_pk_bf16(v1[2], v1[3]);
                        *(u32x4*)(rowp + bj * HALF) = w; } }
        } else {
            const int col0 = (u.pn - 15) * BM + wc * 32 + 8 * fq;
            f32x4 bv[2][2];
#pragma unroll
            for (int bj = 0; bj < 2; ++bj)
#pragma unroll
                for (int n = 0; n < 2; ++n) bv[bj][n] = *(const f32x4*)(bgate + col0 + bj * HALF + 4 * n);
#pragma unroll
            for (int ai = 0; ai < 2; ++ai)
#pragma unroll
                for (int m = 0; m < 4; ++m) { unsigned char* rowp = (unsigned char*)G + (size_t)(row0 + ai * HALF + m * 16) * 2048 + col0;
#pragma unroll
                    for (int bj = 0; bj < 2; ++bj) { const f32x4 v0 = acc[ai][bj][m][0] * wsc + bv[bj][0], v1 = acc[ai][bj][m][1] * wsc + bv[bj][1];
                        int w0 = 0, w1 = 0;
                        w0 = __builtin_amdgcn_cvt_pk_fp8_f32(sigmoidf_(v0[0]), sigmoidf_(v0[1]), w0, false); w0 = __builtin_amdgcn_cvt_pk_fp8_f32(sigmoidf_(v0[2]), sigmoidf_(v0[3]), w0, true);
                        w1 = __builtin_amdgcn_cvt_pk_fp8_f32(sigmoidf_(v1[0]), sigmoidf_(v1[1]), w1, false); w1 = __builtin_amdgcn_cvt_pk_fp8_f32(sigmoidf_(v1[2]), sigmoidf_(v1[3]), w1, true);
                        *(unsigned long long*)(rowp + bj * HALF) = (unsigned long long)(unsigned)w0 | ((unsigned long long)(unsigned)w1 << 32); } }
        }
    }
};
template <bool ADD, bool F8OUT> struct EpiGate {
    static constexpr bool PERM = true, AFTER_DRAIN = false;
    bf16_t* O; const bf16_t* G; int gcol; unsigned char* O8; float o8scale;
    __device__ __forceinline__ void operator()(const f32x4 (&acc)[2][2][4][2], const Unit& u, int wr, int wc, int fr, int fq) const {
        const int row0 = u.pm * BM + wr * 64 + fr, col0 = u.pn * BM + wc * 32 + 8 * fq;
#pragma unroll
        for (int ai = 0; ai < 2; ++ai)
#pragma unroll
            for (int m = 0; m < 4; ++m) { const size_t row = (size_t)(row0 + ai * HALF + m * 16); bf16_t* rowp = O + row * 1024 + col0;
#pragma unroll
                for (int bj = 0; bj < 2; ++bj) { const f32x4 v0 = acc[ai][bj][m][0], v1 = acc[ai][bj][m][1];
                    const unsigned long long g8 = *(const unsigned long long*)((const unsigned char*)G + row * 2048 + gcol + col0 + bj * HALF); const int gl = (int)(unsigned)g8, gh = (int)(unsigned)(g8 >> 32);
                    typedef float f32x2g __attribute__((ext_vector_type(2)));
                    const f32x2g ga = __builtin_amdgcn_cvt_pk_f32_fp8(gl, false), gb = __builtin_amdgcn_cvt_pk_f32_fp8(gl, true), gc = __builtin_amdgcn_cvt_pk_f32_fp8(gh, false), gd = __builtin_amdgcn_cvt_pk_f32_fp8(gh, true);
                    float r0 = ga.x * v0[0], r1 = ga.y * v0[1], r2 = gb.x * v0[2], r3 = gb.y * v0[3];
                    float r4 = gc.x * v1[0], r5 = gc.y * v1[1], r6 = gd.x * v1[2], r7 = gd.y * v1[3];
                    if (ADD) {
                        const unsigned long long p8 = *(const unsigned long long*)(O8 + row * 1024 + col0 + bj * HALF); const int pl = (int)(unsigned)p8, phh = (int)(unsigned)(p8 >> 32); const float is = 1.0f / o8scale;
                        const f32x2g pa = __builtin_amdgcn_cvt_pk_f32_fp8(pl, false), pb = __builtin_amdgcn_cvt_pk_f32_fp8(pl, true), pc = __builtin_amdgcn_cvt_pk_f32_fp8(phh, false), pd = __builtin_amdgcn_cvt_pk_f32_fp8(phh, true);
                        r0 += pa.x * is; r1 += pa.y * is; r2 += pb.x * is; r3 += pb.y * is; r4 += pc.x * is; r5 += pc.y * is; r6 += pd.x * is; r7 += pd.y * is; }
                    if (F8OUT) { int w0 = 0, w1 = 0;
                        w0 = __builtin_amdgcn_cvt_pk_fp8_f32(r0 * o8scale, r1 * o8scale, w0, false); w0 = __builtin_amdgcn_cvt_pk_fp8_f32(r2 * o8scale, r3 * o8scale, w0, true);
                        w1 = __builtin_amdgcn_cvt_pk_fp8_f32(r4 * o8scale, r5 * o8scale, w1, false); w1 = __builtin_amdgcn_cvt_pk_fp8_f32(r6 * o8scale, r7 * o8scale, w1, true);
                        *(unsigned long long*)(O8 + row * 1024 + col0 + bj * HALF) = (unsigned long long)(unsigned)w0 | ((unsigned long long)(unsigned)w1 << 32);
                    } else { u32x4 w; w.x = cvt_pk_bf16(r0, r1); w.y = cvt_pk_bf16(r2, r3); w.z = cvt_pk_bf16(r4, r5); w.w = cvt_pk_bf16(r6, r7);
                        *(u32x4*)(rowp + bj * HALF) = w; } } }
    }
};
struct EpiRes {
    static constexpr bool PERM = false, AFTER_DRAIN = false;
    const float* base; float* out; int ldc; float sc; bf16_t* xb; float* rowss; unsigned char* xb8; const bf16_t* base16;
    __device__ __forceinline__ void operator()(const f32x4 (&acc)[2][2][4][2], const Unit& u, int wr, int wc, int fr, int fq) const {
        const int col0 = u.pn * BM + wc * 32 + 4 * fq;
#pragma unroll
        for (int ai = 0; ai < 2; ++ai)
#pragma unroll
            for (int m = 0; m < 4; ++m) { const int row = u.pm * BM + ai * HALF + wr * 64 + m * 16 + fr; const size_t off = (size_t)row * ldc + col0; float ss = 0.f;
#pragma unroll
                for (int bj = 0; bj < 2; ++bj)
#pragma unroll
                    for (int n = 0; n < 2; ++n) { f32x4 bs;
                        if (base16) { const unsigned long long w = *(const unsigned long long*)(base16 + off + bj * HALF + n * 16); const unsigned lo = (unsigned)w, hi = (unsigned)(w >> 32); bs = (f32x4){bf_lo(lo), bf_hi(lo), bf_lo(hi), bf_hi(hi)}; }
                        else bs = *(const f32x4*)(base + off + bj * HALF + n * 16);
                        const f32x4 o = (sc != 0.f) ? bs + acc[ai][bj][m][n] * sc : bs;
                        if (out) *(f32x4*)(out + off + bj * HALF + n * 16) = o;
                        if (xb) { unsigned long long w = (unsigned long long)cvt_pk_bf16(o[0], o[1]) | ((unsigned long long)cvt_pk_bf16(o[2], o[3]) << 32); *(unsigned long long*)(xb + off + bj * HALF + n * 16) = w; }
                        if (xb8) { int w8 = 0; w8 = __builtin_amdgcn_cvt_pk_fp8_f32(o[0], o[1], w8, false); w8 = __builtin_amdgcn_cvt_pk_fp8_f32(o[2], o[3], w8, true); *(unsigned*)(xb8 + off + bj * HALF + n * 16) = (unsigned)w8; }
                        if (rowss) ss += (o[0] * o[0] + o[1] * o[1]) + (o[2] * o[2] + o[3] * o[3]); }
                if (rowss) { ss += __shfl_xor(ss, 16); ss += __shfl_xor(ss, 32); if (fq == 0) atomicAdd(rowss + row, ss); } }
    }
};
struct EpiStoreRs {
    static constexpr bool PERM = true, AFTER_DRAIN = false;
    bf16_t* O; int ldc; const float* rowss; float sc;
    __device__ __forceinline__ void operator()(const f32x4 (&acc)[2][2][4][2], const Unit& u, int wr, int wc, int fr, int fq) const {
        const int row0 = u.pm * BM + wr * 64 + fr, col0 = u.pn * BM + wc * 32 + 8 * fq;
#pragma unroll
        for (int ai = 0; ai < 2; ++ai)
#pragma unroll
            for (int m = 0; m < 4; ++m) { const int row = row0 + ai * HALF + m * 16; bf16_t* rowp = O + (size_t)row * ldc + col0; const float ri = rsqrtf(rowss[row] * (1.0f / 1024.0f) + 1e-6f) * sc;
#pragma unroll
                for (int bj = 0; bj < 2; ++bj) { const f32x4 v0 = acc[ai][bj][m][0] * ri, v1 = acc[ai][bj][m][1] * ri;
                    u32x4 w; w.x = cvt_pk_bf16(v0[0], v0[1]); w.y = cvt_pk_bf16(v0[2], v0[3]); w.z = cvt_pk_bf16(v1[0], v1[1]); w.w = cvt_pk_bf16(v1[2], v1[3]);
                    *(u32x4*)(rowp + bj * HALF) = w; } }
    }
};
template <class Epi, class Sched, bool ALIGN_EPI = false, bool SP2 = false, bool F8 = false>
__device__ __forceinline__ void gemm_phase(PG8_LAS unsigned char* lds, const Gemm g, const Sched& S, const Epi& E) {
    const int tid = threadIdx.x, wid = __builtin_amdgcn_readfirstlane(tid >> 6), lane = tid & 63, wr = wid >> 2, wc = wid & 3, fr = lane & 15, fq = lane >> 4;
    const int K = g.K, nt = K / BK;
    unsigned voffA[2], voffB[2];
#pragma unroll
    for (int i = 0; i < 2; ++i) { int R, C; stage_rc(tid * 16 + i * 8192, R, C); const int Rb = Epi::PERM ? ((R & ~31) + perm32(R & 31)) : R;
        voffA[i] = (unsigned)(R * K + C) * 2u; voffB[i] = (unsigned)(Rb * K + C) * 2u; }
    const size_t kstep = (size_t)(BK * 2);
    const size_t hstep = (size_t)HALF * K * 2;
    const size_t tstep = 2 * hstep;
    const unsigned ldsw = (unsigned)wid * 1024u;
    const int aoff = lds_byte(wr * 64 + fr, fq * 8), boff = lds_byte(wc * 32 + fr, fq * 8);
#define PG8_SA(b, h) (((b) * 2 + (h)) * HTB)
#define PG8_SB(b, h) ((4 + (b) * 2 + (h)) * HTB)
#define PG8_STAGE(bufoff, gbase, voff) do { _Pragma("unroll") for (int _i = 0; _i < 2; ++_i) \
        __builtin_amdgcn_global_load_lds((const unsigned*)((const char*)(gbase) + (voff)[_i]), (PG8_LAS unsigned*)(lds + (bufoff) + ldsw + _i * 8192), 16, 0, 0); } while (0)
#define PG8_LDA(dst, b, h) do { if constexpr (F8) { _Pragma("unroll") for (int m = 0; m < 4; ++m) dst##8[m] = __builtin_shufflevector(*(const PG8_LAS v4i32*)(lds + PG8_SA(b, h) + aoff + m * 2048), *(const PG8_LAS v4i32*)(lds + PG8_SA(b, h) + aoff + m * 2048 + 1024), 0, 1, 2, 3, 4, 5, 6, 7); } \
        else { _Pragma("unroll") for (int m = 0; m < 4; ++m) _Pragma("unroll") for (int k = 0; k < 2; ++k) dst[m][k] = *(const PG8_LAS bf16x8*)(lds + PG8_SA(b, h) + aoff + m * 2048 + k * 1024); } } while (0)
#define PG8_LDB(dst, b, h) do { if constexpr (F8) { _Pragma("unroll") for (int n = 0; n < 2; ++n) dst##8[n] = __builtin_shufflevector(*(const PG8_LAS v4i32*)(lds + PG8_SB(b, h) + boff + n * 2048), *(const PG8_LAS v4i32*)(lds + PG8_SB(b, h) + boff + n * 2048 + 1024), 0, 1, 2, 3, 4, 5, 6, 7); } \
        else { _Pragma("unroll") for (int n = 0; n < 2; ++n) _Pragma("unroll") for (int k = 0; k < 2; ++k) dst[n][k] = *(const PG8_LAS bf16x8*)(lds + PG8_SB(b, h) + boff + n * 2048 + k * 1024); } } while (0)
#define PG8_MMA(ai, bj, At, Bt) do { __builtin_amdgcn_s_setprio(1); if constexpr (F8) { \
        _Pragma("unroll") for (int m = 0; m < 4; ++m) _Pragma("unroll") for (int n = 0; n < 2; ++n) \
            asm volatile("v_mfma_scale_f32_16x16x128_f8f6f4 %0, %1, %2, %0, %3, %3 op_sel_hi:[0,0,0]" : "+v"(acc[ai][bj][m][n]) : "v"(Bt##8[n]), "v"(At##8[m]), "v"(f8scale)); \
    } else { _Pragma("unroll") for (int m = 0; m < 4; ++m) _Pragma("unroll") for (int n = 0; n < 2; ++n) _Pragma("unroll") for (int k = 0; k < 2; ++k) \
        acc[ai][bj][m][n] = __builtin_amdgcn_mfma_f32_16x16x32_bf16(Bt[n][k], At[m][k], acc[ai][bj][m][n], 0, 0, 0); } __builtin_amdgcn_s_setprio(0); } while (0)
#define PG8_WAIT_V(n) asm volatile("s_waitcnt vmcnt(" #n ")" ::: "memory")
#define PG8_WAIT_L(n) asm volatile("s_waitcnt lgkmcnt(" #n ")" ::: "memory")
#define PG8_BAR __builtin_amdgcn_s_barrier()
#define PG8_SCHED __builtin_amdgcn_sched_barrier(0)
    Unit cur, nxt; int ui = 0;
    if (!S.next(0, cur)) return;
    f32x4 acc[2][2][4][2];
#pragma unroll
    for (int a = 0; a < 2; ++a)
#pragma unroll
        for (int b = 0; b < 2; ++b)
#pragma unroll
            for (int m = 0; m < 4; ++m)
#pragma unroll
                for (int n = 0; n < 2; ++n) acc[a][b][m][n] = (f32x4){0.f, 0.f, 0.f, 0.f};
    bf16x8 At[4][2], B0[2][2], B1[2][2]; v8i32 At8[4], B08[2], B18[2]; const int f8scale = 0x7f7f7f7f;
    const char* cA = (const char*)g.A + (size_t)cur.pm * tstep; const char* cB = (const char*)g.Bt + (size_t)cur.pn * tstep;
    S.a_ready(cur);
    if constexpr (SP2) {
        PG8_STAGE(PG8_SB(0, 0), cB, voffB); PG8_STAGE(PG8_SB(0, 1), cB + hstep, voffB); PG8_STAGE(PG8_SA(0, 0), cA, voffA); PG8_STAGE(PG8_SA(0, 1), cA + hstep, voffA);
        if (wr == 1) PG8_BAR;
        PG8_WAIT_V(2); PG8_BAR;
        PG8_STAGE(PG8_SB(1, 0), cB + kstep, voffB); PG8_STAGE(PG8_SA(1, 0), cA + kstep, voffA); PG8_STAGE(PG8_SB(1, 1), cB + hstep + kstep, voffB);
        PG8_WAIT_V(6); PG8_BAR;
    } else {
        PG8_STAGE(PG8_SB(0, 0), cB, voffB); PG8_STAGE(PG8_SA(0, 0), cA, voffA); PG8_STAGE(PG8_SB(0, 1), cB + hstep, voffB); PG8_STAGE(PG8_SA(0, 1), cA + hstep, voffA);
        if (wr == 1) PG8_BAR;
        PG8_WAIT_V(4); PG8_BAR;
        PG8_STAGE(PG8_SB(1, 0), cB + kstep, voffB); PG8_STAGE(PG8_SA(1, 0), cA + kstep, voffA); PG8_STAGE(PG8_SB(1, 1), cB + hstep + kstep, voffB);
        PG8_WAIT_V(6); PG8_BAR;
    }
    for (;;) {
        const bool has_next = S.next(ui + 1, nxt);
        const char* nA = has_next ? (const char*)g.A + (size_t)nxt.pm * tstep : cA; const char* nB = has_next ? (const char*)g.Bt + (size_t)nxt.pn * tstep : cB;
        for (int t = 0; t < nt; t += 2) {
            const bool last = (t == nt - 2);
            const char* a1 = cA + (size_t)(t + 1) * kstep;
            const char* a2 = last ? nA : cA + (size_t)(t + 2) * kstep; const char* b2 = last ? nB : cB + (size_t)(t + 2) * kstep;
            const char* a3 = a2 + kstep; const char* b3 = b2 + kstep;
            if (last && has_next) S.a_ready(nxt);
            if constexpr (SP2) {
            PG8_LDB(B0, 0, 0); PG8_LDB(B1, 0, 1); PG8_SCHED; PG8_LDA(At, 0, 0); PG8_STAGE(PG8_SA(1, 1), a1 + hstep, voffA);
            PG8_WAIT_V(8); PG8_WAIT_L(0); PG8_BAR; PG8_MMA(0, 0, At, B0); PG8_MMA(0, 1, At, B1); PG8_BAR; PG8_SCHED;
            PG8_LDA(At, 0, 1); PG8_STAGE(PG8_SB(0, 0), b2, voffB); PG8_STAGE(PG8_SB(0, 1), b2 + hstep, voffB); PG8_STAGE(PG8_SA(0, 0), a2, voffA);
            PG8_WAIT_V(8); PG8_WAIT_L(0); PG8_BAR; PG8_MMA(1, 0, At, B0); PG8_MMA(1, 1, At, B1); PG8_BAR; PG8_SCHED;
            PG8_LDB(B0, 1, 0); PG8_LDB(B1, 1, 1); PG8_SCHED; PG8_LDA(At, 1, 0); PG8_STAGE(PG8_SA(0, 1), a2 + hstep, voffA);
            PG8_WAIT_V(8); PG8_WAIT_L(0); PG8_BAR; PG8_MMA(0, 0, At, B0); PG8_MMA(0, 1, At, B1); PG8_BAR; PG8_SCHED;
            PG8_LDA(At, 1, 1); PG8_STAGE(PG8_SB(1, 0), b3, voffB); PG8_STAGE(PG8_SB(1, 1), b3 + hstep, voffB); PG8_STAGE(PG8_SA(1, 0), a3, voffA);
            PG8_WAIT_V(8); PG8_WAIT_L(0); PG8_BAR; PG8_MMA(1, 0, At, B0); PG8_MMA(1, 1, At, B1); PG8_BAR; PG8_SCHED;
            } else {
            PG8_LDB(B0, 0, 0); PG8_SCHED; PG8_LDA(At, 0, 0); PG8_STAGE(PG8_SA(1, 1), a1 + hstep, voffA);
            PG8_WAIT_L(8); PG8_BAR; PG8_WAIT_L(0); PG8_MMA(0, 0, At, B0); PG8_BAR; PG8_SCHED;
            PG8_LDB(B1, 0, 1); PG8_STAGE(PG8_SB(0, 0), b2, voffB);
            PG8_BAR; PG8_WAIT_L(0); PG8_MMA(0, 1, At, B1); PG8_BAR;
            PG8_LDA(At, 0, 1); PG8_STAGE(PG8_SA(0, 0), a2, voffA);
            PG8_BAR; PG8_WAIT_L(0); PG8_MMA(1, 0, At, B0); PG8_BAR; PG8_SCHED;
            PG8_STAGE(PG8_SB(0, 1), b2 + hstep, voffB);
            PG8_WAIT_V(6); PG8_BAR; PG8_MMA(1, 1, At, B1); PG8_BAR;
            PG8_LDB(B0, 1, 0); PG8_SCHED; PG8_LDA(At, 1, 0); PG8_STAGE(PG8_SA(0, 1), a2 + hstep, voffA);
            PG8_WAIT_L(8); PG8_BAR; PG8_WAIT_L(0); PG8_MMA(0, 0, At, B0); PG8_BAR; PG8_SCHED;
            PG8_LDB(B1, 1, 1); PG8_STAGE(PG8_SB(1, 0), b3, voffB);
            PG8_BAR; PG8_WAIT_L(0); PG8_MMA(0, 1, At, B1); PG8_BAR;
            PG8_LDA(At, 1, 1); PG8_STAGE(PG8_SA(1, 0), a3, voffA);
            PG8_BAR; PG8_WAIT_L(0); PG8_MMA(1, 0, At, B0); PG8_BAR; PG8_SCHED;
            PG8_STAGE(PG8_SB(1, 1), b3 + hstep, voffB);
            PG8_WAIT_V(6); PG8_BAR; PG8_MMA(1, 1, At, B1); PG8_BAR;
            }
        }
        if constexpr (ALIGN_EPI) { if (wr == 0) PG8_BAR; }
        if constexpr (F8) asm volatile("s_nop 15\n\ts_nop 15" ::: "memory");
        if constexpr (!Epi::AFTER_DRAIN) { E(acc, cur, wr, wc, fr, fq); S.done(cur); }
        if (!has_next) break;
#pragma unroll
        for (int a = 0; a < 2; ++a)
#pragma unroll
            for (int b = 0; b < 2; ++b)
#pragma unroll
                for (int m = 0; m < 4; ++m)
#pragma unroll
                    for (int n = 0; n < 2; ++n) acc[a][b][m][n] = (f32x4){0.f, 0.f, 0.f, 0.f};
        cur = nxt; cA = nA; cB = nB; ++ui;
        if constexpr (ALIGN_EPI) { if (wr == 1) PG8_BAR; }
    }
    PG8_WAIT_V(0);
    if constexpr (!ALIGN_EPI) { if (wr == 0) PG8_BAR; }
    PG8_BAR;
    if constexpr (Epi::AFTER_DRAIN) { E.fused(acc, cur, wr, wc, fr, fq, lds, wid, lane); S.done(cur); }
#undef PG8_SA
#undef PG8_SB
#undef PG8_STAGE
#undef PG8_LDA
#undef PG8_LDB
#undef PG8_MMA
#undef PG8_WAIT_V
#undef PG8_WAIT_L
#undef PG8_BAR
#undef PG8_SCHED
}
}

constexpr int NB = 8, SEQ = 4096, DM = 1024, T = NB * SEQ, NMEM = 256, MROWS = NB * NMEM;
constexpr int QKVW = 3840, GATEW = 2048, NIN = 5888;
constexpr float RMS_EPS = 1e-6f;
constexpr int NPH = 15;
constexpr float WIN8_SCALE = 32.0f, MRG8_SCALE = 16.0f;
#ifndef DBG_MIX
#define DBG_MIX 1
#endif
#ifndef DBG_CROSS
#define DBG_CROSS 1
#endif
#ifndef DBG_PEER
#define DBG_PEER 1
#endif
#ifndef DBG_TOPK_SIMPLE
#define DBG_TOPK_SIMPLE 0
#endif
#ifndef DBG_CHECK
#define DBG_CHECK 0
#endif
#ifndef DBG_ATTN_CHECK
#define DBG_ATTN_CHECK 0
#endif
#ifndef DBG_CROSS_CHECK
#define DBG_CROSS_CHECK 0
#endif
#ifndef DBG_NOBIAS
#define DBG_NOBIAS 0
#endif
#ifndef DBG_DIL_CHECK
#define DBG_DIL_CHECK 0
#endif
#ifndef PROBE_PH
#define PROBE_PH (-1)
#endif
#ifndef PROBE_K
#define PROBE_K 200000.0f
#endif
#ifndef DBG_P4CHK
#define DBG_P4CHK 1
#endif
#ifndef ATTN_MFMA
#define ATTN_MFMA 1
#endif
#if DBG_CHECK
#define DBG_YPTR ((float*)(ws + 510 * MiB))
#else
#define DBG_YPTR ((float*)nullptr)
#endif
#ifndef MK_ONE_LAUNCH
#define MK_ONE_LAUNCH 1
#endif
constexpr size_t MiB = 1u << 20;
constexpr size_t WS_CTL = 0, CTL_ZERO_BYTES = 1 * MiB;
constexpr size_t WS_KMEAN = 1 * MiB;
constexpr size_t WS_INV = 2 * MiB;
constexpr size_t WS_WIN = 3 * MiB;
constexpr size_t WS_WA = 15 * MiB, WS_WB = 16 * MiB, WS_WOUT = 17 * MiB, WS_WQC = 19 * MiB, WS_WKVC = 20 * MiB, WS_WOC = 22 * MiB, WS_WQP = 23 * MiB, WS_SUBK = 27 * MiB;
constexpr size_t WS_U = 28 * MiB, WS_V = 60 * MiB;
constexpr size_t WS_H = 92 * MiB;
constexpr size_t WS_MEMB = 156 * MiB, WS_KVC = 160 * MiB;
constexpr size_t WS_ODIL = 164 * MiB, WS_OMOBA = 180 * MiB;
constexpr size_t WS_PQKV = 212 * MiB;
constexpr size_t WS_MERGED = WS_PQKV, WS_X1 = WS_PQKV + 64 * MiB, WS_QC = WS_PQKV + 192 * MiB, WS_OC = WS_ODIL;
constexpr size_t WS_EXP = WS_PQKV, WS_EW = WS_PQKV + 16 * MiB;
constexpr size_t WS_ODG = 452 * MiB, WS_LSE = 500 * MiB;
constexpr size_t WS_END = 502 * MiB;
constexpr int CW_TMO = 0, CW_CODE = 1, CW_WORK = 128, CW_BAR = 4096;
constexpr size_t WS_RSS1 = 256 * 1024, WS_RSS2 = 384 * 1024;
constexpr int RING_OFF = 0, RING_BYTES = 131072;
constexpr int LDSCTL_OFF = RING_BYTES, MISC_OFF = LDSCTL_OFF + 320;
constexpr int LDS_BYTES = 163840;
constexpr int NWAVES = 8;

#define GAS __attribute__((address_space(1)))
#define LAS __attribute__((address_space(3)))
typedef unsigned short bf16;
typedef unsigned v4u __attribute__((ext_vector_type(4)));
typedef float f32x4 __attribute__((ext_vector_type(4)));
typedef float f32x16 __attribute__((ext_vector_type(16)));
typedef short bf16x8 __attribute__((ext_vector_type(8)));
typedef __bf16 bf2_t __attribute__((ext_vector_type(2)));
typedef GAS unsigned gu32;
#define RLX_AGENT __ATOMIC_RELAXED, __HIP_MEMORY_SCOPE_AGENT
#define LDS_WAIT() asm volatile("s_waitcnt lgkmcnt(0)" ::: "memory")
#define VM_WAIT() asm volatile("s_waitcnt vmcnt(0)" ::: "memory")
__device__ __forceinline__ unsigned pk2(float lo, float hi) { return pg8::cvt_pk_bf16(lo, hi); }
__device__ __forceinline__ float bf_lo(unsigned w) { return __uint_as_float(w << 16); }
__device__ __forceinline__ float bf_hi(unsigned w) { return __uint_as_float(w & 0xffff0000u); }
__device__ __forceinline__ float bf2f(bf16 b) { return __uint_as_float((unsigned)b << 16); }

#define XB_TMO      128
#define XB_XCNT(j)  (256  + 64 * (j))
#define XB_XSUB(j)  (1280 + 64 * (j))
#define XB_XGEN(j)  (2304 + 64 * (j))
#define XB_TOP      3328
#define XB_TOPGEN   3392
#define XCD_BAR_WORDS 3456
#define XB_SPIN_CAP (1u << 18)

__device__ __forceinline__ unsigned xb_ld(unsigned* p)              { return __hip_atomic_load(p, __ATOMIC_RELAXED, __HIP_MEMORY_SCOPE_AGENT); }
__device__ __forceinline__ unsigned xb_add(unsigned* p, unsigned v) { return __hip_atomic_fetch_add(p, v, __ATOMIC_RELAXED, __HIP_MEMORY_SCOPE_AGENT); }
__device__ __forceinline__ unsigned xb_xcc_id() { return (unsigned)__builtin_amdgcn_s_getreg((3 << 11) | 20) & 0xFu; }
#define XB_SPIN(cond, bar) do { unsigned _sp = 0; while (cond) { __builtin_amdgcn_s_sleep(1); \
    if ((++_sp & 255u) == 0u) { if (xb_ld(&(bar)[XB_TMO])) break; if (_sp > XB_SPIN_CAP) { atomicAdd(&(bar)[XB_TMO], 1u); break; } } } } while (0)

struct XcdBarrier {
    unsigned* bar; unsigned x;
    volatile LAS unsigned* st;
};

__device__ __forceinline__ XcdBarrier xcd_barrier_post(unsigned* bar, volatile LAS unsigned* st) {
    XcdBarrier b; b.bar = bar; b.x = xb_xcc_id(); b.st = st;
    if (threadIdx.x == 0) (void)xb_add(&bar[XB_XCNT(b.x)], 1u);
    return b;
}
__device__ __forceinline__ void xcd_barrier_complete(unsigned* bar, unsigned x, unsigned& nloc, unsigned& nx) {
    const unsigned G = gridDim.x * gridDim.y * gridDim.z;
    unsigned sum, cnt, mine, sp = 0u;
    for (;;) {
        sum = 0u; cnt = 0u; mine = 0u;
#pragma unroll
        for (unsigned j = 0; j < 16; ++j) { const unsigned c = xb_ld(&bar[XB_XCNT(j)]); sum += c; cnt += (c > 0u) ? 1u : 0u; mine = (j == x) ? c : mine; }
        if (sum == G) break;
        __builtin_amdgcn_s_sleep(1);
        if ((++sp & 255u) == 0u) { if (xb_ld(&bar[XB_TMO])) break; if (sp > XB_SPIN_CAP) { atomicAdd(&bar[XB_TMO], 1u); break; } }
    }
    nloc = mine > 0u ? mine : 1u; nx = cnt > 0u ? cnt : 1u;
}

__device__ __forceinline__ void xcd_barrier(const XcdBarrier& b) {
    asm volatile("s_waitcnt vmcnt(0)" ::: "memory");
    __syncthreads();
    if (threadIdx.x == 0) {
        unsigned* bar = b.bar;
        __builtin_amdgcn_s_waitcnt(0);
        unsigned nloc = b.st[0], nx = b.st[1];
        if (nloc == 0u) { xcd_barrier_complete(bar, b.x, nloc, nx); b.st[0] = nloc; b.st[1] = nx; }
        const unsigned old = xb_add(&bar[XB_XSUB(b.x)], 1u);
        const unsigned gen = old / nloc;
        if (old + 1u == (gen + 1u) * nloc) {
            __builtin_amdgcn_fence(__ATOMIC_RELEASE, "agent");
            asm volatile("s_waitcnt vmcnt(0)" ::: "memory");
            const unsigned og = xb_add(&bar[XB_TOP], 1u);
            const unsigned tg = og / nx;
            if (og + 1u == (tg + 1u) * nx) xb_add(&bar[XB_TOPGEN], 1u);
            else XB_SPIN(xb_ld(&bar[XB_TOPGEN]) == tg, bar);
            __builtin_amdgcn_fence(__ATOMIC_ACQUIRE, "agent");
            xb_add(&bar[XB_XGEN(b.x)], 1u);
            asm volatile("s_waitcnt vmcnt(0)" ::: "memory");
        } else {
            XB_SPIN(xb_ld(&bar[XB_XGEN(b.x)]) == gen, bar);
            __builtin_amdgcn_fence(__ATOMIC_ACQUIRE, "agent");
            asm volatile("s_waitcnt vmcnt(0)" ::: "memory");
        }
    }
    __syncthreads();
}

__device__ __forceinline__ float wave_sum(float v) {
#pragma unroll
    for (int o = 1; o < 64; o <<= 1) v += __shfl_xor(v, o);
    return v;
}
__device__ __forceinline__ int t5_bucket(int n) {
    int b = n;
    if (n >= 16) { b = 16 + (n >= 22) + (n >= 30) + (n >= 40) + (n >= 54) + (n >= 73) + (n >= 99) + (n >= 134) + (n >= 182) + (n >= 246) + (n >= 332) + (n >= 450) + (n >= 609) + (n >= 825) + (n >= 1117) + (n >= 1513); }
    return b;
}
__device__ __forceinline__ void p0_transpose_item(const float* W, int K, int N, bf16* WT, LAS float* scr, int item, int lane, const float* gk = nullptr) {
    const int nblk = N / 32, kb = item / nblk, nb = item % nblk, k0 = 64 * kb, n0 = 32 * nb;
#pragma unroll 8
    for (int i = 0; i < 32; ++i) { const int kk = 2 * i + (lane >> 5); scr[kk * 33 + (lane & 31)] = W[(size_t)(k0 + kk) * N + n0 + (lane & 31)] * (gk ? gk[k0 + kk] : 1.0f); }
    LDS_WAIT(); asm volatile("" ::: "memory");
    const int c = lane & 7;
#pragma unroll
    for (int j = 0; j < 4; ++j) { const int n = (lane >> 3) + 8 * j; const LAS float* s = scr + (8 * c) * 33 + n;
        v4u o; o.x = pk2(s[0 * 33], s[1 * 33]); o.y = pk2(s[2 * 33], s[3 * 33]); o.z = pk2(s[4 * 33], s[5 * 33]); o.w = pk2(s[6 * 33], s[7 * 33]);
        *(GAS v4u*)(WT + (size_t)(n0 + n) * K + k0 + 8 * c) = o; }
    LDS_WAIT(); asm volatile("" ::: "memory");
}
__device__ __forceinline__ void rms_row_to_bf16(const float* xrow, const float* g, bf16* orow, int lane) {
    const f32x4* xr = (const f32x4*)xrow + lane; const f32x4* gr = (const f32x4*)g + lane;
    f32x4 v[4]; float s = 0.f;
#pragma unroll
    for (int j = 0; j < 4; ++j) { v[j] = xr[64 * j]; s += (v[j].x * v[j].x + v[j].y * v[j].y) + (v[j].z * v[j].z + v[j].w * v[j].w); }
    const float rinv = rsqrtf(wave_sum(s) * (1.f / 1024.f) + RMS_EPS);
    unsigned long long* o8 = (unsigned long long*)orow + lane;
#pragma unroll
    for (int j = 0; j < 4; ++j) { const f32x4 gv = gr[64 * j]; o8[64 * j] = (unsigned long long)pk2(v[j].x * rinv * gv.x, v[j].y * rinv * gv.y) | ((unsigned long long)pk2(v[j].z * rinv * gv.z, v[j].w * rinv * gv.w) << 32); }
}
__device__ __forceinline__ void cvt_f32_to_bf16_bulk(const float* src, bf16* dst, size_t n, size_t gtid, size_t nthr) {
    for (size_t i = gtid; i < n / 8; i += nthr) { const f32x4 a = ((const f32x4*)src)[2 * i], b = ((const f32x4*)src)[2 * i + 1];
        v4u o; o.x = pk2(a.x, a.y); o.y = pk2(a.z, a.w); o.z = pk2(b.x, b.y); o.w = pk2(b.z, b.w); ((v4u*)dst)[i] = o; }
}
__device__ __forceinline__ void os_step(const float (&q)[64], float (&o)[64], float& m, float& l, const bf16* krow, const bf16* vrow, float bias) {
    const v4u* kp = (const v4u*)krow; float s = 0.f;
#pragma unroll
    for (int c = 0; c < 8; ++c) { const v4u w = kp[c];
        s += q[8 * c + 0] * bf_lo(w.x) + q[8 * c + 1] * bf_hi(w.x) + q[8 * c + 2] * bf_lo(w.y) + q[8 * c + 3] * bf_hi(w.y)
           + q[8 * c + 4] * bf_lo(w.z) + q[8 * c + 5] * bf_hi(w.z) + q[8 * c + 6] * bf_lo(w.w) + q[8 * c + 7] * bf_hi(w.w); }
    s += bias;
    const float mn = fmaxf(m, s), al = __expf(m - mn), p = __expf(s - mn);
    l = l * al + p; m = mn;
    const v4u* vp = (const v4u*)vrow;
#pragma unroll
    for (int c = 0; c < 8; ++c) { const v4u w = vp[c];
        o[8 * c + 0] = o[8 * c + 0] * al + p * bf_lo(w.x); o[8 * c + 1] = o[8 * c + 1] * al + p * bf_hi(w.x);
        o[8 * c + 2] = o[8 * c + 2] * al + p * bf_lo(w.y); o[8 * c + 3] = o[8 * c + 3] * al + p * bf_hi(w.y);
        o[8 * c + 4] = o[8 * c + 4] * al + p * bf_lo(w.z); o[8 * c + 5] = o[8 * c + 5] * al + p * bf_hi(w.z);
        o[8 * c + 6] = o[8 * c + 6] * al + p * bf_lo(w.w); o[8 * c + 7] = o[8 * c + 7] * al + p * bf_hi(w.w); }
}
__device__ __forceinline__ void load_q64(float (&q)[64], const bf16* qrow, float scale) {
    const v4u* qp = (const v4u*)qrow;
#pragma unroll
    for (int c = 0; c < 8; ++c) { const v4u w = qp[c];
        q[8 * c + 0] = bf_lo(w.x) * scale; q[8 * c + 1] = bf_hi(w.x) * scale; q[8 * c + 2] = bf_lo(w.y) * scale; q[8 * c + 3] = bf_hi(w.y) * scale;
        q[8 * c + 4] = bf_lo(w.z) * scale; q[8 * c + 5] = bf_hi(w.z) * scale; q[8 * c + 6] = bf_lo(w.w) * scale; q[8 * c + 7] = bf_hi(w.w) * scale; }
}
__device__ __forceinline__ void store_o64(const float (&o)[64], float inv, bf16* orow) {
    v4u* op = (v4u*)orow;
#pragma unroll
    for (int c = 0; c < 8; ++c) { v4u w; w.x = pk2(o[8 * c + 0] * inv, o[8 * c + 1] * inv); w.y = pk2(o[8 * c + 2] * inv, o[8 * c + 3] * inv);
        w.z = pk2(o[8 * c + 4] * inv, o[8 * c + 5] * inv); w.w = pk2(o[8 * c + 6] * inv, o[8 * c + 7] * inv); op[c] = w; }
}
__device__ __forceinline__ void cmp_o64(const float (&o)[64], float inv, const bf16* ref, float& num, float& den) {
#pragma unroll
    for (int c = 0; c < 64; ++c) { const float a = o[c] * inv, b = bf2f(ref[c]); num += (a - b) * (a - b); den += a * a; }
}
__device__ __forceinline__ void dbg_acc2(float* acc, float num, float den) { num = wave_sum(num); den = wave_sum(den); if ((threadIdx.x & 63) == 0 && acc) { atomicAdd(acc, num); atomicAdd(acc + 1, den); } }
__device__ __forceinline__ void cvt_f32_to_fp8_bulk(const float* src, unsigned char* dst, size_t n, float scale, size_t gtid, size_t nthr, const float* gc = nullptr) {
    for (size_t i = gtid; i < n / 16; i += nthr) { const f32x4* s = (const f32x4*)src + 4 * i; f32x4 a = s[0] * scale, b = s[1] * scale, c = s[2] * scale, d = s[3] * scale;
        if (gc) { const f32x4* g4 = (const f32x4*)gc + 4 * (i & 63); a = a * g4[0]; b = b * g4[1]; c = c * g4[2]; d = d * g4[3]; }
        int w0 = 0, w1 = 0, w2 = 0, w3 = 0;
        w0 = __builtin_amdgcn_cvt_pk_fp8_f32(a.x, a.y, w0, false); w0 = __builtin_amdgcn_cvt_pk_fp8_f32(a.z, a.w, w0, true);
        w1 = __builtin_amdgcn_cvt_pk_fp8_f32(b.x, b.y, w1, false); w1 = __builtin_amdgcn_cvt_pk_fp8_f32(b.z, b.w, w1, true);
        w2 = __builtin_amdgcn_cvt_pk_fp8_f32(c.x, c.y, w2, false); w2 = __builtin_amdgcn_cvt_pk_fp8_f32(c.z, c.w, w2, true);
        w3 = __builtin_amdgcn_cvt_pk_fp8_f32(d.x, d.y, w3, false); w3 = __builtin_amdgcn_cvt_pk_fp8_f32(d.z, d.w, w3, true);
        v4u o; o.x = (unsigned)w0; o.y = (unsigned)w1; o.z = (unsigned)w2; o.w = (unsigned)w3; ((v4u*)dst)[i] = o; }
}
__device__ __forceinline__ void rms_row_to_fp8(const float* xrow, const float* g, unsigned char* orow, int lane) {
    const f32x4* xr = (const f32x4*)xrow + lane; const f32x4* gr = (const f32x4*)g + lane;
    f32x4 v[4]; float s = 0.f;
#pragma unroll
    for (int j = 0; j < 4; ++j) { v[j] = xr[64 * j]; s += (v[j].x * v[j].x + v[j].y * v[j].y) + (v[j].z * v[j].z + v[j].w * v[j].w); }
    const float rinv = rsqrtf(wave_sum(s) * (1.f / 1024.f) + RMS_EPS);
    unsigned* o4 = (unsigned*)orow + lane;
#pragma unroll
    for (int j = 0; j < 4; ++j) { const f32x4 gv = gr[64 * j]; int w = 0;
        w = __builtin_amdgcn_cvt_pk_fp8_f32(v[j].x * rinv * gv.x, v[j].y * rinv * gv.y, w, false); w = __builtin_amdgcn_cvt_pk_fp8_f32(v[j].z * rinv * gv.z, v[j].w * rinv * gv.w, w, true); o4[64 * j] = (unsigned)w; }
}
__device__ __forceinline__ void p0_transpose_item_fp8(const float* W, int K, int N, unsigned char* WT, LAS float* scr, int item, int lane, float scale, const float* gk = nullptr) {
    const int nblk = N / 32, kb = item / nblk, nb = item % nblk, k0 = 64 * kb, n0 = 32 * nb;
#pragma unroll 8
    for (int i = 0; i < 32; ++i) { const int kk = 2 * i + (lane >> 5); scr[kk * 33 + (lane & 31)] = W[(size_t)(k0 + kk) * N + n0 + (lane & 31)] * (gk ? scale * gk[k0 + kk] : scale); }
    LDS_WAIT(); asm volatile("" ::: "memory");
    const int c = lane & 3;
#pragma unroll
    for (int j = 0; j < 2; ++j) { const int n = (lane >> 2) + 16 * j; const LAS float* s = scr + (16 * c) * 33 + n;
        int w0 = 0, w1 = 0, w2 = 0, w3 = 0;
        w0 = __builtin_amdgcn_cvt_pk_fp8_f32(s[0 * 33], s[1 * 33], w0, false); w0 = __builtin_amdgcn_cvt_pk_fp8_f32(s[2 * 33], s[3 * 33], w0, true);
        w1 = __builtin_amdgcn_cvt_pk_fp8_f32(s[4 * 33], s[5 * 33], w1, false); w1 = __builtin_amdgcn_cvt_pk_fp8_f32(s[6 * 33], s[7 * 33], w1, true);
        w2 = __builtin_amdgcn_cvt_pk_fp8_f32(s[8 * 33], s[9 * 33], w2, false); w2 = __builtin_amdgcn_cvt_pk_fp8_f32(s[10 * 33], s[11 * 33], w2, true);
        w3 = __builtin_amdgcn_cvt_pk_fp8_f32(s[12 * 33], s[13 * 33], w3, false); w3 = __builtin_amdgcn_cvt_pk_fp8_f32(s[14 * 33], s[15 * 33], w3, true);
        v4u o; o.x = (unsigned)w0; o.y = (unsigned)w1; o.z = (unsigned)w2; o.w = (unsigned)w3;
        *(GAS v4u*)(WT + (size_t)(n0 + n) * K + k0 + 16 * c) = o; }
    LDS_WAIT(); asm volatile("" ::: "memory");
}
template <bool SAMP> __device__ __forceinline__ void phase_dil_simple(const bf16* P, const float* rel_bias, bf16* ODIL, int gtid, int nthr, float* acc = nullptr) {
    float cnum = 0.f, cden = 0.f;
    constexpr int NTOK = SAMP ? T / 16 : T;
    for (int item = gtid; item < 4 * NTOK; item += nthr) {
        const int h = item / NTOK, ti = item % NTOK, tok = SAMP ? ti * 16 + 5 : ti, b = tok / SEQ, t = tok % SEQ;
        float o[64], q[64]; float m = -1e30f, l = 0.f;
#pragma unroll
        for (int c = 0; c < 64; ++c) o[c] = 0.f;
        for (int g = 0; g < 3; ++g) {
            const int d = 1 << (2 * g);
            load_q64(q, P + (size_t)tok * QKVW + g * 768 + h * 64, 0.125f);
            for (int j = 0; j <= 128; ++j) {
                const int tp = t - j * d;
                if (tp >= 0) {
                    const bf16* kr = P + (size_t)(b * SEQ + tp) * QKVW + g * 768 + 256 + h * 64;
                    os_step(q, o, m, l, kr, kr + 256, DBG_NOBIAS ? 0.f : rel_bias[t5_bucket(j * d) * 20 + g * 4 + h]);
                }
            }
        }
        if (SAMP) cmp_o64(o, 1.0f / l, ODIL + (size_t)tok * 256 + h * 64, cnum, cden); else store_o64(o, 1.0f / l, ODIL + (size_t)ti * 256 + h * 64);
    }
    if (SAMP) dbg_acc2(acc, cnum, cden);
}
template <bool SAMP> __device__ __forceinline__ void phase_moba_simple(const bf16* P, const float* KMEAN, const float* rel_bias, bf16* OMOBA, int gtid, int nthr, float* acc = nullptr) {
    float cnum = 0.f, cden = 0.f, cnum2 = 0.f, cden2 = 0.f;
    constexpr int NTOK = SAMP ? T / 16 : T;
    for (int item = gtid; item < 8 * NTOK; item += nthr) {
        const int h = item / NTOK, ti = item % NTOK, tok = SAMP ? ti * 16 + 5 : ti, b = tok / SEQ, t = tok % SEQ, qb = t >> 8;
        float o[64], q[64]; float m = -1e30f, l = 0.f;
#pragma unroll
        for (int c = 0; c < 64; ++c) o[c] = 0.f;
        load_q64(q, P + (size_t)tok * QKVW + 2304 + h * 64, 1.0f);
        float v1 = -3e38f, v2 = -3e38f, v3 = -3e38f; int i1 = -1, i2 = -1, i3 = -1;
        for (int n = 0; n < qb; ++n) {
            const float* km = KMEAN + (size_t)((b * 8 + h) * 16 + n) * 64; float gs = 0.f;
#pragma unroll
            for (int c = 0; c < 64; ++c) gs += q[c] * km[c];
            if (gs > v1) { v3 = v2; i3 = i2; v2 = v1; i2 = i1; v1 = gs; i1 = n; }
            else if (gs > v2) { v3 = v2; i3 = i2; v2 = gs; i2 = n; }
            else if (gs > v3) { v3 = gs; i3 = n; }
        }
        unsigned sel = 0u;
        if (i1 >= 0) sel |= 1u << i1;
        if (i2 >= 0) sel |= 1u << i2;
        if (i3 >= 0) sel |= 1u << i3;
#pragma unroll
        for (int c = 0; c < 64; ++c) q[c] *= 0.125f;
        const bf16* Kb = P + (size_t)(b * SEQ) * QKVW + 2304 + 512 + h * 64;
        for (int n = 0; n < 16; ++n) {
            const bool on = ((sel >> n) & 1u) && (n < qb);
            if (__any(on)) {
                for (int j = 0; j < 256; ++j) {
                    const int kpos = n * 256 + j;
                    if (on) { const bf16* kr = Kb + (size_t)kpos * QKVW; os_step(q, o, m, l, kr, kr + 512, DBG_NOBIAS ? 0.f : rel_bias[t5_bucket(t - kpos) * 20 + 12 + h]); }
                }
            }
        }
        for (int j = 0; j < 256; ++j) { const int kpos = qb * 256 + j;
            if (kpos <= t) { const bf16* kr = Kb + (size_t)kpos * QKVW; os_step(q, o, m, l, kr, kr + 512, DBG_NOBIAS ? 0.f : rel_bias[t5_bucket(t - kpos) * 20 + 12 + h]); }
        }
        if (SAMP) { if (qb == 0) cmp_o64(o, 1.0f / l, OMOBA + (size_t)tok * 512 + h * 64, cnum, cden); else cmp_o64(o, 1.0f / l, OMOBA + (size_t)tok * 512 + h * 64, cnum2, cden2); } else store_o64(o, 1.0f / l, OMOBA + (size_t)ti * 512 + h * 64);
    }
    if (SAMP) { dbg_acc2(acc, cnum, cden); dbg_acc2(acc + 2, cnum2, cden2); }
}
template <bool SAMP> __device__ __forceinline__ void phase_cross_simple(const bf16* QC, const bf16* KVC, bf16* OC, int gtid, int nthr, float* acc = nullptr) {
    float cnum = 0.f, cden = 0.f;
    constexpr int NTOK = SAMP ? T / 16 : T;
    for (int item = gtid; item < 8 * NTOK; item += nthr) {
        const int half = item & 1, pr = item >> 1, h = pr / NTOK, ti = pr % NTOK, tok = SAMP ? ti * 16 + 5 : ti, b = tok / SEQ;
        float o[64], q[64]; float m = -1e30f, l = 0.f;
#pragma unroll
        for (int c = 0; c < 64; ++c) o[c] = 0.f;
        load_q64(q, QC + (size_t)tok * 512 + h * 128 + half * 64, 0.08838834764831845f);
        const bf16* Kb = KVC + (size_t)(b * NMEM) * 1024 + h * 128 + half * 64;
        for (int j = 0; j < NMEM; ++j) {
            const v4u* kp = (const v4u*)(Kb + (size_t)j * 1024); float s = 0.f;
#pragma unroll
            for (int c = 0; c < 8; ++c) { const v4u w = kp[c];
                s += q[8 * c + 0] * bf_lo(w.x) + q[8 * c + 1] * bf_hi(w.x) + q[8 * c + 2] * bf_lo(w.y) + q[8 * c + 3] * bf_hi(w.y)
                   + q[8 * c + 4] * bf_lo(w.z) + q[8 * c + 5] * bf_hi(w.z) + q[8 * c + 6] * bf_lo(w.w) + q[8 * c + 7] * bf_hi(w.w); }
            s += __shfl_xor(s, 1);
            const float mn = fmaxf(m, s), al = __expf(m - mn), p = __expf(s - mn);
            l = l * al + p; m = mn;
            const v4u* vp = (const v4u*)(Kb + (size_t)j * 1024 + 512);
#pragma unroll
            for (int c = 0; c < 8; ++c) { const v4u w = vp[c];
                o[8 * c + 0] = o[8 * c + 0] * al + p * bf_lo(w.x); o[8 * c + 1] = o[8 * c + 1] * al + p * bf_hi(w.x);
                o[8 * c + 2] = o[8 * c + 2] * al + p * bf_lo(w.y); o[8 * c + 3] = o[8 * c + 3] * al + p * bf_hi(w.y);
                o[8 * c + 4] = o[8 * c + 4] * al + p * bf_lo(w.z); o[8 * c + 5] = o[8 * c + 5] * al + p * bf_hi(w.z);
                o[8 * c + 6] = o[8 * c + 6] * al + p * bf_lo(w.w); o[8 * c + 7] = o[8 * c + 7] * al + p * bf_hi(w.w); }
        }
        if (SAMP) cmp_o64(o, 1.0f / l, OC + (size_t)tok * 512 + h * 128 + half * 64, cnum, cden); else store_o64(o, 1.0f / l, OC + (size_t)ti * 512 + h * 128 + half * 64);
    }
    if (SAMP) dbg_acc2(acc, cnum, cden);
}

constexpr int PVQ = 2;
constexpr int PNQ = 4, PEG = 128 / PNQ, PSH = 14 - 2;
__device__ __forceinline__ float tk_max(float a, float b) { return fmaxf(a, b); }
__device__ __forceinline__ float tk_min(float a, float b) { return fminf(a, b); }
template <int OFF> __device__ __forceinline__ void sort16_desc(float* v) {
#pragma unroll
    for (int k = 2; k <= 16; k <<= 1) {
#pragma unroll
        for (int j = k >> 1; j > 0; j >>= 1) {
#pragma unroll
            for (int i = 0; i < 16; ++i) {
                const int l = i ^ j;
                if (l > i) {
                    const bool desc = ((i & k) == 0);
                    const float x = v[OFF + i], y = v[OFF + l];
                    const float hi = tk_max(x, y), lo = tk_min(x, y);
                    v[OFF + i] = desc ? hi : lo; v[OFF + l] = desc ? lo : hi;
                }
            }
        }
    }
}
template <int OA, int OB, bool SORT> __device__ __forceinline__ void merge_top16(float* a, const float* b) {
#pragma unroll
    for (int i = 0; i < 16; ++i) a[OA + i] = tk_max(a[OA + i], b[OB + 15 - i]);
    if (SORT) {
#pragma unroll
        for (int j = 8; j > 0; j >>= 1) {
#pragma unroll
            for (int i = 0; i < 16; ++i) {
                const int l = i ^ j;
                if (l > i) { const float x = a[OA + i], y = a[OA + l]; a[OA + i] = tk_max(x, y); a[OA + l] = tk_min(x, y); }
            }
        }
    }
}
constexpr int cand_i(int c) { int n = 0; for (int i = 0; i < 16; ++i) for (int j = 0; j < 16 / (i + 1); ++j) { if (n == c) return i; ++n; } return 0; }
constexpr int cand_j(int c) { int n = 0; for (int i = 0; i < 16; ++i) for (int j = 0; j < 16 / (i + 1); ++j) { if (n == c) return j; ++n; } return 0; }
template <int C> struct CandT { static constexpr int I = cand_i(C), J = cand_j(C); };

__device__ __forceinline__ void peer_level1(const bf16* qrow  , const LAS unsigned char* sk  ,
                                            int r, int hh, float (&out)[16]) {
    bf16x8 qf[8];
#pragma unroll
    for (int ks = 0; ks < 8; ++ks) qf[ks] = *(const bf16x8*)(qrow + ks * 16 + hh * 8);
    float v[64];
#pragma unroll
    for (int kb = 0; kb < 4; ++kb) {
        f32x16 sc = {0.f, 0.f, 0.f, 0.f, 0.f, 0.f, 0.f, 0.f, 0.f, 0.f, 0.f, 0.f, 0.f, 0.f, 0.f, 0.f};
        const int key = kb * 32 + r;
#pragma unroll
        for (int ks = 0; ks < 8; ++ks) {
            const bf16x8 af = *(const LAS bf16x8*)(sk + key * 256 + (((2 * ks + hh) ^ (key & 15)) << 4));
            sc = __builtin_amdgcn_mfma_f32_32x32x16_bf16(af, qf[ks], sc, 0, 0, 0);
        }
#pragma unroll
        for (int reg = 0; reg < 16; ++reg) {
            const unsigned idx = (unsigned)(kb * 32 + (reg & 3) + 8 * (reg >> 2)) | ((unsigned)hh << 2);
            v[kb * 16 + reg] = __uint_as_float((__float_as_uint(sc[reg]) & ~127u) | idx);
        }
    }
    sort16_desc<0>(v); sort16_desc<16>(v); sort16_desc<32>(v); sort16_desc<48>(v);
    merge_top16<0, 16, true>(v, v); merge_top16<32, 48, true>(v, v); merge_top16<0, 32, true>(v, v);
    float other[16];
#pragma unroll
    for (int i = 0; i < 16; ++i) other[i] = __shfl_xor(v[i], 32);
    merge_top16<0, 0, true>(v, other);
#pragma unroll
    for (int i = 0; i < 16; ++i) out[i] = v[i];
}
template <int C, class EP, class WP> __device__ __forceinline__ void peer_emit(const float (&a)[16], const float (&b)[16], const float (&s)[64], float tau, int& cnt, float& den, bool writer, EP eo, WP wo) {
    if constexpr (C < 50) {
        const bool take = (s[C] >= tau) && (cnt < 16);
        const float e = __expf(s[C] - s[0]);
        if (take) {
            if (writer) { eo[cnt] = (int)(((__float_as_uint(a[CandT<C>::I]) & 127u) << 7) | (__float_as_uint(b[CandT<C>::J]) & 127u)); wo[cnt] = e; }
            cnt += 1; den += e;
        }
        peer_emit<C + 1, EP, WP>(a, b, s, tau, cnt, den, writer, eo, wo);
    }
}
template <int C> __device__ __forceinline__ void peer_sums(const float (&a)[16], const float (&b)[16], float (&s)[64]) {
    if constexpr (C < 50) { s[C] = a[CandT<C>::I] + b[CandT<C>::J]; peer_sums<C + 1>(a, b, s); }
}
__device__ __forceinline__ void phase_topk(LAS unsigned char* lds, const bf16* QP, const bf16* SUBK, int* PE, float* PG, int tid, int lane, int wave, int vcu, int G) {
    for (int c = tid; c < 2 * 128 * 16; c += NWAVES * 64) { const int row = c >> 4, ch = c & 15; const v4u w = ((const v4u*)SUBK)[c]; *(LAS v4u*)(lds + row * 256 + ((ch ^ (row & 15)) << 4)) = w; }
    __syncthreads();
    LAS int* stE = (LAS int*)(lds + 65536);
    LAS float* stW = (LAS float*)(lds + 65536 + 16384);
    const int r = lane & 31, hh = lane >> 5, head = wave;
    for (int tile = vcu; tile < T / 32; tile += G) {
        const int tok = tile * 32 + r;
        const bf16* qrow = QP + (size_t)tok * 2048 + head * 256;
        float a[16], b[16];
        peer_level1(qrow, lds, r, hh, a);
        peer_level1(qrow + 128, lds + 128 * 256, r, hh, b);
        float s[64];
        peer_sums<0>(a, b, s);
#pragma unroll
        for (int c = 50; c < 64; ++c) s[c] = -INFINITY;
        float w[64];
#pragma unroll
        for (int c = 0; c < 64; ++c) w[c] = s[c];
        sort16_desc<0>(w); sort16_desc<16>(w); sort16_desc<32>(w); sort16_desc<48>(w);
        merge_top16<0, 16, true>(w, w); merge_top16<32, 48, true>(w, w); merge_top16<0, 32, false>(w, w);
        float tau = w[0];
#pragma unroll
        for (int i = 1; i < 16; ++i) tau = tk_min(tau, w[i]);
        int cnt = 0; float den = 0.f;
        LAS int* eo = stE + r * 128 + head * 16; LAS float* wo = stW + r * 128 + head * 16;
        peer_emit<0, LAS int*, LAS float*>(a, b, s, tau, cnt, den, hh == 0, eo, wo);
        if (hh == 0) { const float inv = 1.0f / den; asm volatile("s_waitcnt lgkmcnt(0)" ::: "memory");
#pragma unroll
            for (int k = 0; k < 16; ++k) wo[k] *= inv; }
        __syncthreads();
#pragma unroll 1
        for (int i = 0; i < 4; ++i) { const int tl = wave * 4 + i; const size_t tg = (size_t)(tile * 32 + tl) * 128;
            const int e0 = stE[tl * 128 + lane], e1 = stE[tl * 128 + 64 + lane]; const float g0 = stW[tl * 128 + lane], g1 = stW[tl * 128 + 64 + lane];
            const int s0 = e0 >> PSH, s1 = e1 >> PSH; int base = 0, p0 = 0, p1 = 0;
#pragma unroll
            for (int bq = 0; bq < PNQ; ++bq) {
                const unsigned long long m0 = __ballot(s0 == bq), m1 = __ballot(s1 == bq);
                const int c0 = __popcll(m0), c1 = __popcll(m1);
                const int r0 = (int)__builtin_amdgcn_mbcnt_hi((unsigned)(m0 >> 32), __builtin_amdgcn_mbcnt_lo((unsigned)m0, 0u));
                const int r1 = (int)__builtin_amdgcn_mbcnt_hi((unsigned)(m1 >> 32), __builtin_amdgcn_mbcnt_lo((unsigned)m1, 0u));
                if (s0 == bq) p0 = base + r0;
                if (s1 == bq) p1 = base + c0 + r1;
                base += c0 + c1;
            }
            PE[tg + p0] = e0; PE[tg + p1] = e1; PG[tg + p0] = g0; PG[tg + p1] = g1; }
        __syncthreads();
    }
}

__device__ __forceinline__ float dot2_bf16(unsigned w, unsigned x, float acc) { return __builtin_amdgcn_fdot2_f32_bf16(__builtin_bit_cast(bf2_t, w), __builtin_bit_cast(bf2_t, x), acc, false); }
__device__ __forceinline__ float dot8_bf16(const v4u a, const v4u b, float acc) {
    acc = dot2_bf16(a.x, b.x, acc); acc = dot2_bf16(a.y, b.y, acc); acc = dot2_bf16(a.z, b.z, acc); acc = dot2_bf16(a.w, b.w, acc);
    return acc;
}
template <int N> __device__ __forceinline__ void xpose_reduce(float (&p)[64], int lane) {
    if constexpr (N >= 1) {
        const bool up = (lane & N) != 0;
#pragma unroll
        for (int k = 0; k < N; ++k) { const float keep = up ? p[k + N] : p[k], send = up ? p[k] : p[k + N]; p[k] = keep + __shfl_xor(send, N); }
        xpose_reduce<N / 2>(p, lane);
    }
}
__device__ __forceinline__ float gelu_exact(float x) { return 0.5f * x * (1.0f + erff(x * 0.70710678118654752f)); }
__device__ __forceinline__ float gelu_as(float v) {
    const float t = __builtin_amdgcn_rcpf(fabsf(v) * 0.2316418882f + 1.0f);
    float q = t * 0.5307027145f + (-0.7265760135f); q = q * t + 0.7107068705f; q = q * t + (-0.142248368f); q = q * t + 0.127414796f; q = q * t;
    const float e = __builtin_amdgcn_exp2f(v * v * (-0.72134752044f));
    const float m = v * (q * e);
    return v < 0.f ? m : v - m;
}
typedef float f32x2_ __attribute__((ext_vector_type(2)));
__device__ __forceinline__ void fp8x16_to_f32(const v4u w, float (&f)[16]) {
    const int w0 = (int)w.x, w1 = (int)w.y, w2 = (int)w.z, w3 = (int)w.w;
    f32x2_ t;
    t = __builtin_amdgcn_cvt_pk_f32_fp8(w0, false); f[0] = t.x; f[1] = t.y; t = __builtin_amdgcn_cvt_pk_f32_fp8(w0, true); f[2] = t.x; f[3] = t.y;
    t = __builtin_amdgcn_cvt_pk_f32_fp8(w1, false); f[4] = t.x; f[5] = t.y; t = __builtin_amdgcn_cvt_pk_f32_fp8(w1, true); f[6] = t.x; f[7] = t.y;
    t = __builtin_amdgcn_cvt_pk_f32_fp8(w2, false); f[8] = t.x; f[9] = t.y; t = __builtin_amdgcn_cvt_pk_f32_fp8(w2, true); f[10] = t.x; f[11] = t.y;
    t = __builtin_amdgcn_cvt_pk_f32_fp8(w3, false); f[12] = t.x; f[13] = t.y; t = __builtin_amdgcn_cvt_pk_f32_fp8(w3, true); f[14] = t.x; f[15] = t.y;
}
constexpr float U8_SCALE = 32.0f, V8_SCALE = 2.0f;
template <int N> __device__ __forceinline__ void xpose_reduce32(float (&p)[32], int lane) {
    if constexpr (N >= 1) {
        const bool up = (lane & N) != 0;
#pragma unroll
        for (int k = 0; k < N; ++k) { const float keep = up ? p[k + N] : p[k], send = up ? p[k] : p[k + N]; p[k] = keep + __shfl_xor(send, N); }
        xpose_reduce32<N / 2>(p, lane);
    } else { p[0] += __shfl_xor(p[0], 32); }
}
__device__ __forceinline__ void peer_u_group(__amdgpu_buffer_rsrc_t U8, const float (&h)[16], int ev, float gv, float zsc, float* wf, int lane) {
    f32x2_ h2[8];
#pragma unroll
    for (int c = 0; c < 8; ++c) { h2[c].x = h[2 * c]; h2[c].y = h[2 * c + 1]; }
    float p[PEG];
#pragma unroll
    for (int i0 = 0; i0 < PEG; i0 += 8) {
        v4u ua[8];
#pragma unroll
        for (int k = 0; k < 8; ++k) { const int eid = __builtin_amdgcn_readlane(ev, i0 + k); ua[k] = __builtin_amdgcn_raw_buffer_load_b128(U8, lane * 16, eid * 1024, 0); }
#pragma unroll
        for (int k = 0; k < 8; ++k) { const int w0 = (int)ua[k].x, w1 = (int)ua[k].y, w2 = (int)ua[k].z, w3 = (int)ua[k].w;
            f32x2_ a0 = h2[0] * __builtin_amdgcn_cvt_pk_f32_fp8(w0, false), a1 = h2[1] * __builtin_amdgcn_cvt_pk_f32_fp8(w0, true);
            a0 += h2[2] * __builtin_amdgcn_cvt_pk_f32_fp8(w1, false); a1 += h2[3] * __builtin_amdgcn_cvt_pk_f32_fp8(w1, true);
            a0 += h2[4] * __builtin_amdgcn_cvt_pk_f32_fp8(w2, false); a1 += h2[5] * __builtin_amdgcn_cvt_pk_f32_fp8(w2, true);
            a0 += h2[6] * __builtin_amdgcn_cvt_pk_f32_fp8(w3, false); a1 += h2[7] * __builtin_amdgcn_cvt_pk_f32_fp8(w3, true);
            a0 += a1; p[i0 + k] = a0.x + a0.y; }
    }
    xpose_reduce32<16>(p, lane);
    if (lane < PEG) wf[lane] = gelu_exact(p[0] * zsc) * gv * (1.0f / V8_SCALE);
}
__device__ __forceinline__ void peer_v_group(__amdgpu_buffer_rsrc_t V8, float (&y)[16], int ev, float wv, int lane) {
#pragma unroll
    for (int i0 = 0; i0 < PEG; i0 += 16) {
        v4u va[16]; float ws[16];
#pragma unroll
        for (int k = 0; k < 16; ++k) { const int eid = __builtin_amdgcn_readlane(ev, i0 + k); ws[k] = __int_as_float(__builtin_amdgcn_readlane(__float_as_int(wv), i0 + k));
            va[k] = __builtin_amdgcn_raw_buffer_load_b128(V8, lane * 16, eid * 1024, 0); }
#pragma unroll
        for (int k = 0; k < 16; ++k) { float f[16]; fp8x16_to_f32(va[k], f);
#pragma unroll
            for (int c = 0; c < 16; ++c) y[c] += ws[k] * f[c]; }
    }
}
__device__ __forceinline__ void peer_v_half(__amdgpu_buffer_rsrc_t V8, float (&y)[16], int ev, float wv, int lane) {
    for (int i0 = 0; i0 < 64; i0 += 16) {
        v4u va[16]; float ws[16];
#pragma unroll
        for (int k = 0; k < 16; ++k) { const int eid = __builtin_amdgcn_readlane(ev, i0 + k); ws[k] = __int_as_float(__builtin_amdgcn_readlane(__float_as_int(wv), i0 + k));
            va[k] = __builtin_amdgcn_raw_buffer_load_b128(V8, lane * 16, eid * 1024, 0); }
#pragma unroll
        for (int k = 0; k < 16; ++k) { float f[16]; fp8x16_to_f32(va[k], f);
#pragma unroll
            for (int c = 0; c < 16; ++c) y[c] += ws[k] * f[c]; }
    }
}
constexpr int XS_LO = 1088;
constexpr int UT_PITCH = 1040, UT_BYTES = 16 * UT_PITCH, UT_XS = 8 * UT_BYTES, XS_BYTES = 2176;
struct PeerVisit { int ev; float gv, rss; v4u ha, hb; };
__device__ __forceinline__ void peer_visit_load(PeerVisit& v, const bf16* H, const float* rowss, const int* PE, const float* PG, int tok, int g, int lane, bool dbg0) {
    const size_t eb = (size_t)tok * 128 + g * PEG;
    const int e = PE[eb + (lane & 31)]; v.ev = dbg0 ? 0 : e;
    v.gv = PG[eb + (lane & 31)]; v.rss = rowss[tok];
    v.ha = *(const v4u*)(H + (size_t)tok * 1024 + 16 * lane); v.hb = *(const v4u*)(H + (size_t)tok * 1024 + 16 * lane + 8);
}
__device__ __forceinline__ void peer_u_dma_tile(__amdgpu_buffer_rsrc_t U8, LAS unsigned char* tb, int ev, int t, int lane) {
#pragma unroll
    for (int r = 0; r < 16; ++r) { const int eid = __builtin_amdgcn_readlane(ev, 16 * t + r);
        __builtin_amdgcn_raw_ptr_buffer_load_lds(U8, (LAS unsigned*)(tb + r * UT_PITCH), 16, lane * 16, eid * 1024, 0, 0); }
}
__device__ __forceinline__ void peer_u_frags(const LAS unsigned char* tb, pg8::v8i32 (&ub)[8], int lane) {
    const LAS unsigned char* p = tb + (lane & 15) * UT_PITCH + (lane >> 4) * 16;
#pragma unroll
    for (int ks = 0; ks < 8; ++ks) { const v4u q0 = *(const LAS v4u*)(p + ks * 128), q1 = *(const LAS v4u*)(p + ks * 128 + 64);
        ub[ks] = (pg8::v8i32){(int)q0.x, (int)q0.y, (int)q0.z, (int)q0.w, (int)q1.x, (int)q1.y, (int)q1.z, (int)q1.w}; }
}
__device__ __forceinline__ void peer_u_visit(__amdgpu_buffer_rsrc_t U8, LAS unsigned char* tb, LAS unsigned char* xs, const PeerVisit& cur, PeerVisit& nxt, const bf16* H, const float* rowss, const int* PE, const float* PG,
                                             int tokn, int gn, bool dbg0, float* wf, int lane) {
    const int j = lane & 15, q = lane >> 4;
    {
        const v4u ha = cur.ha, hb = cur.hb;
        const float sc = rsqrtf(cur.rss * (1.0f / 1024.0f) + RMS_EPS) * 16.0f;
        float h[16];
        h[0] = bf_lo(ha.x) * sc; h[1] = bf_hi(ha.x) * sc; h[2] = bf_lo(ha.y) * sc; h[3] = bf_hi(ha.y) * sc; h[4] = bf_lo(ha.z) * sc; h[5] = bf_hi(ha.z) * sc; h[6] = bf_lo(ha.w) * sc; h[7] = bf_hi(ha.w) * sc;
        h[8] = bf_lo(hb.x) * sc; h[9] = bf_hi(hb.x) * sc; h[10] = bf_lo(hb.y) * sc; h[11] = bf_hi(hb.y) * sc; h[12] = bf_lo(hb.z) * sc; h[13] = bf_hi(hb.z) * sc; h[14] = bf_lo(hb.w) * sc; h[15] = bf_hi(hb.w) * sc;
        int hi[4], lo[4];
#pragma unroll
        for (int c = 0; c < 4; ++c) { int w = 0; w = __builtin_amdgcn_cvt_pk_fp8_f32(h[4 * c], h[4 * c + 1], w, false); w = __builtin_amdgcn_cvt_pk_fp8_f32(h[4 * c + 2], h[4 * c + 3], w, true); hi[c] = w;
            const f32x2_ b0 = __builtin_amdgcn_cvt_pk_f32_fp8(w, false), b1 = __builtin_amdgcn_cvt_pk_f32_fp8(w, true);
            int v = 0; v = __builtin_amdgcn_cvt_pk_fp8_f32((h[4 * c] - b0.x) * 16.0f, (h[4 * c + 1] - b0.y) * 16.0f, v, false); v = __builtin_amdgcn_cvt_pk_fp8_f32((h[4 * c + 2] - b1.x) * 16.0f, (h[4 * c + 3] - b1.y) * 16.0f, v, true); lo[c] = v; }
        *(LAS v4u*)(xs + 16 * lane) = (v4u){(unsigned)hi[0], (unsigned)hi[1], (unsigned)hi[2], (unsigned)hi[3]};
        *(LAS v4u*)(xs + XS_LO + 16 * lane) = (v4u){(unsigned)lo[0], (unsigned)lo[1], (unsigned)lo[2], (unsigned)lo[3]};
    }
    const LAS unsigned char* xb = xs + (j & 1) * XS_LO + q * 16;
    pg8::v8i32 xa[8];
#pragma unroll
    for (int ks = 0; ks < 8; ++ks) { const v4u q0 = *(const LAS v4u*)(xb + ks * 128), q1 = *(const LAS v4u*)(xb + ks * 128 + 64);
        xa[ks] = (pg8::v8i32){(int)q0.x, (int)q0.y, (int)q0.z, (int)q0.w, (int)q1.x, (int)q1.y, (int)q1.z, (int)q1.w}; }
    peer_visit_load(nxt, H, rowss, PE, PG, tokn, gn, lane, dbg0);
    pg8::v8i32 ub[8];
    f32x4 acc0 = {0.f, 0.f, 0.f, 0.f}, acc1 = {0.f, 0.f, 0.f, 0.f};
    const int unit = 0x7f7f7f7f;
    asm volatile("s_waitcnt vmcnt(0)" ::: "memory");
    peer_u_frags(tb, ub, lane);
    asm volatile("s_waitcnt lgkmcnt(0)" ::: "memory");
    peer_u_dma_tile(U8, tb, cur.ev, 1, lane);
#pragma unroll
    for (int ks = 0; ks < 8; ++ks) asm volatile("v_mfma_scale_f32_16x16x128_f8f6f4 %0, %1, %2, %0, %3, %3 op_sel_hi:[0,0,0]" : "+v"(acc0) : "v"(xa[ks]), "v"(ub[ks]), "v"(unit));
    asm volatile("s_waitcnt vmcnt(0)" ::: "memory");
    peer_u_frags(tb, ub, lane);
    asm volatile("s_waitcnt lgkmcnt(0)" ::: "memory");
    peer_u_dma_tile(U8, tb, nxt.ev, 0, lane);
#pragma unroll
    for (int ks = 0; ks < 8; ++ks) asm volatile("v_mfma_scale_f32_16x16x128_f8f6f4 %0, %1, %2, %0, %3, %3 op_sel_hi:[0,0,0]" : "+v"(acc1) : "v"(xa[ks]), "v"(ub[ks]), "v"(unit));
    asm volatile("s_nop 15\n\ts_nop 15" : "+v"(acc0), "+v"(acc1));
    const float z = (lane < 16) ? acc0.x + acc0.y * (1.0f / 16.0f) : acc1.x + acc1.y * (1.0f / 16.0f);
    if (lane < 32) wf[lane] = gelu_exact(z * (1.0f / (16.0f * U8_SCALE))) * cur.gv * (1.0f / V8_SCALE);
}
constexpr float PV_WSC = 64.0f;
struct PeerVRec { int ev; float w; };
__device__ __forceinline__ void peer_v_rec_load(PeerVRec& v, const float* WF, const int* PE, int tok, int g, int lane, bool dbg0) {
    const size_t eb = (size_t)tok * 128 + g * PEG;
    const int e = PE[eb + (lane & 31)]; v.ev = dbg0 ? 0 : e; v.w = WF[eb + (lane & 31)];
}
__device__ __forceinline__ void peer_v_load8(__amdgpu_buffer_rsrc_t V8, v4u (&L)[8], int ev, int base, int lane) {
#pragma unroll
    for (int r = 0; r < 8; ++r) { const int eid = __builtin_amdgcn_readlane(ev, base + r); L[r] = __builtin_amdgcn_raw_buffer_load_b128(V8, lane * 16, eid * 1024, 0); }
}
__device__ __forceinline__ void peer_v_mma8(const v4u (&L)[8], int w16, int base, int sh_in, int sh_out, unsigned mask0, unsigned mask1, f32x16& acc0, f32x16& acc1) {
#pragma unroll
    for (int r = 0; r < 8; ++r) {
        const unsigned s = (unsigned)__builtin_amdgcn_readlane(w16, base + r);
        const unsigned x = ((s >> sh_in) & 0xffu) << sh_out;
        const unsigned a0 = x & mask0, a1 = x & mask1;
        const long a = (long)(((unsigned long long)a1 << 32) | a0);
        const long b0 = (long)(((unsigned long long)L[r].y << 32) | L[r].x), b1 = (long)(((unsigned long long)L[r].w << 32) | L[r].z);
        acc0 = __builtin_amdgcn_mfma_f32_32x32x16_fp8_fp8(a, b0, acc0, 0, 0, 0);
        acc1 = __builtin_amdgcn_mfma_f32_32x32x16_fp8_fp8(a, b1, acc1, 0, 0, 0);
    }
}
__device__ __forceinline__ void peer_v_finish(float (&y)[16], int tok, int g, LAS unsigned char* pl, const bf16* H, const float* gfin, float* OUT, float* ydbg, bool dbg0, float oscale, int lane) {
    if (g < PNQ - 1) {
        *(LAS v4u*)(pl + 16 * lane) = (v4u){pk2(y[0], y[1]), pk2(y[2], y[3]), pk2(y[4], y[5]), pk2(y[6], y[7])}; *(LAS v4u*)(pl + 1024 + 16 * lane) = (v4u){pk2(y[8], y[9]), pk2(y[10], y[11]), pk2(y[12], y[13]), pk2(y[14], y[15])};
    } else {
        if (dbg0) {
#pragma unroll
            for (int c = 0; c < 16; ++c) y[c] = 0.f; }
        if (ydbg) { const int s_ = tok / 512; if (tok == s_ * 512 + 3 + (s_ & 7) * 37) {
#pragma unroll
            for (int c = 0; c < 16; ++c) ydbg[(size_t)s_ * 1024 + 16 * lane + c] = y[c]; } }
        const f32x4* gr = (const f32x4*)gfin + 4 * lane;
        const v4u xa = *(const v4u*)(H + (size_t)tok * 1024 + 16 * lane), xbv = *(const v4u*)(H + (size_t)tok * 1024 + 16 * lane + 8);
        f32x4 xv[4]; float ss = 0.f;
        xv[0] = (f32x4){bf_lo(xa.x), bf_hi(xa.x), bf_lo(xa.y), bf_hi(xa.y)}; xv[1] = (f32x4){bf_lo(xa.z), bf_hi(xa.z), bf_lo(xa.w), bf_hi(xa.w)};
        xv[2] = (f32x4){bf_lo(xbv.x), bf_hi(xbv.x), bf_lo(xbv.y), bf_hi(xbv.y)}; xv[3] = (f32x4){bf_lo(xbv.z), bf_hi(xbv.z), bf_lo(xbv.w), bf_hi(xbv.w)};
#pragma unroll
        for (int i = 0; i < 4; ++i) { xv[i].x += y[4 * i]; xv[i].y += y[4 * i + 1]; xv[i].z += y[4 * i + 2]; xv[i].w += y[4 * i + 3];
            ss += (xv[i].x * xv[i].x + xv[i].y * xv[i].y) + (xv[i].z * xv[i].z + xv[i].w * xv[i].w); }
        const float rinv = rsqrtf(wave_sum(ss) * (1.f / 1024.f) + RMS_EPS) * oscale;
        f32x4* orow = (f32x4*)(OUT + (size_t)tok * 1024) + 4 * lane;
#pragma unroll
        for (int i = 0; i < 4; ++i) orow[i] = xv[i] * rinv * gr[i];
    }
}
constexpr int PV_TOK = 8;
template <int F> __device__ __forceinline__ void peer_v_pass(__amdgpu_buffer_rsrc_t V8, const bf16* H, const float* WF, const int* PE, const float* gfin, float* OUT, float* ydbg, float oscale, LAS unsigned char* ldsw,
                                                             int lane, int wave, int gw, int ngw, float dbg_sc) {
    const int ntok = (T - gw + ngw - 1) / ngw; const bool dbg0 = dbg_sc == 0.f;
    LAS unsigned char* pbase = ldsw + wave * UT_BYTES;
    static_assert(PV_TOK * 2048 <= UT_BYTES, "the parked sums live in the wave's tile buffer");
    const int m_ = lane & 31, s8_ = (m_ & 3) + 4 * ((m_ >> 3) & 1); const bool nz_ = (lane >> 5) == ((m_ >> 2) & 1);
    const int sh_in = (m_ >> 4) * 8, sh_out = 8 * (s8_ & 3);
    const unsigned mask0 = (nz_ && s8_ < 4) ? 0xffffffffu : 0u, mask1 = (nz_ && s8_ >= 4) ? 0xffffffffu : 0u;
    PeerVRec ra, rb; v4u LA[8], LB[8];
    const bool wgsync = (T % ngw) == 0;
    if (ntok <= 0) return;
    peer_v_rec_load(ra, WF, PE, gw, 0, lane, dbg0); if (F & 1) ra.ev &= 2047;
    peer_v_load8(V8, LA, ra.ev, 0, lane);
    int t0 = 0, g = 0, k = 0;
#define PEER_V_NEXT(T0, G, K, T0N, GN, KN, LAST) do { const int nr_ = (ntok - (T0) < PV_TOK) ? ntok - (T0) : PV_TOK; T0N = (T0); GN = (G); KN = (K) + 1; LAST = false; \
        if (KN >= nr_) { KN = 0; GN = (G) + 1; if (GN >= PNQ) { GN = 0; T0N = (T0) + PV_TOK; if (T0N >= ntok) { T0N = (T0); GN = (G); KN = (K); LAST = true; } } } } while (0)
#define PEER_V_EAT(LL, BASE) do { if constexpr (F & 2) { _Pragma("unroll") for (int r_ = 0; r_ < 8; ++r_) { c0_[r_ & 7] += __uint_as_float(LL[r_].x ^ LL[r_].y); c1_[r_ & 7] += __uint_as_float(LL[r_].z ^ LL[r_].w); } } \
        else peer_v_mma8(LL, w16_, (BASE), sh_in, sh_out, mask0, mask1, c0_, c1_); } while (0)
#define PEER_V_VISIT(CUR, NXT, T0C, GC, KC, T0N, GN, KN) do { \
        const int tokc_ = gw + ((T0C) + (KC)) * ngw, tokn_ = gw + ((T0N) + (KN)) * ngw; LAS unsigned char* pl_ = pbase + (KC) * 2048; \
        peer_v_rec_load(NXT, WF, PE, tokn_, GN, lane, dbg0); if (F & 1) NXT.ev &= 2047; \
        peer_v_load8(V8, LB, CUR.ev, 8, lane); \
        int w16_; { int wq_ = 0; wq_ = __builtin_amdgcn_cvt_pk_fp8_f32(CUR.w * PV_WSC, 0.f, wq_, false); const f32x2_ bk_ = __builtin_amdgcn_cvt_pk_f32_fp8(wq_, false); \
            int lq_ = 0; lq_ = __builtin_amdgcn_cvt_pk_fp8_f32((CUR.w * PV_WSC - bk_.x) * 16.0f, 0.f, lq_, false); w16_ = (wq_ & 0xff) | ((lq_ & 0xff) << 8); } \
        f32x16 c0_, c1_; \
        if ((GC) > 0) { const v4u pa_ = *(const LAS v4u*)(pl_ + 16 * lane), pb_ = *(const LAS v4u*)(pl_ + 1024 + 16 * lane); \
            c0_[0] = bf_lo(pa_.x) * PV_WSC; c0_[1] = bf_hi(pa_.x) * PV_WSC; c0_[2] = bf_lo(pa_.y) * PV_WSC; c0_[3] = bf_hi(pa_.y) * PV_WSC; \
            c0_[4] = bf_lo(pa_.z) * PV_WSC; c0_[5] = bf_hi(pa_.z) * PV_WSC; c0_[6] = bf_lo(pa_.w) * PV_WSC; c0_[7] = bf_hi(pa_.w) * PV_WSC; \
            c1_[0] = bf_lo(pb_.x) * PV_WSC; c1_[1] = bf_hi(pb_.x) * PV_WSC; c1_[2] = bf_lo(pb_.y) * PV_WSC; c1_[3] = bf_hi(pb_.y) * PV_WSC; \
            c1_[4] = bf_lo(pb_.z) * PV_WSC; c1_[5] = bf_hi(pb_.z) * PV_WSC; c1_[6] = bf_lo(pb_.w) * PV_WSC; c1_[7] = bf_hi(pb_.w) * PV_WSC; \
        } else { _Pragma("unroll") for (int r_ = 0; r_ < 8; ++r_) { c0_[r_] = 0.f; c1_[r_] = 0.f; } } \
        _Pragma("unroll") for (int r_ = 8; r_ < 16; ++r_) { c0_[r_] = 0.f; c1_[r_] = 0.f; } \
        PEER_V_EAT(LA, 0);  peer_v_load8(V8, LA, CUR.ev, 16, lane); \
        PEER_V_EAT(LB, 8);  peer_v_load8(V8, LB, CUR.ev, 24, lane); \
        PEER_V_EAT(LA, 16); peer_v_load8(V8, LA, NXT.ev, 0, lane); \
        PEER_V_EAT(LB, 24); \
        float y[16]; \
        _Pragma("unroll") for (int r_ = 0; r_ < 8; ++r_) { y[r_] = (c0_[r_] + c0_[r_ + 8] * (1.0f / 16.0f)) * (1.0f / PV_WSC); y[8 + r_] = (c1_[r_] + c1_[r_ + 8] * (1.0f / 16.0f)) * (1.0f / PV_WSC); } \
        peer_v_finish(y, tokc_, GC, pl_, H, gfin, OUT, ydbg, dbg0, oscale, lane); \
        if (wgsync && (KN) == 0 && ((GN) != (GC) || (T0N) != (T0C))) __builtin_amdgcn_s_barrier(); } while (0)
    for (;;) {
        int t1, g1, k1, t2, g2, k2; bool last1, last2;
        PEER_V_NEXT(t0, g, k, t1, g1, k1, last1);
        PEER_V_VISIT(ra, rb, t0, g, k, t1, g1, k1);
        if (last1) break;
        PEER_V_NEXT(t1, g1, k1, t2, g2, k2, last2);
        PEER_V_VISIT(rb, ra, t1, g1, k1, t2, g2, k2);
        if (last2) break;
        t0 = t2; g = g2; k = k2;
    }
#undef PEER_V_VISIT
#undef PEER_V_EAT
#undef PEER_V_NEXT
}
__device__ __forceinline__ void phase_peer(const bf16* H, const float* rowss, const unsigned char* U8p, const unsigned char* V8p, float* WF, const int* PE, const float* PG,
                                           const float* gfin, float* OUT, int lane, int wave, int gw, int ngw, float dbg_sc, float* ydbg, float oscale, LAS unsigned char* ldsw) {
    static_assert(PEG == 32, "the group code is written for 32 entries per group");
    const __amdgpu_buffer_rsrc_t U8 = __builtin_amdgcn_make_buffer_rsrc((void*)U8p, 0, 16 << 20, 0x00020000), V8 = __builtin_amdgcn_make_buffer_rsrc((void*)V8p, 0, 16 << 20, 0x00020000);
    {   const int ntok = (T - gw + ngw - 1) / ngw, nvis = PNQ * ntok; const bool dbg0 = dbg_sc == 0.f; const bool usync = (T % ngw) == 0;
        LAS unsigned char* tb = ldsw + wave * UT_BYTES; LAS unsigned char* xs = ldsw + UT_XS + wave * XS_BYTES;
        PeerVisit va, vb;
        peer_visit_load(va, H, rowss, PE, PG, gw, 0, lane, dbg0);
        peer_u_dma_tile(U8, tb, va.ev, 0, lane);
        int g = 0, tok = gw;
        for (int vi = 0; vi < nvis; vi += 2) {
            int g1 = g, tok1 = tok + ngw; if (tok1 >= T) { tok1 = gw; g1 = g + 1; }
            if (vi + 1 >= nvis) { tok1 = tok; g1 = g; }
            peer_u_visit(U8, tb, xs, va, vb, H, rowss, PE, PG, tok1, g1, dbg0, WF + (size_t)tok * 128 + g * PEG, lane);
            if (vi + 1 >= nvis) break;
            if (usync && g1 != g) __builtin_amdgcn_s_barrier();
            int g2 = g1, tok2 = tok1 + ngw; if (tok2 >= T) { tok2 = gw; g2 = g1 + 1; }
            if (vi + 2 >= nvis) { tok2 = tok1; g2 = g1; }
            peer_u_visit(U8, tb, xs, vb, va, H, rowss, PE, PG, tok2, g2, dbg0, WF + (size_t)tok1 * 128 + g1 * PEG, lane);
            if (usync && g2 != g1 && vi + 2 < nvis) __builtin_amdgcn_s_barrier();
            g = g2; tok = tok2;
        }
    }
    asm volatile("s_waitcnt vmcnt(0)" ::: "memory");
    peer_v_pass<0>(V8, H, WF, PE, gfin, OUT, ydbg, oscale, ldsw, lane, wave, gw, ngw, dbg_sc);
}
#if PROBE_PH >= 20
template <int MODE> __device__ __forceinline__ void peer_probe(const bf16* H, const float* rowss, const unsigned char* U8p, const unsigned char* V8p, float* WF, const int* PE, const float* PG,
                                                               float* OUT, int lane, int wave, int gw, int ngw, int vcu, LAS unsigned char* ldsp, const float* gfin) {
    const __amdgpu_buffer_rsrc_t U8 = __builtin_amdgcn_make_buffer_rsrc((void*)U8p, 0, 16 << 20, 0x00020000), V8 = __builtin_amdgcn_make_buffer_rsrc((void*)V8p, 0, 16 << 20, 0x00020000);
    if constexpr (MODE >= 20) { peer_v_pass<MODE - 20>(V8, H, WF, PE, gfin, OUT, nullptr, 1.0f, ldsp, lane, wave, gw, ngw, 1.0f); }
    else if constexpr (MODE == 0 || MODE == 1 || MODE == 2 || MODE == 6) {
        for (int g = 0; g < PNQ; ++g) {
            for (int tok = gw; tok < T; tok += ngw) {
                int ev = PE[(size_t)tok * 128 + g * PEG + (lane & (PEG - 1))]; const float gv = PG[(size_t)tok * 128 + g * PEG + (lane & (PEG - 1))];
                ev &= 16383;
                if (MODE == 1 || MODE == 6) ev = (ev & 2047) | ((vcu >> 5) << 11);
                const v4u ha = *(const v4u*)(H + (size_t)tok * 1024 + 16 * lane), hb = *(const v4u*)(H + (size_t)tok * 1024 + 16 * lane + 8);
                float h[16];
                h[0] = bf_lo(ha.x); h[1] = bf_hi(ha.x); h[2] = bf_lo(ha.y); h[3] = bf_hi(ha.y); h[4] = bf_lo(ha.z); h[5] = bf_hi(ha.z); h[6] = bf_lo(ha.w); h[7] = bf_hi(ha.w);
                h[8] = bf_lo(hb.x); h[9] = bf_hi(hb.x); h[10] = bf_lo(hb.y); h[11] = bf_hi(hb.y); h[12] = bf_lo(hb.z); h[13] = bf_hi(hb.z); h[14] = bf_lo(hb.w); h[15] = bf_hi(hb.w);
                const float zsc = rsqrtf(rowss[tok] * (1.0f / 1024.0f) + RMS_EPS) * (1.0f / U8_SCALE);
                if constexpr (MODE == 2 || MODE == 6) {
                    unsigned acc = 0u;
#pragma unroll
                    for (int i0 = 0; i0 < PEG; i0 += 8) {
                        v4u ua[8];
#pragma unroll
                        for (int k = 0; k < 8; ++k) { const int eid = __builtin_amdgcn_readlane(ev, i0 + k); ua[k] = __builtin_amdgcn_raw_buffer_load_b128(U8, lane * 16, eid * 1024, 0); }
#pragma unroll
                        for (int k = 0; k < 8; ++k) acc ^= (ua[k].x ^ ua[k].y) ^ (ua[k].z ^ ua[k].w);
                    }
                    if (lane < PEG) (WF + (size_t)tok * 128 + g * PEG)[lane] = __uint_as_float(acc) * zsc * gv * h[0];
                } else peer_u_group(U8, h, ev, gv, zsc, WF + (size_t)tok * 128 + g * PEG, lane);
            }
        }
    } else {
        for (int tq = gw; tq < T; tq += PVQ * ngw) {
            float y[PVQ][16];
#pragma unroll
            for (int j = 0; j < PVQ; ++j)
#pragma unroll
                for (int c = 0; c < 16; ++c) y[j][c] = 0.f;
#pragma unroll
            for (int half = 0; half < 2; ++half)
#pragma unroll
                for (int j = 0; j < PVQ; ++j) { const size_t t_ = (size_t)(tq + j * ngw);
                    int ev = PE[t_ * 128 + half * 64 + lane] & 16383; const float wv = WF[t_ * 128 + half * 64 + lane];
                    if (MODE == 4) ev &= 2047;
                    if constexpr (MODE == 5) {
                        for (int i0 = 0; i0 < 64; i0 += 16) {
                            v4u va[16];
#pragma unroll
                            for (int k = 0; k < 16; ++k) { const int eid = __builtin_amdgcn_readlane(ev, i0 + k); va[k] = __builtin_amdgcn_raw_buffer_load_b128(V8, lane * 16, eid * 1024, 0); }
#pragma unroll
                            for (int k = 0; k < 16; ++k) { y[j][0] = __uint_as_float(__float_as_uint(y[j][0]) ^ va[k].x); y[j][1] = __uint_as_float(__float_as_uint(y[j][1]) ^ va[k].y);
                                y[j][2] = __uint_as_float(__float_as_uint(y[j][2]) ^ va[k].z); y[j][3] = __uint_as_float(__float_as_uint(y[j][3]) ^ va[k].w); }
                        }
                        y[j][4] += wv;
                    } else peer_v_half(V8, y[j], ev, wv, lane);
                }
#pragma unroll
            for (int j = 0; j < PVQ; ++j) {
                const int tok = tq + j * ngw;
                const v4u xa = *(const v4u*)(H + (size_t)tok * 1024 + 16 * lane), xbv = *(const v4u*)(H + (size_t)tok * 1024 + 16 * lane + 8);
                f32x4 xv[4]; float ss = 0.f;
                xv[0] = (f32x4){bf_lo(xa.x), bf_hi(xa.x), bf_lo(xa.y), bf_hi(xa.y)}; xv[1] = (f32x4){bf_lo(xa.z), bf_hi(xa.z), bf_lo(xa.w), bf_hi(xa.w)};
                xv[2] = (f32x4){bf_lo(xbv.x), bf_hi(xbv.x), bf_lo(xbv.y), bf_hi(xbv.y)}; xv[3] = (f32x4){bf_lo(xbv.z), bf_hi(xbv.z), bf_lo(xbv.w), bf_hi(xbv.w)};
#pragma unroll
                for (int i = 0; i < 4; ++i) { xv[i].x += y[j][4 * i]; xv[i].y += y[j][4 * i + 1]; xv[i].z += y[j][4 * i + 2]; xv[i].w += y[j][4 * i + 3];
                    ss += (xv[i].x * xv[i].x + xv[i].y * xv[i].y) + (xv[i].z * xv[i].z + xv[i].w * xv[i].w); }
                const float rinv = rsqrtf(wave_sum(ss) * (1.f / 1024.f) + RMS_EPS);
                f32x4* orow = (f32x4*)(OUT + (size_t)tok * 1024) + 4 * lane;
#pragma unroll
                for (int i = 0; i < 4; ++i) orow[i] = xv[i] * rinv;
            }
        }
    }
}
#endif
constexpr float L2E = 1.4426950408889634f;
#ifndef ATT_THR
#define ATT_THR 8.0f
#endif
typedef short v4i16_t __attribute__((ext_vector_type(4)));
__device__ __forceinline__ float amax3(float a, float b, float c) { float r; asm("v_max3_f32 %0, %1, %2, %3" : "=v"(r) : "v"(a), "v"(b), "v"(c)); return r; }
template <int D> struct ACfg { static constexpr int KS = D / 16, NBLK = D / 32, PITCH = D * 2 + 16, TILEB = 64 * PITCH, VPITCH = (D == 64 ? 192 : 320)  , VTILEB = 64 * VPITCH, PIECES = D / 64, CPR = D / 8; };
__device__ __forceinline__ bf16x8 pack8(float a0, float a1, float a2, float a3, float a4, float a5, float a6, float a7) {
    v4u u; u.x = pk2(a0, a1); u.y = pk2(a2, a3); u.z = pk2(a4, a5); u.w = pk2(a6, a7); return __builtin_bit_cast(bf16x8, u);
}
template <int D> __device__ __forceinline__ void attn_stage_load(v4u (&kr)[D / 64], v4u (&vr)[D / 64], const bf16* Kg, const bf16* Vg, size_t rowstride, int tid) {
#pragma unroll
    for (int p = 0; p < D / 64; ++p) { const int idx = tid + 512 * p, row = idx / ACfg<D>::CPR, ch = idx % ACfg<D>::CPR;
        kr[p] = *(const v4u*)(Kg + (size_t)row * rowstride + ch * 8); vr[p] = *(const v4u*)(Vg + (size_t)row * rowstride + ch * 8); }
}
template <int D> __device__ __forceinline__ void attn_stage_store(const v4u (&kr)[D / 64], const v4u (&vr)[D / 64], LAS unsigned char* Kl, LAS unsigned char* Vl, int tid) {
#pragma unroll
    for (int p = 0; p < D / 64; ++p) { const int idx = tid + 512 * p, row = idx / ACfg<D>::CPR, ch = idx % ACfg<D>::CPR;
        *(LAS v4u*)(Kl + row * ACfg<D>::PITCH + ch * 16) = kr[p]; *(LAS v4u*)(Vl + row * ACfg<D>::VPITCH + ch * 16) = vr[p]; }
}
template <int D> __device__ __forceinline__ void attn_load_q(bf16x8 (&qf)[D / 16], const bf16* qrow, int hh, float scale) {
#pragma unroll
    for (int ks = 0; ks < D / 16; ++ks) { const v4u w = *(const v4u*)(qrow + ks * 16 + hh * 8);
        qf[ks] = pack8(bf_lo(w.x) * scale, bf_hi(w.x) * scale, bf_lo(w.y) * scale, bf_hi(w.y) * scale, bf_lo(w.z) * scale, bf_hi(w.z) * scale, bf_lo(w.w) * scale, bf_hi(w.w) * scale); }
}
template <int D, int BIAS  > __device__ __forceinline__ void attn_tile(const LAS unsigned char* Kl, const LAS unsigned char* Vl, const bf16x8 (&qf)[D / 16], f32x16 (&o)[D / 32], float& m, float& l,
                                                                      const LAS float* tb, bool active, int lane, float cbias = 0.f) {
    constexpr int PITCH = ACfg<D>::PITCH, VPITCH = ACfg<D>::VPITCH;
    const int r = lane & 31, hh = lane >> 5;
    f32x16 s0, s1;
    if (BIAS == 2) {
#pragma unroll
        for (int reg = 0; reg < 16; ++reg) { s0[reg] = cbias; s1[reg] = cbias; }
    } else if (BIAS == 1) {
#pragma unroll
        for (int reg = 0; reg < 16; ++reg) { s0[reg] = tb[(reg & 3) + 8 * (reg >> 2)]; s1[reg] = tb[32 + (reg & 3) + 8 * (reg >> 2)]; }
    } else {
#pragma unroll
        for (int reg = 0; reg < 16; ++reg) { s0[reg] = 0.f; s1[reg] = 0.f; }
    }
#pragma unroll
    for (int ks = 0; ks < D / 16; ++ks) {
        const bf16x8 k0 = *(const LAS bf16x8*)(Kl + r * PITCH + (2 * ks + hh) * 16);
        const bf16x8 k1 = *(const LAS bf16x8*)(Kl + (32 + r) * PITCH + (2 * ks + hh) * 16);
        s0 = __builtin_amdgcn_mfma_f32_32x32x16_bf16(k0, qf[ks], s0, 0, 0, 0);
        s1 = __builtin_amdgcn_mfma_f32_32x32x16_bf16(k1, qf[ks], s1, 0, 0, 0);
    }
    asm volatile("s_nop 15\n\ts_nop 7" : "+v"(s0), "+v"(s1));
    float mx = amax3(s0[0], s1[0], s0[1]), mx2 = amax3(s1[1], s0[2], s1[2]);
#pragma unroll
    for (int reg = 3; reg < 15; reg += 2) { mx = amax3(mx, s0[reg], s1[reg]); mx2 = amax3(mx2, s0[reg + 1], s1[reg + 1]); }
    mx = amax3(mx, mx2, s0[15]); mx = amax3(mx, s1[15], s1[15]); mx = amax3(mx, __shfl_xor(mx, 32), mx);
    if (__any(active && (mx > m + ATT_THR))) {
        const float mn = active ? fmaxf(m, mx) : m;
        const float alpha = __builtin_amdgcn_exp2f(m - mn);
        l *= alpha; m = mn;
#pragma unroll
        for (int blk = 0; blk < D / 32; ++blk)
#pragma unroll
            for (int reg = 0; reg < 16; ++reg) o[blk][reg] *= alpha;
    }
    const float meff = active ? m : __builtin_inff();
    float ls = 0.f;
#pragma unroll
    for (int reg = 0; reg < 16; ++reg) { s0[reg] = __builtin_amdgcn_exp2f(s0[reg] - meff); s1[reg] = __builtin_amdgcn_exp2f(s1[reg] - meff); ls += s0[reg] + s1[reg]; }
    l += ls;
    bf16x8 pf[4];
    pf[0] = pack8(s0[0], s0[1], s0[2], s0[3], s0[4], s0[5], s0[6], s0[7]); pf[1] = pack8(s0[8], s0[9], s0[10], s0[11], s0[12], s0[13], s0[14], s0[15]);
    pf[2] = pack8(s1[0], s1[1], s1[2], s1[3], s1[4], s1[5], s1[6], s1[7]); pf[3] = pack8(s1[8], s1[9], s1[10], s1[11], s1[12], s1[13], s1[14], s1[15]);
    const int i16 = lane & 15;
    unsigned vbo = (unsigned)((4 * hh + (i16 >> 2)) * VPITCH + (16 * ((lane >> 4) & 1) + 4 * (i16 & 3)) * 2);
    asm volatile("" : "+v"(vbo) :: "memory");
    const LAS unsigned char* vb = Vl + vbo;
#pragma unroll
    for (int blk = 0; blk < D / 32; ++blk) {
#pragma unroll
        for (int ks = 0; ks < 4; ++ks) {
            const v4i16_t lo = __builtin_amdgcn_ds_read_tr16_b64_v4i16((LAS v4i16_t*)(vb + (16 * ks) * VPITCH + blk * 64));
            const v4i16_t hi = __builtin_amdgcn_ds_read_tr16_b64_v4i16((LAS v4i16_t*)(vb + (16 * ks + 8) * VPITCH + blk * 64));
            const bf16x8 va = {lo[0], lo[1], lo[2], lo[3], hi[0], hi[1], hi[2], hi[3]};
            o[blk] = __builtin_amdgcn_mfma_f32_32x32x16_bf16(va, pf[ks], o[blk], 0, 0, 0);
        }
    }
}
template <int D> __device__ __forceinline__ void attn_store_o(const f32x16 (&o)[D / 32], float inv, bf16* orow, int hh) {
#pragma unroll
    for (int blk = 0; blk < D / 32; ++blk)
#pragma unroll
        for (int g4 = 0; g4 < 4; ++g4) { unsigned long long w = (unsigned long long)pk2(o[blk][4 * g4] * inv, o[blk][4 * g4 + 1] * inv) | ((unsigned long long)pk2(o[blk][4 * g4 + 2] * inv, o[blk][4 * g4 + 3] * inv) << 32);
            *(unsigned long long*)(orow + 32 * blk + 8 * g4 + 4 * hh) = w; }
}
constexpr int ATT_TB_BYTES = 18432;

__device__ __forceinline__ void moba_unit(LAS unsigned char* lds, const bf16* P, const float* KMEAN, const float* rel_bias, bf16* OMOBA, int b, int h, int qb, int tid, int lane, int wave) {
    constexpr int TILEB = ACfg<64>::TILEB, VTILEB = ACfg<64>::VTILEB;
    const int r = lane & 31, hh = lane >> 5;
    LAS float* TB = (LAS float*)lds;
    LAS unsigned char* Kb = lds + ATT_TB_BYTES; LAS unsigned char* Vb = Kb + 2 * TILEB;
    LAS float* KM = (LAS float*)(lds + ATT_TB_BYTES + 4 * TILEB + 4 * VTILEB);
#pragma unroll
    for (int i = 0; i < 9; ++i) { const int x = tid + i * (NWAVES * 64); if (x < 4352) { const int dist = 4095 - x; float tv = -__builtin_inff(); if (dist >= 0) tv = DBG_NOBIAS ? 0.f : rel_bias[t5_bucket(dist) * 20 + 12 + h] * L2E; TB[x] = tv; } }
#pragma unroll
    for (int i = 0; i < 2; ++i) { const int x = tid + i * (NWAVES * 64); if (x < qb * 64) KM[x] = KMEAN[(size_t)((b * 8 + h) * 16) * 64 + x]; }
    __syncthreads();
    const int qpos = qb * 256 + wave * 32 + r; const size_t tokq = (size_t)b * SEQ + qpos;
    const bf16* qrow = P + tokq * QKVW + 2304 + h * 64;
    unsigned sel = 0u;
    {
        float q[64]; load_q64(q, qrow, 1.0f);
        float v1 = -3e38f, v2 = -3e38f, v3 = -3e38f; int i1 = -1, i2 = -1, i3 = -1;
        for (int n = 0; n < qb; ++n) {
            const LAS f32x4* km = (const LAS f32x4*)(KM + n * 64); float gs = 0.f;
#pragma unroll
            for (int c = 0; c < 16; ++c) { const f32x4 kv = km[c]; gs += q[4 * c] * kv.x + q[4 * c + 1] * kv.y + q[4 * c + 2] * kv.z + q[4 * c + 3] * kv.w; }
            if (gs > v1) { v3 = v2; i3 = i2; v2 = v1; i2 = i1; v1 = gs; i1 = n; }
            else if (gs > v2) { v3 = v2; i3 = i2; v2 = gs; i2 = n; }
            else if (gs > v3) { v3 = gs; i3 = n; }
        }
        if (i1 >= 0) sel |= 1u << i1;
        if (i2 >= 0) sel |= 1u << i2;
        if (i3 >= 0) sel |= 1u << i3;
    }
    bf16x8 qf[4]; attn_load_q<64>(qf, qrow, hh, 0.125f * L2E);
    f32x16 o[2];
#pragma unroll
    for (int reg = 0; reg < 16; ++reg) { o[0][reg] = 0.f; o[1][reg] = 0.f; }
    float m = -1e30f, l = 0.f;
    const bf16* Kg0 = P + (size_t)b * SEQ * QKVW + 2304 + 512 + h * 64;
    const int nt = 4 + 4 * qb;
#define MOBA_K0(i) ((i) < 4 ? qb * 256 + 64 * (i) : 64 * ((i) - 4))
    LAS unsigned char* Kb2 = Kb; LAS unsigned char* Vb2 = Kb + 4 * TILEB;
    LAS float* KM2 = (LAS float*)(Kb + 4 * TILEB + 4 * VTILEB); (void)KM2;
    v4u krA[1], vrA[1], krB[1], vrB[1];
    { const int k0 = MOBA_K0(0), k1 = MOBA_K0(1);
      attn_stage_load<64>(krA, vrA, Kg0 + (size_t)k0 * QKVW, Kg0 + (size_t)k0 * QKVW + 512, QKVW, tid); attn_stage_load<64>(krB, vrB, Kg0 + (size_t)k1 * QKVW, Kg0 + (size_t)k1 * QKVW + 512, QKVW, tid);
      attn_stage_store<64>(krA, vrA, Kb2, Vb2, tid); attn_stage_store<64>(krB, vrB, Kb2 + TILEB, Vb2 + VTILEB, tid); }
    __syncthreads();
    for (int i = 0; i < nt; i += 2) {
        const int sb = (i >> 1) & 1;
        if (i + 2 < nt) { const int k2 = MOBA_K0(i + 2), k3 = MOBA_K0(i + 3);
            attn_stage_load<64>(krA, vrA, Kg0 + (size_t)k2 * QKVW, Kg0 + (size_t)k2 * QKVW + 512, QKVW, tid); attn_stage_load<64>(krB, vrB, Kg0 + (size_t)k3 * QKVW, Kg0 + (size_t)k3 * QKVW + 512, QKVW, tid); }
#pragma unroll
        for (int e = 0; e < 2; ++e) { const int ii = i + e; const int k0 = MOBA_K0(ii);
            bool on; bool go;
            if (ii < 4) { on = true; go = (ii <= (wave >> 1)); }
            else { on = (sel >> ((ii - 4) >> 2)) & 1u; go = __any(on) != 0; }
            if (go) attn_tile<64, 1>(Kb2 + (2 * sb + e) * TILEB, Vb2 + (2 * sb + e) * VTILEB, qf, o, m, l, TB + (k0 - qpos + 4095 + 4 * hh), on, lane); }
        if (i + 2 < nt) { attn_stage_store<64>(krA, vrA, Kb2 + (2 * (sb ^ 1)) * TILEB, Vb2 + (2 * (sb ^ 1)) * VTILEB, tid); attn_stage_store<64>(krB, vrB, Kb2 + (2 * (sb ^ 1) + 1) * TILEB, Vb2 + (2 * (sb ^ 1) + 1) * VTILEB, tid); }
        __syncthreads();
    }
#undef MOBA_K0
    const float lt = l + __shfl_xor(l, 32);
    attn_store_o<64>(o, 1.0f / lt, OMOBA + tokq * 512 + h * 64, hh);
}
__device__ __forceinline__ void dil_unit(LAS unsigned char* lds, const bf16* P, const float* rel_bias, bf16* ODG, float* LSE, int b, int g, int h, int res, int blk, int tid, int lane, int wave) {
    constexpr int TILEB = ACfg<64>::TILEB, VTILEB = ACfg<64>::VTILEB;
    const int r = lane & 31, hh = lane >> 5, d = 1 << (2 * g), l0 = blk * 256;
    LAS float* TB = (LAS float*)lds;
    LAS unsigned char* Kb = lds + ATT_TB_BYTES; LAS unsigned char* Vb = Kb + 2 * TILEB;
    float tbv; { const int j = 256 - tid, jc = j < 0 ? 0 : (j > 128 ? 128 : j); tbv = (DBG_NOBIAS ? 0.f : rel_bias[t5_bucket(jc * d) * 20 + g * 4 + h] * L2E); if (j < 0 || j > 128) tbv = -__builtin_inff(); }
    const int q0w = l0 + wave * 32, lq = q0w + r; const size_t tokq = (size_t)b * SEQ + (size_t)lq * d + res;
    v4u qw[4];
#pragma unroll
    for (int ks = 0; ks < 4; ++ks) qw[ks] = *(const v4u*)(P + tokq * QKVW + g * 768 + h * 64 + ks * 16 + hh * 8);
    f32x16 o[2];
#pragma unroll
    for (int reg = 0; reg < 16; ++reg) { o[0][reg] = 0.f; o[1][reg] = 0.f; }
    float m = -1e30f, l = 0.f;
    const bf16* Kg0 = P + ((size_t)b * SEQ + res) * QKVW + g * 768 + 256 + h * 64;
    const size_t rs = (size_t)QKVW * d;
    const int kt0 = (l0 == 0) ? 0 : -2, nt = 4 - kt0;
    LAS unsigned char* Kb2 = Kb; LAS unsigned char* Vb2 = Kb + 4 * TILEB;
#define DIL_TILE(j, e) ((e) == 0 ? (j) : (nt == 6 ? (j) + 3 : 3 - (j)))
#define DIL_LOAD(i, kr, vr) do { const int k0_ = l0 + 64 * (kt0 + (i)); attn_stage_load<64>(kr, vr, Kg0 + (size_t)k0_ * rs, Kg0 + (size_t)k0_ * rs + 256, rs, tid); } while (0)
    v4u kr0[1], vr0[1], kr1[1], vr1[1], kr2[1], vr2[1], kr3[1], vr3[1], kr4[1], vr4[1], kr5[1], vr5[1];
    DIL_LOAD(DIL_TILE(0, 0), kr0, vr0); DIL_LOAD(DIL_TILE(0, 1), kr1, vr1); DIL_LOAD(DIL_TILE(1, 0), kr2, vr2); DIL_LOAD(DIL_TILE(1, 1), kr3, vr3);
    if (nt == 6) { DIL_LOAD(DIL_TILE(2, 0), kr4, vr4); DIL_LOAD(DIL_TILE(2, 1), kr5, vr5); }
    TB[tid] = tbv;
    bf16x8 qf[4];
#pragma unroll
    for (int ks = 0; ks < 4; ++ks) { const float sc_ = 0.125f * L2E; const v4u w = qw[ks];
        qf[ks] = pack8(bf_lo(w.x) * sc_, bf_hi(w.x) * sc_, bf_lo(w.y) * sc_, bf_hi(w.y) * sc_, bf_lo(w.z) * sc_, bf_hi(w.z) * sc_, bf_lo(w.w) * sc_, bf_hi(w.w) * sc_); }
    attn_stage_store<64>(kr0, vr0, Kb2, Vb2, tid); attn_stage_store<64>(kr1, vr1, Kb2 + TILEB, Vb2 + VTILEB, tid);
    __syncthreads();
    const int nsteps = nt >> 1;
#define DIL_STEP(j, KRN0, VRN0, KRN1, VRN1) do { if ((j) < nsteps) { const int sb = (j) & 1; \
        _Pragma("unroll") for (int e = 0; e < 2; ++e) { const int k0 = l0 + 64 * (kt0 + DIL_TILE((j), e)); \
            const bool go = (k0 + 63 >= q0w - 128) && (k0 <= q0w + 31); \
            if (go) attn_tile<64, 1>(Kb2 + (2 * sb + e) * TILEB, Vb2 + (2 * sb + e) * VTILEB, qf, o, m, l, TB + (k0 - lq + 256 + 4 * hh), true, lane); } \
        if ((j) + 1 < nsteps) { attn_stage_store<64>(KRN0, VRN0, Kb2 + (2 * (sb ^ 1)) * TILEB, Vb2 + (2 * (sb ^ 1)) * VTILEB, tid); attn_stage_store<64>(KRN1, VRN1, Kb2 + (2 * (sb ^ 1) + 1) * TILEB, Vb2 + (2 * (sb ^ 1) + 1) * VTILEB, tid); } \
        __syncthreads(); } } while (0)
    DIL_STEP(0, kr2, vr2, kr3, vr3);
    DIL_STEP(1, kr4, vr4, kr5, vr5);
    DIL_STEP(2, kr4, vr4, kr5, vr5);
#undef DIL_STEP
#undef DIL_TILE
#undef DIL_LOAD
    const float lt = l + __shfl_xor(l, 32);
    attn_store_o<64>(o, 1.0f / lt, ODG + ((size_t)g * T + tokq) * 256 + h * 64, hh);
    if (hh == 0) LSE[((size_t)g * T + tokq) * 4 + h] = (m + __builtin_amdgcn_logf(lt)) * 0.6931471805599453f;
}
__device__ __forceinline__ void cross_unit(LAS unsigned char* lds, const bf16* QC, const bf16* KVC, bf16* OC, int b, int h, int qblk, int tid, int lane, int wave) {
    constexpr int TILEB = ACfg<128>::TILEB, VTILEB = ACfg<128>::VTILEB;
    const int r = lane & 31, hh = lane >> 5;
    LAS unsigned char* Kb = lds + ATT_TB_BYTES; LAS unsigned char* Vb = Kb + 2 * TILEB;
    const size_t tokq = (size_t)b * SEQ + qblk * 256 + wave * 32 + r;
    bf16x8 qf[8]; attn_load_q<128>(qf, QC + tokq * 512 + h * 128, hh, 0.08838834764831845f * L2E);
    f32x16 o[4];
#pragma unroll
    for (int reg = 0; reg < 16; ++reg) { o[0][reg] = 0.f; o[1][reg] = 0.f; o[2][reg] = 0.f; o[3][reg] = 0.f; }
    float m = -1e30f, l = 0.f;
    const bf16* Kg0 = KVC + (size_t)b * NMEM * 1024 + h * 128;
    v4u kr[2], vr[2];
    attn_stage_load<128>(kr, vr, Kg0, Kg0 + 512, 1024, tid); attn_stage_store<128>(kr, vr, Kb, Vb, tid);
    __syncthreads();
    for (int i = 0; i < 4; ++i) {
        if (i + 1 < 4) attn_stage_load<128>(kr, vr, Kg0 + (size_t)(64 * (i + 1)) * 1024, Kg0 + (size_t)(64 * (i + 1)) * 1024 + 512, 1024, tid);
        attn_tile<128, 0>(Kb + (i & 1) * TILEB, Vb + (i & 1) * VTILEB, qf, o, m, l, (const LAS float*)lds, true, lane);
        if (i + 1 < 4) attn_stage_store<128>(kr, vr, Kb + ((i + 1) & 1) * TILEB, Vb + ((i + 1) & 1) * VTILEB, tid);
        __syncthreads();
    }
    const float lt = l + __shfl_xor(l, 32);
    attn_store_o<128>(o, 1.0f / lt, OC + tokq * 512 + h * 128, hh);
}
__device__ __forceinline__ void dil_combine(const bf16* ODG, const float* LSE, bf16* ODIL, int gtid, int nthr) {
    for (int it = gtid; it < T * 32; it += nthr) { const int tok = it >> 5, c = it & 31, h = c >> 3;
        const float a0 = LSE[((size_t)0 * T + tok) * 4 + h], a1 = LSE[((size_t)1 * T + tok) * 4 + h], a2 = LSE[((size_t)2 * T + tok) * 4 + h];
        const float mx = fmaxf(a0, fmaxf(a1, a2)); float w0 = __expf(a0 - mx), w1 = __expf(a1 - mx), w2 = __expf(a2 - mx); const float inv = 1.0f / (w0 + w1 + w2); w0 *= inv; w1 *= inv; w2 *= inv;
        const v4u x0 = *(const v4u*)(ODG + ((size_t)0 * T + tok) * 256 + c * 8), x1 = *(const v4u*)(ODG + ((size_t)1 * T + tok) * 256 + c * 8), x2 = *(const v4u*)(ODG + ((size_t)2 * T + tok) * 256 + c * 8);
        v4u o; o.x = pk2(w0 * bf_lo(x0.x) + w1 * bf_lo(x1.x) + w2 * bf_lo(x2.x), w0 * bf_hi(x0.x) + w1 * bf_hi(x1.x) + w2 * bf_hi(x2.x));
        o.y = pk2(w0 * bf_lo(x0.y) + w1 * bf_lo(x1.y) + w2 * bf_lo(x2.y), w0 * bf_hi(x0.y) + w1 * bf_hi(x1.y) + w2 * bf_hi(x2.y));
        o.z = pk2(w0 * bf_lo(x0.z) + w1 * bf_lo(x1.z) + w2 * bf_lo(x2.z), w0 * bf_hi(x0.z) + w1 * bf_hi(x1.z) + w2 * bf_hi(x2.z));
        o.w = pk2(w0 * bf_lo(x0.w) + w1 * bf_lo(x1.w) + w2 * bf_lo(x2.w), w0 * bf_hi(x0.w) + w1 * bf_hi(x1.w) + w2 * bf_hi(x2.w));
        *(v4u*)(ODIL + (size_t)tok * 256 + c * 8) = o; }
}
__device__ __forceinline__ void phase_topk_simple(const bf16* QP, const float* subk, int* EXP, float* EW, float* INV, int lane, int gw, int ngw) {
    for (int unit = gw; unit < T * 8; unit += ngw) {
        const int tok = unit >> 3, head = unit & 7;
        const bf16* qrow = QP + (size_t)tok * 2048 + head * 256;
        float av = 0.f, bv[4] = {0.f, 0.f, 0.f, 0.f}; int ai = 0, bi[4] = {0, 0, 0, 0};
#pragma unroll
        for (int p = 0; p < 2; ++p) {
            float s0 = 0.f, s1 = 0.f;
            const float* k0 = subk + (size_t)(p * 128 + lane) * 128; const float* k1 = subk + (size_t)(p * 128 + 64 + lane) * 128;
            for (int c = 0; c < 128; ++c) { const float qv = bf2f(qrow[p * 128 + c]); s0 += qv * k0[c]; s1 += qv * k1[c]; }
#pragma unroll
            for (int i = 0; i < 16; ++i) {
                float mloc = fmaxf(s0, s1); float mw = mloc;
#pragma unroll
                for (int o = 1; o < 64; o <<= 1) mw = fmaxf(mw, __shfl_xor(mw, o));
                const unsigned long long bal = __ballot(mloc == mw);
                const int wl = __ffsll((long long)bal) - 1;
                int idx = -1;
                if (lane == wl) { if (s0 >= s1) { idx = lane; s0 = -3e38f; } else { idx = lane + 64; s1 = -3e38f; } }
                idx = __shfl(idx, wl);
                if (p == 0) { if ((lane & 15) == i) { av = mw; ai = idx; } }
                else { if ((lane >> 4) == (i >> 2)) { bv[i & 3] = mw; bi[i & 3] = idx; } }
            }
        }
        float cs[4];
#pragma unroll
        for (int jj = 0; jj < 4; ++jj) cs[jj] = av + bv[jj];
        float top0 = 0.f, den = 0.f; int myexp = 0; float myw = 0.f;
#pragma unroll
        for (int k = 0; k < 16; ++k) {
            float mloc = fmaxf(fmaxf(cs[0], cs[1]), fmaxf(cs[2], cs[3])); float mw = mloc;
#pragma unroll
            for (int o = 1; o < 64; o <<= 1) mw = fmaxf(mw, __shfl_xor(mw, o));
            const unsigned long long bal = __ballot(mloc == mw);
            const int wl = __ffsll((long long)bal) - 1;
            int ex = 0;
            if (lane == wl) {
                if (cs[0] == mw) { ex = ai * 128 + bi[0]; cs[0] = -3e38f; }
                else if (cs[1] == mw) { ex = ai * 128 + bi[1]; cs[1] = -3e38f; }
                else if (cs[2] == mw) { ex = ai * 128 + bi[2]; cs[2] = -3e38f; }
                else { ex = ai * 128 + bi[3]; cs[3] = -3e38f; }
            }
            ex = __shfl(ex, wl);
            if (k == 0) top0 = mw;
            const float e = __expf(mw - top0); den += e;
            if (lane == k) { myexp = ex; myw = e; }
        }
        if (lane < 16) { EXP[(size_t)tok * 128 + head * 16 + lane] = myexp; EW[(size_t)tok * 128 + head * 16 + lane] = myw; }
        if (lane == 0) INV[(size_t)tok * 8 + head] = 1.0f / den;
    }
}
#if DBG_CHECK || DBG_ATTN_CHECK
constexpr size_t WS_YDBG = 510 * MiB;
constexpr int CW_DBG = 64;
__device__ __forceinline__ void dbg_acc(float* acc, float num, float den, int lane) { num = wave_sum(num); den = wave_sum(den); if (lane == 0) { atomicAdd(acc, num); atomicAdd(acc + 1, den); } }
__device__ __forceinline__ int dbg_tok(int s) { return s * 512 + 3 + (s & 7) * 37; }
__device__ __forceinline__ void dbg_check_qp(const bf16* H, const float* w_qp, const bf16* QP, float* acc, int gtid, int nthr, int lane) {
    float num = 0.f, den = 0.f;
    for (int item = gtid; item < 64 * 2048; item += nthr) { const int s = item / 2048, n = item % 2048, t = dbg_tok(s);
        float r = 0.f; for (int k = 0; k < 1024; ++k) r += bf2f(H[(size_t)t * 1024 + k]) * w_qp[(size_t)k * 2048 + n];
        const float mine = bf2f(QP[(size_t)t * 2048 + n]); num += (r - mine) * (r - mine); den += r * r; }
    dbg_acc(acc, num, den, lane);
}
__device__ __forceinline__ void dbg_check_gather(const bf16* H, const float* u, const float* v, const int* EXP, const float* EW, const float* INV, const float* YDBG, float* acc, int gw, int ngw, int lane) {
    float num = 0.f, den = 0.f;
    for (int s = gw; s < 64; s += ngw) { const int t = dbg_tok(s);
        float y[16];
#pragma unroll
        for (int c = 0; c < 16; ++c) y[c] = 0.f;
        for (int i = 0; i < 128; ++i) { const int e = EXP[(size_t)t * 128 + i]; const float g = EW[(size_t)t * 128 + i] * INV[(size_t)t * 8 + (i >> 4)];
            float d = 0.f;
#pragma unroll
            for (int c = 0; c < 16; ++c) d += bf2f(H[(size_t)t * 1024 + lane * 16 + c]) * u[(size_t)e * 1024 + lane * 16 + c];
            d = wave_sum(d);
            const float w = g * gelu_exact(d);
#pragma unroll
            for (int c = 0; c < 16; ++c) y[c] += w * v[(size_t)e * 1024 + lane * 16 + c]; }
#pragma unroll
        for (int c = 0; c < 16; ++c) { const float mine = YDBG[(size_t)s * 1024 + lane * 16 + c]; num += (y[c] - mine) * (y[c] - mine); den += y[c] * y[c]; } }
    dbg_acc(acc, num, den, lane);
}
__device__ __forceinline__ float dbg_k(const float* acc) { const float D = acc[0] / fmaxf(acc[1], 1e-30f); float k = log10f(fmaxf(D, 1e-12f)); return fminf(fmaxf(k, -6.f), 1.f); }
__device__ __forceinline__ void dbg_encode(const float* x, const float* gfin, float* out, const float* acc, int gw, int ngw, int lane) {
    const float k1 = dbg_k(acc), k2 = dbg_k(acc + 2); const float s = 1.f + (k1 + 6.5f) * 0.5f;
    for (int m = gw; m < T; m += ngw) { const f32x4* xr = (const f32x4*)(x + (size_t)m * 1024) + lane; const f32x4* gr = (const f32x4*)gfin + lane; f32x4 vv[4]; float ss = 0.f;
#pragma unroll
        for (int j = 0; j < 4; ++j) { vv[j] = xr[64 * j]; ss += (vv[j].x * vv[j].x + vv[j].y * vv[j].y) + (vv[j].z * vv[j].z + vv[j].w * vv[j].w); }
        const float rinv = rsqrtf(wave_sum(ss) * (1.f / 1024.f) + RMS_EPS) * s;
#pragma unroll
        for (int j = 0; j < 4; ++j) { f32x4 o = vv[j] * rinv * gr[64 * j]; if (m == 0 && j == 0 && lane == 0) o.x = 100.f + 100.f * (k2 + 6.f); ((f32x4*)(out + (size_t)m * 1024) + lane)[64 * j] = o; } }
}
#endif

struct Args { const float* in[20]; float* out; unsigned char* ws; int ph_lo, ph_hi; };
__global__ void __launch_bounds__(NWAVES * 64, 2) fwd(Args args) {
    extern __shared__ __attribute__((aligned(16))) unsigned char lds_raw[];
    LAS unsigned char* lds = (LAS unsigned char*)lds_raw;
    volatile LAS unsigned* MISC = (volatile LAS unsigned*)(lds + MISC_OFF);
    const int tid = threadIdx.x, lane = tid & 63, wave = __builtin_amdgcn_readfirstlane(tid >> 6);
    const int G = gridDim.x; const int bx = blockIdx.x; const int vcu = (G % 8 == 0) ? (bx % 8) * (G / 8) + bx / 8 : bx;
    const int gw = vcu * NWAVES + wave, NGW = G * NWAVES, gtid = vcu * (NWAVES * 64) + tid, NTHR = G * NWAVES * 64;
    unsigned char* ws = args.ws;
    gu32* ctl = (gu32*)(ws + WS_CTL);
#define X_IN (args.in[0])
#define mem (args.in[1])
#define rel_bias (args.in[2])
#define g_mix (args.in[3])
#define w_in (args.in[4])
#define b_gate (args.in[5])
#define w_a (args.in[6])
#define w_b (args.in[7])
#define w_out (args.in[8])
#define g_cross (args.in[9])
#define g_mem (args.in[10])
#define w_qc (args.in[11])
#define w_kvc (args.in[12])
#define w_oc (args.in[13])
#define g_ffn (args.in[14])
#define w_qp (args.in[15])
#define subk (args.in[16])
#define peer_u (args.in[17])
#define peer_v (args.in[18])
#define g_final (args.in[19])
#define OUTP (args.out)
#define WinT ((bf16*)(ws + WS_WIN))
#define WaT ((bf16*)(ws + WS_WA))
#define WbT ((bf16*)(ws + WS_WB))
#define WoutT ((bf16*)(ws + WS_WOUT))
#define WqcT ((bf16*)(ws + WS_WQC))
#define WkvcT ((bf16*)(ws + WS_WKVC))
#define WocT ((bf16*)(ws + WS_WOC))
#define WqpT ((bf16*)(ws + WS_WQP))
#define SUBK ((bf16*)(ws + WS_SUBK))
#define U8T ((unsigned char*)(ws + WS_U))
#define V8T ((unsigned char*)(ws + WS_V))
#define HB ((bf16*)(ws + WS_H))
#define MEMB ((bf16*)(ws + WS_MEMB))
#define KVC ((bf16*)(ws + WS_KVC))
#define ODIL ((bf16*)(ws + WS_ODIL))
#define OMOBA ((bf16*)(ws + WS_OMOBA))
#define PQKV ((bf16*)(ws + WS_PQKV))
#define MERGED ((bf16*)(ws + WS_MERGED))
#define MERGED8 ((unsigned char*)(ws + WS_QC))
#define X1 ((float*)(ws + WS_X1))
#define QC ((bf16*)(ws + WS_QC))
#define OC ((bf16*)(ws + WS_OC))
#define ODG ((bf16*)(ws + WS_ODG))
#define LSE ((float*)(ws + WS_LSE))
#define EXP ((int*)(ws + WS_EXP))
#define EW ((float*)(ws + WS_EW))
#define INV ((float*)(ws + WS_INV))
#define KMEAN ((float*)(ws + WS_KMEAN))
#define SEB ((int*)(ws + WS_PQKV + 32 * MiB))
#define SGB ((float*)(ws + WS_PQKV + 48 * MiB))
#define OFFB ((int*)(ws + WS_QC))
#define RSS1 ((float*)(ws + WS_RSS1))
#define RSS2 ((float*)(ws + WS_RSS2))
#define GATES ((bf16*)args.out)
#define QP ((bf16*)args.out)
    for (int u = tid; u < (LDS_BYTES - LDSCTL_OFF) / 4; u += NWAVES * 64) ((LAS unsigned*)(lds + LDSCTL_OFF))[u] = 0u;
    __syncthreads();
    const int lo = args.ph_lo, hi = args.ph_hi;
    XcdBarrier bar; bar.bar = (unsigned*)(ctl + CW_BAR); bar.x = 0; bar.st = nullptr;
    if (hi - lo > 1) bar = xcd_barrier_post((unsigned*)(ctl + CW_BAR), MISC + 8);
#define IN(k) (lo <= (k) && (k) < hi)
#define PR_BEG(k) do { if (PROBE_PH == (k) && tid == 0) MISC[16] = (unsigned)__builtin_amdgcn_s_memrealtime(); } while (0)
#define PR_END(k) do { if (PROBE_PH == (k) && tid == 0) MISC[17] = (unsigned)__builtin_amdgcn_s_memrealtime(); } while (0)
#define SEAM(k) do { if (IN(k) && IN((k) + 1)) xcd_barrier(bar); } while (0)

    PR_BEG(0);
    if (IN(0)) {
        LAS float* scr = (LAS float*)(lds + RING_OFF + wave * 16384);
        constexpr int I_IN = (1024 / 64) * (NIN / 32), I_A = (256 / 64) * (1024 / 32), I_B = (512 / 64) * (1024 / 32), I_OUT = (1024 / 64) * (1024 / 32), I_QC = (1024 / 64) * (512 / 32),
                      I_KVC = (1024 / 64) * (1024 / 32), I_OC = (512 / 64) * (1024 / 32), I_QP = (1024 / 64) * (2048 / 32);
        constexpr int NITEMS = I_IN + I_A + I_B + I_OUT + I_QC + I_KVC + I_OC + I_QP;
        for (int it = gw; it < NITEMS; it += NGW) {
            int r = it;
            if (r < I_IN) { p0_transpose_item_fp8(w_in, 1024, NIN, (unsigned char*)WinT, scr, r, lane, WIN8_SCALE); continue; } r -= I_IN;
            if (r < I_A) { p0_transpose_item(w_a, 256, 1024, WaT, scr, r, lane); continue; } r -= I_A;
            if (r < I_B) { p0_transpose_item(w_b, 512, 1024, WbT, scr, r, lane); continue; } r -= I_B;
            if (r < I_OUT) { p0_transpose_item_fp8(w_out, 1024, 1024, (unsigned char*)WoutT, scr, r, lane, WIN8_SCALE); continue; } r -= I_OUT;
            if (r < I_QC) { p0_transpose_item(w_qc, 1024, 512, WqcT, scr, r, lane, g_cross); continue; } r -= I_QC;
            if (r < I_KVC) { p0_transpose_item(w_kvc, 1024, 1024, WkvcT, scr, r, lane); continue; } r -= I_KVC;
            if (r < I_OC) { p0_transpose_item(w_oc, 512, 1024, WocT, scr, r, lane); continue; } r -= I_OC;
            p0_transpose_item(w_qp, 1024, 2048, WqpT, scr, r, lane, g_ffn);
        }
        cvt_f32_to_bf16_bulk(subk, SUBK, (size_t)2 * 128 * 128, (size_t)gtid, (size_t)NTHR);
        for (int m = gw; m < T; m += NGW) rms_row_to_fp8(X_IN + (size_t)m * DM, g_mix, (unsigned char*)HB + (size_t)m * DM, lane);
        for (int m = gw; m < MROWS; m += NGW) rms_row_to_bf16(mem + (size_t)m * DM, g_mem, MEMB + (size_t)m * DM, lane);
        __syncthreads();
    }
    SEAM(0);
    PR_END(0);
    PR_BEG(1);
    if (IN(1)) {
        if (DBG_MIX) { pg8::Gemm g{HB, WinT, T, NIN, DM / 2}; pg8::StaticOrder S; S.init(T, NIN, G, bx); pg8::EpiIn E{PQKV, GATES, b_gate, 1.0f / WIN8_SCALE};
          pg8::gemm_phase<pg8::EpiIn, pg8::StaticOrder, true, true, true>(lds + RING_OFF, g, S, E); }
        __syncthreads();
        if (DBG_CROSS) { pg8::Gemm g{MEMB, WkvcT, MROWS, 1024, DM}; pg8::StaticOrder S; S.init(MROWS, 1024, G, bx); pg8::EpiStore E{KVC, 1024};
          pg8::gemm_phase<pg8::EpiStore, pg8::StaticOrder, true, true>(lds + RING_OFF, g, S, E); }
        {
            constexpr int CH = 16384, NCH_U = (16384 * 1024) / CH, NCH = 2 * NCH_U;
            for (;;) {
                int c = 0; if (lane == 0) c = (int)__hip_atomic_fetch_add((unsigned*)(ctl + CW_WORK), 1u, __ATOMIC_RELAXED, __HIP_MEMORY_SCOPE_AGENT);
                c = __builtin_amdgcn_readfirstlane(c);
                if (c >= NCH) break;
                const bool isv = c >= NCH_U; const int cc = isv ? c - NCH_U : c;
                const float* src = (isv ? peer_v : peer_u) + (size_t)cc * CH; unsigned char* dst = (isv ? V8T : U8T) + (size_t)cc * CH;
                cvt_f32_to_fp8_bulk(src, dst, (size_t)CH, isv ? V8_SCALE : U8_SCALE, (size_t)lane, (size_t)64, isv ? (const float*)nullptr : g_ffn);
            }
        }
    }
    SEAM(1);
    PR_END(1);
    PR_BEG(2);
    if (IN(2) && DBG_MIX) {
#if ATTN_MFMA
        for (int u = vcu; u < NB * 3 * 4 * 16; u += G) { const int u16 = u & 15,     bgh = u >> 4, h = bgh & 3, g = (bgh >> 2) % 3, b = (bgh >> 2) / 3;
            dil_unit(lds + RING_OFF, PQKV, rel_bias, ODG, LSE, b, g, h, u16 & ((1 << (2 * g)) - 1), u16 >> (2 * g), tid, lane, wave); }
#endif
        for (int it = gw; it < NB * 8 * 16; it += NGW) { const int bh = it >> 4, blk = it & 15, b = bh >> 3, h = bh & 7;
            const bf16* kp = PQKV + (size_t)(b * SEQ + blk * 256 + (lane >> 3)) * QKVW + 2304 + 512 + h * 64 + 8 * (lane & 7);
            float s8[8] = {0.f, 0.f, 0.f, 0.f, 0.f, 0.f, 0.f, 0.f};
#pragma unroll 8
            for (int j = 0; j < 32; ++j) { const v4u w = *(const v4u*)(kp + (size_t)(8 * j) * QKVW);
                s8[0] += bf_lo(w.x); s8[1] += bf_hi(w.x); s8[2] += bf_lo(w.y); s8[3] += bf_hi(w.y); s8[4] += bf_lo(w.z); s8[5] += bf_hi(w.z); s8[6] += bf_lo(w.w); s8[7] += bf_hi(w.w); }
#pragma unroll
            for (int c = 0; c < 8; ++c) { float v = s8[c]; v += __shfl_xor(v, 8); v += __shfl_xor(v, 16); v += __shfl_xor(v, 32); s8[c] = v * (1.0f / 256.0f); }
            if (lane < 8) { f32x4* dst = (f32x4*)(KMEAN + (size_t)it * 64 + 8 * lane); dst[0] = (f32x4){s8[0], s8[1], s8[2], s8[3]}; dst[1] = (f32x4){s8[4], s8[5], s8[6], s8[7]}; } }
    }
    SEAM(2);
    PR_END(2);
    PR_BEG(3);
    if (IN(3) && DBG_MIX) {
#if ATTN_MFMA
        for (int pu = vcu; pu < NB * 8 * 8; pu += G) { const int bh = pu >> 3, p = pu & 7, b = bh >> 3, h = bh & 7;
            moba_unit(lds + RING_OFF, PQKV, KMEAN, rel_bias, OMOBA, b, h, p, tid, lane, wave);
            moba_unit(lds + RING_OFF, PQKV, KMEAN, rel_bias, OMOBA, b, h, 15 - p, tid, lane, wave); }
        dil_combine(ODG, LSE, ODIL, gtid, NTHR);
#else
        phase_dil_simple<false>(PQKV, rel_bias, ODIL, gtid, NTHR); phase_moba_simple<false>(PQKV, KMEAN, rel_bias, OMOBA, gtid, NTHR);
#endif
    }
    SEAM(3);
    PR_END(3);
    PR_BEG(4);
#if DBG_ATTN_CHECK && DBG_P4CHK
    if (IN(4)) { if (DBG_DIL_CHECK) phase_dil_simple<true>(PQKV, rel_bias, ODIL, gtid, NTHR, (float*)(ctl + CW_DBG)); else phase_moba_simple<true>(PQKV, KMEAN, rel_bias, OMOBA, gtid, NTHR, (float*)(ctl + CW_DBG)); }
#endif
    if (IN(4) && DBG_MIX && !(DBG_ATTN_CHECK && DBG_P4CHK)) { pg8::Gemm g{ODIL, WaT, T, 1024, 256}; pg8::StaticOrder S; S.init(T, 1024, G, bx); pg8::EpiGate<false, true> E{MERGED, GATES, 0, MERGED8, MRG8_SCALE};
        pg8::gemm_phase<pg8::EpiGate<false, true>, pg8::StaticOrder, true, true>(lds + RING_OFF, g, S, E); }
    SEAM(4);
    PR_END(4);
    PR_BEG(5);
    if (IN(5) && DBG_MIX && !(DBG_ATTN_CHECK && DBG_P4CHK)) { pg8::Gemm g{OMOBA, WbT, T, 1024, 512}; pg8::StaticOrder S; S.init(T, 1024, G, bx); pg8::EpiGate<true, true> E{MERGED, GATES, 1024, MERGED8, MRG8_SCALE};
        pg8::gemm_phase<pg8::EpiGate<true, true>, pg8::StaticOrder, true, true>(lds + RING_OFF, g, S, E); }
    SEAM(5);
    PR_END(5);
    PR_BEG(6);
    if (IN(6) && !(DBG_ATTN_CHECK && DBG_P4CHK)) { pg8::Gemm g{(const bf16*)MERGED8, WoutT, T, 1024, 1024 / 2}; pg8::StaticOrder S; S.init(T, 1024, G, bx); pg8::EpiRes E{X_IN, nullptr, 1024, (float)DBG_MIX / (MRG8_SCALE * WIN8_SCALE), HB, RSS1, nullptr, nullptr};
        pg8::gemm_phase<pg8::EpiRes, pg8::StaticOrder, true, true, true>(lds + RING_OFF, g, S, E); }
    SEAM(6);
    PR_END(6);
    PR_BEG(7);
    PR_BEG(8);
    if (IN(8) && DBG_CROSS) { pg8::Gemm g{HB, WqcT, T, 512, 1024}; pg8::StaticOrder S; S.init(T, 512, G, bx); pg8::EpiStoreRs E{QC, 512, RSS1, 1.0f};
        pg8::gemm_phase<pg8::EpiStoreRs, pg8::StaticOrder, true, true>(lds + RING_OFF, g, S, E); }
    SEAM(8);
    PR_END(8);
    PR_BEG(9);
    if (IN(9) && DBG_CROSS) {
#if ATTN_MFMA
        for (int u = vcu; u < NB * 4 * 16; u += G) cross_unit(lds + RING_OFF, QC, KVC, OC, u >> 6, (u >> 4) & 3, u & 15, tid, lane, wave);
#else
        phase_cross_simple<false>(QC, KVC, OC, gtid, NTHR);
#endif
    }
    SEAM(9);
    PR_END(9);
    PR_BEG(10);
#if DBG_ATTN_CHECK
    if (IN(10) && DBG_CROSS_CHECK) phase_cross_simple<true>(QC, KVC, OC, gtid, NTHR, (float*)(ctl + CW_DBG) + 2);
#endif
    if (IN(10)) { pg8::Gemm g{OC, WocT, T, 1024, 512}; pg8::StaticOrder S; S.init(T, 1024, G, bx); pg8::EpiRes E{nullptr, nullptr, 1024, (float)DBG_CROSS, HB, RSS2, nullptr, HB};
        pg8::gemm_phase<pg8::EpiRes, pg8::StaticOrder, true, true>(lds + RING_OFF, g, S, E); }
    SEAM(10);
    PR_END(10);
    PR_BEG(11);
    PR_BEG(12);
    if (IN(12) && DBG_PEER) { pg8::Gemm g{HB, WqpT, T, 2048, 1024}; pg8::StaticOrder S; S.init(T, 2048, G, bx); pg8::EpiStoreRs E{QP, 2048, RSS2, 1.0f};
        pg8::gemm_phase<pg8::EpiStoreRs, pg8::StaticOrder, true, true>(lds + RING_OFF, g, S, E); }
    SEAM(12);
    PR_END(12);
    PR_BEG(13);
#if DBG_CHECK
    if (IN(13)) dbg_check_qp(HB, w_qp, QP, (float*)(ctl + CW_DBG), gtid, NTHR, lane);
#endif
#if DBG_TOPK_SIMPLE
    if (IN(13) && DBG_PEER) { phase_topk_simple(QP, subk, EXP, EW, INV, lane, gw, NGW); }
#else
    if (IN(13) && DBG_PEER) { phase_topk(lds + RING_OFF, QP, SUBK, SEB, (float*)OFFB, tid, lane, wave, vcu, G); }
#endif
    SEAM(13);
    PR_END(13);
#if PROBE_PH >= 20
    PR_BEG(PROBE_PH);
    if (IN(14)) { const int lane15 = (int)__builtin_amdgcn_mbcnt_hi(~0u, __builtin_amdgcn_mbcnt_lo(~0u, 0u));
        peer_probe<PROBE_PH - 20>(HB, RSS2, U8T, V8T, SGB, SEB, (const float*)OFFB, OUTP, lane15, wave, gw, NGW, vcu, lds, g_final); xcd_barrier(bar); }
    PR_END(PROBE_PH);
#endif
    PR_BEG(14);
    if (IN(14)) { const int lane14 = (int)__builtin_amdgcn_mbcnt_hi(~0u, __builtin_amdgcn_mbcnt_lo(~0u, 0u));
        phase_peer(HB, RSS2, U8T, V8T, SGB, SEB, (const float*)OFFB, g_final, OUTP, lane14, wave, gw, NGW, (float)DBG_PEER, DBG_YPTR, (PROBE_PH >= 0 && PROBE_PH < 20) ? 1.0f + sqrtf((float)(MISC[17] - MISC[16]) * (0.01f / PROBE_K)) : 1.0f, lds); }
#if DBG_CHECK || DBG_ATTN_CHECK
#if DBG_CHECK
    if (IN(15)) dbg_check_gather(HB, peer_u, peer_v, EXP, EW, INV, (const float*)(ws + WS_YDBG), (float*)(ctl + CW_DBG) + 2, gw, NGW, lane);
#endif
    if (IN(16)) dbg_encode(X_IN, g_final, OUTP, (const float*)(ctl + CW_DBG), gw, NGW, lane);
#endif
#undef IN
#undef SEAM
#undef X_IN
#undef mem
#undef rel_bias
#undef g_mix
#undef w_in
#undef b_gate
#undef w_a
#undef w_b
#undef w_out
#undef g_cross
#undef g_mem
#undef w_qc
#undef w_kvc
#undef w_oc
#undef g_ffn
#undef w_qp
#undef subk
#undef peer_u
#undef peer_v
#undef g_final
#undef OUTP
#undef WinT
#undef WaT
#undef WbT
#undef WoutT
#undef WqcT
#undef WkvcT
#undef WocT
#undef WqpT
#undef SUBK
#undef U8T
#undef V8T
#undef HB
#undef MEMB
#undef KVC
#undef ODIL
#undef OMOBA
#undef PQKV
#undef MERGED
#undef MERGED8
#undef X1
#undef QC
#undef OC
#undef ODG
#undef LSE
#undef EXP
#undef EW
#undef INV
#undef KMEAN
#undef RSS1
#undef SEB
#undef SGB
#undef OFFB
#undef RSS2
#undef GATES
#undef QP

}

extern "C" void kernel_launch(void* const* d_in, const int* in_sizes, int n_in, void* d_out, int out_size, void* d_ws, size_t ws_size, hipStream_t stream) {
    static int grid = 0;
    if (grid == 0) {
        if (n_in != 20 || out_size != T * DM || ws_size < WS_END) { fprintf(stderr, "kernel_launch: unexpected shapes (n_in %d, out %d, ws %zu); nothing launched\n", n_in, out_size, ws_size); grid = -1; return; }
        int dev = 0, cus = 0, per_cu = 0;
        if (hipGetDevice(&dev) != hipSuccess || hipDeviceGetAttribute(&cus, hipDeviceAttributeMultiprocessorCount, dev) != hipSuccess) { grid = -1; return; }
        if (hipFuncSetAttribute((const void*)fwd, hipFuncAttributeMaxDynamicSharedMemorySize, LDS_BYTES) != hipSuccess) { fprintf(stderr, "kernel_launch: hipFuncSetAttribute failed\n"); grid = -1; return; }
        if (hipOccupancyMaxActiveBlocksPerMultiprocessor(&per_cu, (const void*)fwd, NWAVES * 64, LDS_BYTES) != hipSuccess || per_cu < 1) { fprintf(stderr, "kernel_launch: occupancy query says %d\n", per_cu); }
        (void)hipGetLastError();
        grid = cus;
    }
    if (grid < 0) return;
    if (hipMemsetAsync((char*)d_ws + WS_CTL, 0, CTL_ZERO_BYTES, stream) != hipSuccess) return;
    Args a{};
    for (int i = 0; i < 20; ++i) a.in[i] = (const float*)d_in[i];
    a.out = (float*)d_out; a.ws = (unsigned char*)d_ws;
#if MK_ONE_LAUNCH
    a.ph_lo = 0; a.ph_hi = NPH;
    hipLaunchKernelGGL(fwd, dim3(grid), dim3(NWAVES * 64), LDS_BYTES, stream, a);
#else
    for (int p = 0; p < NPH + ((DBG_CHECK || DBG_ATTN_CHECK) ? 2 : 0); ++p) { a.ph_lo = p; a.ph_hi = p + 1; hipLaunchKernelGGL(fwd, dim3(grid), dim3(NWAVES * 64), LDS_BYTES, stream, a); }
#endif
}
```

```cpp
#include <hip/hip_runtime.h>
#include <cstdio>
#include <cstdint>
#include <cmath>
namespace pg8 {
#define PG8_LAS __attribute__((address_space(3)))
typedef unsigned short bf16_t;
typedef short bf16x8 __attribute__((ext_vector_type(8)));
typedef float f32x4 __attribute__((ext_vector_type(4)));
typedef unsigned u32x4 __attribute__((ext_vector_type(4)));
typedef int v4i32 __attribute__((ext_vector_type(4)));
typedef int v8i32 __attribute__((ext_vector_type(8)));
constexpr int BM = 256, BK = 64, HALF = 128, HTB = HALF * BK * 2  , STAGE_BYTES = 8 * HTB, NXCD = 8, WGM = 8;

__host__ __device__ __forceinline__ int lds_byte(int r, int c) { const int st = (r >> 4) * 2 + (c >> 5), rr = r & 15, cc = c & 31, ob = rr * 64 + cc * 2; return st * 1024 + (ob ^ (((ob >> 9) & 1) << 5)); }
__host__ __device__ __forceinline__ void stage_rc(int b, int& R, int& C) { const int st = b / 1024, sb = b % 1024, swz = sb ^ (((sb >> 9) & 1) << 5); R = (st >> 1) * 16 + swz / 64; C = (st & 1) * 32 + (swz % 64) / 2; }
__host__ __device__ __forceinline__ int perm32(int rho) { const int n = rho >> 4, i = rho & 15; return 8 * (i >> 2) + 4 * n + (i & 3); }

struct Unit { int pm, pn; };
struct Gemm { const bf16_t* A; const bf16_t* Bt; int M, N, K; };

struct StaticOrder {
    int nM, nN, nwg, G, c;
    __host__ __device__ void init(int M, int N, int G_, int c_) { nM = M / BM; nN = N / BM; nwg = nM * nN; G = G_; c = c_; }
    __host__ __device__ bool next(int i, Unit& u) const {
        const long L = (long)i * G + c; if (L >= nwg) return false;
        int wgid = (int)L; { const int q = nwg / NXCD, r = nwg % NXCD, xcd = wgid % NXCD, off = wgid / NXCD; wgid = (xcd < r ? xcd * (q + 1) : r * (q + 1) + (xcd - r) * q) + off; }
        const int nig = WGM * nN, gid = wgid / nig, fm = gid * WGM, gsz = (nM - fm) < WGM ? (nM - fm) : WGM;
        u.pm = fm + ((wgid % nig) % gsz); u.pn = (wgid % nig) / gsz; return true;
    }
    __device__ __forceinline__ void a_ready(const Unit&) const {}
    __device__ __forceinline__ void done(const Unit&) const {}
};

__device__ __forceinline__ unsigned cvt_pk_bf16(float lo, float hi) { unsigned r; asm volatile("v_cvt_pk_bf16_f32 %0, %1, %2" : "=v"(r) : "v"(lo), "v"(hi)); return r; }
typedef float f32x2 __attribute__((ext_vector_type(2)));
__device__ __forceinline__ float bf_lo(unsigned w) { return __uint_as_float(w << 16); }
__device__ __forceinline__ float bf_hi(unsigned w) { return __uint_as_float(w & 0xffff0000u); }
__device__ __forceinline__ float sigmoidf_(float x) { return 1.0f / (1.0f + __expf(-x)); }
struct EpiStore {
    static constexpr bool PERM = true, AFTER_DRAIN = false;
    bf16_t* O; int ldc;
    __device__ __forceinline__ void operator()(const f32x4 (&acc)[2][2][4][2], const Unit& u, int wr, int wc, int fr, int fq) const {
        const int row0 = u.pm * BM + wr * 64 + fr, col0 = u.pn * BM + wc * 32 + 8 * fq;
#pragma unroll
        for (int ai = 0; ai < 2; ++ai)
#pragma unroll
            for (int m = 0; m < 4; ++m) { bf16_t* rowp = O + (size_t)(row0 + ai * HALF + m * 16) * ldc + col0;
#pragma unroll
                for (int bj = 0; bj < 2; ++bj) { const f32x4 v0 = acc[ai][bj][m][0], v1 = acc[ai][bj][m][1];
                    u32x4 w; w.x = cvt_pk_bf16(v0[0], v0[1]); w.y = cvt_pk_bf16(v0[2], v0[3]); w.z = cvt_pk_bf16(v1[0], v1[1]); w.w = cvt_pk_bf16(v1[2], v1[3]);
                    *(u32x4*)(rowp + bj * HALF) = w; } }
    }
};
struct EpiIn {
    static constexpr bool PERM = true, AFTER_DRAIN = false;
    bf16_t* P; bf16_t* G; const float* bgate; float wsc;
    __device__ __forceinline__ void operator()(const f32x4 (&acc)[2][2][4][2], const Unit& u, int wr, int wc, int fr, int fq) const {
        const int row0 = u.pm * BM + wr * 64 + fr;
        if (u.pn < 15) {
            const int col0 = u.pn * BM + wc * 32 + 8 * fq;
#pragma unroll
            for (int ai = 0; ai < 2; ++ai)
#pragma unroll
                for (int m = 0; m < 4; ++m) { bf16_t* rowp = P + (size_t)(row0 + ai * HALF + m * 16) * 3840 + col0;
#pragma unroll
                    for (int bj = 0; bj < 2; ++bj) { const f32x4 v0 = acc[ai][bj][m][0] * wsc, v1 = acc[ai][bj][m][1] * wsc;
                        u32x4 w; w.x = cvt_pk_bf16(v0[0], v0[1]); w.y = cvt_pk_bf16(v0[2], v0[3]); w.z = cvt_pk_bf16(v1[0], v1[1]); w.w = cvt_pk_bf16(v1[2], v1[3]);
                        __builtin_nontemporal_store(w, (u32x4*)(rowp + bj * HALF)); } }
        } else {
            const int col0 = (u.pn - 15) * BM + wc * 32 + 8 * fq;
            f32x4 bv[2][2];
#pragma unroll
            for (int bj = 0; bj < 2; ++bj)
#pragma unroll
                for (int n = 0; n < 2; ++n) bv[bj][n] = *(const f32x4*)(bgate + col0 + bj * HALF + 4 * n);
#pragma unroll
            for (int ai = 0; ai < 2; ++ai)
#pragma unroll
                for (int m = 0; m < 4; ++m) { unsigned char* rowp = (unsigned char*)G + (size_t)(row0 + ai * HALF + m * 16) * 2048 + col0;
#pragma unroll
                    for (int bj = 0; bj < 2; ++bj) { const f32x4 v0 = acc[ai][bj][m][0] * wsc + bv[bj][0], v1 = acc[ai][bj][m][1] * wsc + bv[bj][1];
                        int w0 = 0, w1 = 0;
                        w0 = __builtin_amdgcn_cvt_pk_fp8_f32(sigmoidf_(v0[0]), sigmoidf_(v0[1]), w0, false); w0 = __builtin_amdgcn_cvt_pk_fp8_f32(sigmoidf_(v0[2]), sigmoidf_(v0[3]), w0, true);
                        w1 = __builtin_amdgcn_cvt_pk_fp8_f32(sigmoidf_(v1[0]), sigmoidf_(v1[1]), w1, false); w1 = __builtin_amdgcn_cvt_pk_fp8_f32(sigmoidf_(v1[2]), sigmoidf_(v1[3]), w1, true);
                        __builtin_nontemporal_store((unsigned long long)(unsigned)w0 | ((unsigned long long)(unsigned)w1 << 32), (unsigned long long*)(rowp + bj * HALF)); } }
        }
    }
};
template <bool ADD, bool F8OUT> struct EpiGate {
    static constexpr bool PERM = true, AFTER_DRAIN = false;
    bf16_t* O; const bf16_t* G; int gcol; unsigned char* O8; float o8scale;
    __device__ __forceinline__ void operator()(const f32x4 (&acc)[2][2][4][2], const Unit& u, int wr, int wc, int fr, int fq) const {
        const int row0 = u.pm * BM + wr * 64 + fr, col0 = u.pn * BM + wc * 32 + 8 * fq;
#pragma unroll
        for (int ai = 0; ai < 2; ++ai)
#pragma unroll
            for (int m = 0; m < 4; ++m) { const size_t row = (size_t)(row0 + ai * HALF + m * 16); bf16_t* rowp = O + row * 1024 + col0;
#pragma unroll
                for (int bj = 0; bj < 2; ++bj) { const f32x4 v0 = acc[ai][bj][m][0], v1 = acc[ai][bj][m][1];
                    const unsigned long long g8 = *(const unsigned long long*)((const unsigned char*)G + row * 2048 + gcol + col0 + bj * HALF); const int gl = (int)(unsigned)g8, gh = (int)(unsigned)(g8 >> 32);
                    typedef float f32x2g __attribute__((ext_vector_type(2)));
                    const f32x2g ga = __builtin_amdgcn_cvt_pk_f32_fp8(gl, false), gb = __builtin_amdgcn_cvt_pk_f32_fp8(gl, true), gc = __builtin_amdgcn_cvt_pk_f32_fp8(gh, false), gd = __builtin_amdgcn_cvt_pk_f32_fp8(gh, true);
                    float r0 = ga.x * v0[0], r1 = ga.y * v0[1], r2 = gb.x * v0[2], r3 = gb.y * v0[3];
                    float r4 = gc.x * v1[0], r5 = gc.y * v1[1], r6 = gd.x * v1[2], r7 = gd.y * v1[3];
                    if (ADD) {
                        const unsigned long long p8 = *(const unsigned long long*)(O8 + row * 1024 + col0 + bj * HALF); const int pl = (int)(unsigned)p8, phh = (int)(unsigned)(p8 >> 32); const float is = 1.0f / o8scale;
                        const f32x2g pa = __builtin_amdgcn_cvt_pk_f32_fp8(pl, false), pb = __builtin_amdgcn_cvt_pk_f32_fp8(pl, true), pc = __builtin_amdgcn_cvt_pk_f32_fp8(phh, false), pd = __builtin_amdgcn_cvt_pk_f32_fp8(phh, true);
                        r0 += pa.x * is; r1 += pa.y * is; r2 += pb.x * is; r3 += pb.y * is; r4 += pc.x * is; r5 += pc.y * is; r6 += pd.x * is; r7 += pd.y * is; }
                    if (F8OUT) { int w0 = 0, w1 = 0;
                        w0 = __builtin_amdgcn_cvt_pk_fp8_f32(r0 * o8scale, r1 * o8scale, w0, false); w0 = __builtin_amdgcn_cvt_pk_fp8_f32(r2 * o8scale, r3 * o8scale, w0, true);
                        w1 = __builtin_amdgcn_cvt_pk_fp8_f32(r4 * o8scale, r5 * o8scale, w1, false); w1 = __builtin_amdgcn_cvt_pk_fp8_f32(r6 * o8scale, r7 * o8scale, w1, true);
                        *(unsigned long long*)(O8 + row * 1024 + col0 + bj * HALF) = (unsigned long long)(unsigned)w0 | ((unsigned long long)(unsigned)w1 << 32);
                    } else { u32x4 w; w.x = cvt_pk_bf16(r0, r1); w.y = cvt_pk_bf16(r2, r3); w.z = cvt_pk_bf16(r4, r5); w.w = cvt_pk_bf16(r6, r7);
                        *(u32x4*)(rowp + bj * HALF) = w; } } }
    }
};
struct EpiRes {
    static constexpr bool PERM = false, AFTER_DRAIN = false;
    const float* base; float* out; int ldc; float sc; bf16_t* xb; float* rowss; unsigned char* xb8; const bf16_t* base16;
    __device__ __forceinline__ void operator()(const f32x4 (&acc)[2][2][4][2], const Unit& u, int wr, int wc, int fr, int fq) const {
        const int col0 = u.pn * BM + wc * 32 + 4 * fq;
#pragma unroll
        for (int ai = 0; ai < 2; ++ai)
#pragma unroll
            for (int m = 0; m < 4; ++m) { const int row = u.pm * BM + ai * HALF + wr * 64 + m * 16 + fr; const size_t off = (size_t)row * ldc + col0; float ss = 0.f;
#pragma unroll
                for (int bj = 0; bj < 2; ++bj)
#pragma unroll
                    for (int n = 0; n < 2; ++n) { f32x4 bs;
                        if (base16) { const unsigned long long w = *(const unsigned long long*)(base16 + off + bj * HALF + n * 16); const unsigned lo = (unsigned)w, hi = (unsigned)(w >> 32); bs = (f32x4){bf_lo(lo), bf_hi(lo), bf_lo(hi), bf_hi(hi)}; }
                        else bs = *(const f32x4*)(base + off + bj * HALF + n * 16);
                        const f32x4 o = (sc != 0.f) ? bs + acc[ai][bj][m][n] * sc : bs;
                        if (out) *(f32x4*)(out + off + bj * HALF + n * 16) = o;
                        if (xb) { unsigned long long w = (unsigned long long)cvt_pk_bf16(o[0], o[1]) | ((unsigned long long)cvt_pk_bf16(o[2], o[3]) << 32); *(unsigned long long*)(xb + off + bj * HALF + n * 16) = w; }
                        if (xb8) { int w8 = 0; w8 = __builtin_amdgcn_cvt_pk_fp8_f32(o[0], o[1], w8, false); w8 = __builtin_amdgcn_cvt_pk_fp8_f32(o[2], o[3], w8, true); *(unsigned*)(xb8 + off + bj * HALF + n * 16) = (unsigned)w8; }
                        if (rowss) ss += (o[0] * o[0] + o[1] * o[1]) + (o[2] * o[2] + o[3] * o[3]); }
                if (rowss) { ss += __shfl_xor(ss, 16); ss += __shfl_xor(ss, 32); if (fq == 0) atomicAdd(rowss + row, ss); } }
    }
};
struct EpiStoreRs {
    static constexpr bool PERM = true, AFTER_DRAIN = false;
    bf16_t* O; int ldc; const float* rowss; float sc;
    __device__ __forceinline__ void operator()(const f32x4 (&acc)[2][2][4][2], const Unit& u, int wr, int wc, int fr, int fq) const {
        const int row0 = u.pm * BM + wr * 64 + fr, col0 = u.pn * BM + wc * 32 + 8 * fq;
#pragma unroll
        for (int ai = 0; ai < 2; ++ai)
#pragma unroll
            for (int m = 0; m < 4; ++m) { const int row = row0 + ai * HALF + m * 16; bf16_t* rowp = O + (size_t)row * ldc + col0; const float ri = rsqrtf(rowss[row] * (1.0f / 1024.0f) + 1e-6f) * sc;
#pragma unroll
                for (int bj = 0; bj < 2; ++bj) { const f32x4 v0 = acc[ai][bj][m][0] * ri, v1 = acc[ai][bj][m][1] * ri;
                    u32x4 w; w.x = cvt_pk_bf16(v0[0], v0[1]); w.y = cvt_pk_bf16(v0[2], v0[3]); w.z = cvt_pk_bf16(v1[0], v1[1]); w.w = cvt_pk_bf16(v1[2], v1[3]);
                    *(u32x4*)(rowp + bj * HALF) = w; } }
    }
};

struct EpiNull {
    static constexpr bool PERM = true, AFTER_DRAIN = false;
    float* sink;
    __device__ __forceinline__ void operator()(const f32x4 (&acc)[2][2][4][2], const Unit& u, int wr, int wc, int fr, int fq) const {
        float s = 0.f;
#pragma unroll
        for (int ai = 0; ai < 2; ++ai)
#pragma unroll
            for (int bj = 0; bj < 2; ++bj)
#pragma unroll
                for (int m = 0; m < 4; ++m)
#pragma unroll
                    for (int n = 0; n < 2; ++n) s += (acc[ai][bj][m][n][0] + acc[ai][bj][m][n][1]) + (acc[ai][bj][m][n][2] + acc[ai][bj][m][n][3]);
        if (s == 1.2345678e33f) sink[0] = s;
    }
};
template <class Epi, class Sched, bool ALIGN_EPI = false, bool SP2 = false, bool F8 = false>
__device__ __forceinline__ void gemm_phase(PG8_LAS unsigned char* lds, const Gemm g, const Sched& S, const Epi& E) {
    const int tid = threadIdx.x, wid = __builtin_amdgcn_readfirstlane(tid >> 6), lane = tid & 63, wr = wid >> 2, wc = wid & 3, fr = lane & 15, fq = lane >> 4;
    const int K = g.K, nt = K / BK;
    unsigned voffA[2], voffB[2];
#pragma unroll
    for (int i = 0; i < 2; ++i) { int R, C; stage_rc(tid * 16 + i * 8192, R, C); const int Rb = Epi::PERM ? ((R & ~31) + perm32(R & 31)) : R;
        voffA[i] = (unsigned)(R * K + C) * 2u; voffB[i] = (unsigned)(Rb * K + C) * 2u; }
    const size_t kstep = (size_t)(BK * 2);
    const size_t hstep = (size_t)HALF * K * 2;
    const size_t tstep = 2 * hstep;
    const unsigned ldsw = (unsigned)wid * 1024u;
    const int aoff = lds_byte(wr * 64 + fr, fq * 8), boff = lds_byte(wc * 32 + fr, fq * 8);
#define PG8_SA(b, h) (((b) * 2 + (h)) * HTB)
#define PG8_SB(b, h) ((4 + (b) * 2 + (h)) * HTB)
#define PG8_STAGE(bufoff, gbase, voff) do { _Pragma("unroll") for (int _i = 0; _i < 2; ++_i) \
        __builtin_amdgcn_global_load_lds((const unsigned*)((const char*)(gbase) + (voff)[_i]), (PG8_LAS unsigned*)(lds + (bufoff) + ldsw + _i * 8192), 16, 0, 0); } while (0)
#define PG8_LDA(dst, b, h) do { if constexpr (F8) { _Pragma("unroll") for (int m = 0; m < 4; ++m) dst##8[m] = __builtin_shufflevector(*(const PG8_LAS v4i32*)(lds + PG8_SA(b, h) + aoff + m * 2048), *(const PG8_LAS v4i32*)(lds + PG8_SA(b, h) + aoff + m * 2048 + 1024), 0, 1, 2, 3, 4, 5, 6, 7); } \
        else { _Pragma("unroll") for (int m = 0; m < 4; ++m) _Pragma("unroll") for (int k = 0; k < 2; ++k) dst[m][k] = *(const PG8_LAS bf16x8*)(lds + PG8_SA(b, h) + aoff + m * 2048 + k * 1024); } } while (0)
#define PG8_LDB(dst, b, h) do { if constexpr (F8) { _Pragma("unroll") for (int n = 0; n < 2; ++n) dst##8[n] = __builtin_shufflevector(*(const PG8_LAS v4i32*)(lds + PG8_SB(b, h) + boff + n * 2048), *(const PG8_LAS v4i32*)(lds + PG8_SB(b, h) + boff + n * 2048 + 1024), 0, 1, 2, 3, 4, 5, 6, 7); } \
        else { _Pragma("unroll") for (int n = 0; n < 2; ++n) _Pragma("unroll") for (int k = 0; k < 2; ++k) dst[n][k] = *(const PG8_LAS bf16x8*)(lds + PG8_SB(b, h) + boff + n * 2048 + k * 1024); } } while (0)
#define PG8_MMA(ai, bj, At, Bt) do { __builtin_amdgcn_s_setprio(1); if constexpr (F8) { \
        _Pragma("unroll") for (int m = 0; m < 4; ++m) _Pragma("unroll") for (int n = 0; n < 2; ++n) \
            asm volatile("v_mfma_scale_f32_16x16x128_f8f6f4 %0, %1, %2, %0, %3, %3 op_sel_hi:[0,0,0]" : "+v"(acc[ai][bj][m][n]) : "v"(Bt##8[n]), "v"(At##8[m]), "v"(f8scale)); \
    } else { _Pragma("unroll") for (int m = 0; m < 4; ++m) _Pragma("unroll") for (int n = 0; n < 2; ++n) _Pragma("unroll") for (int k = 0; k < 2; ++k) \
        acc[ai][bj][m][n] = __builtin_amdgcn_mfma_f32_16x16x32_bf16(Bt[n][k], At[m][k], acc[ai][bj][m][n], 0, 0, 0); } __builtin_amdgcn_s_setprio(0); } while (0)
#define PG8_WAIT_V(n) asm volatile("s_waitcnt vmcnt(" #n ")" ::: "memory")
#define PG8_WAIT_L(n) asm volatile("s_waitcnt lgkmcnt(" #n ")" ::: "memory")
#define PG8_BAR __builtin_amdgcn_s_barrier()
#define PG8_SCHED __builtin_amdgcn_sched_barrier(0)
    Unit cur, nxt; int ui = 0;
    if (!S.next(0, cur)) return;
    f32x4 acc[2][2][4][2];
#pragma unroll
    for (int a = 0; a < 2; ++a)
#pragma unroll
        for (int b = 0; b < 2; ++b)
#pragma unroll
            for (int m = 0; m < 4; ++m)
#pragma unroll
                for (int n = 0; n < 2; ++n) acc[a][b][m][n] = (f32x4){0.f, 0.f, 0.f, 0.f};
    bf16x8 At[4][2], B0[2][2], B1[2][2]; v8i32 At8[4], B08[2], B18[2]; const int f8scale = 0x7f7f7f7f;
    const char* cA = (const char*)g.A + (size_t)cur.pm * tstep; const char* cB = (const char*)g.Bt + (size_t)cur.pn * tstep;
    S.a_ready(cur);
    if constexpr (SP2) {
        PG8_STAGE(PG8_SB(0, 0), cB, voffB); PG8_STAGE(PG8_SB(0, 1), cB + hstep, voffB); PG8_STAGE(PG8_SA(0, 0), cA, voffA); PG8_STAGE(PG8_SA(0, 1), cA + hstep, voffA);
        if (wr == 1) PG8_BAR;
        PG8_WAIT_V(2); PG8_BAR;
        PG8_STAGE(PG8_SB(1, 0), cB + kstep, voffB); PG8_STAGE(PG8_SA(1, 0), cA + kstep, voffA); PG8_STAGE(PG8_SB(1, 1), cB + hstep + kstep, voffB);
        PG8_WAIT_V(6); PG8_BAR;
    } else {
        PG8_STAGE(PG8_SB(0, 0), cB, voffB); PG8_STAGE(PG8_SA(0, 0), cA, voffA); PG8_STAGE(PG8_SB(0, 1), cB + hstep, voffB); PG8_STAGE(PG8_SA(0, 1), cA + hstep, voffA);
        if (wr == 1) PG8_BAR;
        PG8_WAIT_V(4); PG8_BAR;
        PG8_STAGE(PG8_SB(1, 0), cB + kstep, voffB); PG8_STAGE(PG8_SA(1, 0), cA + kstep, voffA); PG8_STAGE(PG8_SB(1, 1), cB + hstep + kstep, voffB);
        PG8_WAIT_V(6); PG8_BAR;
    }
    for (;;) {
        const bool has_next = S.next(ui + 1, nxt);
        const char* nA = has_next ? (const char*)g.A + (size_t)nxt.pm * tstep : cA; const char* nB = has_next ? (const char*)g.Bt + (size_t)nxt.pn * tstep : cB;
        for (int t = 0; t < nt; t += 2) {
            const bool last = (t == nt - 2);
            const char* a1 = cA + (size_t)(t + 1) * kstep;
            const char* a2 = last ? nA : cA + (size_t)(t + 2) * kstep; const char* b2 = last ? nB : cB + (size_t)(t + 2) * kstep;
            const char* a3 = a2 + kstep; const char* b3 = b2 + kstep;
            if (last && has_next) S.a_ready(nxt);
            if constexpr (SP2) {
            PG8_LDB(B0, 0, 0); PG8_LDB(B1, 0, 1); PG8_SCHED; PG8_LDA(At, 0, 0); PG8_STAGE(PG8_SA(1, 1), a1 + hstep, voffA);
            PG8_WAIT_V(8); PG8_WAIT_L(0); PG8_BAR; PG8_MMA(0, 0, At, B0); PG8_MMA(0, 1, At, B1); PG8_BAR; PG8_SCHED;
            PG8_LDA(At, 0, 1); PG8_STAGE(PG8_SB(0, 0), b2, voffB); PG8_STAGE(PG8_SB(0, 1), b2 + hstep, voffB); PG8_STAGE(PG8_SA(0, 0), a2, voffA);
            PG8_WAIT_V(8); PG8_WAIT_L(0); PG8_BAR; PG8_MMA(1, 0, At, B0); PG8_MMA(1, 1, At, B1); PG8_BAR; PG8_SCHED;
            PG8_LDB(B0, 1, 0); PG8_LDB(B1, 1, 1); PG8_SCHED; PG8_LDA(At, 1, 0); PG8_STAGE(PG8_SA(0, 1), a2 + hstep, voffA);
            PG8_WAIT_V(8); PG8_WAIT_L(0); PG8_BAR; PG8_MMA(0, 0, At, B0); PG8_MMA(0, 1, At, B1); PG8_BAR; PG8_SCHED;
            PG8_LDA(At, 1, 1); PG8_STAGE(PG8_SB(1, 0), b3, voffB); PG8_STAGE(PG8_SB(1, 1), b3 + hstep, voffB); PG8_STAGE(PG8_SA(1, 0), a3, voffA);
            PG8_WAIT_V(8); PG8_WAIT_L(0); PG8_BAR; PG8_MMA(1, 0, At, B0); PG8_MMA(1, 1, At, B1); PG8_BAR; PG8_SCHED;
            } else {
            PG8_LDB(B0, 0, 0); PG8_SCHED; PG8_LDA(At, 0, 0); PG8_STAGE(PG8_SA(1, 1), a1 + hstep, voffA);
            PG8_WAIT_L(8); PG8_BAR; PG8_WAIT_L(0); PG8_MMA(0, 0, At, B0); PG8_BAR; PG8_SCHED;
            PG8_LDB(B1, 0, 1); PG8_STAGE(PG8_SB(0, 0), b2, voffB);
            PG8_BAR; PG8_WAIT_L(0); PG8_MMA(0, 1, At, B1); PG8_BAR;
            PG8_LDA(At, 0, 1); PG8_STAGE(PG8_SA(0, 0), a2, voffA);
            PG8_BAR; PG8_WAIT_L(0); PG8_MMA(1, 0, At, B0); PG8_BAR; PG8_SCHED;
            PG8_STAGE(PG8_SB(0, 1), b2 + hstep, voffB);
            PG8_WAIT_V(6); PG8_BAR; PG8_MMA(1, 1, At, B1); PG8_BAR;
            PG8_LDB(B0, 1, 0); PG8_SCHED; PG8_LDA(At, 1, 0); PG8_STAGE(PG8_SA(0, 1), a2 + hstep, voffA);
            PG8_WAIT_L(8); PG8_BAR; PG8_WAIT_L(0); PG8_MMA(0, 0, At, B0); PG8_BAR; PG8_SCHED;
            PG8_LDB(B1, 1, 1); PG8_STAGE(PG8_SB(1, 0), b3, voffB);
            PG8_BAR; PG8_WAIT_L(0); PG8_MMA(0, 1, At, B1); PG8_BAR;
            PG8_LDA(At, 1, 1); PG8_STAGE(PG8_SA(1, 0), a3, voffA);
            PG8_BAR; PG8_WAIT_L(0); PG8_MMA(1, 0, At, B0); PG8_BAR; PG8_SCHED;
            PG8_STAGE(PG8_SB(1, 1), b3 + hstep, voffB);
            PG8_WAIT_V(6); PG8_BAR; PG8_MMA(1, 1, At, B1); PG8_BAR;
            }
        }
        if constexpr (ALIGN_EPI) { if (wr == 0) PG8_BAR; }
        if constexpr (F8) asm volatile("s_nop 15\n\ts_nop 15" ::: "memory");
        if constexpr (!Epi::AFTER_DRAIN) { E(acc, cur, wr, wc, fr, fq); S.done(cur); }
        if (!has_next) break;
#pragma unroll
        for (int a = 0; a < 2; ++a)
#pragma unroll
            for (int b = 0; b < 2; ++b)
#pragma unroll
                for (int m = 0; m < 4; ++m)
#pragma unroll
                    for (int n = 0; n < 2; ++n) acc[a][b][m][n] = (f32x4){0.f, 0.f, 0.f, 0.f};
        cur = nxt; cA = nA; cB = nB; ++ui;
        if constexpr (ALIGN_EPI) { if (wr == 1) PG8_BAR; }
    }
    PG8_WAIT_V(0);
    if constexpr (!ALIGN_EPI) { if (wr == 0) PG8_BAR; }
    PG8_BAR;
    if constexpr (Epi::AFTER_DRAIN) { E.fused(acc, cur, wr, wc, fr, fq, lds, wid, lane); S.done(cur); }
#undef PG8_SA
#undef PG8_SB
#undef PG8_STAGE
#undef PG8_LDA
#undef PG8_LDB
#undef PG8_MMA
#undef PG8_WAIT_V
#undef PG8_WAIT_L
#undef PG8_BAR
#undef PG8_SCHED
}
}

constexpr int NB = 8, SEQ = 4096, DM = 1024, T = NB * SEQ, NMEM = 256, MROWS = NB * NMEM;
constexpr int QKVW = 3840, GATEW = 2048, NIN = 5888;
constexpr float RMS_EPS = 1e-6f;
constexpr int NPH = 15;
constexpr float WIN8_SCALE = 32.0f, MRG8_SCALE = 16.0f;
#ifndef DBG_MIX
#define DBG_MIX 1
#endif
#ifndef DBG_CROSS
#define DBG_CROSS 1
#endif
#ifndef DBG_PEER
#define DBG_PEER 1
#endif
#ifndef DBG_TOPK_SIMPLE
#define DBG_TOPK_SIMPLE 0
#endif
#ifndef DBG_CHECK
#define DBG_CHECK 0
#endif
#ifndef DBG_ATTN_CHECK
#define DBG_ATTN_CHECK 0
#endif
#ifndef DBG_CROSS_CHECK
#define DBG_CROSS_CHECK 0
#endif
#ifndef DBG_NOBIAS
#define DBG_NOBIAS 0
#endif
#ifndef DBG_DIL_CHECK
#define DBG_DIL_CHECK 0
#endif
#ifndef PROBE_PH
#define PROBE_PH (-1)
#endif
#ifndef PROBE_K
#define PROBE_K 200000.0f
#endif
#ifndef DBG_P4CHK
#define DBG_P4CHK 1
#endif
#ifndef ATTN_MFMA
#define ATTN_MFMA 1
#endif
#if DBG_CHECK
#define DBG_YPTR ((float*)(ws + 510 * MiB))
#else
#define DBG_YPTR ((float*)nullptr)
#endif
#ifndef MK_ONE_LAUNCH
#define MK_ONE_LAUNCH 1
#endif
constexpr size_t MiB = 1u << 20;
constexpr size_t WS_CTL = 0, CTL_ZERO_BYTES = 1 * MiB;
constexpr size_t WS_KMEAN = 1 * MiB;
constexpr size_t WS_INV = 2 * MiB;
constexpr size_t WS_WIN = 3 * MiB;
constexpr size_t WS_WA = 15 * MiB, WS_WB = 16 * MiB, WS_WOUT = 17 * MiB, WS_WQC = 19 * MiB, WS_WKVC = 20 * MiB, WS_WOC = 22 * MiB, WS_WQP = 23 * MiB, WS_SUBK = 27 * MiB;
constexpr size_t WS_U = 28 * MiB, WS_V = 60 * MiB;
constexpr size_t WS_H = 92 * MiB;
constexpr size_t WS_MEMB = 156 * MiB, WS_KVC = 160 * MiB;
constexpr size_t WS_ODIL = 164 * MiB, WS_OMOBA = 180 * MiB;
constexpr size_t WS_PQKV = 212 * MiB;
constexpr size_t WS_MERGED = WS_PQKV, WS_X1 = WS_PQKV + 64 * MiB, WS_QC = WS_PQKV + 192 * MiB, WS_OC = WS_ODIL;
constexpr size_t WS_EXP = WS_PQKV, WS_EW = WS_PQKV + 16 * MiB;
constexpr size_t WS_ODG = 452 * MiB, WS_LSE = 500 * MiB;
constexpr size_t WS_END = 502 * MiB;
constexpr int CW_TMO = 0, CW_CODE = 1, CW_WORK = 128, CW_BAR = 4096;
constexpr size_t WS_RSS1 = 256 * 1024, WS_RSS2 = 384 * 1024;
constexpr int RING_OFF = 0, RING_BYTES = 131072;
constexpr int LDSCTL_OFF = RING_BYTES, MISC_OFF = LDSCTL_OFF + 320;
constexpr int LDS_BYTES = 163840;
constexpr int NWAVES = 8;

#define GAS __attribute__((address_space(1)))
#define LAS __attribute__((address_space(3)))
typedef unsigned short bf16;
typedef unsigned v4u __attribute__((ext_vector_type(4)));
typedef float f32x4 __attribute__((ext_vector_type(4)));
typedef float f32x16 __attribute__((ext_vector_type(16)));
typedef short bf16x8 __attribute__((ext_vector_type(8)));
typedef __bf16 bf2_t __attribute__((ext_vector_type(2)));
typedef GAS unsigned gu32;
#define RLX_AGENT __ATOMIC_RELAXED, __HIP_MEMORY_SCOPE_AGENT
#define LDS_WAIT() asm volatile("s_waitcnt lgkmcnt(0)" ::: "memory")
#define VM_WAIT() asm volatile("s_waitcnt vmcnt(0)" ::: "memory")
__device__ __forceinline__ unsigned pk2(float lo, float hi) { return pg8::cvt_pk_bf16(lo, hi); }
__device__ __forceinline__ float bf_lo(unsigned w) { return __uint_as_float(w << 16); }
__device__ __forceinline__ float bf_hi(unsigned w) { return __uint_as_float(w & 0xffff0000u); }
__device__ __forceinline__ float bf2f(bf16 b) { return __uint_as_float((unsigned)b << 16); }

#define XB_TMO      128
#define XB_XCNT(j)  (256  + 64 * (j))
#define XB_XSUB(j)  (1280 + 64 * (j))
#define XB_XGEN(j)  (2304 + 64 * (j))
#define XB_TOP      3328
#define XB_TOPGEN   3392
#define XCD_BAR_WORDS 3456
#define XB_SPIN_CAP (1u << 18)

__device__ __forceinline__ unsigned xb_ld(unsigned* p)              { return __hip_atomic_load(p, __ATOMIC_RELAXED, __HIP_MEMORY_SCOPE_AGENT); }
__device__ __forceinline__ unsigned xb_add(unsigned* p, unsigned v) { return __hip_atomic_fetch_add(p, v, __ATOMIC_RELAXED, __HIP_MEMORY_SCOPE_AGENT); }
__device__ __forceinline__ unsigned xb_xcc_id() { return (unsigned)__builtin_amdgcn_s_getreg((3 << 11) | 20) & 0xFu; }
#define XB_SPIN(cond, bar) do { unsigned _sp = 0; while (cond) { __builtin_amdgcn_s_sleep(1); \
    if ((++_sp & 255u) == 0u) { if (xb_ld(&(bar)[XB_TMO])) break; if (_sp > XB_SPIN_CAP) { atomicAdd(&(bar)[XB_TMO], 1u); break; } } } } while (0)

struct XcdBarrier {
    unsigned* bar; unsigned x;
    volatile LAS unsigned* st;
};

__device__ __forceinline__ XcdBarrier xcd_barrier_post(unsigned* bar, volatile LAS unsigned* st) {
    XcdBarrier b; b.bar = bar; b.x = xb_xcc_id(); b.st = st;
    if (threadIdx.x == 0) (void)xb_add(&bar[XB_XCNT(b.x)], 1u);
    return b;
}
__device__ __forceinline__ void xcd_barrier_complete(unsigned* bar, unsigned x, unsigned& nloc, unsigned& nx) {
    const unsigned G = gridDim.x * gridDim.y * gridDim.z;
    unsigned sum, cnt, mine, sp = 0u;
    for (;;) {
        sum = 0u; cnt = 0u; mine = 0u;
#pragma unroll
        for (unsigned j = 0; j < 16; ++j) { const unsigned c = xb_ld(&bar[XB_XCNT(j)]); sum += c; cnt += (c > 0u) ? 1u : 0u; mine = (j == x) ? c : mine; }
        if (sum == G) break;
        __builtin_amdgcn_s_sleep(1);
        if ((++sp & 255u) == 0u) { if (xb_ld(&bar[XB_TMO])) break; if (sp > XB_SPIN_CAP) { atomicAdd(&bar[XB_TMO], 1u); break; } }
    }
    nloc = mine > 0u ? mine : 1u; nx = cnt > 0u ? cnt : 1u;
}

__device__ __forceinline__ void xcd_barrier(const XcdBarrier& b) {
    asm volatile("s_waitcnt vmcnt(0)" ::: "memory");
    __syncthreads();
    if (threadIdx.x == 0) {
        unsigned* bar = b.bar;
        __builtin_amdgcn_s_waitcnt(0);
        unsigned nloc = b.st[0], nx = b.st[1];
        if (nloc == 0u) { xcd_barrier_complete(bar, b.x, nloc, nx); b.st[0] = nloc; b.st[1] = nx; }
        const unsigned old = xb_add(&bar[XB_XSUB(b.x)], 1u);
        const unsigned gen = old / nloc;
        if (old + 1u == (gen + 1u) * nloc) {
            __builtin_amdgcn_fence(__ATOMIC_RELEASE, "agent");
            asm volatile("s_waitcnt vmcnt(0)" ::: "memory");
            const unsigned og = xb_add(&bar[XB_TOP], 1u);
            const unsigned tg = og / nx;
            if (og + 1u == (tg + 1u) * nx) xb_add(&bar[XB_TOPGEN], 1u);
            else XB_SPIN(xb_ld(&bar[XB_TOPGEN]) == tg, bar);
            __builtin_amdgcn_fence(__ATOMIC_ACQUIRE, "agent");
            xb_add(&bar[XB_XGEN(b.x)], 1u);
            asm volatile("s_waitcnt vmcnt(0)" ::: "memory");
        } else {
            XB_SPIN(xb_ld(&bar[XB_XGEN(b.x)]) == gen, bar);
            __builtin_amdgcn_fence(__ATOMIC_ACQUIRE, "agent");
            asm volatile("s_waitcnt vmcnt(0)" ::: "memory");
        }
    }
    __syncthreads();
}

__device__ __forceinline__ float wave_sum(float v) {
#pragma unroll
    for (int o = 1; o < 64; o <<= 1) v += __shfl_xor(v, o);
    return v;
}
__device__ __forceinline__ int t5_bucket(int n) {
    int b = n;
    if (n >= 16) { b = 16 + (n >= 22) + (n >= 30) + (n >= 40) + (n >= 54) + (n >= 73) + (n >= 99) + (n >= 134) + (n >= 182) + (n >= 246) + (n >= 332) + (n >= 450) + (n >= 609) + (n >= 825) + (n >= 1117) + (n >= 1513); }
    return b;
}
__device__ __forceinline__ void p0_transpose_item(const float* W, int K, int N, bf16* WT, LAS float* scr, int item, int lane, const float* gk = nullptr) {
    const int nblk = N / 32, kb = item / nblk, nb = item % nblk, k0 = 64 * kb, n0 = 32 * nb;
#pragma unroll 8
    for (int i = 0; i < 32; ++i) { const int kk = 2 * i + (lane >> 5); scr[kk * 33 + (lane & 31)] = __builtin_nontemporal_load(W + (size_t)(k0 + kk) * N + n0 + (lane & 31)) * (gk ? gk[k0 + kk] : 1.0f); }
    LDS_WAIT(); asm volatile("" ::: "memory");
    const int c = lane & 7;
#pragma unroll
    for (int j = 0; j < 4; ++j) { const int n = (lane >> 3) + 8 * j; const LAS float* s = scr + (8 * c) * 33 + n;
        v4u o; o.x = pk2(s[0 * 33], s[1 * 33]); o.y = pk2(s[2 * 33], s[3 * 33]); o.z = pk2(s[4 * 33], s[5 * 33]); o.w = pk2(s[6 * 33], s[7 * 33]);
        *(GAS v4u*)(WT + (size_t)(n0 + n) * K + k0 + 8 * c) = o; }
    LDS_WAIT(); asm volatile("" ::: "memory");
}
__device__ __forceinline__ void rms_row_to_bf16(const float* xrow, const float* g, bf16* orow, int lane) {
    const f32x4* xr = (const f32x4*)xrow + lane; const f32x4* gr = (const f32x4*)g + lane;
    f32x4 v[4]; float s = 0.f;
#pragma unroll
    for (int j = 0; j < 4; ++j) { v[j] = xr[64 * j]; s += (v[j].x * v[j].x + v[j].y * v[j].y) + (v[j].z * v[j].z + v[j].w * v[j].w); }
    const float rinv = rsqrtf(wave_sum(s) * (1.f / 1024.f) + RMS_EPS);
    unsigned long long* o8 = (unsigned long long*)orow + lane;
#pragma unroll
    for (int j = 0; j < 4; ++j) { const f32x4 gv = gr[64 * j]; o8[64 * j] = (unsigned long long)pk2(v[j].x * rinv * gv.x, v[j].y * rinv * gv.y) | ((unsigned long long)pk2(v[j].z * rinv * gv.z, v[j].w * rinv * gv.w) << 32); }
}
__device__ __forceinline__ void cvt_f32_to_bf16_bulk(const float* src, bf16* dst, size_t n, size_t gtid, size_t nthr) {
    for (size_t i = gtid; i < n / 8; i += nthr) { const f32x4 a = ((const f32x4*)src)[2 * i], b = ((const f32x4*)src)[2 * i + 1];
        v4u o; o.x = pk2(a.x, a.y); o.y = pk2(a.z, a.w); o.z = pk2(b.x, b.y); o.w = pk2(b.z, b.w); ((v4u*)dst)[i] = o; }
}
__device__ __forceinline__ void os_step(const float (&q)[64], float (&o)[64], float& m, float& l, const bf16* krow, const bf16* vrow, float bias) {
    const v4u* kp = (const v4u*)krow; float s = 0.f;
#pragma unroll
    for (int c = 0; c < 8; ++c) { const v4u w = kp[c];
        s += q[8 * c + 0] * bf_lo(w.x) + q[8 * c + 1] * bf_hi(w.x) + q[8 * c + 2] * bf_lo(w.y) + q[8 * c + 3] * bf_hi(w.y)
           + q[8 * c + 4] * bf_lo(w.z) + q[8 * c + 5] * bf_hi(w.z) + q[8 * c + 6] * bf_lo(w.w) + q[8 * c + 7] * bf_hi(w.w); }
    s += bias;
    const float mn = fmaxf(m, s), al = __expf(m - mn), p = __expf(s - mn);
    l = l * al + p; m = mn;
    const v4u* vp = (const v4u*)vrow;
#pragma unroll
    for (int c = 0; c < 8; ++c) { const v4u w = vp[c];
        o[8 * c + 0] = o[8 * c + 0] * al + p * bf_lo(w.x); o[8 * c + 1] = o[8 * c + 1] * al + p * bf_hi(w.x);
        o[8 * c + 2] = o[8 * c + 2] * al + p * bf_lo(w.y); o[8 * c + 3] = o[8 * c + 3] * al + p * bf_hi(w.y);
        o[8 * c + 4] = o[8 * c + 4] * al + p * bf_lo(w.z); o[8 * c + 5] = o[8 * c + 5] * al + p * bf_hi(w.z);
        o[8 * c + 6] = o[8 * c + 6] * al + p * bf_lo(w.w); o[8 * c + 7] = o[8 * c + 7] * al + p * bf_hi(w.w); }
}
__device__ __forceinline__ void load_q64(float (&q)[64], const bf16* qrow, float scale) {
    const v4u* qp = (const v4u*)qrow;
#pragma unroll
    for (int c = 0; c < 8; ++c) { const v4u w = qp[c];
        q[8 * c + 0] = bf_lo(w.x) * scale; q[8 * c + 1] = bf_hi(w.x) * scale; q[8 * c + 2] = bf_lo(w.y) * scale; q[8 * c + 3] = bf_hi(w.y) * scale;
        q[8 * c + 4] = bf_lo(w.z) * scale; q[8 * c + 5] = bf_hi(w.z) * scale; q[8 * c + 6] = bf_lo(w.w) * scale; q[8 * c + 7] = bf_hi(w.w) * scale; }
}
__device__ __forceinline__ void store_o64(const float (&o)[64], float inv, bf16* orow) {
    v4u* op = (v4u*)orow;
#pragma unroll
    for (int c = 0; c < 8; ++c) { v4u w; w.x = pk2(o[8 * c + 0] * inv, o[8 * c + 1] * inv); w.y = pk2(o[8 * c + 2] * inv, o[8 * c + 3] * inv);
        w.z = pk2(o[8 * c + 4] * inv, o[8 * c + 5] * inv); w.w = pk2(o[8 * c + 6] * inv, o[8 * c + 7] * inv); op[c] = w; }
}
__device__ __forceinline__ void cmp_o64(const float (&o)[64], float inv, const bf16* ref, float& num, float& den) {
#pragma unroll
    for (int c = 0; c < 64; ++c) { const float a = o[c] * inv, b = bf2f(ref[c]); num += (a - b) * (a - b); den += a * a; }
}
__device__ __forceinline__ void dbg_acc2(float* acc, float num, float den) { num = wave_sum(num); den = wave_sum(den); if ((threadIdx.x & 63) == 0 && acc) { atomicAdd(acc, num); atomicAdd(acc + 1, den); } }
__device__ __forceinline__ void cvt_f32_to_fp8_bulk(const float* src, unsigned char* dst, size_t n, float scale, size_t gtid, size_t nthr, const float* gc = nullptr) {
    const f32x4* s = (const f32x4*)src; unsigned* d = (unsigned*)dst; const size_t nq = n / 4;
    for (size_t q = gtid; q < nq; q += 4 * nthr) {
        f32x4 v[4];
#pragma unroll
        for (int k = 0; k < 4; ++k) { const size_t qq = q + k * nthr; v[k] = (qq < nq) ? __builtin_nontemporal_load(s + qq) * scale : (f32x4){0.f, 0.f, 0.f, 0.f}; }
#pragma unroll
        for (int k = 0; k < 4; ++k) { const size_t qq = q + k * nthr; if (qq < nq) { f32x4 a = v[k]; if (gc) a = a * ((const f32x4*)gc)[qq & 255];
            int w = 0; w = __builtin_amdgcn_cvt_pk_fp8_f32(a.x, a.y, w, false); w = __builtin_amdgcn_cvt_pk_fp8_f32(a.z, a.w, w, true); __builtin_nontemporal_store((unsigned)w, d + qq); } }
    }
}
__device__ __forceinline__ void rms_row_to_fp8(const float* xrow, const float* g, unsigned char* orow, int lane) {
    const f32x4* xr = (const f32x4*)xrow + lane; const f32x4* gr = (const f32x4*)g + lane;
    f32x4 v[4]; float s = 0.f;
#pragma unroll
    for (int j = 0; j < 4; ++j) { v[j] = __builtin_nontemporal_load(xr + 64 * j); s += (v[j].x * v[j].x + v[j].y * v[j].y) + (v[j].z * v[j].z + v[j].w * v[j].w); }
    const float rinv = rsqrtf(wave_sum(s) * (1.f / 1024.f) + RMS_EPS);
    unsigned* o4 = (unsigned*)orow + lane;
#pragma unroll
    for (int j = 0; j < 4; ++j) { const f32x4 gv = gr[64 * j]; int w = 0;
        w = __builtin_amdgcn_cvt_pk_fp8_f32(v[j].x * rinv * gv.x, v[j].y * rinv * gv.y, w, false); w = __builtin_amdgcn_cvt_pk_fp8_f32(v[j].z * rinv * gv.z, v[j].w * rinv * gv.w, w, true); o4[64 * j] = (unsigned)w; }
}
__device__ __forceinline__ void p0_transpose_item_fp8(const float* W, int K, int N, unsigned char* WT, LAS float* scr, int item, int lane, float scale, const float* gk = nullptr) {
    const int nblk = N / 32, kb = item / nblk, nb = item % nblk, k0 = 64 * kb, n0 = 32 * nb;
#pragma unroll 8
    for (int i = 0; i < 32; ++i) { const int kk = 2 * i + (lane >> 5); scr[kk * 33 + (lane & 31)] = __builtin_nontemporal_load(W + (size_t)(k0 + kk) * N + n0 + (lane & 31)) * (gk ? scale * gk[k0 + kk] : scale); }
    LDS_WAIT(); asm volatile("" ::: "memory");
    const int c = lane & 3;
#pragma unroll
    for (int j = 0; j < 2; ++j) { const int n = (lane >> 2) + 16 * j; const LAS float* s = scr + (16 * c) * 33 + n;
        int w0 = 0, w1 = 0, w2 = 0, w3 = 0;
        w0 = __builtin_amdgcn_cvt_pk_fp8_f32(s[0 * 33], s[1 * 33], w0, false); w0 = __builtin_amdgcn_cvt_pk_fp8_f32(s[2 * 33], s[3 * 33], w0, true);
        w1 = __builtin_amdgcn_cvt_pk_fp8_f32(s[4 * 33], s[5 * 33], w1, false); w1 = __builtin_amdgcn_cvt_pk_fp8_f32(s[6 * 33], s[7 * 33], w1, true);
        w2 = __builtin_amdgcn_cvt_pk_fp8_f32(s[8 * 33], s[9 * 33], w2, false); w2 = __builtin_amdgcn_cvt_pk_fp8_f32(s[10 * 33], s[11 * 33], w2, true);
        w3 = __builtin_amdgcn_cvt_pk_fp8_f32(s[12 * 33], s[13 * 33], w3, false); w3 = __builtin_amdgcn_cvt_pk_fp8_f32(s[14 * 33], s[15 * 33], w3, true);
        v4u o; o.x = (unsigned)w0; o.y = (unsigned)w1; o.z = (unsigned)w2; o.w = (unsigned)w3;
        *(GAS v4u*)(WT + (size_t)(n0 + n) * K + k0 + 16 * c) = o; }
    LDS_WAIT(); asm volatile("" ::: "memory");
}
template <bool SAMP> __device__ __forceinline__ void phase_dil_simple(const bf16* P, const float* rel_bias, bf16* ODIL, int gtid, int nthr, float* acc = nullptr) {
    float cnum = 0.f, cden = 0.f;
    constexpr int NTOK = SAMP ? T / 16 : T;
    for (int item = gtid; item < 4 * NTOK; item += nthr) {
        const int h = item / NTOK, ti = item % NTOK, tok = SAMP ? ti * 16 + 5 : ti, b = tok / SEQ, t = tok % SEQ;
        float o[64], q[64]; float m = -1e30f, l = 0.f;
#pragma unroll
        for (int c = 0; c < 64; ++c) o[c] = 0.f;
        for (int g = 0; g < 3; ++g) {
            const int d = 1 << (2 * g);
            load_q64(q, P + (size_t)tok * QKVW + g * 768 + h * 64, 0.125f);
            for (int j = 0; j <= 128; ++j) {
                const int tp = t - j * d;
                if (tp >= 0) {
                    const bf16* kr = P + (size_t)(b * SEQ + tp) * QKVW + g * 768 + 256 + h * 64;
                    os_step(q, o, m, l, kr, kr + 256, DBG_NOBIAS ? 0.f : rel_bias[t5_bucket(j * d) * 20 + g * 4 + h]);
                }
            }
        }
        if (SAMP) cmp_o64(o, 1.0f / l, ODIL + (size_t)tok * 256 + h * 64, cnum, cden); else store_o64(o, 1.0f / l, ODIL + (size_t)ti * 256 + h * 64);
    }
    if (SAMP) dbg_acc2(acc, cnum, cden);
}
template <bool SAMP> __device__ __forceinline__ void phase_moba_simple(const bf16* P, const float* KMEAN, const float* rel_bias, bf16* OMOBA, int gtid, int nthr, float* acc = nullptr) {
    float cnum = 0.f, cden = 0.f, cnum2 = 0.f, cden2 = 0.f;
    constexpr int NTOK = SAMP ? T / 16 : T;
    for (int item = gtid; item < 8 * NTOK; item += nthr) {
        const int h = item / NTOK, ti = item % NTOK, tok = SAMP ? ti * 16 + 5 : ti, b = tok / SEQ, t = tok % SEQ, qb = t >> 8;
        float o[64], q[64]; float m = -1e30f, l = 0.f;
#pragma unroll
        for (int c = 0; c < 64; ++c) o[c] = 0.f;
        load_q64(q, P + (size_t)tok * QKVW + 2304 + h * 64, 1.0f);
        float v1 = -3e38f, v2 = -3e38f, v3 = -3e38f; int i1 = -1, i2 = -1, i3 = -1;
        for (int n = 0; n < qb; ++n) {
            const float* km = KMEAN + (size_t)((b * 8 + h) * 16 + n) * 64; float gs = 0.f;
#pragma unroll
            for (int c = 0; c < 64; ++c) gs += q[c] * km[c];
            if (gs > v1) { v3 = v2; i3 = i2; v2 = v1; i2 = i1; v1 = gs; i1 = n; }
            else if (gs > v2) { v3 = v2; i3 = i2; v2 = gs; i2 = n; }
            else if (gs > v3) { v3 = gs; i3 = n; }
        }
        unsigned sel = 0u;
        if (i1 >= 0) sel |= 1u << i1;
        if (i2 >= 0) sel |= 1u << i2;
        if (i3 >= 0) sel |= 1u << i3;
#pragma unroll
        for (int c = 0; c < 64; ++c) q[c] *= 0.125f;
        const bf16* Kb = P + (size_t)(b * SEQ) * QKVW + 2304 + 512 + h * 64;
        for (int n = 0; n < 16; ++n) {
            const bool on = ((sel >> n) & 1u) && (n < qb);
            if (__any(on)) {
                for (int j = 0; j < 256; ++j) {
                    const int kpos = n * 256 + j;
                    if (on) { const bf16* kr = Kb + (size_t)kpos * QKVW; os_step(q, o, m, l, kr, kr + 512, DBG_NOBIAS ? 0.f : rel_bias[t5_bucket(t - kpos) * 20 + 12 + h]); }
                }
            }
        }
        for (int j = 0; j < 256; ++j) { const int kpos = qb * 256 + j;
            if (kpos <= t) { const bf16* kr = Kb + (size_t)kpos * QKVW; os_step(q, o, m, l, kr, kr + 512, DBG_NOBIAS ? 0.f : rel_bias[t5_bucket(t - kpos) * 20 + 12 + h]); }
        }
        if (SAMP) { if (qb == 0) cmp_o64(o, 1.0f / l, OMOBA + (size_t)tok * 512 + h * 64, cnum, cden); else cmp_o64(o, 1.0f / l, OMOBA + (size_t)tok * 512 + h * 64, cnum2, cden2); } else store_o64(o, 1.0f / l, OMOBA + (size_t)ti * 512 + h * 64);
    }
    if (SAMP) { dbg_acc2(acc, cnum, cden); dbg_acc2(acc + 2, cnum2, cden2); }
}
template <bool SAMP> __device__ __forceinline__ void phase_cross_simple(const bf16* QC, const bf16* KVC, bf16* OC, int gtid, int nthr, float* acc = nullptr) {
    float cnum = 0.f, cden = 0.f;
    constexpr int NTOK = SAMP ? T / 16 : T;
    for (int item = gtid; item < 8 * NTOK; item += nthr) {
        const int half = item & 1, pr = item >> 1, h = pr / NTOK, ti = pr % NTOK, tok = SAMP ? ti * 16 + 5 : ti, b = tok / SEQ;
        float o[64], q[64]; float m = -1e30f, l = 0.f;
#pragma unroll
        for (int c = 0; c < 64; ++c) o[c] = 0.f;
        load_q64(q, QC + (size_t)tok * 512 + h * 128 + half * 64, 0.08838834764831845f);
        const bf16* Kb = KVC + (size_t)(b * NMEM) * 1024 + h * 128 + half * 64;
        for (int j = 0; j < NMEM; ++j) {
            const v4u* kp = (const v4u*)(Kb + (size_t)j * 1024); float s = 0.f;
#pragma unroll
            for (int c = 0; c < 8; ++c) { const v4u w = kp[c];
                s += q[8 * c + 0] * bf_lo(w.x) + q[8 * c + 1] * bf_hi(w.x) + q[8 * c + 2] * bf_lo(w.y) + q[8 * c + 3] * bf_hi(w.y)
                   + q[8 * c + 4] * bf_lo(w.z) + q[8 * c + 5] * bf_hi(w.z) + q[8 * c + 6] * bf_lo(w.w) + q[8 * c + 7] * bf_hi(w.w); }
            s += __shfl_xor(s, 1);
            const float mn = fmaxf(m, s), al = __expf(m - mn), p = __expf(s - mn);
            l = l * al + p; m = mn;
            const v4u* vp = (const v4u*)(Kb + (size_t)j * 1024 + 512);
#pragma unroll
            for (int c = 0; c < 8; ++c) { const v4u w = vp[c];
                o[8 * c + 0] = o[8 * c + 0] * al + p * bf_lo(w.x); o[8 * c + 1] = o[8 * c + 1] * al + p * bf_hi(w.x);
                o[8 * c + 2] = o[8 * c + 2] * al + p * bf_lo(w.y); o[8 * c + 3] = o[8 * c + 3] * al + p * bf_hi(w.y);
                o[8 * c + 4] = o[8 * c + 4] * al + p * bf_lo(w.z); o[8 * c + 5] = o[8 * c + 5] * al + p * bf_hi(w.z);
                o[8 * c + 6] = o[8 * c + 6] * al + p * bf_lo(w.w); o[8 * c + 7] = o[8 * c + 7] * al + p * bf_hi(w.w); }
        }
        if (SAMP) cmp_o64(o, 1.0f / l, OC + (size_t)tok * 512 + h * 128 + half * 64, cnum, cden); else store_o64(o, 1.0f / l, OC + (size_t)ti * 512 + h * 128 + half * 64);
    }
    if (SAMP) dbg_acc2(acc, cnum, cden);
}

constexpr int PVQ = 2;
constexpr int PNQ = 4, PEG = 128 / PNQ;
constexpr int PSORT = 8, PSH = 14 - 3;
constexpr int PVS = PSORT, PVE = 128 / PVS;
__device__ __forceinline__ float tk_max(float a, float b) { return fmaxf(a, b); }
__device__ __forceinline__ float tk_min(float a, float b) { return fminf(a, b); }
template <int OFF> __device__ __forceinline__ void sort16_desc(float* v) {
#pragma unroll
    for (int k = 2; k <= 16; k <<= 1) {
#pragma unroll
        for (int j = k >> 1; j > 0; j >>= 1) {
#pragma unroll
            for (int i = 0; i < 16; ++i) {
                const int l = i ^ j;
                if (l > i) {
                    const bool desc = ((i & k) == 0);
                    const float x = v[OFF + i], y = v[OFF + l];
                    const float hi = tk_max(x, y), lo = tk_min(x, y);
                    v[OFF + i] = desc ? hi : lo; v[OFF + l] = desc ? lo : hi;
                }
            }
        }
    }
}
template <int OA, int OB, bool SORT> __device__ __forceinline__ void merge_top16(float* a, const float* b) {
#pragma unroll
    for (int i = 0; i < 16; ++i) a[OA + i] = tk_max(a[OA + i], b[OB + 15 - i]);
    if (SORT) {
#pragma unroll
        for (int j = 8; j > 0; j >>= 1) {
#pragma unroll
            for (int i = 0; i < 16; ++i) {
                const int l = i ^ j;
                if (l > i) { const float x = a[OA + i], y = a[OA + l]; a[OA + i] = tk_max(x, y); a[OA + l] = tk_min(x, y); }
            }
        }
    }
}
constexpr int cand_i(int c) { int n = 0; for (int i = 0; i < 16; ++i) for (int j = 0; j < 16 / (i + 1); ++j) { if (n == c) return i; ++n; } return 0; }
constexpr int cand_j(int c) { int n = 0; for (int i = 0; i < 16; ++i) for (int j = 0; j < 16 / (i + 1); ++j) { if (n == c) return j; ++n; } return 0; }
template <int C> struct CandT { static constexpr int I = cand_i(C), J = cand_j(C); };

__device__ __forceinline__ void peer_level1(const bf16* qrow  , const LAS unsigned char* sk  ,
                                            int r, int hh, float (&out)[16]) {
    bf16x8 qf[8];
#pragma unroll
    for (int ks = 0; ks < 8; ++ks) qf[ks] = *(const bf16x8*)(qrow + ks * 16 + hh * 8);
    float v[64];
#pragma unroll
    for (int kb = 0; kb < 4; ++kb) {
        f32x16 sc = {0.f, 0.f, 0.f, 0.f, 0.f, 0.f, 0.f, 0.f, 0.f, 0.f, 0.f, 0.f, 0.f, 0.f, 0.f, 0.f};
        const int key = kb * 32 + r;
#pragma unroll
        for (int ks = 0; ks < 8; ++ks) {
            const bf16x8 af = *(const LAS bf16x8*)(sk + key * 256 + (((2 * ks + hh) ^ (key & 15)) << 4));
            sc = __builtin_amdgcn_mfma_f32_32x32x16_bf16(af, qf[ks], sc, 0, 0, 0);
        }
#pragma unroll
        for (int reg = 0; reg < 16; ++reg) {
            const unsigned idx = (unsigned)(kb * 32 + (reg & 3) + 8 * (reg >> 2)) | ((unsigned)hh << 2);
            v[kb * 16 + reg] = __uint_as_float((__float_as_uint(sc[reg]) & ~127u) | idx);
        }
    }
    sort16_desc<0>(v); sort16_desc<16>(v); sort16_desc<32>(v); sort16_desc<48>(v);
    merge_top16<0, 16, true>(v, v); merge_top16<32, 48, true>(v, v); merge_top16<0, 32, true>(v, v);
    float other[16];
#pragma unroll
    for (int i = 0; i < 16; ++i) other[i] = __shfl_xor(v[i], 32);
    merge_top16<0, 0, true>(v, other);
#pragma unroll
    for (int i = 0; i < 16; ++i) out[i] = v[i];
}
template <int C, class EP, class WP> __device__ __forceinline__ void peer_emit(const float (&a)[16], const float (&b)[16], const float (&s)[64], float tau, int& cnt, float& den, bool writer, EP eo, WP wo) {
    if constexpr (C < 50) {
        const bool take = (s[C] >= tau) && (cnt < 16);
        const float e = __expf(s[C] - s[0]);
        if (take) {
            if (writer) { eo[cnt] = (int)(((__float_as_uint(a[CandT<C>::I]) & 127u) << 7) | (__float_as_uint(b[CandT<C>::J]) & 127u)); wo[cnt] = e; }
            cnt += 1; den += e;
        }
        peer_emit<C + 1, EP, WP>(a, b, s, tau, cnt, den, writer, eo, wo);
    }
}
template <int C> __device__ __forceinline__ void peer_sums(const float (&a)[16], const float (&b)[16], float (&s)[64]) {
    if constexpr (C < 50) { s[C] = a[CandT<C>::I] + b[CandT<C>::J]; peer_sums<C + 1>(a, b, s); }
}
__device__ __forceinline__ void phase_topk(LAS unsigned char* lds, const bf16* QP, const bf16* SUBK, int* PE, float* PG, int tid, int lane, int wave, int vcu, int G) {
    for (int c = tid; c < 2 * 128 * 16; c += NWAVES * 64) { const int row = c >> 4, ch = c & 15; const v4u w = ((const v4u*)SUBK)[c]; *(LAS v4u*)(lds + row * 256 + ((ch ^ (row & 15)) << 4)) = w; }
    __syncthreads();
    LAS int* stE = (LAS int*)(lds + 65536);
    LAS float* stW = (LAS float*)(lds + 65536 + 16384);
    const int r = lane & 31, hh = lane >> 5, head = wave;
    for (int tile = vcu; tile < T / 32; tile += G) {
        const int tok = tile * 32 + r;
        const bf16* qrow = QP + (size_t)tok * 2048 + head * 256;
        float a[16], b[16];
        peer_level1(qrow, lds, r, hh, a);
        peer_level1(qrow + 128, lds + 128 * 256, r, hh, b);
        float s[64];
        peer_sums<0>(a, b, s);
#pragma unroll
        for (int c = 50; c < 64; ++c) s[c] = -INFINITY;
        float w[64];
#pragma unroll
        for (int c = 0; c < 64; ++c) w[c] = s[c];
        sort16_desc<0>(w); sort16_desc<16>(w); sort16_desc<32>(w); sort16_desc<48>(w);
        merge_top16<0, 16, true>(w, w); merge_top16<32, 48, true>(w, w); merge_top16<0, 32, false>(w, w);
        float tau = w[0];
#pragma unroll
        for (int i = 1; i < 16; ++i) tau = tk_min(tau, w[i]);
        int cnt = 0; float den = 0.f;
        LAS int* eo = stE + r * 128 + head * 16; LAS float* wo = stW + r * 128 + head * 16;
        peer_emit<0, LAS int*, LAS float*>(a, b, s, tau, cnt, den, hh == 0, eo, wo);
        if (hh == 0) { const float inv = 1.0f / den; asm volatile("s_waitcnt lgkmcnt(0)" ::: "memory");
#pragma unroll
            for (int k = 0; k < 16; ++k) wo[k] *= inv; }
        __syncthreads();
#pragma unroll 1
        for (int i = 0; i < 4; ++i) { const int tl = wave * 4 + i; const size_t tg = (size_t)(tile * 32 + tl) * 128;
            const int e0 = stE[tl * 128 + lane], e1 = stE[tl * 128 + 64 + lane]; const float g0 = stW[tl * 128 + lane], g1 = stW[tl * 128 + 64 + lane];
            const int s0 = e0 >> PSH, s1 = e1 >> PSH; int base = 0, p0 = 0, p1 = 0;
#pragma unroll
            for (int bq = 0; bq < PSORT; ++bq) {
                const unsigned long long m0 = __ballot(s0 == bq), m1 = __ballot(s1 == bq);
                const int c0 = __popcll(m0), c1 = __popcll(m1);
                const int r0 = (int)__builtin_amdgcn_mbcnt_hi((unsigned)(m0 >> 32), __builtin_amdgcn_mbcnt_lo((unsigned)m0, 0u));
                const int r1 = (int)__builtin_amdgcn_mbcnt_hi((unsigned)(m1 >> 32), __builtin_amdgcn_mbcnt_lo((unsigned)m1, 0u));
                if (s0 == bq) p0 = base + r0;
                if (s1 == bq) p1 = base + c0 + r1;
                base += c0 + c1;
            }
            PE[tg + p0] = e0; PE[tg + p1] = e1; PG[tg + p0] = g0; PG[tg + p1] = g1; }
        __syncthreads();
    }
}

__device__ __forceinline__ float dot2_bf16(unsigned w, unsigned x, float acc) { return __builtin_amdgcn_fdot2_f32_bf16(__builtin_bit_cast(bf2_t, w), __builtin_bit_cast(bf2_t, x), acc, false); }
__device__ __forceinline__ float dot8_bf16(const v4u a, const v4u b, float acc) {
    acc = dot2_bf16(a.x, b.x, acc); acc = dot2_bf16(a.y, b.y, acc); acc = dot2_bf16(a.z, b.z, acc); acc = dot2_bf16(a.w, b.w, acc);
    return acc;
}
template <int N> __device__ __forceinline__ void xpose_reduce(float (&p)[64], int lane) {
    if constexpr (N >= 1) {
        const bool up = (lane & N) != 0;
#pragma unroll
        for (int k = 0; k < N; ++k) { const float keep = up ? p[k + N] : p[k], send = up ? p[k] : p[k + N]; p[k] = keep + __shfl_xor(send, N); }
        xpose_reduce<N / 2>(p, lane);
    }
}
__device__ __forceinline__ float gelu_exact(float x) { return 0.5f * x * (1.0f + erff(x * 0.70710678118654752f)); }
__device__ __forceinline__ float gelu_as(float v) {
    const float t = __builtin_amdgcn_rcpf(fabsf(v) * 0.2316418882f + 1.0f);
    float q = t * 0.5307027145f + (-0.7265760135f); q = q * t + 0.7107068705f; q = q * t + (-0.142248368f); q = q * t + 0.127414796f; q = q * t;
    const float e = __builtin_amdgcn_exp2f(v * v * (-0.72134752044f));
    const float m = v * (q * e);
    return v < 0.f ? m : v - m;
}
typedef float f32x2_ __attribute__((ext_vector_type(2)));
__device__ __forceinline__ void fp8x16_to_f32(const v4u w, float (&f)[16]) {
    const int w0 = (int)w.x, w1 = (int)w.y, w2 = (int)w.z, w3 = (int)w.w;
    f32x2_ t;
    t = __builtin_amdgcn_cvt_pk_f32_fp8(w0, false); f[0] = t.x; f[1] = t.y; t = __builtin_amdgcn_cvt_pk_f32_fp8(w0, true); f[2] = t.x; f[3] = t.y;
    t = __builtin_amdgcn_cvt_pk_f32_fp8(w1, false); f[4] = t.x; f[5] = t.y; t = __builtin_amdgcn_cvt_pk_f32_fp8(w1, true); f[6] = t.x; f[7] = t.y;
    t = __builtin_amdgcn_cvt_pk_f32_fp8(w2, false); f[8] = t.x; f[9] = t.y; t = __builtin_amdgcn_cvt_pk_f32_fp8(w2, true); f[10] = t.x; f[11] = t.y;
    t = __builtin_amdgcn_cvt_pk_f32_fp8(w3, false); f[12] = t.x; f[13] = t.y; t = __builtin_amdgcn_cvt_pk_f32_fp8(w3, true); f[14] = t.x; f[15] = t.y;
}
constexpr float U8_SCALE = 32.0f, V8_SCALE = 2.0f;
template <int N> __device__ __forceinline__ void xpose_reduce32(float (&p)[32], int lane) {
    if constexpr (N >= 1) {
        const bool up = (lane & N) != 0;
#pragma unroll
        for (int k = 0; k < N; ++k) { const float keep = up ? p[k + N] : p[k], send = up ? p[k] : p[k + N]; p[k] = keep + __shfl_xor(send, N); }
        xpose_reduce32<N / 2>(p, lane);
    } else { p[0] += __shfl_xor(p[0], 32); }
}
__device__ __forceinline__ void peer_u_group(__amdgpu_buffer_rsrc_t U8, const float (&h)[16], int ev, float gv, float zsc, float* wf, int lane) {
    f32x2_ h2[8];
#pragma unroll
    for (int c = 0; c < 8; ++c) { h2[c].x = h[2 * c]; h2[c].y = h[2 * c + 1]; }
    float p[PEG];
#pragma unroll
    for (int i0 = 0; i0 < PEG; i0 += 8) {
        v4u ua[8];
#pragma unroll
        for (int k = 0; k < 8; ++k) { const int eid = __builtin_amdgcn_readlane(ev, i0 + k); ua[k] = __builtin_amdgcn_raw_buffer_load_b128(U8, lane * 16, eid * 1024, 0); }
#pragma unroll
        for (int k = 0; k < 8; ++k) { const int w0 = (int)ua[k].x, w1 = (int)ua[k].y, w2 = (int)ua[k].z, w3 = (int)ua[k].w;
            f32x2_ a0 = h2[0] * __builtin_amdgcn_cvt_pk_f32_fp8(w0, false), a1 = h2[1] * __builtin_amdgcn_cvt_pk_f32_fp8(w0, true);
            a0 += h2[2] * __builtin_amdgcn_cvt_pk_f32_fp8(w1, false); a1 += h2[3] * __builtin_amdgcn_cvt_pk_f32_fp8(w1, true);
            a0 += h2[4] * __builtin_amdgcn_cvt_pk_f32_fp8(w2, false); a1 += h2[5] * __builtin_amdgcn_cvt_pk_f32_fp8(w2, true);
            a0 += h2[6] * __builtin_amdgcn_cvt_pk_f32_fp8(w3, false); a1 += h2[7] * __builtin_amdgcn_cvt_pk_f32_fp8(w3, true);
            a0 += a1; p[i0 + k] = a0.x + a0.y; }
    }
    xpose_reduce32<16>(p, lane);
    if (lane < PEG) wf[lane] = gelu_exact(p[0] * zsc) * gv * (1.0f / V8_SCALE);
}
__device__ __forceinline__ void peer_v_group(__amdgpu_buffer_rsrc_t V8, float (&y)[16], int ev, float wv, int lane) {
#pragma unroll
    for (int i0 = 0; i0 < PEG; i0 += 16) {
        v4u va[16]; float ws[16];
#pragma unroll
        for (int k = 0; k < 16; ++k) { const int eid = __builtin_amdgcn_readlane(ev, i0 + k); ws[k] = __int_as_float(__builtin_amdgcn_readlane(__float_as_int(wv), i0 + k));
            va[k] = __builtin_amdgcn_raw_buffer_load_b128(V8, lane * 16, eid * 1024, 0); }
#pragma unroll
        for (int k = 0; k < 16; ++k) { float f[16]; fp8x16_to_f32(va[k], f);
#pragma unroll
            for (int c = 0; c < 16; ++c) y[c] += ws[k] * f[c]; }
    }
}
__device__ __forceinline__ void peer_v_half(__amdgpu_buffer_rsrc_t V8, float (&y)[16], int ev, float wv, int lane) {
    for (int i0 = 0; i0 < 64; i0 += 16) {
        v4u va[16]; float ws[16];
#pragma unroll
        for (int k = 0; k < 16; ++k) { const int eid = __builtin_amdgcn_readlane(ev, i0 + k); ws[k] = __int_as_float(__builtin_amdgcn_readlane(__float_as_int(wv), i0 + k));
            va[k] = __builtin_amdgcn_raw_buffer_load_b128(V8, lane * 16, eid * 1024, 0); }
#pragma unroll
        for (int k = 0; k < 16; ++k) { float f[16]; fp8x16_to_f32(va[k], f);
#pragma unroll
            for (int c = 0; c < 16; ++c) y[c] += ws[k] * f[c]; }
    }
}
constexpr int XS_LO = 1088;
constexpr int UT_PITCH = 1040, UT_BYTES = 16 * UT_PITCH, UT_XS = 8 * UT_BYTES, XS_BYTES = 2176;
struct PeerVisit { int ev; float gv, rss; v4u ha, hb; };
__device__ __forceinline__ void peer_visit_load(PeerVisit& v, const bf16* H, const float* rowss, const int* PE, const float* PG, int tok, int g, int lane, bool dbg0) {
    const size_t eb = (size_t)tok * 128 + g * PEG;
    const int e = PE[eb + (lane & 31)]; v.ev = dbg0 ? 0 : e;
    v.gv = PG[eb + (lane & 31)]; v.rss = rowss[tok];
    v.ha = *(const v4u*)(H + (size_t)tok * 1024 + 16 * lane); v.hb = *(const v4u*)(H + (size_t)tok * 1024 + 16 * lane + 8);
}
__device__ __forceinline__ void peer_u_dma_tile(__amdgpu_buffer_rsrc_t U8, LAS unsigned char* tb, int ev, int t, int lane) {
#pragma unroll
    for (int r = 0; r < 16; ++r) { const int eid = __builtin_amdgcn_readlane(ev, 16 * t + r);
        __builtin_amdgcn_raw_ptr_buffer_load_lds(U8, (LAS unsigned*)(tb + r * UT_PITCH), 16, lane * 16, eid * 1024, 0, 0); }
}
__device__ __forceinline__ void peer_u_frags(const LAS unsigned char* tb, pg8::v8i32 (&ub)[8], int lane) {
    const LAS unsigned char* p = tb + (lane & 15) * UT_PITCH + (lane >> 4) * 16;
#pragma unroll
    for (int ks = 0; ks < 8; ++ks) { const v4u q0 = *(const LAS v4u*)(p + ks * 128), q1 = *(const LAS v4u*)(p + ks * 128 + 64);
        ub[ks] = (pg8::v8i32){(int)q0.x, (int)q0.y, (int)q0.z, (int)q0.w, (int)q1.x, (int)q1.y, (int)q1.z, (int)q1.w}; }
}
template <int F> __device__ __forceinline__ void peer_u_visit(__amdgpu_buffer_rsrc_t U8, LAS unsigned char* tb, LAS unsigned char* xs, const PeerVisit& cur, PeerVisit& nxt, const bf16* H, const float* rowss, const int* PE, const float* PG,
                                             int tokn, int gn, bool dbg0, float* wf, int lane) {
    const int j = lane & 15, q = lane >> 4;
    {
        const v4u ha = cur.ha, hb = cur.hb;
        const float sc = rsqrtf(cur.rss * (1.0f / 1024.0f) + RMS_EPS) * 16.0f;
        float h[16];
        h[0] = bf_lo(ha.x) * sc; h[1] = bf_hi(ha.x) * sc; h[2] = bf_lo(ha.y) * sc; h[3] = bf_hi(ha.y) * sc; h[4] = bf_lo(ha.z) * sc; h[5] = bf_hi(ha.z) * sc; h[6] = bf_lo(ha.w) * sc; h[7] = bf_hi(ha.w) * sc;
        h[8] = bf_lo(hb.x) * sc; h[9] = bf_hi(hb.x) * sc; h[10] = bf_lo(hb.y) * sc; h[11] = bf_hi(hb.y) * sc; h[12] = bf_lo(hb.z) * sc; h[13] = bf_hi(hb.z) * sc; h[14] = bf_lo(hb.w) * sc; h[15] = bf_hi(hb.w) * sc;
        int hi[4], lo[4];
#pragma unroll
        for (int c = 0; c < 4; ++c) { int w = 0; w = __builtin_amdgcn_cvt_pk_fp8_f32(h[4 * c], h[4 * c + 1], w, false); w = __builtin_amdgcn_cvt_pk_fp8_f32(h[4 * c + 2], h[4 * c + 3], w, true); hi[c] = w;
            const f32x2_ b0 = __builtin_amdgcn_cvt_pk_f32_fp8(w, false), b1 = __builtin_amdgcn_cvt_pk_f32_fp8(w, true);
            int v = 0; v = __builtin_amdgcn_cvt_pk_fp8_f32((h[4 * c] - b0.x) * 16.0f, (h[4 * c + 1] - b0.y) * 16.0f, v, false); v = __builtin_amdgcn_cvt_pk_fp8_f32((h[4 * c + 2] - b1.x) * 16.0f, (h[4 * c + 3] - b1.y) * 16.0f, v, true); lo[c] = v; }
        *(LAS v4u*)(xs + 16 * lane) = (v4u){(unsigned)hi[0], (unsigned)hi[1], (unsigned)hi[2], (unsigned)hi[3]};
        *(LAS v4u*)(xs + XS_LO + 16 * lane) = (v4u){(unsigned)lo[0], (unsigned)lo[1], (unsigned)lo[2], (unsigned)lo[3]};
    }
    const LAS unsigned char* xb = xs + (j & 1) * XS_LO + q * 16;
    pg8::v8i32 xa[8];
#pragma unroll
    for (int ks = 0; ks < 8; ++ks) { const v4u q0 = *(const LAS v4u*)(xb + ks * 128), q1 = *(const LAS v4u*)(xb + ks * 128 + 64);
        xa[ks] = (pg8::v8i32){(int)q0.x, (int)q0.y, (int)q0.z, (int)q0.w, (int)q1.x, (int)q1.y, (int)q1.z, (int)q1.w}; }
    peer_visit_load(nxt, H, rowss, PE, PG, tokn, gn, lane, dbg0);
    pg8::v8i32 ub[8];
    f32x4 acc0 = {0.f, 0.f, 0.f, 0.f}, acc1 = {0.f, 0.f, 0.f, 0.f};
    const int unit = 0x7f7f7f7f;
    asm volatile("s_waitcnt vmcnt(0)" ::: "memory");
    if constexpr (!(F & 1)) peer_u_frags(tb, ub, lane);
    asm volatile("s_waitcnt lgkmcnt(0)" ::: "memory");
    peer_u_dma_tile(U8, tb, cur.ev, 1, lane);
#pragma unroll
    for (int ks = 0; ks < ((F & 1) ? 0 : 8); ++ks) asm volatile("v_mfma_scale_f32_16x16x128_f8f6f4 %0, %1, %2, %0, %3, %3 op_sel_hi:[0,0,0]" : "+v"(acc0) : "v"(xa[ks]), "v"(ub[ks]), "v"(unit));
    asm volatile("s_waitcnt vmcnt(0)" ::: "memory");
    if constexpr (!(F & 1)) peer_u_frags(tb, ub, lane);
    asm volatile("s_waitcnt lgkmcnt(0)" ::: "memory");
    peer_u_dma_tile(U8, tb, nxt.ev, 0, lane);
#pragma unroll
    for (int ks = 0; ks < ((F & 1) ? 0 : 8); ++ks) asm volatile("v_mfma_scale_f32_16x16x128_f8f6f4 %0, %1, %2, %0, %3, %3 op_sel_hi:[0,0,0]" : "+v"(acc1) : "v"(xa[ks]), "v"(ub[ks]), "v"(unit));
    asm volatile("s_nop 15\n\ts_nop 15" : "+v"(acc0), "+v"(acc1));
    const float z = (lane < 16) ? acc0.x + acc0.y * (1.0f / 16.0f) : acc1.x + acc1.y * (1.0f / 16.0f);
    if (lane < 32) wf[lane] = gelu_exact(z * (1.0f / (16.0f * U8_SCALE))) * cur.gv * (1.0f / V8_SCALE);
}
template <int F> __device__ __forceinline__ void peer_u_pass(__amdgpu_buffer_rsrc_t U8, const bf16* H, const float* rowss, float* WF, const int* PE, const float* PG, LAS unsigned char* ldsw, int lane, int wave, int gw, int ngw, float dbg_sc) {
    {   const int ntok = (T - gw + ngw - 1) / ngw, nvis = PNQ * ntok; const bool dbg0 = dbg_sc == 0.f; const bool usync = (T % ngw) == 0;
        LAS unsigned char* tb = ldsw + wave * UT_BYTES; LAS unsigned char* xs = ldsw + UT_XS + wave * XS_BYTES;
        PeerVisit va, vb;
        peer_visit_load(va, H, rowss, PE, PG, gw, 0, lane, dbg0);
        peer_u_dma_tile(U8, tb, va.ev, 0, lane);
        int g = 0, tok = gw;
        for (int vi = 0; vi < nvis; vi += 2) {
            int g1 = g, tok1 = tok + ngw; if (tok1 >= T) { tok1 = gw; g1 = g + 1; }
            if (vi + 1 >= nvis) { tok1 = tok; g1 = g; }
            peer_u_visit<F>(U8, tb, xs, va, vb, H, rowss, PE, PG, tok1, g1, dbg0, WF + (size_t)tok * 128 + g * PEG, lane);
            if (vi + 1 >= nvis) break;
            if (usync && g1 != g) __builtin_amdgcn_s_barrier();
            int g2 = g1, tok2 = tok1 + ngw; if (tok2 >= T) { tok2 = gw; g2 = g1 + 1; }
            if (vi + 2 >= nvis) { tok2 = tok1; g2 = g1; }
            peer_u_visit<F>(U8, tb, xs, vb, va, H, rowss, PE, PG, tok2, g2, dbg0, WF + (size_t)tok1 * 128 + g1 * PEG, lane);
            if (usync && g2 != g1 && vi + 2 < nvis) __builtin_amdgcn_s_barrier();
            g = g2; tok = tok2;
        }
    }
    asm volatile("s_waitcnt vmcnt(0)" ::: "memory");
}
constexpr float PV_WSC = 64.0f;
struct PeerVRec { int ev; float w; };
__device__ __forceinline__ void peer_v_rec_load(PeerVRec& v, const float* WF, const int* PE, int tok, int g, int lane, bool dbg0) {
    const size_t eb = (size_t)tok * 128 + g * PVE;
    const int e = PE[eb + (lane & (PVE - 1))]; v.ev = dbg0 ? 0 : e; v.w = WF[eb + (lane & (PVE - 1))];
}
__device__ __forceinline__ void peer_v_load8(__amdgpu_buffer_rsrc_t V8, v4u (&L)[8], int ev, int base, int lane) {
#pragma unroll
    for (int r = 0; r < 8; ++r) { const int eid = __builtin_amdgcn_readlane(ev, base + r); L[r] = __builtin_amdgcn_raw_buffer_load_b128(V8, lane * 16, eid * 1024, 0); }
}
__device__ __forceinline__ void peer_v_mma8(const v4u (&L)[8], int w8, int base, const unsigned (&sel)[8], f32x16& acc) {
    int scl1 = 0x7f7f7f7f;
#pragma unroll
    for (int r = 0; r < 8; r += 2) {
        const unsigned s = ((unsigned)__builtin_amdgcn_readlane(w8, base + r) & 0xffu) | (((unsigned)__builtin_amdgcn_readlane(w8, base + r + 1) & 0xffu) << 8);
        const pg8::v8i32 a = {(int)__builtin_amdgcn_perm(0u, s, sel[0]), (int)__builtin_amdgcn_perm(0u, s, sel[1]), (int)__builtin_amdgcn_perm(0u, s, sel[2]), (int)__builtin_amdgcn_perm(0u, s, sel[3]),
                              (int)__builtin_amdgcn_perm(0u, s, sel[4]), (int)__builtin_amdgcn_perm(0u, s, sel[5]), (int)__builtin_amdgcn_perm(0u, s, sel[6]), (int)__builtin_amdgcn_perm(0u, s, sel[7])};
        const pg8::v8i32 b = {(int)L[r].x, (int)L[r].y, (int)L[r].z, (int)L[r].w, (int)L[r + 1].x, (int)L[r + 1].y, (int)L[r + 1].z, (int)L[r + 1].w};
        asm volatile("s_nop 1\n\tv_mfma_scale_f32_32x32x64_f8f6f4 %0, %1, %2, %0, %3, %3 op_sel_hi:[0,0,0]" : "+v"(acc) : "v"(a), "v"(b), "v"(scl1));
    }
}
__device__ __forceinline__ void peer_v_finish(float (&y)[16], int tok, int g, LAS unsigned char* pl, const bf16* H, const float* gfin, float* OUT, float* ydbg, bool dbg0, float oscale, int lane) {
    if (g < PVS - 1) {
        *(LAS v4u*)(pl + 16 * lane) = (v4u){pk2(y[0], y[1]), pk2(y[2], y[3]), pk2(y[4], y[5]), pk2(y[6], y[7])}; *(LAS v4u*)(pl + 1024 + 16 * lane) = (v4u){pk2(y[8], y[9]), pk2(y[10], y[11]), pk2(y[12], y[13]), pk2(y[14], y[15])};
    } else {
#pragma unroll
        for (int c = 0; c < 16; ++c) y[c] *= (1.0f / PV_WSC);
        if (dbg0) {
#pragma unroll
            for (int c = 0; c < 16; ++c) y[c] = 0.f; }
        if (ydbg) { const int s_ = tok / 512; if (tok == s_ * 512 + 3 + (s_ & 7) * 37) {
#pragma unroll
            for (int c = 0; c < 16; ++c) ydbg[(size_t)s_ * 1024 + 16 * lane + c] = y[c]; } }
        const f32x4* gr = (const f32x4*)gfin + 4 * lane;
        const v4u xa = *(const v4u*)(H + (size_t)tok * 1024 + 16 * lane), xbv = *(const v4u*)(H + (size_t)tok * 1024 + 16 * lane + 8);
        f32x4 xv[4]; float ss = 0.f;
        xv[0] = (f32x4){bf_lo(xa.x), bf_hi(xa.x), bf_lo(xa.y), bf_hi(xa.y)}; xv[1] = (f32x4){bf_lo(xa.z), bf_hi(xa.z), bf_lo(xa.w), bf_hi(xa.w)};
        xv[2] = (f32x4){bf_lo(xbv.x), bf_hi(xbv.x), bf_lo(xbv.y), bf_hi(xbv.y)}; xv[3] = (f32x4){bf_lo(xbv.z), bf_hi(xbv.z), bf_lo(xbv.w), bf_hi(xbv.w)};
#pragma unroll
        for (int i = 0; i < 4; ++i) { xv[i].x += y[4 * i]; xv[i].y += y[4 * i + 1]; xv[i].z += y[4 * i + 2]; xv[i].w += y[4 * i + 3];
            ss += (xv[i].x * xv[i].x + xv[i].y * xv[i].y) + (xv[i].z * xv[i].z + xv[i].w * xv[i].w); }
        const float rinv = rsqrtf(wave_sum(ss) * (1.f / 1024.f) + RMS_EPS) * oscale;
        unsigned char* orow = (unsigned char*)(OUT + (size_t)tok * 1024);
#pragma unroll
        for (int i = 0; i < 4; ++i) xv[i] = xv[i] * rinv * gr[i];
#pragma unroll
        for (int hf = 0; hf < 2; ++hf) {
            if ((lane >> 5) == hf) {
#pragma unroll
                for (int i = 0; i < 4; ++i) *(LAS f32x4*)(pl + 64 * (lane & 31) + 16 * i) = xv[i]; }
            asm volatile("s_waitcnt lgkmcnt(0)" ::: "memory");
            const f32x4 r0 = *(const LAS f32x4*)(pl + 16 * lane), r1 = *(const LAS f32x4*)(pl + 1024 + 16 * lane);
            asm volatile("s_waitcnt lgkmcnt(0)" ::: "memory");
            __builtin_nontemporal_store(r0, (f32x4*)(orow + 2048 * hf + 16 * lane)); __builtin_nontemporal_store(r1, (f32x4*)(orow + 2048 * hf + 1024 + 16 * lane));
        }
    }
}
constexpr int PV_TOK = 8;
template <int F> __device__ __forceinline__ void peer_v_pass(__amdgpu_buffer_rsrc_t V8, const bf16* H, const float* WF, const int* PE, const float* gfin, float* OUT, float* ydbg, float oscale, LAS unsigned char* ldsw,
                                                             int lane, int wave, int gw, int ngw, float dbg_sc) {
    const int ntok = (T - gw + ngw - 1) / ngw; const bool dbg0 = dbg_sc == 0.f;
    LAS unsigned char* pbase = ldsw + wave * UT_BYTES;
    static_assert(PV_TOK * 2048 <= UT_BYTES, "the parked sums live in the wave's tile buffer");
    const int m_ = lane & 31, c_ = (m_ & 3) + 4 * (m_ >> 3); const bool nz_ = (lane >> 5) == ((m_ >> 2) & 1);
    unsigned sel[8];
#pragma unroll
    for (int i = 0; i < 8; ++i) { const unsigned byte_ = (unsigned)(i >> 2); const unsigned pick_ = (0x0c0c0c0cu & ~(0xffu << (8 * (c_ & 3)))) | (byte_ << (8 * (c_ & 3)));
        sel[i] = (nz_ && (i & 3) == (c_ >> 2)) ? pick_ : 0x0c0c0c0cu; }
    PeerVRec ra, rb; v4u LA[8], LB[8];
    const bool wgsync = (T % ngw) == 0;
    if (ntok <= 0) return;
    peer_v_rec_load(ra, WF, PE, gw, 0, lane, dbg0); if (F & 1) ra.ev &= 2047;
    peer_v_load8(V8, LA, ra.ev, 0, lane);
    int t0 = 0, g = 0, k = 0;
#define PEER_V_NEXT(T0, G, K, T0N, GN, KN, LAST) do { const int nr_ = (ntok - (T0) < PV_TOK) ? ntok - (T0) : PV_TOK; T0N = (T0); GN = (G); KN = (K) + 1; LAST = false; \
        if (KN >= nr_) { KN = 0; GN = (G) + 1; if (GN >= PVS) { GN = 0; T0N = (T0) + PV_TOK; if (T0N >= ntok) { T0N = (T0); GN = (G); KN = (K); LAST = true; } } } } while (0)
#define PEER_V_EAT(LL, BASE) do { if constexpr (F & 2) { _Pragma("unroll") for (int r_ = 0; r_ < 8; ++r_) { c0_[r_ & 7] += __uint_as_float(LL[r_].x ^ LL[r_].y); c0_[8 + (r_ & 7)] += __uint_as_float(LL[r_].z ^ LL[r_].w); } } \
        else peer_v_mma8(LL, w8_, (BASE), sel, c0_); } while (0)
#define PEER_V_VISIT(CUR, NXT, T0C, GC, KC, T0N, GN, KN) do { \
        const int tokc_ = gw + ((T0C) + (KC)) * ngw, tokn_ = gw + ((T0N) + (KN)) * ngw; LAS unsigned char* pl_ = pbase + (KC) * 2048; \
        peer_v_rec_load(NXT, WF, PE, tokn_, GN, lane, dbg0); if (F & 1) NXT.ev &= 2047; \
        peer_v_load8(V8, LB, CUR.ev, 8, lane); \
        int w8_; { int wq_ = 0; wq_ = __builtin_amdgcn_cvt_pk_fp8_f32(CUR.w * PV_WSC, 0.f, wq_, false); w8_ = wq_ & 0xff; }     \
        f32x16 c0_; \
        if ((GC) > 0) { const v4u pa_ = *(const LAS v4u*)(pl_ + 16 * lane), pb_ = *(const LAS v4u*)(pl_ + 1024 + 16 * lane); \
            c0_[0] = bf_lo(pa_.x); c0_[1] = bf_hi(pa_.x); c0_[2] = bf_lo(pa_.y); c0_[3] = bf_hi(pa_.y); \
            c0_[4] = bf_lo(pa_.z); c0_[5] = bf_hi(pa_.z); c0_[6] = bf_lo(pa_.w); c0_[7] = bf_hi(pa_.w); \
            c0_[8] = bf_lo(pb_.x); c0_[9] = bf_hi(pb_.x); c0_[10] = bf_lo(pb_.y); c0_[11] = bf_hi(pb_.y); \
            c0_[12] = bf_lo(pb_.z); c0_[13] = bf_hi(pb_.z); c0_[14] = bf_lo(pb_.w); c0_[15] = bf_hi(pb_.w); \
        } else { _Pragma("unroll") for (int r_ = 0; r_ < 16; ++r_) c0_[r_] = 0.f; } \
        static_assert(PVE == 16, "a visit = two batches of 8 rows"); \
        PEER_V_EAT(LA, 0);  peer_v_load8(V8, LA, NXT.ev, 0, lane); \
        PEER_V_EAT(LB, 8); \
        float y[16]; \
        asm volatile("s_nop 15\n\ts_nop 15\n\ts_nop 15\n\ts_nop 15\n\ts_nop 15" : "+v"(c0_));     \
        _Pragma("unroll") for (int r_ = 0; r_ < 16; ++r_) y[r_] = c0_[r_]; \
        peer_v_finish(y, tokc_, GC, pl_, H, gfin, OUT, ydbg, dbg0, oscale, lane); \
        if (wgsync && (KN) == 0 && ((GN) != (GC) || (T0N) != (T0C))) __builtin_amdgcn_s_barrier(); } while (0)
    for (;;) {
        int t1, g1, k1, t2, g2, k2; bool last1, last2;
        PEER_V_NEXT(t0, g, k, t1, g1, k1, last1);
        PEER_V_VISIT(ra, rb, t0, g, k, t1, g1, k1);
        if (last1) break;
        PEER_V_NEXT(t1, g1, k1, t2, g2, k2, last2);
        PEER_V_VISIT(rb, ra, t1, g1, k1, t2, g2, k2);
        if (last2) break;
        t0 = t2; g = g2; k = k2;
    }
#undef PEER_V_VISIT
#undef PEER_V_EAT
#undef PEER_V_NEXT
}
__device__ __forceinline__ void phase_peer(const bf16* H, const float* rowss, const unsigned char* U8p, const unsigned char* V8p, float* WF, const int* PE, const float* PG,
                                           const float* gfin, float* OUT, int lane, int wave, int gw, int ngw, float dbg_sc, float* ydbg, float oscale, LAS unsigned char* ldsw) {
    static_assert(PEG == 32, "the group code is written for 32 entries per group");
    const __amdgpu_buffer_rsrc_t U8 = __builtin_amdgcn_make_buffer_rsrc((void*)U8p, 0, 16 << 20, 0x00020000), V8 = __builtin_amdgcn_make_buffer_rsrc((void*)V8p, 0, 16 << 20, 0x00020000);
    peer_u_pass<0>(U8, H, rowss, WF, PE, PG, ldsw, lane, wave, gw, ngw, dbg_sc);
    asm volatile("s_waitcnt vmcnt(0)" ::: "memory");
    if ((T % ngw) == 0) __builtin_amdgcn_s_barrier();
    peer_v_pass<0>(V8, H, WF, PE, gfin, OUT, ydbg, oscale, ldsw, lane, wave, gw, ngw, dbg_sc);
}
#if PROBE_PH >= 20
template <int MODE> __device__ __forceinline__ void peer_probe(const bf16* H, const float* rowss, const unsigned char* U8p, const unsigned char* V8p, float* WF, const int* PE, const float* PG,
                                                               float* OUT, int lane, int wave, int gw, int ngw, int vcu, LAS unsigned char* ldsp, const float* gfin) {
    const __amdgpu_buffer_rsrc_t U8 = __builtin_amdgcn_make_buffer_rsrc((void*)U8p, 0, 16 << 20, 0x00020000), V8 = __builtin_amdgcn_make_buffer_rsrc((void*)V8p, 0, 16 << 20, 0x00020000);
    if constexpr (MODE >= 10 && MODE < 20) { peer_u_pass<MODE - 10>(U8, H, rowss, WF, PE, PG, ldsp, lane, wave, gw, ngw, 1.0f); }
    else if constexpr (MODE >= 20) { peer_v_pass<MODE - 20>(V8, H, WF, PE, gfin, OUT, nullptr, 1.0f, ldsp, lane, wave, gw, ngw, 1.0f); }
    else if constexpr (MODE == 0 || MODE == 1 || MODE == 2 || MODE == 6) {
        for (int g = 0; g < PNQ; ++g) {
            for (int tok = gw; tok < T; tok += ngw) {
                int ev = PE[(size_t)tok * 128 + g * PEG + (lane & (PEG - 1))]; const float gv = PG[(size_t)tok * 128 + g * PEG + (lane & (PEG - 1))];
                ev &= 16383;
                if (MODE == 1 || MODE == 6) ev = (ev & 2047) | ((vcu >> 5) << 11);
                const v4u ha = *(const v4u*)(H + (size_t)tok * 1024 + 16 * lane), hb = *(const v4u*)(H + (size_t)tok * 1024 + 16 * lane + 8);
                float h[16];
                h[0] = bf_lo(ha.x); h[1] = bf_hi(ha.x); h[2] = bf_lo(ha.y); h[3] = bf_hi(ha.y); h[4] = bf_lo(ha.z); h[5] = bf_hi(ha.z); h[6] = bf_lo(ha.w); h[7] = bf_hi(ha.w);
                h[8] = bf_lo(hb.x); h[9] = bf_hi(hb.x); h[10] = bf_lo(hb.y); h[11] = bf_hi(hb.y); h[12] = bf_lo(hb.z); h[13] = bf_hi(hb.z); h[14] = bf_lo(hb.w); h[15] = bf_hi(hb.w);
                const float zsc = rsqrtf(rowss[tok] * (1.0f / 1024.0f) + RMS_EPS) * (1.0f / U8_SCALE);
                if constexpr (MODE == 2 || MODE == 6) {
                    unsigned acc = 0u;
#pragma unroll
                    for (int i0 = 0; i0 < PEG; i0 += 8) {
                        v4u ua[8];
#pragma unroll
                        for (int k = 0; k < 8; ++k) { const int eid = __builtin_amdgcn_readlane(ev, i0 + k); ua[k] = __builtin_amdgcn_raw_buffer_load_b128(U8, lane * 16, eid * 1024, 0); }
#pragma unroll
                        for (int k = 0; k < 8; ++k) acc ^= (ua[k].x ^ ua[k].y) ^ (ua[k].z ^ ua[k].w);
                    }
                    if (lane < PEG) (WF + (size_t)tok * 128 + g * PEG)[lane] = __uint_as_float(acc) * zsc * gv * h[0];
                } else peer_u_group(U8, h, ev, gv, zsc, WF + (size_t)tok * 128 + g * PEG, lane);
            }
        }
    } else {
        for (int tq = gw; tq < T; tq += PVQ * ngw) {
            float y[PVQ][16];
#pragma unroll
            for (int j = 0; j < PVQ; ++j)
#pragma unroll
                for (int c = 0; c < 16; ++c) y[j][c] = 0.f;
#pragma unroll
            for (int half = 0; half < 2; ++half)
#pragma unroll
                for (int j = 0; j < PVQ; ++j) { const size_t t_ = (size_t)(tq + j * ngw);
                    int ev = PE[t_ * 128 + half * 64 + lane] & 16383; const float wv = WF[t_ * 128 + half * 64 + lane];
                    if (MODE == 4) ev &= 2047;
                    if constexpr (MODE == 5) {
                        for (int i0 = 0; i0 < 64; i0 += 16) {
                            v4u va[16];
#pragma unroll
                            for (int k = 0; k < 16; ++k) { const int eid = __builtin_amdgcn_readlane(ev, i0 + k); va[k] = __builtin_amdgcn_raw_buffer_load_b128(V8, lane * 16, eid * 1024, 0); }
#pragma unroll
                            for (int k = 0; k < 16; ++k) { y[j][0] = __uint_as_float(__float_as_uint(y[j][0]) ^ va[k].x); y[j][1] = __uint_as_float(__float_as_uint(y[j][1]) ^ va[k].y);
                                y[j][2] = __uint_as_float(__float_as_uint(y[j][2]) ^ va[k].z); y[j][3] = __uint_as_float(__float_as_uint(y[j][3]) ^ va[k].w); }
                        }
                        y[j][4] += wv;
                    } else peer_v_half(V8, y[j], ev, wv, lane);
                }
#pragma unroll
            for (int j = 0; j < PVQ; ++j) {
                const int tok = tq + j * ngw;
                const v4u xa = *(const v4u*)(H + (size_t)tok * 1024 + 16 * lane), xbv = *(const v4u*)(H + (size_t)tok * 1024 + 16 * lane + 8);
                f32x4 xv[4]; float ss = 0.f;
                xv[0] = (f32x4){bf_lo(xa.x), bf_hi(xa.x), bf_lo(xa.y), bf_hi(xa.y)}; xv[1] = (f32x4){bf_lo(xa.z), bf_hi(xa.z), bf_lo(xa.w), bf_hi(xa.w)};
                xv[2] = (f32x4){bf_lo(xbv.x), bf_hi(xbv.x), bf_lo(xbv.y), bf_hi(xbv.y)}; xv[3] = (f32x4){bf_lo(xbv.z), bf_hi(xbv.z), bf_lo(xbv.w), bf_hi(xbv.w)};
#pragma unroll
                for (int i = 0; i < 4; ++i) { xv[i].x += y[j][4 * i]; xv[i].y += y[j][4 * i + 1]; xv[i].z += y[j][4 * i + 2]; xv[i].w += y[j][4 * i + 3];
                    ss += (xv[i].x * xv[i].x + xv[i].y * xv[i].y) + (xv[i].z * xv[i].z + xv[i].w * xv[i].w); }
                const float rinv = rsqrtf(wave_sum(ss) * (1.f / 1024.f) + RMS_EPS);
                f32x4* orow = (f32x4*)(OUT + (size_t)tok * 1024) + 4 * lane;
#pragma unroll
                for (int i = 0; i < 4; ++i) orow[i] = xv[i] * rinv;
            }
        }
    }
}
#endif
constexpr float L2E = 1.4426950408889634f;
#ifndef ATT_THR
#define ATT_THR 8.0f
#endif
typedef short v4i16_t __attribute__((ext_vector_type(4)));
__device__ __forceinline__ float amax3(float a, float b, float c) { float r; asm("v_max3_f32 %0, %1, %2, %3" : "=v"(r) : "v"(a), "v"(b), "v"(c)); return r; }
template <int D> struct ACfg { static constexpr int KS = D / 16, NBLK = D / 32, PITCH = D * 2 + 16, TILEB = 64 * PITCH, VPITCH = (D == 64 ? 192 : 320)  , VTILEB = 64 * VPITCH, PIECES = D / 64, CPR = D / 8; };
__device__ __forceinline__ bf16x8 pack8(float a0, float a1, float a2, float a3, float a4, float a5, float a6, float a7) {
    v4u u; u.x = pk2(a0, a1); u.y = pk2(a2, a3); u.z = pk2(a4, a5); u.w = pk2(a6, a7); return __builtin_bit_cast(bf16x8, u);
}
template <int D> __device__ __forceinline__ void attn_stage_load(v4u (&kr)[D / 64], v4u (&vr)[D / 64], const bf16* Kg, const bf16* Vg, size_t rowstride, int tid) {
#pragma unroll
    for (int p = 0; p < D / 64; ++p) { const int idx = tid + 512 * p, row = idx / ACfg<D>::CPR, ch = idx % ACfg<D>::CPR;
        kr[p] = *(const v4u*)(Kg + (size_t)row * rowstride + ch * 8); vr[p] = *(const v4u*)(Vg + (size_t)row * rowstride + ch * 8); }
}
template <int D> __device__ __forceinline__ void attn_stage_store(const v4u (&kr)[D / 64], const v4u (&vr)[D / 64], LAS unsigned char* Kl, LAS unsigned char* Vl, int tid) {
#pragma unroll
    for (int p = 0; p < D / 64; ++p) { const int idx = tid + 512 * p, row = idx / ACfg<D>::CPR, ch = idx % ACfg<D>::CPR;
        *(LAS v4u*)(Kl + row * ACfg<D>::PITCH + ch * 16) = kr[p]; *(LAS v4u*)(Vl + row * ACfg<D>::VPITCH + ch * 16) = vr[p]; }
}
template <int D> __device__ __forceinline__ void attn_load_q(bf16x8 (&qf)[D / 16], const bf16* qrow, int hh, float scale) {
#pragma unroll
    for (int ks = 0; ks < D / 16; ++ks) { const v4u w = *(const v4u*)(qrow + ks * 16 + hh * 8);
        qf[ks] = pack8(bf_lo(w.x) * scale, bf_hi(w.x) * scale, bf_lo(w.y) * scale, bf_hi(w.y) * scale, bf_lo(w.z) * scale, bf_hi(w.z) * scale, bf_lo(w.w) * scale, bf_hi(w.w) * scale); }
}
template <int D, int BIAS  > __device__ __forceinline__ void attn_tile(const LAS unsigned char* Kl, const LAS unsigned char* Vl, const bf16x8 (&qf)[D / 16], f32x16 (&o)[D / 32], float& m, float& l,
                                                                      const LAS float* tb, bool active, int lane, float cbias = 0.f) {
    constexpr int PITCH = ACfg<D>::PITCH, VPITCH = ACfg<D>::VPITCH;
    const int r = lane & 31, hh = lane >> 5;
    f32x16 s0, s1;
    if (BIAS == 2) {
#pragma unroll
        for (int reg = 0; reg < 16; ++reg) { s0[reg] = cbias; s1[reg] = cbias; }
    } else if (BIAS == 1) {
#pragma unroll
        for (int reg = 0; reg < 16; ++reg) { s0[reg] = tb[(reg & 3) + 8 * (reg >> 2)]; s1[reg] = tb[32 + (reg & 3) + 8 * (reg >> 2)]; }
    } else {
#pragma unroll
        for (int reg = 0; reg < 16; ++reg) { s0[reg] = 0.f; s1[reg] = 0.f; }
    }
#pragma unroll
    for (int ks = 0; ks < D / 16; ++ks) {
        const bf16x8 k0 = *(const LAS bf16x8*)(Kl + r * PITCH + (2 * ks + hh) * 16);
        const bf16x8 k1 = *(const LAS bf16x8*)(Kl + (32 + r) * PITCH + (2 * ks + hh) * 16);
        s0 = __builtin_amdgcn_mfma_f32_32x32x16_bf16(k0, qf[ks], s0, 0, 0, 0);
        s1 = __builtin_amdgcn_mfma_f32_32x32x16_bf16(k1, qf[ks], s1, 0, 0, 0);
    }
    asm volatile("s_nop 15\n\ts_nop 7" : "+v"(s0), "+v"(s1));
    float mx = amax3(s0[0], s1[0], s0[1]), mx2 = amax3(s1[1], s0[2], s1[2]);
#pragma unroll
    for (int reg = 3; reg < 15; reg += 2) { mx = amax3(mx, s0[reg], s1[reg]); mx2 = amax3(mx2, s0[reg + 1], s1[reg + 1]); }
    mx = amax3(mx, mx2, s0[15]); mx = amax3(mx, s1[15], s1[15]); mx = amax3(mx, __shfl_xor(mx, 32), mx);
    if (__any(active && (mx > m + ATT_THR))) {
        const float mn = active ? fmaxf(m, mx) : m;
        const float alpha = __builtin_amdgcn_exp2f(m - mn);
        l *= alpha; m = mn;
#pragma unroll
        for (int blk = 0; blk < D / 32; ++blk)
#pragma unroll
            for (int reg = 0; reg < 16; ++reg) o[blk][reg] *= alpha;
    }
    const float meff = active ? m : __builtin_inff();
    float ls = 0.f;
#pragma unroll
    for (int reg = 0; reg < 16; ++reg) { s0[reg] = __builtin_amdgcn_exp2f(s0[reg] - meff); s1[reg] = __builtin_amdgcn_exp2f(s1[reg] - meff); ls += s0[reg] + s1[reg]; }
    l += ls;
    bf16x8 pf[4];
    pf[0] = pack8(s0[0], s0[1], s0[2], s0[3], s0[4], s0[5], s0[6], s0[7]); pf[1] = pack8(s0[8], s0[9], s0[10], s0[11], s0[12], s0[13], s0[14], s0[15]);
    pf[2] = pack8(s1[0], s1[1], s1[2], s1[3], s1[4], s1[5], s1[6], s1[7]); pf[3] = pack8(s1[8], s1[9], s1[10], s1[11], s1[12], s1[13], s1[14], s1[15]);
    const int i16 = lane & 15;
    unsigned vbo = (unsigned)((4 * hh + (i16 >> 2)) * VPITCH + (16 * ((lane >> 4) & 1) + 4 * (i16 & 3)) * 2);
    asm volatile("" : "+v"(vbo) :: "memory");
    const LAS unsigned char* vb = Vl + vbo;
#pragma unroll
    for (int blk = 0; blk < D / 32; ++blk) {
#pragma unroll
        for (int ks = 0; ks < 4; ++ks) {
            const v4i16_t lo = __builtin_amdgcn_ds_read_tr16_b64_v4i16((LAS v4i16_t*)(vb + (16 * ks) * VPITCH + blk * 64));
            const v4i16_t hi = __builtin_amdgcn_ds_read_tr16_b64_v4i16((LAS v4i16_t*)(vb + (16 * ks + 8) * VPITCH + blk * 64));
            const bf16x8 va = {lo[0], lo[1], lo[2], lo[3], hi[0], hi[1], hi[2], hi[3]};
            o[blk] = __builtin_amdgcn_mfma_f32_32x32x16_bf16(va, pf[ks], o[blk], 0, 0, 0);
        }
    }
}
template <int D> __device__ __forceinline__ void attn_store_o(const f32x16 (&o)[D / 32], float inv, bf16* orow, int hh) {
#pragma unroll
    for (int blk = 0; blk < D / 32; ++blk)
#pragma unroll
        for (int g4 = 0; g4 < 4; ++g4) { unsigned long long w = (unsigned long long)pk2(o[blk][4 * g4] * inv, o[blk][4 * g4 + 1] * inv) | ((unsigned long long)pk2(o[blk][4 * g4 + 2] * inv, o[blk][4 * g4 + 3] * inv) << 32);
            *(unsigned long long*)(orow + 32 * blk + 8 * g4 + 4 * hh) = w; }
}
constexpr int ATT_OST_OFF = 147456;
__device__ __forceinline__ void attn_store_o_rows64(const f32x16 (&o)[2], float inv, bf16* obase, size_t rstride, LAS unsigned char* st, int lane) {
    const int r = lane & 31, hh = lane >> 5;
    unsigned long long w[8];
#pragma unroll
    for (int blk = 0; blk < 2; ++blk)
#pragma unroll
        for (int g4 = 0; g4 < 4; ++g4) w[blk * 4 + g4] = (unsigned long long)pk2(o[blk][4 * g4] * inv, o[blk][4 * g4 + 1] * inv) | ((unsigned long long)pk2(o[blk][4 * g4 + 2] * inv, o[blk][4 * g4 + 3] * inv) << 32);
#pragma unroll
    for (int half = 0; half < 2; ++half) {
        if ((r >> 4) == half) {
#pragma unroll
            for (int i = 0; i < 8; ++i) *(LAS unsigned long long*)(st + (r & 15) * 128 + 64 * (i >> 2) + 16 * (i & 3) + 8 * hh) = w[i]; }
        asm volatile("s_waitcnt lgkmcnt(0)" ::: "memory");
        const v4u c0 = *(const LAS v4u*)(st + 16 * lane), c1 = *(const LAS v4u*)(st + 1024 + 16 * lane);
        asm volatile("s_waitcnt lgkmcnt(0)" ::: "memory");
        *(v4u*)(obase + (size_t)(16 * half + (lane >> 3)) * rstride + 8 * (lane & 7)) = c0;
        *(v4u*)(obase + (size_t)(16 * half + 8 + (lane >> 3)) * rstride + 8 * (lane & 7)) = c1;
    }
}
constexpr int ATT_TB_BYTES = 18432;

__device__ __forceinline__ void moba_unit(LAS unsigned char* lds, const bf16* P, const float* KMEAN, const float* rel_bias, bf16* OMOBA, int b, int h, int qb, int tid, int lane, int wave) {
    constexpr int TILEB = ACfg<64>::TILEB, VTILEB = ACfg<64>::VTILEB;
    const int r = lane & 31, hh = lane >> 5;
    LAS float* TB = (LAS float*)lds;
    LAS unsigned char* Kb = lds + ATT_TB_BYTES; LAS unsigned char* Vb = Kb + 2 * TILEB;
    LAS float* KM = (LAS float*)(lds + ATT_TB_BYTES + 4 * TILEB + 4 * VTILEB);
#pragma unroll
    for (int i = 0; i < 9; ++i) { const int x = tid + i * (NWAVES * 64); if (x < 4352) { const int dist = 4095 - x; float tv = -__builtin_inff(); if (dist >= 0) tv = DBG_NOBIAS ? 0.f : rel_bias[t5_bucket(dist) * 20 + 12 + h] * L2E; TB[x] = tv; } }
#pragma unroll
    for (int i = 0; i < 2; ++i) { const int x = tid + i * (NWAVES * 64); if (x < qb * 64) KM[x] = KMEAN[(size_t)((b * 8 + h) * 16) * 64 + x]; }
    __syncthreads();
    const int qpos = qb * 256 + wave * 32 + r; const size_t tokq = (size_t)b * SEQ + qpos;
    const bf16* qrow = P + tokq * QKVW + 2304 + h * 64;
    unsigned sel = 0u;
    {
        float q[64]; load_q64(q, qrow, 1.0f);
        float v1 = -3e38f, v2 = -3e38f, v3 = -3e38f; int i1 = -1, i2 = -1, i3 = -1;
        for (int n = 0; n < qb; ++n) {
            const LAS f32x4* km = (const LAS f32x4*)(KM + n * 64); float gs = 0.f;
#pragma unroll
            for (int c = 0; c < 16; ++c) { const f32x4 kv = km[c]; gs += q[4 * c] * kv.x + q[4 * c + 1] * kv.y + q[4 * c + 2] * kv.z + q[4 * c + 3] * kv.w; }
            if (gs > v1) { v3 = v2; i3 = i2; v2 = v1; i2 = i1; v1 = gs; i1 = n; }
            else if (gs > v2) { v3 = v2; i3 = i2; v2 = gs; i2 = n; }
            else if (gs > v3) { v3 = gs; i3 = n; }
        }
        if (i1 >= 0) sel |= 1u << i1;
        if (i2 >= 0) sel |= 1u << i2;
        if (i3 >= 0) sel |= 1u << i3;
    }
    bf16x8 qf[4]; attn_load_q<64>(qf, qrow, hh, 0.125f * L2E);
    f32x16 o[2];
#pragma unroll
    for (int reg = 0; reg < 16; ++reg) { o[0][reg] = 0.f; o[1][reg] = 0.f; }
    float m = -1e30f, l = 0.f;
    const bf16* Kg0 = P + (size_t)b * SEQ * QKVW + 2304 + 512 + h * 64;
    const int nt = 4 + 4 * qb;
#define MOBA_K0(i) ((i) < 4 ? qb * 256 + 64 * (i) : 64 * ((i) - 4))
    LAS unsigned char* Kb2 = Kb; LAS unsigned char* Vb2 = Kb + 4 * TILEB;
    LAS float* KM2 = (LAS float*)(Kb + 4 * TILEB + 4 * VTILEB); (void)KM2;
    v4u krA[1], vrA[1], krB[1], vrB[1];
    { const int k0 = MOBA_K0(0), k1 = MOBA_K0(1);
      attn_stage_load<64>(krA, vrA, Kg0 + (size_t)k0 * QKVW, Kg0 + (size_t)k0 * QKVW + 512, QKVW, tid); attn_stage_load<64>(krB, vrB, Kg0 + (size_t)k1 * QKVW, Kg0 + (size_t)k1 * QKVW + 512, QKVW, tid);
      attn_stage_store<64>(krA, vrA, Kb2, Vb2, tid); attn_stage_store<64>(krB, vrB, Kb2 + TILEB, Vb2 + VTILEB, tid); }
    __syncthreads();
    for (int i = 0; i < nt; i += 2) {
        const int sb = (i >> 1) & 1;
        if (i + 2 < nt) { const int k2 = MOBA_K0(i + 2), k3 = MOBA_K0(i + 3);
            attn_stage_load<64>(krA, vrA, Kg0 + (size_t)k2 * QKVW, Kg0 + (size_t)k2 * QKVW + 512, QKVW, tid); attn_stage_load<64>(krB, vrB, Kg0 + (size_t)k3 * QKVW, Kg0 + (size_t)k3 * QKVW + 512, QKVW, tid); }
#pragma unroll
        for (int e = 0; e < 2; ++e) { const int ii = i + e; const int k0 = MOBA_K0(ii);
            bool on; bool go;
            if (ii < 4) { on = true; go = (ii <= (wave >> 1)); }
            else { on = (sel >> ((ii - 4) >> 2)) & 1u; go = __any(on) != 0; }
            if (go) attn_tile<64, 1>(Kb2 + (2 * sb + e) * TILEB, Vb2 + (2 * sb + e) * VTILEB, qf, o, m, l, TB + (k0 - qpos + 4095 + 4 * hh), on, lane); }
        if (i + 2 < nt) { attn_stage_store<64>(krA, vrA, Kb2 + (2 * (sb ^ 1)) * TILEB, Vb2 + (2 * (sb ^ 1)) * VTILEB, tid); attn_stage_store<64>(krB, vrB, Kb2 + (2 * (sb ^ 1) + 1) * TILEB, Vb2 + (2 * (sb ^ 1) + 1) * VTILEB, tid); }
        __syncthreads();
    }
#undef MOBA_K0
    const float lt = l + __shfl_xor(l, 32);
    attn_store_o_rows64(o, 1.0f / lt, OMOBA + ((size_t)b * SEQ + qb * 256 + wave * 32) * 512 + h * 64, 512, lds + ATT_OST_OFF + wave * 2048, lane);
}
__device__ __forceinline__ void dil_unit(LAS unsigned char* lds, const bf16* P, const float* rel_bias, bf16* ODG, float* LSE, int b, int g, int h, int res, int blk, int tid, int lane, int wave) {
    constexpr int TILEB = ACfg<64>::TILEB, VTILEB = ACfg<64>::VTILEB;
    const int r = lane & 31, hh = lane >> 5, d = 1 << (2 * g), l0 = blk * 256;
    LAS float* TB = (LAS float*)lds;
    LAS unsigned char* Kb = lds + ATT_TB_BYTES; LAS unsigned char* Vb = Kb + 2 * TILEB;
    float tbv; { const int j = 256 - tid, jc = j < 0 ? 0 : (j > 128 ? 128 : j); tbv = (DBG_NOBIAS ? 0.f : rel_bias[t5_bucket(jc * d) * 20 + g * 4 + h] * L2E); if (j < 0 || j > 128) tbv = -__builtin_inff(); }
    const int q0w = l0 + wave * 32, lq = q0w + r; const size_t tokq = (size_t)b * SEQ + (size_t)lq * d + res;
    v4u qw[4];
#pragma unroll
    for (int ks = 0; ks < 4; ++ks) qw[ks] = *(const v4u*)(P + tokq * QKVW + g * 768 + h * 64 + ks * 16 + hh * 8);
    f32x16 o[2];
#pragma unroll
    for (int reg = 0; reg < 16; ++reg) { o[0][reg] = 0.f; o[1][reg] = 0.f; }
    float m = -1e30f, l = 0.f;
    const bf16* Kg0 = P + ((size_t)b * SEQ + res) * QKVW + g * 768 + 256 + h * 64;
    const size_t rs = (size_t)QKVW * d;
    const int kt0 = (l0 == 0) ? 0 : -2, nt = 4 - kt0;
    LAS unsigned char* Kb2 = Kb; LAS unsigned char* Vb2 = Kb + 4 * TILEB;
#define DIL_TILE(j, e) ((e) == 0 ? (j) : (nt == 6 ? (j) + 3 : 3 - (j)))
#define DIL_LOAD(i, kr, vr) do { const int k0_ = l0 + 64 * (kt0 + (i)); attn_stage_load<64>(kr, vr, Kg0 + (size_t)k0_ * rs, Kg0 + (size_t)k0_ * rs + 256, rs, tid); } while (0)
    v4u kr0[1], vr0[1], kr1[1], vr1[1], kr2[1], vr2[1], kr3[1], vr3[1], kr4[1], vr4[1], kr5[1], vr5[1];
    DIL_LOAD(DIL_TILE(0, 0), kr0, vr0); DIL_LOAD(DIL_TILE(0, 1), kr1, vr1); DIL_LOAD(DIL_TILE(1, 0), kr2, vr2); DIL_LOAD(DIL_TILE(1, 1), kr3, vr3);
    if (nt == 6) { DIL_LOAD(DIL_TILE(2, 0), kr4, vr4); DIL_LOAD(DIL_TILE(2, 1), kr5, vr5); }
    TB[tid] = tbv;
    bf16x8 qf[4];
#pragma unroll
    for (int ks = 0; ks < 4; ++ks) { const float sc_ = 0.125f * L2E; const v4u w = qw[ks];
        qf[ks] = pack8(bf_lo(w.x) * sc_, bf_hi(w.x) * sc_, bf_lo(w.y) * sc_, bf_hi(w.y) * sc_, bf_lo(w.z) * sc_, bf_hi(w.z) * sc_, bf_lo(w.w) * sc_, bf_hi(w.w) * sc_); }
    attn_stage_store<64>(kr0, vr0, Kb2, Vb2, tid); attn_stage_store<64>(kr1, vr1, Kb2 + TILEB, Vb2 + VTILEB, tid);
    __syncthreads();
    const int nsteps = nt >> 1;
#define DIL_STEP(j, KRN0, VRN0, KRN1, VRN1) do { if ((j) < nsteps) { const int sb = (j) & 1; \
        _Pragma("unroll") for (int e = 0; e < 2; ++e) { const int k0 = l0 + 64 * (kt0 + DIL_TILE((j), e)); \
            const bool go = (k0 + 63 >= q0w - 128) && (k0 <= q0w + 31); \
            if (go) attn_tile<64, 1>(Kb2 + (2 * sb + e) * TILEB, Vb2 + (2 * sb + e) * VTILEB, qf, o, m, l, TB + (k0 - lq + 256 + 4 * hh), true, lane); } \
        if ((j) + 1 < nsteps) { attn_stage_store<64>(KRN0, VRN0, Kb2 + (2 * (sb ^ 1)) * TILEB, Vb2 + (2 * (sb ^ 1)) * VTILEB, tid); attn_stage_store<64>(KRN1, VRN1, Kb2 + (2 * (sb ^ 1) + 1) * TILEB, Vb2 + (2 * (sb ^ 1) + 1) * VTILEB, tid); } \
        __syncthreads(); } } while (0)
    DIL_STEP(0, kr2, vr2, kr3, vr3);
    DIL_STEP(1, kr4, vr4, kr5, vr5);
    DIL_STEP(2, kr4, vr4, kr5, vr5);
#undef DIL_STEP
#undef DIL_TILE
#undef DIL_LOAD
    const float lt = l + __shfl_xor(l, 32);
    attn_store_o_rows64(o, 1.0f / lt, ODG + ((size_t)g * T + (size_t)b * SEQ + (size_t)q0w * d + res) * 256 + h * 64, (size_t)d * 256, lds + ATT_OST_OFF + wave * 2048, lane);
    if (hh == 0) LSE[((size_t)g * T + tokq) * 4 + h] = (m + __builtin_amdgcn_logf(lt)) * 0.6931471805599453f;
}
__device__ __forceinline__ void cross_unit(LAS unsigned char* lds, const bf16* QC, const bf16* KVC, bf16* OC, int b, int h, int qblk, int tid, int lane, int wave) {
    constexpr int TILEB = ACfg<128>::TILEB, VTILEB = ACfg<128>::VTILEB;
    const int r = lane & 31, hh = lane >> 5;
    LAS unsigned char* Kb = lds + ATT_TB_BYTES; LAS unsigned char* Vb = Kb + 2 * TILEB;
    const size_t tokq = (size_t)b * SEQ + qblk * 256 + wave * 32 + r;
    bf16x8 qf[8]; attn_load_q<128>(qf, QC + tokq * 512 + h * 128, hh, 0.08838834764831845f * L2E);
    f32x16 o[4];
#pragma unroll
    for (int reg = 0; reg < 16; ++reg) { o[0][reg] = 0.f; o[1][reg] = 0.f; o[2][reg] = 0.f; o[3][reg] = 0.f; }
    float m = -1e30f, l = 0.f;
    const bf16* Kg0 = KVC + (size_t)b * NMEM * 1024 + h * 128;
    v4u kr[2], vr[2];
    attn_stage_load<128>(kr, vr, Kg0, Kg0 + 512, 1024, tid); attn_stage_store<128>(kr, vr, Kb, Vb, tid);
    __syncthreads();
    for (int i = 0; i < 4; ++i) {
        if (i + 1 < 4) attn_stage_load<128>(kr, vr, Kg0 + (size_t)(64 * (i + 1)) * 1024, Kg0 + (size_t)(64 * (i + 1)) * 1024 + 512, 1024, tid);
        attn_tile<128, 0>(Kb + (i & 1) * TILEB, Vb + (i & 1) * VTILEB, qf, o, m, l, (const LAS float*)lds, true, lane);
        if (i + 1 < 4) attn_stage_store<128>(kr, vr, Kb + ((i + 1) & 1) * TILEB, Vb + ((i + 1) & 1) * VTILEB, tid);
        __syncthreads();
    }
    const float lt = l + __shfl_xor(l, 32);
    attn_store_o<128>(o, 1.0f / lt, OC + tokq * 512 + h * 128, hh);
}
__device__ __forceinline__ void dil_combine(const bf16* ODG, const float* LSE, bf16* ODIL, int gtid, int nthr) {
    for (int it = gtid; it < T * 32; it += nthr) { const int tok = it >> 5, c = it & 31, h = c >> 3;
        const float a0 = LSE[((size_t)0 * T + tok) * 4 + h], a1 = LSE[((size_t)1 * T + tok) * 4 + h], a2 = LSE[((size_t)2 * T + tok) * 4 + h];
        const float mx = fmaxf(a0, fmaxf(a1, a2)); float w0 = __expf(a0 - mx), w1 = __expf(a1 - mx), w2 = __expf(a2 - mx); const float inv = 1.0f / (w0 + w1 + w2); w0 *= inv; w1 *= inv; w2 *= inv;
        const v4u x0 = *(const v4u*)(ODG + ((size_t)0 * T + tok) * 256 + c * 8), x1 = *(const v4u*)(ODG + ((size_t)1 * T + tok) * 256 + c * 8), x2 = *(const v4u*)(ODG + ((size_t)2 * T + tok) * 256 + c * 8);
        v4u o; o.x = pk2(w0 * bf_lo(x0.x) + w1 * bf_lo(x1.x) + w2 * bf_lo(x2.x), w0 * bf_hi(x0.x) + w1 * bf_hi(x1.x) + w2 * bf_hi(x2.x));
        o.y = pk2(w0 * bf_lo(x0.y) + w1 * bf_lo(x1.y) + w2 * bf_lo(x2.y), w0 * bf_hi(x0.y) + w1 * bf_hi(x1.y) + w2 * bf_hi(x2.y));
        o.z = pk2(w0 * bf_lo(x0.z) + w1 * bf_lo(x1.z) + w2 * bf_lo(x2.z), w0 * bf_hi(x0.z) + w1 * bf_hi(x1.z) + w2 * bf_hi(x2.z));
        o.w = pk2(w0 * bf_lo(x0.w) + w1 * bf_lo(x1.w) + w2 * bf_lo(x2.w), w0 * bf_hi(x0.w) + w1 * bf_hi(x1.w) + w2 * bf_hi(x2.w));
        *(v4u*)(ODIL + (size_t)tok * 256 + c * 8) = o; }
}
__device__ __forceinline__ void phase_topk_simple(const bf16* QP, const float* subk, int* EXP, float* EW, float* INV, int lane, int gw, int ngw) {
    for (int unit = gw; unit < T * 8; unit += ngw) {
        const int tok = unit >> 3, head = unit & 7;
        const bf16* qrow = QP + (size_t)tok * 2048 + head * 256;
        float av = 0.f, bv[4] = {0.f, 0.f, 0.f, 0.f}; int ai = 0, bi[4] = {0, 0, 0, 0};
#pragma unroll
        for (int p = 0; p < 2; ++p) {
            float s0 = 0.f, s1 = 0.f;
            const float* k0 = subk + (size_t)(p * 128 + lane) * 128; const float* k1 = subk + (size_t)(p * 128 + 64 + lane) * 128;
            for (int c = 0; c < 128; ++c) { const float qv = bf2f(qrow[p * 128 + c]); s0 += qv * k0[c]; s1 += qv * k1[c]; }
#pragma unroll
            for (int i = 0; i < 16; ++i) {
                float mloc = fmaxf(s0, s1); float mw = mloc;
#pragma unroll
                for (int o = 1; o < 64; o <<= 1) mw = fmaxf(mw, __shfl_xor(mw, o));
                const unsigned long long bal = __ballot(mloc == mw);
                const int wl = __ffsll((long long)bal) - 1;
                int idx = -1;
                if (lane == wl) { if (s0 >= s1) { idx = lane; s0 = -3e38f; } else { idx = lane + 64; s1 = -3e38f; } }
                idx = __shfl(idx, wl);
                if (p == 0) { if ((lane & 15) == i) { av = mw; ai = idx; } }
                else { if ((lane >> 4) == (i >> 2)) { bv[i & 3] = mw; bi[i & 3] = idx; } }
            }
        }
        float cs[4];
#pragma unroll
        for (int jj = 0; jj < 4; ++jj) cs[jj] = av + bv[jj];
        float top0 = 0.f, den = 0.f; int myexp = 0; float myw = 0.f;
#pragma unroll
        for (int k = 0; k < 16; ++k) {
            float mloc = fmaxf(fmaxf(cs[0], cs[1]), fmaxf(cs[2], cs[3])); float mw = mloc;
#pragma unroll
            for (int o = 1; o < 64; o <<= 1) mw = fmaxf(mw, __shfl_xor(mw, o));
            const unsigned long long bal = __ballot(mloc == mw);
            const int wl = __ffsll((long long)bal) - 1;
            int ex = 0;
            if (lane == wl) {
                if (cs[0] == mw) { ex = ai * 128 + bi[0]; cs[0] = -3e38f; }
                else if (cs[1] == mw) { ex = ai * 128 + bi[1]; cs[1] = -3e38f; }
                else if (cs[2] == mw) { ex = ai * 128 + bi[2]; cs[2] = -3e38f; }
                else { ex = ai * 128 + bi[3]; cs[3] = -3e38f; }
            }
            ex = __shfl(ex, wl);
            if (k == 0) top0 = mw;
            const float e = __expf(mw - top0); den += e;
            if (lane == k) { myexp = ex; myw = e; }
        }
        if (lane < 16) { EXP[(size_t)tok * 128 + head * 16 + lane] = myexp; EW[(size_t)tok * 128 + head * 16 + lane] = myw; }
        if (lane == 0) INV[(size_t)tok * 8 + head] = 1.0f / den;
    }
}
#if DBG_CHECK || DBG_ATTN_CHECK
constexpr size_t WS_YDBG = 510 * MiB;
constexpr int CW_DBG = 64;
__device__ __forceinline__ void dbg_acc(float* acc, float num, float den, int lane) { num = wave_sum(num); den = wave_sum(den); if (lane == 0) { atomicAdd(acc, num); atomicAdd(acc + 1, den); } }
__device__ __forceinline__ int dbg_tok(int s) { return s * 512 + 3 + (s & 7) * 37; }
__device__ __forceinline__ void dbg_check_qp(const bf16* H, const float* w_qp, const bf16* QP, float* acc, int gtid, int nthr, int lane) {
    float num = 0.f, den = 0.f;
    for (int item = gtid; item < 64 * 2048; item += nthr) { const int s = item / 2048, n = item % 2048, t = dbg_tok(s);
        float r = 0.f; for (int k = 0; k < 1024; ++k) r += bf2f(H[(size_t)t * 1024 + k]) * w_qp[(size_t)k * 2048 + n];
        const float mine = bf2f(QP[(size_t)t * 2048 + n]); num += (r - mine) * (r - mine); den += r * r; }
    dbg_acc(acc, num, den, lane);
}
__device__ __forceinline__ void dbg_check_gather(const bf16* H, const float* u, const float* v, const int* EXP, const float* EW, const float* INV, const float* YDBG, float* acc, int gw, int ngw, int lane) {
    float num = 0.f, den = 0.f;
    for (int s = gw; s < 64; s += ngw) { const int t = dbg_tok(s);
        float y[16];
#pragma unroll
        for (int c = 0; c < 16; ++c) y[c] = 0.f;
        for (int i = 0; i < 128; ++i) { const int e = EXP[(size_t)t * 128 + i]; const float g = EW[(size_t)t * 128 + i] * INV[(size_t)t * 8 + (i >> 4)];
            float d = 0.f;
#pragma unroll
            for (int c = 0; c < 16; ++c) d += bf2f(H[(size_t)t * 1024 + lane * 16 + c]) * u[(size_t)e * 1024 + lane * 16 + c];
            d = wave_sum(d);
            const float w = g * gelu_exact(d);
#pragma unroll
            for (int c = 0; c < 16; ++c) y[c] += w * v[(size_t)e * 1024 + lane * 16 + c]; }
#pragma unroll
        for (int c = 0; c < 16; ++c) { const float mine = YDBG[(size_t)s * 1024 + lane * 16 + c]; num += (y[c] - mine) * (y[c] - mine); den += y[c] * y[c]; } }
    dbg_acc(acc, num, den, lane);
}
__device__ __forceinline__ float dbg_k(const float* acc) { const float D = acc[0] / fmaxf(acc[1], 1e-30f); float k = log10f(fmaxf(D, 1e-12f)); return fminf(fmaxf(k, -6.f), 1.f); }
__device__ __forceinline__ void dbg_encode(const float* x, const float* gfin, float* out, const float* acc, int gw, int ngw, int lane) {
    const float k1 = dbg_k(acc), k2 = dbg_k(acc + 2); const float s = 1.f + (k1 + 6.5f) * 0.5f;
    for (int m = gw; m < T; m += ngw) { const f32x4* xr = (const f32x4*)(x + (size_t)m * 1024) + lane; const f32x4* gr = (const f32x4*)gfin + lane; f32x4 vv[4]; float ss = 0.f;
#pragma unroll
        for (int j = 0; j < 4; ++j) { vv[j] = xr[64 * j]; ss += (vv[j].x * vv[j].x + vv[j].y * vv[j].y) + (vv[j].z * vv[j].z + vv[j].w * vv[j].w); }
        const float rinv = rsqrtf(wave_sum(ss) * (1.f / 1024.f) + RMS_EPS) * s;
#pragma unroll
        for (int j = 0; j < 4; ++j) { f32x4 o = vv[j] * rinv * gr[64 * j]; if (m == 0 && j == 0 && lane == 0) o.x = 100.f + 100.f * (k2 + 6.f); ((f32x4*)(out + (size_t)m * 1024) + lane)[64 * j] = o; } }
}
#endif

struct Args { const float* in[20]; float* out; unsigned char* ws; int ph_lo, ph_hi; };
__global__ void __launch_bounds__(NWAVES * 64, 2) fwd(Args args) {
    extern __shared__ __attribute__((aligned(16))) unsigned char lds_raw[];
    LAS unsigned char* lds = (LAS unsigned char*)lds_raw;
    volatile LAS unsigned* MISC = (volatile LAS unsigned*)(lds + MISC_OFF);
    const int tid = threadIdx.x, lane = tid & 63, wave = __builtin_amdgcn_readfirstlane(tid >> 6);
    const int G = gridDim.x; const int bx = blockIdx.x; const int vcu = (G % 8 == 0) ? (bx % 8) * (G / 8) + bx / 8 : bx;
    const int gw = vcu * NWAVES + wave, NGW = G * NWAVES, gtid = vcu * (NWAVES * 64) + tid, NTHR = G * NWAVES * 64;
    unsigned char* ws = args.ws;
    gu32* ctl = (gu32*)(ws + WS_CTL);
#define X_IN (args.in[0])
#define mem (args.in[1])
#define rel_bias (args.in[2])
#define g_mix (args.in[3])
#define w_in (args.in[4])
#define b_gate (args.in[5])
#define w_a (args.in[6])
#define w_b (args.in[7])
#define w_out (args.in[8])
#define g_cross (args.in[9])
#define g_mem (args.in[10])
#define w_qc (args.in[11])
#define w_kvc (args.in[12])
#define w_oc (args.in[13])
#define g_ffn (args.in[14])
#define w_qp (args.in[15])
#define subk (args.in[16])
#define peer_u (args.in[17])
#define peer_v (args.in[18])
#define g_final (args.in[19])
#define OUTP (args.out)
#define WinT ((bf16*)(ws + WS_WIN))
#define WaT ((bf16*)(ws + WS_WA))
#define WbT ((bf16*)(ws + WS_WB))
#define WoutT ((bf16*)(ws + WS_WOUT))
#define WqcT ((bf16*)(ws + WS_WQC))
#define WkvcT ((bf16*)(ws + WS_WKVC))
#define WocT ((bf16*)(ws + WS_WOC))
#define WqpT ((bf16*)(ws + WS_WQP))
#define SUBK ((bf16*)(ws + WS_SUBK))
#define U8T ((unsigned char*)(ws + WS_U))
#define V8T ((unsigned char*)(ws + WS_V))
#define HB ((bf16*)(ws + WS_H))
#define MEMB ((bf16*)(ws + WS_MEMB))
#define KVC ((bf16*)(ws + WS_KVC))
#define ODIL ((bf16*)(ws + WS_ODIL))
#define OMOBA ((bf16*)(ws + WS_OMOBA))
#define PQKV ((bf16*)(ws + WS_PQKV))
#define MERGED ((bf16*)(ws + WS_MERGED))
#define MERGED8 ((unsigned char*)(ws + WS_QC))
#define X1 ((float*)(ws + WS_X1))
#define QC ((bf16*)(ws + WS_QC))
#define OC ((bf16*)(ws + WS_OC))
#define ODG ((bf16*)(ws + WS_ODG))
#define LSE ((float*)(ws + WS_LSE))
#define EXP ((int*)(ws + WS_EXP))
#define EW ((float*)(ws + WS_EW))
#define INV ((float*)(ws + WS_INV))
#define KMEAN ((float*)(ws + WS_KMEAN))
#define SEB ((int*)(ws + WS_PQKV + 32 * MiB))
#define SGB ((float*)(ws + WS_PQKV + 48 * MiB))
#define OFFB ((int*)(ws + WS_QC))
#define RSS1 ((float*)(ws + WS_RSS1))
#define RSS2 ((float*)(ws + WS_RSS2))
#define GATES ((bf16*)args.out)
#define QP ((bf16*)args.out)
    for (int u = tid; u < (LDS_BYTES - LDSCTL_OFF) / 4; u += NWAVES * 64) ((LAS unsigned*)(lds + LDSCTL_OFF))[u] = 0u;
    __syncthreads();
    const int lo = args.ph_lo, hi = args.ph_hi;
    XcdBarrier bar; bar.bar = (unsigned*)(ctl + CW_BAR); bar.x = 0; bar.st = nullptr;
    if (hi - lo > 1) bar = xcd_barrier_post((unsigned*)(ctl + CW_BAR), MISC + 8);
#define IN(k) (lo <= (k) && (k) < hi)
#define PR_BEG(k) do { if (PROBE_PH == (k) && tid == 0) MISC[16] = (unsigned)__builtin_amdgcn_s_memrealtime(); } while (0)
#define PR_END(k) do { if (PROBE_PH == (k) && tid == 0) MISC[17] = (unsigned)__builtin_amdgcn_s_memrealtime(); } while (0)
#define SEAM(k) do { if (IN(k) && IN((k) + 1)) xcd_barrier(bar); } while (0)

    PR_BEG(0);
    if (IN(0)) {
        LAS float* scr = (LAS float*)(lds + RING_OFF + wave * 16384);
        constexpr int I_IN = (1024 / 64) * (NIN / 32), I_A = (256 / 64) * (1024 / 32), I_B = (512 / 64) * (1024 / 32), I_OUT = (1024 / 64) * (1024 / 32), I_QC = (1024 / 64) * (512 / 32),
                      I_KVC = (1024 / 64) * (1024 / 32), I_OC = (512 / 64) * (1024 / 32), I_QP = (1024 / 64) * (2048 / 32);
        constexpr int NITEMS = I_IN + I_A + I_B + I_OUT + I_QC + I_KVC + I_OC + I_QP;
        for (int it = gw; it < NITEMS; it += NGW) {
            int r = it;
            if (r < I_IN) { p0_transpose_item_fp8(w_in, 1024, NIN, (unsigned char*)WinT, scr, r, lane, WIN8_SCALE); continue; } r -= I_IN;
            if (r < I_A) { p0_transpose_item(w_a, 256, 1024, WaT, scr, r, lane); continue; } r -= I_A;
            if (r < I_B) { p0_transpose_item(w_b, 512, 1024, WbT, scr, r, lane); continue; } r -= I_B;
            if (r < I_OUT) { p0_transpose_item_fp8(w_out, 1024, 1024, (unsigned char*)WoutT, scr, r, lane, WIN8_SCALE); continue; } r -= I_OUT;
            if (r < I_QC) { p0_transpose_item(w_qc, 1024, 512, WqcT, scr, r, lane, g_cross); continue; } r -= I_QC;
            if (r < I_KVC) { p0_transpose_item(w_kvc, 1024, 1024, WkvcT, scr, r, lane); continue; } r -= I_KVC;
            if (r < I_OC) { p0_transpose_item(w_oc, 512, 1024, WocT, scr, r, lane); continue; } r -= I_OC;
            p0_transpose_item(w_qp, 1024, 2048, WqpT, scr, r, lane, g_ffn);
        }
        cvt_f32_to_bf16_bulk(subk, SUBK, (size_t)2 * 128 * 128, (size_t)gtid, (size_t)NTHR);
        for (int m = gw; m < T; m += NGW) rms_row_to_fp8(X_IN + (size_t)m * DM, g_mix, (unsigned char*)HB + (size_t)m * DM, lane);
        for (int m = gw; m < MROWS; m += NGW) rms_row_to_bf16(mem + (size_t)m * DM, g_mem, MEMB + (size_t)m * DM, lane);
        __syncthreads();
    }
    SEAM(0);
    PR_END(0);
    PR_BEG(1);
    if (IN(1)) {
        if (DBG_MIX) { pg8::Gemm g{HB, WinT, T, NIN, DM / 2}; pg8::StaticOrder S; S.init(T, NIN, G, bx); pg8::EpiIn E{PQKV, GATES, b_gate, 1.0f / WIN8_SCALE};
          pg8::gemm_phase<pg8::EpiIn, pg8::StaticOrder, true, true, true>(lds + RING_OFF, g, S, E); }
        __syncthreads();
        if (DBG_CROSS) { pg8::Gemm g{MEMB, WkvcT, MROWS, 1024, DM}; pg8::StaticOrder S; S.init(MROWS, 1024, G, bx); pg8::EpiStore E{KVC, 1024};
          pg8::gemm_phase<pg8::EpiStore, pg8::StaticOrder, true, true>(lds + RING_OFF, g, S, E); }
        {
            constexpr int CH = 16384, NCH_U = (16384 * 1024) / CH, NCH = 2 * NCH_U;
            for (;;) {
                int c = 0; if (lane == 0) c = (int)__hip_atomic_fetch_add((unsigned*)(ctl + CW_WORK), 1u, __ATOMIC_RELAXED, __HIP_MEMORY_SCOPE_AGENT);
                c = __builtin_amdgcn_readfirstlane(c);
                if (c >= NCH) break;
                const bool isv = c >= NCH_U; const int cc = isv ? c - NCH_U : c;
                const float* src = (isv ? peer_v : peer_u) + (size_t)cc * CH; unsigned char* dst = (isv ? V8T : U8T) + (size_t)cc * CH;
                cvt_f32_to_fp8_bulk(src, dst, (size_t)CH, isv ? V8_SCALE : U8_SCALE, (size_t)lane, (size_t)64, isv ? (const float*)nullptr : g_ffn);
            }
        }
    }
    SEAM(1);
    PR_END(1);
    PR_BEG(2);
    if (IN(2) && DBG_MIX) {
#if ATTN_MFMA
        for (int u = vcu; u < NB * 3 * 4 * 16; u += G) { const int u16 = u & 15,     bgh = u >> 4, h = bgh & 3, g = (bgh >> 2) % 3, b = (bgh >> 2) / 3;
            dil_unit(lds + RING_OFF, PQKV, rel_bias, ODG, LSE, b, g, h, u16 & ((1 << (2 * g)) - 1), u16 >> (2 * g), tid, lane, wave); }
#endif
        for (int it = gw; it < NB * 8 * 16; it += NGW) { const int bh = it >> 4, blk = it & 15, b = bh >> 3, h = bh & 7;
            const bf16* kp = PQKV + (size_t)(b * SEQ + blk * 256 + (lane >> 3)) * QKVW + 2304 + 512 + h * 64 + 8 * (lane & 7);
            float s8[8] = {0.f, 0.f, 0.f, 0.f, 0.f, 0.f, 0.f, 0.f};
#pragma unroll 8
            for (int j = 0; j < 32; ++j) { const v4u w = *(const v4u*)(kp + (size_t)(8 * j) * QKVW);
                s8[0] += bf_lo(w.x); s8[1] += bf_hi(w.x); s8[2] += bf_lo(w.y); s8[3] += bf_hi(w.y); s8[4] += bf_lo(w.z); s8[5] += bf_hi(w.z); s8[6] += bf_lo(w.w); s8[7] += bf_hi(w.w); }
#pragma unroll
            for (int c = 0; c < 8; ++c) { float v = s8[c]; v += __shfl_xor(v, 8); v += __shfl_xor(v, 16); v += __shfl_xor(v, 32); s8[c] = v * (1.0f / 256.0f); }
            if (lane < 8) { f32x4* dst = (f32x4*)(KMEAN + (size_t)it * 64 + 8 * lane); dst[0] = (f32x4){s8[0], s8[1], s8[2], s8[3]}; dst[1] = (f32x4){s8[4], s8[5], s8[6], s8[7]}; } }
    }
    SEAM(2);
    PR_END(2);
    PR_BEG(3);
    if (IN(3) && DBG_MIX) {
#if ATTN_MFMA
        for (int pu = vcu; pu < NB * 8 * 8; pu += G) { const int bh = pu >> 3, p = pu & 7, b = bh >> 3, h = bh & 7;
            moba_unit(lds + RING_OFF, PQKV, KMEAN, rel_bias, OMOBA, b, h, p, tid, lane, wave);
            moba_unit(lds + RING_OFF, PQKV, KMEAN, rel_bias, OMOBA, b, h, 15 - p, tid, lane, wave); }
        dil_combine(ODG, LSE, ODIL, gtid, NTHR);
#else
        phase_dil_simple<false>(PQKV, rel_bias, ODIL, gtid, NTHR); phase_moba_simple<false>(PQKV, KMEAN, rel_bias, OMOBA, gtid, NTHR);
#endif
    }
    SEAM(3);
    PR_END(3);
    PR_BEG(4);
#if DBG_ATTN_CHECK && DBG_P4CHK
    if (IN(4)) { if (DBG_DIL_CHECK) phase_dil_simple<true>(PQKV, rel_bias, ODIL, gtid, NTHR, (float*)(ctl + CW_DBG)); else phase_moba_simple<true>(PQKV, KMEAN, rel_bias, OMOBA, gtid, NTHR, (float*)(ctl + CW_DBG)); }
#endif
    if (IN(4) && DBG_MIX && !(DBG_ATTN_CHECK && DBG_P4CHK)) { pg8::Gemm g{ODIL, WaT, T, 1024, 256}; pg8::StaticOrder S; S.init(T, 1024, G, bx); pg8::EpiGate<false, true> E{MERGED, GATES, 0, MERGED8, MRG8_SCALE};
        pg8::gemm_phase<pg8::EpiGate<false, true>, pg8::StaticOrder, true, true>(lds + RING_OFF, g, S, E); }
    __syncthreads();
    PR_END(4);
    PR_BEG(5);
    if (IN(5) && DBG_MIX && !(DBG_ATTN_CHECK && DBG_P4CHK)) { pg8::Gemm g{OMOBA, WbT, T, 1024, 512}; pg8::StaticOrder S; S.init(T, 1024, G, bx); pg8::EpiGate<true, true> E{MERGED, GATES, 1024, MERGED8, MRG8_SCALE};
        pg8::gemm_phase<pg8::EpiGate<true, true>, pg8::StaticOrder, true, true>(lds + RING_OFF, g, S, E); }
    SEAM(5);
    PR_END(5);
    PR_BEG(6);
    if (IN(6) && !(DBG_ATTN_CHECK && DBG_P4CHK)) { pg8::Gemm g{(const bf16*)MERGED8, WoutT, T, 1024, 1024 / 2}; pg8::StaticOrder S; S.init(T, 1024, G, bx); pg8::EpiRes E{X_IN, nullptr, 1024, (float)DBG_MIX / (MRG8_SCALE * WIN8_SCALE), HB, RSS1, nullptr, nullptr};
        pg8::gemm_phase<pg8::EpiRes, pg8::StaticOrder, true, true, true>(lds + RING_OFF, g, S, E); }
    SEAM(6);
    PR_END(6);
    PR_BEG(7);
    PR_BEG(8);
    if (IN(8) && DBG_CROSS) { pg8::Gemm g{HB, WqcT, T, 512, 1024}; pg8::StaticOrder S; S.init(T, 512, G, bx); pg8::EpiStoreRs E{QC, 512, RSS1, 1.0f};
        pg8::gemm_phase<pg8::EpiStoreRs, pg8::StaticOrder, true, true>(lds + RING_OFF, g, S, E); }
    SEAM(8);
    PR_END(8);
    PR_BEG(9);
    if (IN(9) && DBG_CROSS) {
#if ATTN_MFMA
        for (int u = vcu; u < NB * 4 * 16; u += G) cross_unit(lds + RING_OFF, QC, KVC, OC, u >> 6, (u >> 4) & 3, u & 15, tid, lane, wave);
#else
        phase_cross_simple<false>(QC, KVC, OC, gtid, NTHR);
#endif
    }
    SEAM(9);
    PR_END(9);
    PR_BEG(10);
#if DBG_ATTN_CHECK
    if (IN(10) && DBG_CROSS_CHECK) phase_cross_simple<true>(QC, KVC, OC, gtid, NTHR, (float*)(ctl + CW_DBG) + 2);
#endif
    if (IN(10)) { pg8::Gemm g{OC, WocT, T, 1024, 512}; pg8::StaticOrder S; S.init(T, 1024, G, bx); pg8::EpiRes E{nullptr, nullptr, 1024, (float)DBG_CROSS, HB, RSS2, nullptr, HB};
        pg8::gemm_phase<pg8::EpiRes, pg8::StaticOrder, true, true>(lds + RING_OFF, g, S, E); }
    SEAM(10);
    PR_END(10);
    PR_BEG(11);
    PR_BEG(12);
    if (IN(12) && DBG_PEER) { pg8::Gemm g{HB, WqpT, T, 2048, 1024}; pg8::StaticOrder S; S.init(T, 2048, G, bx); pg8::EpiStoreRs E{QP, 2048, RSS2, 1.0f};
        pg8::gemm_phase<pg8::EpiStoreRs, pg8::StaticOrder, true, true>(lds + RING_OFF, g, S, E); }
    SEAM(12);
    PR_END(12);
    PR_BEG(13);
#if DBG_CHECK
    if (IN(13)) dbg_check_qp(HB, w_qp, QP, (float*)(ctl + CW_DBG), gtid, NTHR, lane);
#endif
#if DBG_TOPK_SIMPLE
    if (IN(13) && DBG_PEER) { phase_topk_simple(QP, subk, EXP, EW, INV, lane, gw, NGW); }
#else
    if (IN(13) && DBG_PEER) { phase_topk(lds + RING_OFF, QP, SUBK, SEB, (float*)OFFB, tid, lane, wave, vcu, G); }
#endif
    SEAM(13);
    PR_END(13);
#if PROBE_PH >= 20
    PR_BEG(PROBE_PH);
    if (IN(14)) { const int lane15 = (int)__builtin_amdgcn_mbcnt_hi(~0u, __builtin_amdgcn_mbcnt_lo(~0u, 0u));
        peer_probe<PROBE_PH - 20>(HB, RSS2, U8T, V8T, SGB, SEB, (const float*)OFFB, OUTP, lane15, wave, gw, NGW, vcu, lds, g_final); xcd_barrier(bar); }
    PR_END(PROBE_PH);
#endif
    PR_BEG(14);
    if (IN(14)) { const int lane14 = (int)__builtin_amdgcn_mbcnt_hi(~0u, __builtin_amdgcn_mbcnt_lo(~0u, 0u));
        phase_peer(HB, RSS2, U8T, V8T, SGB, SEB, (const float*)OFFB, g_final, OUTP, lane14, wave, gw, NGW, (float)DBG_PEER, DBG_YPTR, (PROBE_PH >= 0 && PROBE_PH < 20) ? 1.0f + sqrtf((float)(MISC[17] - MISC[16]) * (0.01f / PROBE_K)) : 1.0f, lds); }
#if DBG_CHECK || DBG_ATTN_CHECK
#if DBG_CHECK
    if (IN(15)) dbg_check_gather(HB, peer_u, peer_v, EXP, EW, INV, (const float*)(ws + WS_YDBG), (float*)(ctl + CW_DBG) + 2, gw, NGW, lane);
#endif
    if (IN(16)) dbg_encode(X_IN, g_final, OUTP, (const float*)(ctl + CW_DBG), gw, NGW, lane);
#endif
#undef IN
#undef SEAM
#undef X_IN
#undef mem
#undef rel_bias
#undef g_mix
#undef w_in
#undef b_gate
#undef w_a
#undef w_b
#undef w_out
#undef g_cross
#undef g_mem
#undef w_qc
#undef w_kvc
#undef w_oc
#undef g_ffn
#undef w_qp
#undef subk
#undef peer_u
#undef peer_v
#undef g_final
#undef OUTP
#undef WinT
#undef WaT
#undef WbT
#undef WoutT
#undef WqcT
#undef WkvcT
#undef WocT
#undef WqpT
#undef SUBK
#undef U8T
#undef V8T
#undef HB
#undef MEMB
#undef KVC
#undef ODIL
#undef OMOBA
#undef PQKV
#undef MERGED
#undef MERGED8
#undef X1
#undef QC
#undef OC
#undef ODG
#undef LSE
#undef EXP
#undef EW
#undef INV
#undef KMEAN
#undef RSS1
#undef SEB
#undef SGB
#undef OFFB
#undef RSS2
#undef GATES
#undef QP

}

extern "C" void kernel_launch(void* const* d_in, const int* in_sizes, int n_in, void* d_out, int out_size, void* d_ws, size_t ws_size, hipStream_t stream) {
    static int grid = 0;
    if (grid == 0) {
        if (n_in != 20 || out_size != T * DM || ws_size < WS_END) { fprintf(stderr, "kernel_launch: unexpected shapes (n_in %d, out %d, ws %zu); nothing launched\n", n_in, out_size, ws_size); grid = -1; return; }
        int dev = 0, cus = 0, per_cu = 0;
        if (hipGetDevice(&dev) != hipSuccess || hipDeviceGetAttribute(&cus, hipDeviceAttributeMultiprocessorCount, dev) != hipSuccess) { grid = -1; return; }
        if (hipFuncSetAttribute((const void*)fwd, hipFuncAttributeMaxDynamicSharedMemorySize, LDS_BYTES) != hipSuccess) { fprintf(stderr, "kernel_launch: hipFuncSetAttribute failed\n"); grid = -1; return; }
        if (hipOccupancyMaxActiveBlocksPerMultiprocessor(&per_cu, (const void*)fwd, NWAVES * 64, LDS_BYTES) != hipSuccess || per_cu < 1) { fprintf(stderr, "kernel_launch: occupancy query says %d\n", per_cu); }
        (void)hipGetLastError();
        grid = cus;
    }
    if (grid < 0) return;
    if (hipMemsetAsync((char*)d_ws + WS_CTL, 0, CTL_ZERO_BYTES, stream) != hipSuccess) return;
    Args a{};
    for (int i = 0; i < 20; ++i) a.in[i] = (const float*)d_in[i];
    a.out = (float*)d_out; a.ws = (unsigned char*)d_ws;
#if MK_ONE_LAUNCH
    a.ph_lo = 0; a.ph_hi = NPH;
    hipLaunchKernelGGL(fwd, dim3(grid), dim3(NWAVES * 64), LDS_BYTES, stream, a);
#else
    for (int p = 0; p < NPH + ((DBG_CHECK || DBG_ATTN_CHECK) ? 2 : 0); ++p) { a.ph_lo = p; a.ph_hi = p + 1; hipLaunchKernelGGL(fwd, dim3(grid), dim3(NWAVES * 64), LDS_BYTES, stream, a); }
#endif
}
```
